# Optimizing an MI355X kernel written in HIP

```python
import jax
import jax.numpy as jnp
from jax import lax
import numpy as np

D_MODEL = 1024
BATCH = 32
SEQ = 2048
DEPTH = 1

CTX_LEN = 256
GRID_W = 64
EPS = 1e-6

ML_WIDTH = D_MODEL // 2
ML_HEADS = 4
ML_HEAD_DIM = ML_WIDTH // ML_HEADS
ML_CHUNK = 128
GLA_WIDTH = D_MODEL - ML_WIDTH
GLA_HEADS = 4
GLA_DV = GLA_WIDTH // GLA_HEADS
GLA_KEY_WIDTH = GLA_WIDTH // 2
GLA_DK = GLA_KEY_WIDTH // GLA_HEADS
GLA_RANK = 16
GLA_TAU = 16.0
GLA_CHUNK = 64
CONV_W = 3
MIX_WIDTH = ML_WIDTH + GLA_WIDTH
PROJ_WIDTHS = (ML_WIDTH, ML_WIDTH, ML_WIDTH, ML_WIDTH, 4 * ML_HEADS,
               GLA_KEY_WIDTH, GLA_KEY_WIDTH, GLA_WIDTH, GLA_WIDTH, 2 * GLA_RANK)
P_TOTAL = sum(PROJ_WIDTHS)

PEER_HEADS = 8
PEER_NKEYS = 128
PEER_EXPERTS = PEER_NKEYS * PEER_NKEYS
PEER_TOPK = 16
PEER_QDIM = 256
PEER_BLOCK = 128

kernel_name = 'hymba_mlstm_gla_peer_dit_block'


def rms_norm(x, g):
    xf = x.astype(jnp.float32)
    y = xf * lax.rsqrt(jnp.mean(xf * xf, axis=-1, keepdims=True) + EPS)
    return y.astype(x.dtype) * g


def head_rms(h, g):
    y = h * lax.rsqrt(jnp.mean(h * h, axis=-1, keepdims=True) + EPS)
    return y.reshape(h.shape[:2] + (-1,)) * g


def short_conv(u, w, on_grid):
    bz, n, ch = u.shape
    if on_grid:
        rows = n // GRID_W
        u = u.reshape(bz * rows, GRID_W, ch)
    y = lax.conv_general_dilated(u, w[:, None, :].astype(u.dtype), (1,),
                                 [(CONV_W // 2, CONV_W // 2)],
                                 dimension_numbers=('NWC', 'WIO', 'NWC'),
                                 feature_group_count=ch)
    return y.reshape(bz, n, ch)


def to_chunks(t, size):
    bz, n, hh = t.shape[:3]
    t = t.reshape((bz, n // size, size, hh) + t.shape[3:])
    return jnp.moveaxis(t, 3, 1)


def from_chunks(t):
    bz, hh, nc, ll, d = t.shape
    return jnp.moveaxis(t, 1, 3).reshape(bz, nc * ll, hh, d)


def orient(t, direction):
    return jnp.flip(t, axis=1) if direction == 1 else t


def prep_mixers(z, conv_w, gate_b, lr_w2, alpha_b, on_grid):
    bz, n, _ = z.shape
    f32 = jnp.float32
    mq, mk, mv, mo, mg, gq, gk, gv, gr, glr = jnp.split(
        z, np.cumsum(PROJ_WIDTHS)[:-1].tolist(), axis=-1)
    mq, mk = jnp.split(jax.nn.silu(short_conv(jnp.concatenate([mq, mk], axis=-1), conv_w, on_grid)),
                       2, axis=-1)
    gates = (mg + gate_b).astype(f32).reshape(bz, n, 2, 2, ML_HEADS)
    alpha = jnp.einsum('bndr,drk->bndk', glr.reshape(bz, n, 2, GLA_RANK), lr_w2) + alpha_b
    return {
        'ml_q': mq.astype(f32).reshape(bz, n, ML_HEADS, ML_HEAD_DIM),
        'ml_k': (mk.astype(f32) * ML_HEAD_DIM ** -0.5).reshape(bz, n, ML_HEADS, ML_HEAD_DIM),
        'ml_v': mv.astype(f32).reshape(bz, n, ML_HEADS, ML_HEAD_DIM),
        'ml_o': mo,
        'ml_ig': gates[:, :, :, 0],
        'ml_lf': jax.nn.log_sigmoid(gates[:, :, :, 1]),
        'gla_q': (gq.astype(f32) * GLA_DK ** -0.5).reshape(bz, n, GLA_HEADS, GLA_DK),
        'gla_k': gk.astype(f32).reshape(bz, n, GLA_HEADS, GLA_DK),
        'gla_v': gv.astype(f32).reshape(bz, n, GLA_HEADS, GLA_DV),
        'gla_r': gr,
        'gla_la': (jax.nn.log_sigmoid(alpha.astype(f32)) / GLA_TAU).reshape(
            bz, n, 2, GLA_HEADS, GLA_DK),
    }


def mlstm_states(k, v, logf, ig, init):
    b = jnp.cumsum(logf, axis=-1)
    b_end = b[..., -1]
    w_log = b_end[..., None] - b + ig
    m_loc = jnp.max(w_log, axis=-1)
    w = jnp.exp(w_log - m_loc[..., None])
    c_loc = jnp.einsum('bhcld,bhcle->bhcde', w[..., None] * v, k)
    n_loc = jnp.einsum('bhcl,bhcle->bhce', w, k)

    def step(carry, inp):
        cm, nv, m = carry
        be, ml, cl, nl = inp
        m_new = jnp.maximum(be + m, ml)
        a = jnp.exp(be + m - m_new)
        bb = jnp.exp(ml - m_new)
        c_new = a[..., None, None] * cm + bb[..., None, None] * cl
        n_new = a[..., None] * nv + bb[..., None] * nl
        return (c_new, n_new, m_new), (cm, nv, m)

    xs = tuple(jnp.moveaxis(t, 2, 0) for t in (b_end, m_loc, c_loc, n_loc))
    final, starts = lax.scan(step, init, xs)
    starts = tuple(jnp.moveaxis(t, 0, 2) for t in starts)
    return starts, final


def mlstm_outputs(q, k, v, logf, ig, starts):
    c_s, n_s, m_s = starts
    ll = q.shape[-2]
    tri = jnp.tril(jnp.ones((ll, ll), dtype=bool))
    b = jnp.cumsum(logf, axis=-1)
    d_log = jnp.where(tri, b[..., :, None] - b[..., None, :] + ig[..., None, :], -jnp.inf)
    inter_log = b + m_s[..., None]
    m_t = jnp.maximum(inter_log, jnp.max(d_log, axis=-1))
    scores = jnp.einsum('bhctd,bhcsd->bhcts', q, k) * jnp.exp(d_log - m_t[..., None])
    inter = jnp.exp(inter_log - m_t)
    num = (jnp.einsum('bhcts,bhcsd->bhctd', scores, v)
           + inter[..., None] * jnp.einsum('bhcde,bhcte->bhctd', c_s, q))
    den = scores.sum(-1) + inter * jnp.einsum('bhce,bhcte->bhct', n_s, q)
    return num / jnp.maximum(jnp.abs(den), jnp.exp(-m_t))[..., None]


def mlstm_direction(lat, ctx, with_ctx_out):
    q, k, v, lf, ig = lat
    qc, kc, vc, lfc, igc = ctx
    bz, hh, _, _, d = q.shape
    init = (jnp.zeros((bz, hh, d, d), jnp.float32), jnp.zeros((bz, hh, d), jnp.float32),
            jnp.zeros((bz, hh), jnp.float32))
    ctx_starts, ctx_final = mlstm_states(kc, vc, lfc, igc, init)
    lat_starts, _ = mlstm_states(k, v, lf, ig, ctx_final)
    h = mlstm_outputs(q, k, v, lf, ig, lat_starts)
    hc = mlstm_outputs(qc, kc, vc, lfc, igc, ctx_starts) if with_ctx_out else None
    return h, hc


def gla_states(k, v, loga, init):
    b = jnp.cumsum(loga, axis=-2)
    b_end = b[..., -1, :]
    s_loc = jnp.einsum('bhcld,bhcle->bhcde', k * jnp.exp(b_end[..., None, :] - b), v)

    def step(s, inp):
        be, sl = inp
        return jnp.exp(be)[..., None] * s + sl, s

    final, starts = lax.scan(step, init, (jnp.moveaxis(b_end, 2, 0), jnp.moveaxis(s_loc, 2, 0)))
    return jnp.moveaxis(starts, 0, 2), final


def gla_outputs(q, k, v, loga, s_start):
    ll = q.shape[-2]
    tri = jnp.tril(jnp.ones((ll, ll), dtype=bool))
    b = jnp.cumsum(loga, axis=-2)
    ref = b[..., ll // 2, :][..., None, :]
    att = jnp.einsum('bhctd,bhcsd->bhcts', q * jnp.exp(b - ref), k * jnp.exp(ref - b))
    att = jnp.where(tri, att, 0.0)
    return (jnp.einsum('bhcts,bhcse->bhcte', att, v)
            + jnp.einsum('bhctd,bhcde->bhcte', q * jnp.exp(b), s_start))


def gla_direction(lat, ctx, with_ctx_out):
    q, k, v, la = lat
    qc, kc, vc, lac = ctx
    bz, hh = q.shape[:2]
    init = jnp.zeros((bz, hh, GLA_DK, GLA_DV), jnp.float32)
    ctx_starts, ctx_final = gla_states(kc, vc, lac, init)
    lat_starts, _ = gla_states(k, v, la, ctx_final)
    h = gla_outputs(q, k, v, la, lat_starts)
    hc = gla_outputs(qc, kc, vc, lac, ctx_starts) if with_ctx_out else None
    return h, hc


def ml_inputs(p, d):
    return [to_chunks(orient(t, d), ML_CHUNK)
            for t in (p['ml_q'], p['ml_k'], p['ml_v'], p['ml_lf'][:, :, d], p['ml_ig'][:, :, d])]


def gla_inputs(p, d):
    return [to_chunks(orient(t, d), GLA_CHUNK)
            for t in (p['gla_q'], p['gla_k'], p['gla_v'], p['gla_la'][:, :, d])]


def mix_out(ml_h, ml_o, gla_h, gla_r, ml_g, gla_g, w_out, dtype):
    ml = jax.nn.sigmoid(ml_o) * head_rms(ml_h, ml_g)
    gl = jax.nn.silu(gla_r) * head_rms(gla_h, gla_g)
    return (jnp.concatenate([ml, gl], axis=-1) @ w_out).astype(dtype)


def token_mixer(h_lat, h_ctx, w_in, conv_w, gate_b, lr_w2, alpha_b, ml_g, gla_g, w_out,
                with_ctx_out):
    lat = prep_mixers(h_lat @ w_in, conv_w, gate_b, lr_w2, alpha_b, True)
    ctx = prep_mixers(h_ctx @ w_in, conv_w, gate_b, lr_w2, alpha_b, False)
    ml_lat, ml_ctx, gla_lat, gla_ctx = [], [], [], []
    for d in range(2):
        h, hc = mlstm_direction(ml_inputs(lat, d), ml_inputs(ctx, d), with_ctx_out)
        ml_lat.append(orient(from_chunks(h), d))
        g, gc = gla_direction(gla_inputs(lat, d), gla_inputs(ctx, d), with_ctx_out)
        gla_lat.append(orient(from_chunks(g), d))
        if with_ctx_out:
            ml_ctx.append(orient(from_chunks(hc), d))
            gla_ctx.append(orient(from_chunks(gc), d))
    y = mix_out(ml_lat[0] + ml_lat[1], lat['ml_o'], gla_lat[0] + gla_lat[1], lat['gla_r'],
                ml_g, gla_g, w_out, h_lat.dtype)
    yc = None
    if with_ctx_out:
        yc = mix_out(ml_ctx[0] + ml_ctx[1], ctx['ml_o'], gla_ctx[0] + gla_ctx[1], ctx['gla_r'],
                     ml_g, gla_g, w_out, h_ctx.dtype)
    return y, yc


def peer_ffn(h, wq, keys, u_tab, v_tab):
    bz, n, d = h.shape
    blocks = h.reshape(bz * n // PEER_BLOCK, PEER_BLOCK, d)

    def retrieve(xb):
        q = (xb @ wq).reshape(PEER_BLOCK, PEER_HEADS, 2, PEER_QDIM // 2)
        s = jnp.einsum('tphq,phkq->tphk', q, keys)
        top_s, top_i = lax.top_k(s, PEER_TOPK)
        cand = top_s[:, :, 0, :, None] + top_s[:, :, 1, None, :]
        best_s, best_c = lax.top_k(cand.reshape(PEER_BLOCK, PEER_HEADS, PEER_TOPK * PEER_TOPK),
                                   PEER_TOPK)
        i1 = jnp.take_along_axis(top_i[:, :, 0], best_c // PEER_TOPK, axis=-1)
        i2 = jnp.take_along_axis(top_i[:, :, 1], best_c % PEER_TOPK, axis=-1)
        idx = i1 * PEER_NKEYS + i2
        g = jax.nn.softmax(best_s.astype(jnp.float32), axis=-1).astype(xb.dtype)
        act = jax.nn.gelu(jnp.einsum('tpkd,td->tpk', u_tab[idx], xb), approximate=False)
        return jnp.einsum('tpk,tpkd->td', g * act, v_tab[idx])

    return lax.map(retrieve, blocks).reshape(bz, n, d)


def setup_inputs(seed: int = 0) -> dict:
    key = jax.random.key(seed)
    ks = jax.random.split(key, 24)

    def nrm(k, shape, scale):
        return jax.random.normal(k, shape, jnp.float32) * scale

    f_bias = jnp.linspace(3.0, 6.0, ML_HEADS, dtype=jnp.float32)
    i_part = nrm(ks[8], (DEPTH, 2, 1, ML_HEADS), 0.1)
    f_part = f_bias + nrm(ks[9], (DEPTH, 2, 1, ML_HEADS), 0.1)
    ml_gate_b = jnp.concatenate([i_part, f_part], axis=2).reshape(DEPTH, 4 * ML_HEADS)
    return {
        'x': nrm(ks[0], (BATCH, SEQ, D_MODEL), 1.0),
        'c': nrm(ks[1], (BATCH, D_MODEL), 1.0),
        'ctx': nrm(ks[2], (BATCH, CTX_LEN, D_MODEL), 1.0),
        'c_ctx': nrm(ks[3], (D_MODEL,), 1.0),
        'w_mod': nrm(ks[4], (DEPTH, D_MODEL, 6 * D_MODEL), 0.5 * D_MODEL ** -0.5),
        'b_mod': nrm(ks[5], (DEPTH, 6 * D_MODEL), 0.02),
        'norm1_g': 1.0 + nrm(ks[6], (DEPTH, D_MODEL), 0.02),
        'w_in': nrm(ks[7], (DEPTH, D_MODEL, P_TOTAL), D_MODEL ** -0.5),
        'ml_conv_w': nrm(ks[10], (DEPTH, CONV_W, 2 * ML_WIDTH), CONV_W ** -0.5),
        'ml_gate_b': ml_gate_b,
        'ml_norm_g': 1.0 + nrm(ks[11], (DEPTH, ML_WIDTH), 0.02),
        'gla_lr_w2': nrm(ks[12], (DEPTH, 2, GLA_RANK, GLA_KEY_WIDTH), GLA_RANK ** -0.5),
        'gla_alpha_b': nrm(ks[13], (DEPTH, 2, GLA_KEY_WIDTH), 0.1),
        'gla_norm_g': 1.0 + nrm(ks[14], (DEPTH, GLA_WIDTH), 0.02),
        'w_out': nrm(ks[15], (DEPTH, MIX_WIDTH, D_MODEL), MIX_WIDTH ** -0.5),
        'norm2_g': 1.0 + nrm(ks[16], (DEPTH, D_MODEL), 0.02),
        'peer_wq': nrm(ks[17], (DEPTH, D_MODEL, PEER_HEADS * PEER_QDIM), D_MODEL ** -0.5),
        'peer_keys': nrm(ks[18], (DEPTH, PEER_HEADS, 2, PEER_NKEYS, PEER_QDIM // 2),
                         (PEER_QDIM // 2) ** -0.5),
        'peer_u': nrm(ks[19], (DEPTH, PEER_EXPERTS, D_MODEL), D_MODEL ** -0.5),
        'peer_v': nrm(ks[20], (DEPTH, PEER_EXPERTS, D_MODEL), PEER_HEADS ** -0.5),
        'norm_f_g': 1.0 + nrm(ks[21], (D_MODEL,), 0.02),
    }


def reference(x, c, ctx, c_ctx, w_mod, b_mod, norm1_g, w_in, ml_conv_w, ml_gate_b, ml_norm_g,
              gla_lr_w2, gla_alpha_b, gla_norm_g, w_out, norm2_g, peer_wq, peer_keys, peer_u,
              peer_v, norm_f_g):
    cond = jax.nn.silu(c)
    cond_ctx = jax.nn.silu(c_ctx)
    for layer in range(DEPTH):
        update_ctx = layer + 1 < DEPTH
        mod = (cond @ w_mod[layer] + b_mod[layer])[:, None, :]
        mod_c = cond_ctx @ w_mod[layer] + b_mod[layer]
        sh1, sc1, g1, sh2, sc2, g2 = jnp.split(mod, 6, axis=-1)
        csh1, csc1, cg1, csh2, csc2, cg2 = jnp.split(mod_c, 6, axis=-1)

        h = rms_norm(x, norm1_g[layer]) * (1.0 + sc1) + sh1
        hc = rms_norm(ctx, norm1_g[layer]) * (1.0 + csc1) + csh1
        y, yc = token_mixer(h, hc, w_in[layer], ml_conv_w[layer], ml_gate_b[layer],
                            gla_lr_w2[layer], gla_alpha_b[layer], ml_norm_g[layer],
                            gla_norm_g[layer], w_out[layer], update_ctx)
        x = x + g1 * y
        h2 = rms_norm(x, norm2_g[layer]) * (1.0 + sc2) + sh2
        x = x + g2 * peer_ffn(h2, peer_wq[layer], peer_keys[layer], peer_u[layer], peer_v[layer])

        if update_ctx:
            ctx = ctx + cg1 * yc
            hc2 = rms_norm(ctx, norm2_g[layer]) * (1.0 + csc2) + csh2
            ctx = ctx + cg2 * peer_ffn(hc2, peer_wq[layer], peer_keys[layer], peer_u[layer],
                                       peer_v[layer])
    return rms_norm(x, norm_f_g)
```

```cpp
#include <hip/hip_runtime.h>
#include <hip/hip_cooperative_groups.h>
#include <cstdio>
#include <cstdint>
namespace cg = cooperative_groups;

#ifndef FUSED
#define FUSED 0
#endif

typedef unsigned short bf16_t;
typedef short bf16x8 __attribute__((ext_vector_type(8)));
typedef float f32x4 __attribute__((ext_vector_type(4)));
typedef unsigned u32x4 __attribute__((ext_vector_type(4)));

constexpr int D = 1024, NB = 32, SEQ = 2048, CTX = 256;
constexpr int TL = NB * SEQ;
constexpr int TC = NB * CTX;
constexpr int TT = TL + TC;
constexpr int PT = 3632;
constexpr int PTP = 3840;
constexpr int ZS = 3632;
constexpr int C_MLQ = 0, C_MLK = 512, C_MLV = 1024, C_MLO = 1536, C_MLG = 2048, C_GQ = 2064, C_GK = 2320, C_GV = 2576, C_GR = 3088, C_LR = 3600;
constexpr int NT = 256;
constexpr int SMEM_BYTES = 80 * 1024;
constexpr float EPS = 1e-6f;

struct Params {
    const float *x, *c, *ctx, *c_ctx, *w_mod, *b_mod, *norm1_g, *w_in, *conv_w, *gate_b, *ml_norm_g, *lr_w2, *alpha_b, *gla_norm_g,
        *w_out, *norm2_g, *wq, *keys, *pu, *pv, *norm_f_g;
    float* out;
    float* mod;
    bf16_t* winT;
    bf16_t* woutT;
    bf16_t* wqT;
    bf16_t* keysb;
    bf16_t* ub;
    bf16_t* vb;
    bf16_t* hbuf;
    bf16_t* z;
    float* zg;
    bf16_t* mixh;
    bf16_t* qbuf;
    int* pidx;
    float* pgw;
};

__device__ __forceinline__ float bf2f(bf16_t v) { return __uint_as_float(((unsigned)v) << 16); }
__device__ __forceinline__ bf16_t f2bf(float f) { unsigned u = __float_as_uint(f); u += 0x7fffu + ((u >> 16) & 1u); return (bf16_t)(u >> 16); }
__device__ __forceinline__ unsigned pack2(float a, float b) { return (unsigned)f2bf(a) | ((unsigned)f2bf(b) << 16); }
__device__ __forceinline__ float lo2f(unsigned w) { return __uint_as_float(w << 16); }
__device__ __forceinline__ float hi2f(unsigned w) { return __uint_as_float(w & 0xffff0000u); }
__device__ __forceinline__ float wave_sum(float v) {
#pragma unroll
    for (int o = 32; o > 0; o >>= 1) v += __shfl_xor(v, o);
    return v;
}
__device__ __forceinline__ float wave_max(float v) {
#pragma unroll
    for (int o = 32; o > 0; o >>= 1) v = fmaxf(v, __shfl_xor(v, o));
    return v;
}
__device__ __forceinline__ float logsig(float x) { return fminf(x, 0.f) - log1pf(__expf(-fabsf(x))); }
__device__ __forceinline__ float silu(float x) { return x / (1.f + __expf(-x)); }
__device__ __forceinline__ float sigm(float x) { return 1.f / (1.f + __expf(-x)); }

__device__ void phase_mod(const Params& p, char* smem, int bid, int nblk) {
    float* condL = (float*)smem;
    const int tid = threadIdx.x, cl = tid & 63, ks = tid >> 6;
    for (int item = bid; item < 96; item += nblk) {
        const int col0 = item * 64, col = col0 + cl;
        float acc[33];
#pragma unroll
        for (int b = 0; b < 33; ++b) acc[b] = 0.f;
        for (int kc = 0; kc < 4; ++kc) {
            __syncthreads();
            for (int e = tid; e < 4 * 64 * 33; e += NT) {
                const int s = e / (64 * 33), kk = (e / 33) % 64, b = e % 33;
                const int k = s * 256 + kc * 64 + kk;
                const float cv = b < 32 ? p.c[b * 1024 + k] : p.c_ctx[k];
                condL[e] = silu(cv);
            }
            __syncthreads();
            for (int kk = 0; kk < 64; ++kk) {
                const int k = ks * 256 + kc * 64 + kk;
                const float w = p.w_mod[(size_t)k * 6144 + col];
                const float* cp = condL + (ks * 64 + kk) * 33;
#pragma unroll
                for (int b = 0; b < 33; ++b) acc[b] += w * cp[b];
            }
        }
        __syncthreads();
#pragma unroll
        for (int b = 0; b < 33; ++b) condL[(ks * 33 + b) * 64 + cl] = acc[b];
        __syncthreads();
        for (int e = tid; e < 33 * 64; e += NT) {
            const int b = e >> 6, cc = e & 63;
            float v = condL[(0 * 33 + b) * 64 + cc] + condL[(1 * 33 + b) * 64 + cc] + condL[(2 * 33 + b) * 64 + cc] + condL[(3 * 33 + b) * 64 + cc];
            p.mod[b * 6144 + col0 + cc] = v + p.b_mod[col0 + cc];
        }
        __syncthreads();
    }
}

__device__ void convT(const float* __restrict__ src, int K, int N, int Npad, bf16_t* __restrict__ dst, char* smem, int bid, int nblk) {
    float* tile = (float*)smem;
    const int tid = threadIdx.x;
    const int nk = K / 64, nn = Npad / 64;
    for (int t = bid; t < nk * nn; t += nblk) {
        const int k0 = (t % nk) * 64, n0 = (t / nk) * 64;
        __syncthreads();
#pragma unroll
        for (int r = 0; r < 16; ++r) {
            const int k = r * 4 + (tid >> 6), n = tid & 63;
            tile[k * 65 + n] = (n0 + n < N) ? src[(size_t)(k0 + k) * N + n0 + n] : 0.f;
        }
        __syncthreads();
#pragma unroll
        for (int r = 0; r < 16; ++r) {
            const int n = r * 4 + (tid >> 6), k = tid & 63;
            dst[(size_t)(n0 + n) * K + k0 + k] = f2bf(tile[k * 65 + n]);
        }
    }
    __syncthreads();
}
__device__ void conv_copy(const float* __restrict__ src, bf16_t* __restrict__ dst, size_t n, int gtid, int gthreads) {
    const size_t n4 = n / 4;
    for (size_t i = gtid; i < n4; i += gthreads) {
        const float4 v = ((const float4*)src)[i];
        uint2 o; o.x = pack2(v.x, v.y); o.y = pack2(v.z, v.w);
        ((uint2*)dst)[i] = o;
    }
}
__device__ void phase_convert(const Params& p, char* smem, int bid, int nblk) {
    convT(p.w_in, 1024, PT, PTP, p.winT, smem, bid, nblk);
    convT(p.w_out, 1024, 1024, 1024, p.woutT, smem, bid, nblk);
    convT(p.wq, 1024, 2048, 2048, p.wqT, smem, bid, nblk);
    const int gtid = bid * NT + threadIdx.x, gth = nblk * NT;
    conv_copy(p.keys, p.keysb, (size_t)8 * 2 * 128 * 128, gtid, gth);
    conv_copy(p.pu, p.ub, (size_t)16384 * 1024, gtid, gth);
    conv_copy(p.pv, p.vb, (size_t)16384 * 1024, gtid, gth);
}

__device__ void phase_norm1(const Params& p, int bid, int nblk) {
    const int lane = threadIdx.x & 63;
    const int gw = bid * (NT / 64) + (threadIdx.x >> 6), nw = nblk * (NT / 64);
    for (int row = gw; row < TT; row += nw) {
        const float* src = row < TL ? p.x + (size_t)row * D : p.ctx + (size_t)(row - TL) * D;
        const float* md = p.mod + (row < TL ? (row >> 11) : 32) * 6144;
        float4 v[4]; float ss = 0.f;
#pragma unroll
        for (int j = 0; j < 4; ++j) { v[j] = *(const float4*)(src + j * 256 + lane * 4); ss += v[j].x * v[j].x + v[j].y * v[j].y + v[j].z * v[j].z + v[j].w * v[j].w; }
        ss = wave_sum(ss);
        const float rstd = rsqrtf(ss * (1.f / 1024.f) + EPS);
#pragma unroll
        for (int j = 0; j < 4; ++j) {
            const int col = j * 256 + lane * 4;
            const float4 g = *(const float4*)(p.norm1_g + col), sc = *(const float4*)(md + 1024 + col), sh = *(const float4*)(md + col);
            uint2 o;
            o.x = pack2(v[j].x * rstd * g.x * (1.f + sc.x) + sh.x, v[j].y * rstd * g.y * (1.f + sc.y) + sh.y);
            o.y = pack2(v[j].z * rstd * g.z * (1.f + sc.z) + sh.z, v[j].w * rstd * g.w * (1.f + sc.w) + sh.w);
            *(uint2*)(p.hbuf + (size_t)row * D + col) = o;
        }
    }
}

template <class Epi>
__device__ void gemm_phase(const bf16_t* __restrict__ A, const bf16_t* __restrict__ Bt, int M, int N, int K, const Epi& epi, char* smem, int bid, int nblk) {
    constexpr int BM = 128, BN = 128, BK = 64, LS = 72;
    bf16_t* sA = (bf16_t*)smem;
    bf16_t* sB = sA + BM * LS;
    const int tid = threadIdx.x, lane = tid & 63, w = tid >> 6, wr = w >> 1, wc = w & 1;
    const int nN = N / BN, ntiles = (M / BM) * nN;
    const int lr = tid >> 3, lc = (tid & 7) * 8;
    for (int tile = bid; tile < ntiles; tile += nblk) {
        const int tm = tile / nN, tn = tile % nN;
        const bf16_t* Ag = A + (size_t)(tm * BM) * K;
        const bf16_t* Bg = Bt + (size_t)(tn * BN) * K;
        f32x4 acc[4][4];
#pragma unroll
        for (int i = 0; i < 4; ++i)
#pragma unroll
            for (int j = 0; j < 4; ++j) acc[i][j] = (f32x4){0.f, 0.f, 0.f, 0.f};
        u32x4 ra[4], rb[4];
#pragma unroll
        for (int i = 0; i < 4; ++i) {
            ra[i] = *(const u32x4*)(Ag + (size_t)(lr + 32 * i) * K + lc);
            rb[i] = *(const u32x4*)(Bg + (size_t)(lr + 32 * i) * K + lc);
        }
        for (int k0 = 0; k0 < K; k0 += BK) {
            __syncthreads();
#pragma unroll
            for (int i = 0; i < 4; ++i) {
                *(u32x4*)(sA + (lr + 32 * i) * LS + lc) = ra[i];
                *(u32x4*)(sB + (lr + 32 * i) * LS + lc) = rb[i];
            }
            __syncthreads();
            {
                const int kn = (k0 + BK < K) ? k0 + BK : k0;
#pragma unroll
                for (int i = 0; i < 4; ++i) {
                    ra[i] = *(const u32x4*)(Ag + (size_t)(lr + 32 * i) * K + kn + lc);
                    rb[i] = *(const u32x4*)(Bg + (size_t)(lr + 32 * i) * K + kn + lc);
                }
            }
#pragma unroll
            for (int kk = 0; kk < 2; ++kk) {
                bf16x8 af[4], bfr[4];
#pragma unroll
                for (int i = 0; i < 4; ++i) {
                    af[i] = *(const bf16x8*)(sA + (wr * 64 + i * 16 + (lane & 15)) * LS + kk * 32 + (lane >> 4) * 8);
                    bfr[i] = *(const bf16x8*)(sB + (wc * 64 + i * 16 + (lane & 15)) * LS + kk * 32 + (lane >> 4) * 8);
                }
#pragma unroll
                for (int i = 0; i < 4; ++i)
#pragma unroll
                    for (int j = 0; j < 4; ++j) acc[i][j] = __builtin_amdgcn_mfma_f32_16x16x32_bf16(af[i], bfr[j], acc[i][j], 0, 0, 0);
            }
        }
#pragma unroll
        for (int i = 0; i < 4; ++i)
#pragma unroll
            for (int j = 0; j < 4; ++j)
#pragma unroll
                for (int r = 0; r < 4; ++r) {
                    const int row = tm * BM + wr * 64 + i * 16 + (lane >> 4) * 4 + r;
                    const int col = tn * BN + wc * 64 + j * 16 + (lane & 15);
                    epi(row, col, acc[i][j][r]);
                }
    }
    __syncthreads();
}

struct EpiInProj {
    bf16_t* z; float* zg; const float* gate_b;
    __device__ __forceinline__ void operator()(int row, int col, float v) const {
        if (col < C_MLG) z[(size_t)row * ZS + col] = f2bf(v);
        else if (col < C_GQ) zg[(size_t)row * 48 + (col - C_MLG)] = v + gate_b[col - C_MLG];
        else if (col < C_LR) z[(size_t)row * ZS + col] = f2bf(v);
        else if (col < PT) zg[(size_t)row * 48 + 16 + (col - C_LR)] = v;
    }
};
struct EpiOutProj {
    const float* x; const float* mod; float* out;
    __device__ __forceinline__ void operator()(int row, int col, float v) const {
        const size_t o = (size_t)row * D + col;
        out[o] = x[o] + mod[(row >> 11) * 6144 + 2048 + col] * v;
    }
};
struct EpiQ {
    bf16_t* q;
    __device__ __forceinline__ void operator()(int row, int col, float v) const { q[(size_t)row * 2048 + col] = f2bf(v); }
};

__device__ void phase_mixers(const Params& p, char* smem, int bid, int nblk) {
    float* L = (float*)smem;
    const int stid = threadIdx.x, lane = stid & 63;
    for (int item = bid; item < 512; item += nblk) {
        const bool isml = item < 256;
        const int it = item & 255, b = it >> 3, h = (it >> 1) & 3, dir = it & 1;
        if (isml) {
            float* qs = L; float* ks = L + 4096; float* vs = L + 8192; float* numb = L + 12288;
            float* igs = L + 16384; float* lfs = L + 16416; float* denp = L + 16448; float* mb = L + 16512;
            float C[64];
#pragma unroll
            for (int e = 0; e < 64; ++e) C[e] = 0.f;
            float nreg = 0.f, m = 0.f;
            const int d = stid >> 1, e0 = (stid & 1) * 64;
            for (int bt = 0; bt < 72; ++bt) {
                const bool lat = bt >= 8;
                const int pos0 = lat ? (bt - 8) * 32 : bt * 32;
                const int seg = lat ? SEQ : CTX;
                const int nlo = dir ? seg - 32 - pos0 : pos0;
                const int rowbase = lat ? b * SEQ : TL + b * CTX;
#pragma unroll
                for (int r = 0; r < 4; ++r) {
                    const int wi = stid + 256 * r, which = wi >> 9, i = (wi >> 4) & 31, ch = (wi & 15) * 8;
                    if (which == 0 && !lat) continue;
                    const int n = dir ? nlo + 31 - i : nlo + i;
                    const int col = which * 512 + h * 128 + ch;
                    const bool vl = lat ? (((n - 1) >> 6) == (n >> 6)) : (n - 1 >= 0);
                    const bool vr = lat ? (((n + 1) >> 6) == (n >> 6)) : (n + 1 < CTX);
                    const bf16_t* zc = p.z + (size_t)(rowbase + n) * ZS + col;
                    const uint4 cc = *(const uint4*)zc;
                    uint4 ll = make_uint4(0, 0, 0, 0), rr = make_uint4(0, 0, 0, 0);
                    if (vl) ll = *(const uint4*)(zc - ZS);
                    if (vr) rr = *(const uint4*)(zc + ZS);
                    const unsigned cw[4] = {cc.x, cc.y, cc.z, cc.w}, lw[4] = {ll.x, ll.y, ll.z, ll.w}, rw[4] = {rr.x, rr.y, rr.z, rr.w};
                    float* dst = (which ? ks : qs) + i * 128 + ch;
                    const float scl = which ? 0.08838834764831845f : 1.f;
#pragma unroll
                    for (int j = 0; j < 4; ++j) {
                        const int c0 = col + 2 * j;
                        const float y0 = p.conv_w[c0] * lo2f(lw[j]) + p.conv_w[1024 + c0] * lo2f(cw[j]) + p.conv_w[2048 + c0] * lo2f(rw[j]);
                        const float y1 = p.conv_w[c0 + 1] * hi2f(lw[j]) + p.conv_w[1024 + c0 + 1] * hi2f(cw[j]) + p.conv_w[2048 + c0 + 1] * hi2f(rw[j]);
                        dst[2 * j] = silu(y0) * scl; dst[2 * j + 1] = silu(y1) * scl;
                    }
                }
#pragma unroll
                for (int r = 0; r < 2; ++r) {
                    const int wi = stid + 256 * r, i = wi >> 4, ch = (wi & 15) * 8;
                    const int n = dir ? nlo + 31 - i : nlo + i;
                    const uint4 cc = *(const uint4*)(p.z + (size_t)(rowbase + n) * ZS + C_MLV + h * 128 + ch);
                    float* dst = vs + i * 128 + ch;
                    dst[0] = lo2f(cc.x); dst[1] = hi2f(cc.x); dst[2] = lo2f(cc.y); dst[3] = hi2f(cc.y);
                    dst[4] = lo2f(cc.z); dst[5] = hi2f(cc.z); dst[6] = lo2f(cc.w); dst[7] = hi2f(cc.w);
                }
                if (stid < 32) {
                    const int n = dir ? nlo + 31 - stid : nlo + stid;
                    const float* g = p.zg + (size_t)(rowbase + n) * 48 + dir * 8 + h;
                    igs[stid] = g[0]; lfs[stid] = logsig(g[4]);
                }
                __syncthreads();
                for (int i = 0; i < 32; ++i) {
                    const float lf = lfs[i], ig = igs[i];
                    const float mn = fmaxf(lf + m, ig);
                    const float a = __expf(lf + m - mn), bi = __expf(ig - mn);
                    m = mn;
                    const float vd = vs[i * 128 + d] * bi;
                    const float4* kp = (const float4*)(ks + i * 128 + e0);
                    const float4* qp = (const float4*)(qs + i * 128 + e0);
                    float num = 0.f;
#pragma unroll
                    for (int j = 0; j < 16; ++j) {
                        const float4 kv = kp[j];
                        C[4 * j + 0] = a * C[4 * j + 0] + vd * kv.x; C[4 * j + 1] = a * C[4 * j + 1] + vd * kv.y;
                        C[4 * j + 2] = a * C[4 * j + 2] + vd * kv.z; C[4 * j + 3] = a * C[4 * j + 3] + vd * kv.w;
                        if (lat) { const float4 qv = qp[j]; num += C[4 * j + 0] * qv.x + C[4 * j + 1] * qv.y + C[4 * j + 2] * qv.z + C[4 * j + 3] * qv.w; }
                    }
                    if (stid < 128) {
                        nreg = a * nreg + bi * ks[i * 128 + stid];
                        if (lat) { float pd = nreg * qs[i * 128 + stid]; pd = wave_sum(pd); if (lane == 0) denp[i * 2 + (stid >> 6)] = pd; }
                    }
                    if (lat) { num += __shfl_xor(num, 1); if (!(stid & 1)) numb[i * 128 + d] = num; }
                    if (stid == 0) mb[i] = m;
                }
                __syncthreads();
                if (lat) {
                    for (int idx = stid; idx < 4096; idx += 256) {
                        const int i = idx >> 7, dd = idx & 127;
                        const float den = denp[2 * i] + denp[2 * i + 1];
                        const float hv = numb[idx] / fmaxf(fabsf(den), __expf(-mb[i]));
                        const int n = dir ? nlo + 31 - i : nlo + i;
                        p.mixh[((size_t)dir * TL + rowbase + n) * 1024 + h * 128 + dd] = f2bf(hv);
                    }
                }
                __syncthreads();
            }
        } else {
            float* qs = L; float* ks = L + 2048; float* dec = L + 4096; float* vs = L + 6144; float* ob = L + 10240;
            float S[32];
#pragma unroll
            for (int e = 0; e < 32; ++e) S[e] = 0.f;
            const int e = stid >> 1, d0 = (stid & 1) * 32;
            for (int bt = 0; bt < 72; ++bt) {
                const bool lat = bt >= 8;
                const int pos0 = lat ? (bt - 8) * 32 : bt * 32;
                const int seg = lat ? SEQ : CTX;
                const int nlo = dir ? seg - 32 - pos0 : pos0;
                const int rowbase = lat ? b * SEQ : TL + b * CTX;
#pragma unroll
                for (int r = 0; r < 2; ++r) {
                    const int wi = stid + 256 * r, which = wi >> 8, i = (wi >> 3) & 31, ch = (wi & 7) * 8;
                    if (which == 0 && !lat) continue;
                    const int n = dir ? nlo + 31 - i : nlo + i;
                    const uint4 cc = *(const uint4*)(p.z + (size_t)(rowbase + n) * ZS + (which ? C_GK : C_GQ) + h * 64 + ch);
                    float* dst = (which ? ks : qs) + i * 64 + ch;
                    const float scl = which ? 1.f : 0.125f;
                    dst[0] = lo2f(cc.x) * scl; dst[1] = hi2f(cc.x) * scl; dst[2] = lo2f(cc.y) * scl; dst[3] = hi2f(cc.y) * scl;
                    dst[4] = lo2f(cc.z) * scl; dst[5] = hi2f(cc.z) * scl; dst[6] = lo2f(cc.w) * scl; dst[7] = hi2f(cc.w) * scl;
                }
#pragma unroll
                for (int r = 0; r < 2; ++r) {
                    const int wi = stid + 256 * r, i = wi >> 4, ch = (wi & 15) * 8;
                    const int n = dir ? nlo + 31 - i : nlo + i;
                    const uint4 cc = *(const uint4*)(p.z + (size_t)(rowbase + n) * ZS + C_GV + h * 128 + ch);
                    float* dst = vs + i * 128 + ch;
                    dst[0] = lo2f(cc.x); dst[1] = hi2f(cc.x); dst[2] = lo2f(cc.y); dst[3] = hi2f(cc.y);
                    dst[4] = lo2f(cc.z); dst[5] = hi2f(cc.z); dst[6] = lo2f(cc.w); dst[7] = hi2f(cc.w);
                }
#pragma unroll
                for (int r = 0; r < 8; ++r) {
                    const int wi = stid + 256 * r, i = wi >> 6, dd = wi & 63;
                    const int n = dir ? nlo + 31 - i : nlo + i;
                    const float* lr = p.zg + (size_t)(rowbase + n) * 48 + 16 + dir * 16;
                    float al = p.alpha_b[dir * 256 + h * 64 + dd];
#pragma unroll
                    for (int q = 0; q < 16; ++q) al += lr[q] * p.lr_w2[(dir * 16 + q) * 256 + h * 64 + dd];
                    dec[i * 64 + dd] = __expf(logsig(al) * (1.f / 16.f));
                }
                __syncthreads();
                for (int i = 0; i < 32; ++i) {
                    const float ve = vs[i * 128 + e];
                    const float4* dp = (const float4*)(dec + i * 64 + d0);
                    const float4* kp = (const float4*)(ks + i * 64 + d0);
                    const float4* qp = (const float4*)(qs + i * 64 + d0);
                    float o = 0.f;
#pragma unroll
                    for (int j = 0; j < 8; ++j) {
                        const float4 dv = dp[j], kv = kp[j];
                        S[4 * j + 0] = dv.x * S[4 * j + 0] + kv.x * ve; S[4 * j + 1] = dv.y * S[4 * j + 1] + kv.y * ve;
                        S[4 * j + 2] = dv.z * S[4 * j + 2] + kv.z * ve; S[4 * j + 3] = dv.w * S[4 * j + 3] + kv.w * ve;
                        if (lat) { const float4 qv = qp[j]; o += qv.x * S[4 * j + 0] + qv.y * S[4 * j + 1] + qv.z * S[4 * j + 2] + qv.w * S[4 * j + 3]; }
                    }
                    if (lat) { o += __shfl_xor(o, 1); if (!(stid & 1)) ob[i * 128 + e] = o; }
                }
                __syncthreads();
                if (lat) {
                    for (int idx = stid; idx < 4096; idx += 256) {
                        const int i = idx >> 7, ee = idx & 127;
                        const int n = dir ? nlo + 31 - i : nlo + i;
                        p.mixh[((size_t)dir * TL + rowbase + n) * 1024 + 512 + h * 128 + ee] = f2bf(ob[idx]);
                    }
                }
                __syncthreads();
            }
        }
    }
}

__device__ void phase_mixprep(const Params& p, int bid, int nblk) {
    const int lane = threadIdx.x & 63;
    const int gw = bid * (NT / 64) + (threadIdx.x >> 6), nw = nblk * (NT / 64);
    const int c0 = lane * 16;
    for (int row = gw; row < TL; row += nw) {
        const uint4* a0 = (const uint4*)(p.mixh + (size_t)row * 1024 + c0);
        const uint4* a1 = (const uint4*)(p.mixh + ((size_t)TL + row) * 1024 + c0);
        const uint4* gp = (const uint4*)(p.z + (size_t)row * ZS + (c0 < 512 ? C_MLO + c0 : C_GR + (c0 - 512)));
        const float* gn = c0 < 512 ? p.ml_norm_g + c0 : p.gla_norm_g + (c0 - 512);
        float s[16], gt[16];
#pragma unroll
        for (int q = 0; q < 2; ++q) {
            const uint4 u0 = a0[q], u1 = a1[q], ug = gp[q];
            const unsigned w0[4] = {u0.x, u0.y, u0.z, u0.w}, w1[4] = {u1.x, u1.y, u1.z, u1.w}, wg[4] = {ug.x, ug.y, ug.z, ug.w};
#pragma unroll
            for (int j = 0; j < 4; ++j) {
                s[q * 8 + 2 * j] = lo2f(w0[j]) + lo2f(w1[j]); s[q * 8 + 2 * j + 1] = hi2f(w0[j]) + hi2f(w1[j]);
                gt[q * 8 + 2 * j] = lo2f(wg[j]); gt[q * 8 + 2 * j + 1] = hi2f(wg[j]);
            }
        }
        float ss = 0.f;
#pragma unroll
        for (int j = 0; j < 16; ++j) ss += s[j] * s[j];
        ss += __shfl_xor(ss, 1); ss += __shfl_xor(ss, 2); ss += __shfl_xor(ss, 4);
        const float rstd = rsqrtf(ss * (1.f / 128.f) + EPS);
        unsigned o[8];
#pragma unroll
        for (int j = 0; j < 8; ++j) {
            float y0, y1;
            const float g0 = gt[2 * j], g1 = gt[2 * j + 1];
            if (c0 < 512) { y0 = sigm(g0); y1 = sigm(g1); } else { y0 = silu(g0); y1 = silu(g1); }
            y0 *= s[2 * j] * rstd * gn[2 * j]; y1 *= s[2 * j + 1] * rstd * gn[2 * j + 1];
            o[j] = pack2(y0, y1);
        }
        uint4* dst = (uint4*)(p.hbuf + (size_t)row * D + c0);
        dst[0] = make_uint4(o[0], o[1], o[2], o[3]); dst[1] = make_uint4(o[4], o[5], o[6], o[7]);
    }
}

__device__ void phase_norm2(const Params& p, int bid, int nblk) {
    const int lane = threadIdx.x & 63;
    const int gw = bid * (NT / 64) + (threadIdx.x >> 6), nw = nblk * (NT / 64);
    for (int row = gw; row < TL; row += nw) {
        const float* src = p.out + (size_t)row * D;
        const float* md = p.mod + (row >> 11) * 6144;
        float4 v[4]; float ss = 0.f;
#pragma unroll
        for (int j = 0; j < 4; ++j) { v[j] = *(const float4*)(src + j * 256 + lane * 4); ss += v[j].x * v[j].x + v[j].y * v[j].y + v[j].z * v[j].z + v[j].w * v[j].w; }
        ss = wave_sum(ss);
        const float rstd = rsqrtf(ss * (1.f / 1024.f) + EPS);
#pragma unroll
        for (int j = 0; j < 4; ++j) {
            const int col = j * 256 + lane * 4;
            const float4 g = *(const float4*)(p.norm2_g + col), sc = *(const float4*)(md + 4096 + col), sh = *(const float4*)(md + 3072 + col);
            uint2 o;
            o.x = pack2(v[j].x * rstd * g.x * (1.f + sc.x) + sh.x, v[j].y * rstd * g.y * (1.f + sc.y) + sh.y);
            o.y = pack2(v[j].z * rstd * g.z * (1.f + sc.z) + sh.z, v[j].w * rstd * g.w * (1.f + sc.w) + sh.w);
            *(uint2*)(p.hbuf + (size_t)row * D + col) = o;
        }
    }
}

__device__ __forceinline__ unsigned fkey(float f) { const unsigned u = __float_as_uint(f); return (u & 0x80000000u) ? ~u : (u | 0x80000000u); }
__device__ __forceinline__ int mbcnt64(unsigned long long m) { return __builtin_amdgcn_mbcnt_hi((unsigned)(m >> 32), __builtin_amdgcn_mbcnt_lo((unsigned)m, 0)); }
#define LDS_FENCE() asm volatile("s_waitcnt lgkmcnt(0)" ::: "memory")

template <int NV>
__device__ __forceinline__ void wave_top16(const float (&val)[NV], const int (&tag)[NV], float* outv, int* outt) {
    unsigned u[NV];
#pragma unroll
    for (int v = 0; v < NV; ++v) u[v] = fkey(val[v]);
    unsigned T = 0;
    for (int bit = 31; bit >= 0; --bit) {
        const unsigned cand = T | (1u << bit);
        int cnt = 0;
#pragma unroll
        for (int v = 0; v < NV; ++v) cnt += __popcll(__ballot(u[v] >= cand));
        if (cnt >= 16) T = cand;
    }
    int base = 0;
#pragma unroll
    for (int v = 0; v < NV; ++v) {
        const bool gt = u[v] > T;
        const unsigned long long mk = __ballot(gt);
        const int pos = base + mbcnt64(mk);
        if (gt) { outv[pos] = val[v]; outt[pos] = tag[v]; }
        base += __popcll(mk);
    }
#pragma unroll
    for (int v = 0; v < NV; ++v) {
        const bool eq = u[v] == T;
        const unsigned long long mk = __ballot(eq);
        const int pos = base + mbcnt64(mk);
        if (eq && pos < 16) { outv[pos] = val[v]; outt[pos] = tag[v]; }
        base += __popcll(mk);
    }
}

__device__ void phase_topk(const Params& p, char* smem, int bid, int nblk) {
    constexpr int KS = 136;
    bf16_t* keysL = (bf16_t*)smem;
    const int tid = threadIdx.x, lane = tid & 63, w = tid >> 6;
    float* wsc = (float*)(smem + 2 * 128 * KS * 2) + w * 320;
    float* qrow = wsc; float* tops = wsc + 256; int* topi = (int*)(wsc + 288);
    constexpr int CH = 256;
    for (int item = bid; item < 8 * (TL / CH); item += nblk) {
        const int ph = item & 7, t0 = (item >> 3) * CH;
        __syncthreads();
        for (int e = tid; e < 2 * 128 * 16; e += NT) {
            const int r = e >> 4, ch = (e & 15) * 8;
            *(uint4*)(keysL + r * KS + ch) = *(const uint4*)(p.keysb + (size_t)ph * 2 * 128 * 128 + r * 128 + ch);
        }
        __syncthreads();
        for (int t = t0 + w; t < t0 + CH; t += NT / 64) {
            {
                const uint2 qq = *(const uint2*)(p.qbuf + (size_t)t * 2048 + ph * 256 + lane * 4);
                *(float4*)(qrow + lane * 4) = make_float4(lo2f(qq.x), hi2f(qq.x), lo2f(qq.y), hi2f(qq.y));
            }
            LDS_FENCE();
#pragma unroll
            for (int hh = 0; hh < 2; ++hh) {
                float s0 = 0.f, s1 = 0.f;
                const bf16_t* k0p = keysL + (hh * 128 + lane) * KS;
                const bf16_t* k1p = k0p + 64 * KS;
                const float* qp = qrow + hh * 128;
#pragma unroll 4
                for (int dc = 0; dc < 16; ++dc) {
                    const float4 qa = *(const float4*)(qp + dc * 8), qb = *(const float4*)(qp + dc * 8 + 4);
                    const uint4 ka = *(const uint4*)(k0p + dc * 8), kb = *(const uint4*)(k1p + dc * 8);
                    s0 += qa.x * lo2f(ka.x) + qa.y * hi2f(ka.x) + qa.z * lo2f(ka.y) + qa.w * hi2f(ka.y) + qb.x * lo2f(ka.z) + qb.y * hi2f(ka.z) + qb.z * lo2f(ka.w) + qb.w * hi2f(ka.w);
                    s1 += qa.x * lo2f(kb.x) + qa.y * hi2f(kb.x) + qa.z * lo2f(kb.y) + qa.w * hi2f(kb.y) + qb.x * lo2f(kb.z) + qb.y * hi2f(kb.z) + qb.z * lo2f(kb.w) + qb.w * hi2f(kb.w);
                }
                const float vv[2] = {s0, s1}; const int tg[2] = {lane, lane + 64};
                wave_top16<2>(vv, tg, tops + hh * 16, topi + hh * 16);
            }
            LDS_FENCE();
            float cv[4]; int ct[4];
#pragma unroll
            for (int j = 0; j < 4; ++j) { const int cidx = lane * 4 + j; cv[j] = tops[cidx >> 4] + tops[16 + (cidx & 15)]; ct[j] = cidx; }
            float* bs = qrow; int* bc = (int*)(qrow + 16);
            LDS_FENCE();
            wave_top16<4>(cv, ct, bs, bc);
            LDS_FENCE();
            const float sv = lane < 16 ? bs[lane] : -3.0e38f;
            const int cc = lane < 16 ? bc[lane] : 0;
            const float mx = wave_max(sv);
            const float ev = lane < 16 ? __expf(sv - mx) : 0.f;
            const float sm = wave_sum(ev);
            if (lane < 16) {
                const int idx = topi[cc >> 4] * 128 + topi[16 + (cc & 15)];
                p.pidx[(size_t)t * 128 + ph * 16 + lane] = idx;
                p.pgw[(size_t)t * 128 + ph * 16 + lane] = ev / sm;
            }
            LDS_FENCE();
        }
    }
    __syncthreads();
}

__device__ __forceinline__ void unpack8(const uint4 u, float* f) {
    f[0] = lo2f(u.x); f[1] = hi2f(u.x); f[2] = lo2f(u.y); f[3] = hi2f(u.y); f[4] = lo2f(u.z); f[5] = hi2f(u.z); f[6] = lo2f(u.w); f[7] = hi2f(u.w);
}
__device__ void phase_gather(const Params& p, int bid, int nblk) {
    const int lane = threadIdx.x & 63;
    const int gw = bid * (NT / 64) + (threadIdx.x >> 6), nw = nblk * (NT / 64);
    for (int t = gw; t < TL; t += nw) {
        float hv[16];
        unpack8(*(const uint4*)(p.hbuf + (size_t)t * D + lane * 8), hv);
        unpack8(*(const uint4*)(p.hbuf + (size_t)t * D + 512 + lane * 8), hv + 8);
        const int ia = p.pidx[(size_t)t * 128 + lane], ib = p.pidx[(size_t)t * 128 + 64 + lane];
        const float ga = p.pgw[(size_t)t * 128 + lane], gb = p.pgw[(size_t)t * 128 + 64 + lane];
        float acc[16];
#pragma unroll
        for (int j = 0; j < 16; ++j) acc[j] = 0.f;
        for (int j0 = 0; j0 < 128; j0 += 4) {
            uint4 u0[4], u1[4], v0[4], v1[4]; float gj[4];
#pragma unroll
            for (int jj = 0; jj < 4; ++jj) {
                const int j = j0 + jj;
                const int e = j0 < 64 ? __builtin_amdgcn_readlane(ia, j & 63) : __builtin_amdgcn_readlane(ib, j & 63);
                const int gi = j0 < 64 ? __builtin_amdgcn_readlane(__float_as_int(ga), j & 63) : __builtin_amdgcn_readlane(__float_as_int(gb), j & 63);
                gj[jj] = __int_as_float(gi);
                const bf16_t* up = p.ub + (size_t)e * D + lane * 8;
                const bf16_t* vp = p.vb + (size_t)e * D + lane * 8;
                u0[jj] = *(const uint4*)up; u1[jj] = *(const uint4*)(up + 512);
                v0[jj] = *(const uint4*)vp; v1[jj] = *(const uint4*)(vp + 512);
            }
#pragma unroll
            for (int jj = 0; jj < 4; ++jj) {
                float uf[16];
                unpack8(u0[jj], uf); unpack8(u1[jj], uf + 8);
                float dot = 0.f;
#pragma unroll
                for (int q = 0; q < 16; ++q) dot += uf[q] * hv[q];
                dot = wave_sum(dot);
                const float act = 0.5f * dot * (1.f + erff(dot * 0.7071067811865476f)) * gj[jj];
                float vf[16];
                unpack8(v0[jj], vf); unpack8(v1[jj], vf + 8);
#pragma unroll
                for (int q = 0; q < 16; ++q) acc[q] += act * vf[q];
            }
        }
        float* orow = p.out + (size_t)t * D;
        const float* g2 = p.mod + (t >> 11) * 6144 + 5120;
        float y[16]; float ss = 0.f;
#pragma unroll
        for (int q = 0; q < 4; ++q) {
            const int col = (q >> 1) * 512 + lane * 8 + (q & 1) * 4;
            const float4 xv = *(const float4*)(orow + col), gv = *(const float4*)(g2 + col);
            y[q * 4 + 0] = xv.x + gv.x * acc[q * 4 + 0]; y[q * 4 + 1] = xv.y + gv.y * acc[q * 4 + 1];
            y[q * 4 + 2] = xv.z + gv.z * acc[q * 4 + 2]; y[q * 4 + 3] = xv.w + gv.w * acc[q * 4 + 3];
            ss += y[q * 4] * y[q * 4] + y[q * 4 + 1] * y[q * 4 + 1] + y[q * 4 + 2] * y[q * 4 + 2] + y[q * 4 + 3] * y[q * 4 + 3];
        }
        ss = wave_sum(ss);
        const float rstd = rsqrtf(ss * (1.f / 1024.f) + EPS);
#pragma unroll
        for (int q = 0; q < 4; ++q) {
            const int col = (q >> 1) * 512 + lane * 8 + (q & 1) * 4;
            const float4 gf = *(const float4*)(p.norm_f_g + col);
            *(float4*)(orow + col) = make_float4(y[q * 4] * rstd * gf.x, y[q * 4 + 1] * rstd * gf.y, y[q * 4 + 2] * rstd * gf.z, y[q * 4 + 3] * rstd * gf.w);
        }
    }
}

extern __shared__ __attribute__((aligned(16))) char dyn_smem[];

__device__ __forceinline__ void run_phase(const Params& p, int ph, char* smem, int bid, int nblk) {
    switch (ph) {
        case 0: phase_mod(p, smem, bid, nblk); phase_convert(p, smem, bid, nblk); break;
        case 1: phase_norm1(p, bid, nblk); break;
        case 2: { EpiInProj e{p.z, p.zg, p.gate_b}; gemm_phase(p.hbuf, p.winT, TT, PTP, 1024, e, smem, bid, nblk); } break;
        case 3: phase_mixers(p, smem, bid, nblk); break;
        case 4: phase_mixprep(p, bid, nblk); break;
        case 5: { EpiOutProj e{p.x, p.mod, p.out}; gemm_phase(p.hbuf, p.woutT, TL, 1024, 1024, e, smem, bid, nblk); } break;
        case 6: phase_norm2(p, bid, nblk); break;
        case 7: { EpiQ e{p.qbuf}; gemm_phase(p.hbuf, p.wqT, TL, 2048, 1024, e, smem, bid, nblk); } break;
        case 8: phase_topk(p, smem, bid, nblk); break;
        case 9: phase_gather(p, bid, nblk); break;
    }
}
constexpr int NPHASE = 10;

#if FUSED
__global__ void __launch_bounds__(NT, 2) mega_kernel(Params p) {
    cg::grid_group grid = cg::this_grid();
    for (int ph = 0; ph < NPHASE; ++ph) {
        run_phase(p, ph, dyn_smem, blockIdx.x, gridDim.x);
        if (ph + 1 < NPHASE) grid.sync();
    }
}
#else
template <int PH>
__global__ void __launch_bounds__(NT, 2) phase_kernel(Params p) { run_phase(p, PH, dyn_smem, blockIdx.x, gridDim.x); }
#endif

static inline char* carve(char*& cur, size_t bytes) { char* r = cur; cur += (bytes + 255) & ~(size_t)255; return r; }

extern "C" void kernel_launch(void* const* d_in, const int* in_sizes, int n_in, void* d_out, int out_size, void* d_ws, size_t ws_size, hipStream_t stream) {
    Params p{};
    p.x = (const float*)d_in[0]; p.c = (const float*)d_in[1]; p.ctx = (const float*)d_in[2]; p.c_ctx = (const float*)d_in[3];
    p.w_mod = (const float*)d_in[4]; p.b_mod = (const float*)d_in[5]; p.norm1_g = (const float*)d_in[6]; p.w_in = (const float*)d_in[7];
    p.conv_w = (const float*)d_in[8]; p.gate_b = (const float*)d_in[9]; p.ml_norm_g = (const float*)d_in[10]; p.lr_w2 = (const float*)d_in[11];
    p.alpha_b = (const float*)d_in[12]; p.gla_norm_g = (const float*)d_in[13]; p.w_out = (const float*)d_in[14]; p.norm2_g = (const float*)d_in[15];
    p.wq = (const float*)d_in[16]; p.keys = (const float*)d_in[17]; p.pu = (const float*)d_in[18]; p.pv = (const float*)d_in[19]; p.norm_f_g = (const float*)d_in[20];
    p.out = (float*)d_out;
    char* cur = (char*)d_ws;
    p.mod = (float*)carve(cur, (size_t)33 * 6144 * 4);
    p.winT = (bf16_t*)carve(cur, (size_t)PTP * 1024 * 2);
    p.woutT = (bf16_t*)carve(cur, (size_t)1024 * 1024 * 2);
    p.wqT = (bf16_t*)carve(cur, (size_t)2048 * 1024 * 2);
    p.keysb = (bf16_t*)carve(cur, (size_t)8 * 2 * 128 * 128 * 2);
    p.ub = (bf16_t*)carve(cur, (size_t)16384 * 1024 * 2);
    p.vb = (bf16_t*)carve(cur, (size_t)16384 * 1024 * 2);
    p.hbuf = (bf16_t*)carve(cur, (size_t)TT * 1024 * 2);
    p.z = (bf16_t*)carve(cur, (size_t)TT * ZS * 2);
    p.zg = (float*)carve(cur, (size_t)TT * 48 * 4);
    p.mixh = (bf16_t*)carve(cur, (size_t)2 * TL * 1024 * 2);
    p.qbuf = p.z;
    p.pidx = (int*)p.mixh;
    p.pgw = (float*)((char*)p.mixh + (size_t)TL * 128 * 4);
    if ((size_t)(cur - (char*)d_ws) > ws_size) { fprintf(stderr, "workspace too small: need %zu have %zu\n", (size_t)(cur - (char*)d_ws), ws_size); return; }
#if FUSED
    static int grid_blocks = 0;
    if (!grid_blocks) {
        int dev = 0, cus = 0, per_cu = 0;
        hipGetDevice(&dev);
        hipDeviceGetAttribute(&cus, hipDeviceAttributeMultiprocessorCount, dev);
        hipFuncSetAttribute((const void*)mega_kernel, hipFuncAttributeMaxDynamicSharedMemorySize, SMEM_BYTES);
        hipOccupancyMaxActiveBlocksPerMultiprocessor(&per_cu, mega_kernel, NT, SMEM_BYTES);
        if (per_cu > 2) per_cu = 2;
        grid_blocks = cus * per_cu;
    }
    void* args[] = {&p};
    hipError_t e = hipLaunchCooperativeKernel((void*)mega_kernel, dim3(grid_blocks), dim3(NT), args, SMEM_BYTES, stream);
    if (e != hipSuccess) fprintf(stderr, "cooperative launch failed: %s (grid %d)\n", hipGetErrorString(e), grid_blocks);
#else
    const int G = 512;
#define LAUNCH(PH) do { hipFuncSetAttribute((const void*)phase_kernel<PH>, hipFuncAttributeMaxDynamicSharedMemorySize, SMEM_BYTES); \
        hipLaunchKernelGGL(phase_kernel<PH>, dim3(G), dim3(NT), SMEM_BYTES, stream, p); } while (0)
    LAUNCH(0); LAUNCH(1); LAUNCH(2); LAUNCH(3); LAUNCH(4); LAUNCH(5); LAUNCH(6); LAUNCH(7); LAUNCH(8); LAUNCH(9);
#endif
}
```

```cpp
#include <hip/hip_runtime.h>
#include <hip/hip_cooperative_groups.h>
#include <cstdio>
#include <cstdint>
namespace cg = cooperative_groups;

#ifndef FUSED
#define FUSED 1
#endif

typedef unsigned short bf16_t;
typedef short bf16x8 __attribute__((ext_vector_type(8)));
typedef float f32x4 __attribute__((ext_vector_type(4)));
typedef unsigned u32x4 __attribute__((ext_vector_type(4)));

constexpr int D = 1024, NB = 32, SEQ = 2048, CTX = 256;
constexpr int TL = NB * SEQ;
constexpr int TC = NB * CTX;
constexpr int TT = TL + TC;
constexpr int PT = 3632;
constexpr int PTP = 3840;
constexpr int ZS = 3632;
constexpr int C_MLQ = 0, C_MLK = 512, C_MLV = 1024, C_MLO = 1536, C_MLG = 2048, C_GQ = 2064, C_GK = 2320, C_GV = 2576, C_GR = 3088, C_LR = 3600;
constexpr int NT = 256;
constexpr int SMEM_BYTES = 80 * 1024;
constexpr float EPS = 1e-6f;

struct Params {
    const float *x, *c, *ctx, *c_ctx, *w_mod, *b_mod, *norm1_g, *w_in, *conv_w, *gate_b, *ml_norm_g, *lr_w2, *alpha_b, *gla_norm_g,
        *w_out, *norm2_g, *wq, *keys, *pu, *pv, *norm_f_g;
    float* out;
    float* mod;
    bf16_t* winT;
    bf16_t* woutT;
    bf16_t* wqT;
    bf16_t* keysb;
    bf16_t* ub;
    bf16_t* vb;
    bf16_t* hbuf;
    bf16_t* z;
    float* zg;
    bf16_t* mixh;
    bf16_t* qbuf;
    int* pidx;
    float* pgw;
};

__device__ __forceinline__ int opaque_tid() { int t = threadIdx.x; asm volatile("" : "+v"(t)); return t; }
__device__ __forceinline__ float bf2f(bf16_t v) { return __uint_as_float(((unsigned)v) << 16); }
__device__ __forceinline__ bf16_t f2bf(float f) { unsigned u = __float_as_uint(f); u += 0x7fffu + ((u >> 16) & 1u); return (bf16_t)(u >> 16); }
__device__ __forceinline__ unsigned pack2(float a, float b) { return (unsigned)f2bf(a) | ((unsigned)f2bf(b) << 16); }
__device__ __forceinline__ float lo2f(unsigned w) { return __uint_as_float(w << 16); }
__device__ __forceinline__ float hi2f(unsigned w) { return __uint_as_float(w & 0xffff0000u); }
__device__ __forceinline__ float wave_sum(float v) {
#pragma unroll
    for (int o = 32; o > 0; o >>= 1) v += __shfl_xor(v, o);
    return v;
}
__device__ __forceinline__ float wave_max(float v) {
#pragma unroll
    for (int o = 32; o > 0; o >>= 1) v = fmaxf(v, __shfl_xor(v, o));
    return v;
}
__device__ __forceinline__ float logsig(float x) { return fminf(x, 0.f) - log1pf(__expf(-fabsf(x))); }
__device__ __forceinline__ float silu(float x) { return x / (1.f + __expf(-x)); }
__device__ __forceinline__ float sigm(float x) { return 1.f / (1.f + __expf(-x)); }

__device__ void phase_mod(const Params& p, char* smem, int bid, int nblk) {
    const int tidx_ = opaque_tid();
    float* condL = (float*)smem;
    const int tid = tidx_, cl = tid & 63, ks = tid >> 6;
    for (int item = bid; item < 96; item += nblk) {
        const int col0 = item * 64, col = col0 + cl;
        float acc[33];
#pragma unroll
        for (int b = 0; b < 33; ++b) acc[b] = 0.f;
        for (int kc = 0; kc < 4; ++kc) {
            __syncthreads();
            for (int e = tid; e < 4 * 64 * 33; e += NT) {
                const int s = e / (64 * 33), kk = (e / 33) % 64, b = e % 33;
                const int k = s * 256 + kc * 64 + kk;
                const float cv = b < 32 ? p.c[b * 1024 + k] : p.c_ctx[k];
                condL[e] = silu(cv);
            }
            __syncthreads();
            for (int kk = 0; kk < 64; ++kk) {
                const int k = ks * 256 + kc * 64 + kk;
                const float w = p.w_mod[(size_t)k * 6144 + col];
                const float* cp = condL + (ks * 64 + kk) * 33;
#pragma unroll
                for (int b = 0; b < 33; ++b) acc[b] += w * cp[b];
            }
        }
        __syncthreads();
#pragma unroll
        for (int b = 0; b < 33; ++b) condL[(ks * 33 + b) * 64 + cl] = acc[b];
        __syncthreads();
        for (int e = tid; e < 33 * 64; e += NT) {
            const int b = e >> 6, cc = e & 63;
            float v = condL[(0 * 33 + b) * 64 + cc] + condL[(1 * 33 + b) * 64 + cc] + condL[(2 * 33 + b) * 64 + cc] + condL[(3 * 33 + b) * 64 + cc];
            p.mod[b * 6144 + col0 + cc] = v + p.b_mod[col0 + cc];
        }
        __syncthreads();
    }
}

__device__ void convT(const float* __restrict__ src, int K, int N, int Npad, bf16_t* __restrict__ dst, char* smem, int bid, int nblk) {
    const int tidx_ = opaque_tid();
    float* tile = (float*)smem;
    const int tid = tidx_;
    const int nk = K / 64, nn = Npad / 64;
    for (int t = bid; t < nk * nn; t += nblk) {
        const int k0 = (t % nk) * 64, n0 = (t / nk) * 64;
        __syncthreads();
#pragma unroll
        for (int r = 0; r < 16; ++r) {
            const int k = r * 4 + (tid >> 6), n = tid & 63;
            tile[k * 65 + n] = (n0 + n < N) ? src[(size_t)(k0 + k) * N + n0 + n] : 0.f;
        }
        __syncthreads();
#pragma unroll
        for (int r = 0; r < 16; ++r) {
            const int n = r * 4 + (tid >> 6), k = tid & 63;
            dst[(size_t)(n0 + n) * K + k0 + k] = f2bf(tile[k * 65 + n]);
        }
    }
    __syncthreads();
}
__device__ void conv_copy(const float* __restrict__ src, bf16_t* __restrict__ dst, size_t n, int gtid, int gthreads) {
    const size_t n4 = n / 4;
    for (size_t i = gtid; i < n4; i += gthreads) {
        const float4 v = ((const float4*)src)[i];
        uint2 o; o.x = pack2(v.x, v.y); o.y = pack2(v.z, v.w);
        ((uint2*)dst)[i] = o;
    }
}
__device__ void phase_convert(const Params& p, char* smem, int bid, int nblk) {
    const int tidx_ = opaque_tid();
    convT(p.w_in, 1024, PT, PTP, p.winT, smem, bid, nblk);
    convT(p.w_out, 1024, 1024, 1024, p.woutT, smem, bid, nblk);
    convT(p.wq, 1024, 2048, 2048, p.wqT, smem, bid, nblk);
    const int gtid = bid * NT + tidx_, gth = nblk * NT;
    conv_copy(p.keys, p.keysb, (size_t)8 * 2 * 128 * 128, gtid, gth);
    conv_copy(p.pu, p.ub, (size_t)16384 * 1024, gtid, gth);
    conv_copy(p.pv, p.vb, (size_t)16384 * 1024, gtid, gth);
}

__device__ void phase_norm1(const Params& p, int bid, int nblk) {
    const int tidx_ = opaque_tid();
    const int lane = tidx_ & 63;
    const int gw = bid * (NT / 64) + (tidx_ >> 6), nw = nblk * (NT / 64);
    for (int row = gw; row < TT; row += nw) {
        const float* src = row < TL ? p.x + (size_t)row * D : p.ctx + (size_t)(row - TL) * D;
        const float* md = p.mod + (row < TL ? (row >> 11) : 32) * 6144;
        float4 v[4]; float ss = 0.f;
#pragma unroll
        for (int j = 0; j < 4; ++j) { v[j] = *(const float4*)(src + j * 256 + lane * 4); ss += v[j].x * v[j].x + v[j].y * v[j].y + v[j].z * v[j].z + v[j].w * v[j].w; }
        ss = wave_sum(ss);
        const float rstd = rsqrtf(ss * (1.f / 1024.f) + EPS);
#pragma unroll
        for (int j = 0; j < 4; ++j) {
            const int col = j * 256 + lane * 4;
            const float4 g = *(const float4*)(p.norm1_g + col), sc = *(const float4*)(md + 1024 + col), sh = *(const float4*)(md + col);
            uint2 o;
            o.x = pack2(v[j].x * rstd * g.x * (1.f + sc.x) + sh.x, v[j].y * rstd * g.y * (1.f + sc.y) + sh.y);
            o.y = pack2(v[j].z * rstd * g.z * (1.f + sc.z) + sh.z, v[j].w * rstd * g.w * (1.f + sc.w) + sh.w);
            *(uint2*)(p.hbuf + (size_t)row * D + col) = o;
        }
    }
}

template <class Epi>
__device__ void gemm_phase(const bf16_t* __restrict__ A, const bf16_t* __restrict__ Bt, int M, int N, int K, const Epi& epi, char* smem, int bid, int nblk) {
    const int tidx_ = opaque_tid();
    constexpr int BM = 128, BN = 128, BK = 64, LS = 72;
    bf16_t* sA = (bf16_t*)smem;
    bf16_t* sB = sA + BM * LS;
    const int tid = tidx_, lane = tid & 63, w = tid >> 6, wr = w >> 1, wc = w & 1;
    const int nN = N / BN, ntiles = (M / BM) * nN;
    const int lr = tid >> 3, lc = (tid & 7) * 8;
    for (int tile = bid; tile < ntiles; tile += nblk) {
        const int tm = tile / nN, tn = tile % nN;
        const bf16_t* Ag = A + (size_t)(tm * BM) * K;
        const bf16_t* Bg = Bt + (size_t)(tn * BN) * K;
        f32x4 acc[4][4];
#pragma unroll
        for (int i = 0; i < 4; ++i)
#pragma unroll
            for (int j = 0; j < 4; ++j) acc[i][j] = (f32x4){0.f, 0.f, 0.f, 0.f};
        u32x4 ra[4], rb[4];
#pragma unroll
        for (int i = 0; i < 4; ++i) {
            ra[i] = *(const u32x4*)(Ag + (size_t)(lr + 32 * i) * K + lc);
            rb[i] = *(const u32x4*)(Bg + (size_t)(lr + 32 * i) * K + lc);
        }
        for (int k0 = 0; k0 < K; k0 += BK) {
            __syncthreads();
#pragma unroll
            for (int i = 0; i < 4; ++i) {
                *(u32x4*)(sA + (lr + 32 * i) * LS + lc) = ra[i];
                *(u32x4*)(sB + (lr + 32 * i) * LS + lc) = rb[i];
            }
            __syncthreads();
            {
                const int kn = (k0 + BK < K) ? k0 + BK : k0;
#pragma unroll
                for (int i = 0; i < 4; ++i) {
                    ra[i] = *(const u32x4*)(Ag + (size_t)(lr + 32 * i) * K + kn + lc);
                    rb[i] = *(const u32x4*)(Bg + (size_t)(lr + 32 * i) * K + kn + lc);
                }
            }
#pragma unroll
            for (int kk = 0; kk < 2; ++kk) {
                bf16x8 af[4], bfr[4];
#pragma unroll
                for (int i = 0; i < 4; ++i) {
                    af[i] = *(const bf16x8*)(sA + (wr * 64 + i * 16 + (lane & 15)) * LS + kk * 32 + (lane >> 4) * 8);
                    bfr[i] = *(const bf16x8*)(sB + (wc * 64 + i * 16 + (lane & 15)) * LS + kk * 32 + (lane >> 4) * 8);
                }
#pragma unroll
                for (int i = 0; i < 4; ++i)
#pragma unroll
                    for (int j = 0; j < 4; ++j) acc[i][j] = __builtin_amdgcn_mfma_f32_16x16x32_bf16(af[i], bfr[j], acc[i][j], 0, 0, 0);
            }
        }
#pragma unroll
        for (int i = 0; i < 4; ++i)
#pragma unroll
            for (int j = 0; j < 4; ++j)
#pragma unroll
                for (int r = 0; r < 4; ++r) {
                    const int row = tm * BM + wr * 64 + i * 16 + (lane >> 4) * 4 + r;
                    const int col = tn * BN + wc * 64 + j * 16 + (lane & 15);
                    epi(row, col, acc[i][j][r]);
                }
    }
    __syncthreads();
}

struct EpiInProj {
    bf16_t* z; float* zg; const float* gate_b;
    __device__ __forceinline__ void operator()(int row, int col, float v) const {
        if (col < C_MLG) z[(size_t)row * ZS + col] = f2bf(v);
        else if (col < C_GQ) zg[(size_t)row * 48 + (col - C_MLG)] = v + gate_b[col - C_MLG];
        else if (col < C_LR) z[(size_t)row * ZS + col] = f2bf(v);
        else if (col < PT) zg[(size_t)row * 48 + 16 + (col - C_LR)] = v;
    }
};
struct EpiOutProj {
    const float* x; const float* mod; float* out;
    __device__ __forceinline__ void operator()(int row, int col, float v) const {
        const size_t o = (size_t)row * D + col;
        out[o] = x[o] + mod[(row >> 11) * 6144 + 2048 + col] * v;
    }
};
struct EpiQ {
    bf16_t* q;
    __device__ __forceinline__ void operator()(int row, int col, float v) const { q[(size_t)row * 2048 + col] = f2bf(v); }
};

__device__ void phase_mixers(const Params& p, char* smem, int bid, int nblk) {
    const int tidx_ = opaque_tid();
    float* L = (float*)smem;
    const int stid = tidx_, lane = stid & 63;
    for (int item = bid; item < 512; item += nblk) {
        const bool isml = item < 256;
        const int it = item & 255, b = it >> 3, h = (it >> 1) & 3, dir = it & 1;
        if (isml) {
            float* qs = L; float* ks = L + 4096; float* vs = L + 8192; float* numb = L + 12288;
            float* igs = L + 16384; float* lfs = L + 16416; float* denp = L + 16448; float* mb = L + 16512;
            float C[64];
#pragma unroll
            for (int e = 0; e < 64; ++e) C[e] = 0.f;
            float nreg = 0.f, m = 0.f;
            const int d = stid >> 1, e0 = (stid & 1) * 64;
            for (int bt = 0; bt < 72; ++bt) {
                const bool lat = bt >= 8;
                const int pos0 = lat ? (bt - 8) * 32 : bt * 32;
                const int seg = lat ? SEQ : CTX;
                const int nlo = dir ? seg - 32 - pos0 : pos0;
                const int rowbase = lat ? b * SEQ : TL + b * CTX;
#pragma unroll
                for (int r = 0; r < 4; ++r) {
                    const int wi = stid + 256 * r, which = wi >> 9, i = (wi >> 4) & 31, ch = (wi & 15) * 8;
                    if (which == 0 && !lat) continue;
                    const int n = dir ? nlo + 31 - i : nlo + i;
                    const int col = which * 512 + h * 128 + ch;
                    const bool vl = lat ? (((n - 1) >> 6) == (n >> 6)) : (n - 1 >= 0);
                    const bool vr = lat ? (((n + 1) >> 6) == (n >> 6)) : (n + 1 < CTX);
                    const bf16_t* zc = p.z + (size_t)(rowbase + n) * ZS + col;
                    const uint4 cc = *(const uint4*)zc;
                    uint4 ll = make_uint4(0, 0, 0, 0), rr = make_uint4(0, 0, 0, 0);
                    if (vl) ll = *(const uint4*)(zc - ZS);
                    if (vr) rr = *(const uint4*)(zc + ZS);
                    const unsigned cw[4] = {cc.x, cc.y, cc.z, cc.w}, lw[4] = {ll.x, ll.y, ll.z, ll.w}, rw[4] = {rr.x, rr.y, rr.z, rr.w};
                    float* dst = (which ? ks : qs) + i * 128 + ch;
                    const float scl = which ? 0.08838834764831845f : 1.f;
#pragma unroll
                    for (int j = 0; j < 4; ++j) {
                        const int c0 = col + 2 * j;
                        const float y0 = p.conv_w[c0] * lo2f(lw[j]) + p.conv_w[1024 + c0] * lo2f(cw[j]) + p.conv_w[2048 + c0] * lo2f(rw[j]);
                        const float y1 = p.conv_w[c0 + 1] * hi2f(lw[j]) + p.conv_w[1024 + c0 + 1] * hi2f(cw[j]) + p.conv_w[2048 + c0 + 1] * hi2f(rw[j]);
                        dst[2 * j] = silu(y0) * scl; dst[2 * j + 1] = silu(y1) * scl;
                    }
                }
#pragma unroll
                for (int r = 0; r < 2; ++r) {
                    const int wi = stid + 256 * r, i = wi >> 4, ch = (wi & 15) * 8;
                    const int n = dir ? nlo + 31 - i : nlo + i;
                    const uint4 cc = *(const uint4*)(p.z + (size_t)(rowbase + n) * ZS + C_MLV + h * 128 + ch);
                    float* dst = vs + i * 128 + ch;
                    dst[0] = lo2f(cc.x); dst[1] = hi2f(cc.x); dst[2] = lo2f(cc.y); dst[3] = hi2f(cc.y);
                    dst[4] = lo2f(cc.z); dst[5] = hi2f(cc.z); dst[6] = lo2f(cc.w); dst[7] = hi2f(cc.w);
                }
                if (stid < 32) {
                    const int n = dir ? nlo + 31 - stid : nlo + stid;
                    const float* g = p.zg + (size_t)(rowbase + n) * 48 + dir * 8 + h;
                    igs[stid] = g[0]; lfs[stid] = logsig(g[4]);
                }
                __syncthreads();
                for (int i = 0; i < 32; ++i) {
                    const float lf = lfs[i], ig = igs[i];
                    const float mn = fmaxf(lf + m, ig);
                    const float a = __expf(lf + m - mn), bi = __expf(ig - mn);
                    m = mn;
                    const float vd = vs[i * 128 + d] * bi;
                    const float4* kp = (const float4*)(ks + i * 128 + e0);
                    const float4* qp = (const float4*)(qs + i * 128 + e0);
                    float num = 0.f;
#pragma unroll
                    for (int j = 0; j < 16; ++j) {
                        const float4 kv = kp[j];
                        C[4 * j + 0] = a * C[4 * j + 0] + vd * kv.x; C[4 * j + 1] = a * C[4 * j + 1] + vd * kv.y;
                        C[4 * j + 2] = a * C[4 * j + 2] + vd * kv.z; C[4 * j + 3] = a * C[4 * j + 3] + vd * kv.w;
                        if (lat) { const float4 qv = qp[j]; num += C[4 * j + 0] * qv.x + C[4 * j + 1] * qv.y + C[4 * j + 2] * qv.z + C[4 * j + 3] * qv.w; }
                    }
                    if (stid < 128) {
                        nreg = a * nreg + bi * ks[i * 128 + stid];
                        if (lat) { float pd = nreg * qs[i * 128 + stid]; pd = wave_sum(pd); if (lane == 0) denp[i * 2 + (stid >> 6)] = pd; }
                    }
                    if (lat) { num += __shfl_xor(num, 1); if (!(stid & 1)) numb[i * 128 + d] = num; }
                    if (stid == 0) mb[i] = m;
                }
                __syncthreads();
                if (lat) {
                    for (int idx = stid; idx < 4096; idx += 256) {
                        const int i = idx >> 7, dd = idx & 127;
                        const float den = denp[2 * i] + denp[2 * i + 1];
                        const float hv = numb[idx] / fmaxf(fabsf(den), __expf(-mb[i]));
                        const int n = dir ? nlo + 31 - i : nlo + i;
                        p.mixh[((size_t)dir * TL + rowbase + n) * 1024 + h * 128 + dd] = f2bf(hv);
                    }
                }
                __syncthreads();
            }
        } else {
            float* qs = L; float* ks = L + 2048; float* dec = L + 4096; float* vs = L + 6144; float* ob = L + 10240;
            float S[32];
#pragma unroll
            for (int e = 0; e < 32; ++e) S[e] = 0.f;
            const int e = stid >> 1, d0 = (stid & 1) * 32;
            for (int bt = 0; bt < 72; ++bt) {
                const bool lat = bt >= 8;
                const int pos0 = lat ? (bt - 8) * 32 : bt * 32;
                const int seg = lat ? SEQ : CTX;
                const int nlo = dir ? seg - 32 - pos0 : pos0;
                const int rowbase = lat ? b * SEQ : TL + b * CTX;
#pragma unroll
                for (int r = 0; r < 2; ++r) {
                    const int wi = stid + 256 * r, which = wi >> 8, i = (wi >> 3) & 31, ch = (wi & 7) * 8;
                    if (which == 0 && !lat) continue;
                    const int n = dir ? nlo + 31 - i : nlo + i;
                    const uint4 cc = *(const uint4*)(p.z + (size_t)(rowbase + n) * ZS + (which ? C_GK : C_GQ) + h * 64 + ch);
                    float* dst = (which ? ks : qs) + i * 64 + ch;
                    const float scl = which ? 1.f : 0.125f;
                    dst[0] = lo2f(cc.x) * scl; dst[1] = hi2f(cc.x) * scl; dst[2] = lo2f(cc.y) * scl; dst[3] = hi2f(cc.y) * scl;
                    dst[4] = lo2f(cc.z) * scl; dst[5] = hi2f(cc.z) * scl; dst[6] = lo2f(cc.w) * scl; dst[7] = hi2f(cc.w) * scl;
                }
#pragma unroll
                for (int r = 0; r < 2; ++r) {
                    const int wi = stid + 256 * r, i = wi >> 4, ch = (wi & 15) * 8;
                    const int n = dir ? nlo + 31 - i : nlo + i;
                    const uint4 cc = *(const uint4*)(p.z + (size_t)(rowbase + n) * ZS + C_GV + h * 128 + ch);
                    float* dst = vs + i * 128 + ch;
                    dst[0] = lo2f(cc.x); dst[1] = hi2f(cc.x); dst[2] = lo2f(cc.y); dst[3] = hi2f(cc.y);
                    dst[4] = lo2f(cc.z); dst[5] = hi2f(cc.z); dst[6] = lo2f(cc.w); dst[7] = hi2f(cc.w);
                }
#pragma unroll
                for (int r = 0; r < 8; ++r) {
                    const int wi = stid + 256 * r, i = wi >> 6, dd = wi & 63;
                    const int n = dir ? nlo + 31 - i : nlo + i;
                    const float* lr = p.zg + (size_t)(rowbase + n) * 48 + 16 + dir * 16;
                    float al = p.alpha_b[dir * 256 + h * 64 + dd];
#pragma unroll
                    for (int q = 0; q < 16; ++q) al += lr[q] * p.lr_w2[(dir * 16 + q) * 256 + h * 64 + dd];
                    dec[i * 64 + dd] = __expf(logsig(al) * (1.f / 16.f));
                }
                __syncthreads();
                for (int i = 0; i < 32; ++i) {
                    const float ve = vs[i * 128 + e];
                    const float4* dp = (const float4*)(dec + i * 64 + d0);
                    const float4* kp = (const float4*)(ks + i * 64 + d0);
                    const float4* qp = (const float4*)(qs + i * 64 + d0);
                    float o = 0.f;
#pragma unroll
                    for (int j = 0; j < 8; ++j) {
                        const float4 dv = dp[j], kv = kp[j];
                        S[4 * j + 0] = dv.x * S[4 * j + 0] + kv.x * ve; S[4 * j + 1] = dv.y * S[4 * j + 1] + kv.y * ve;
                        S[4 * j + 2] = dv.z * S[4 * j + 2] + kv.z * ve; S[4 * j + 3] = dv.w * S[4 * j + 3] + kv.w * ve;
                        if (lat) { const float4 qv = qp[j]; o += qv.x * S[4 * j + 0] + qv.y * S[4 * j + 1] + qv.z * S[4 * j + 2] + qv.w * S[4 * j + 3]; }
                    }
                    if (lat) { o += __shfl_xor(o, 1); if (!(stid & 1)) ob[i * 128 + e] = o; }
                }
                __syncthreads();
                if (lat) {
                    for (int idx = stid; idx < 4096; idx += 256) {
                        const int i = idx >> 7, ee = idx & 127;
                        const int n = dir ? nlo + 31 - i : nlo + i;
                        p.mixh[((size_t)dir * TL + rowbase + n) * 1024 + 512 + h * 128 + ee] = f2bf(ob[idx]);
                    }
                }
                __syncthreads();
            }
        }
    }
}

__device__ void phase_mixprep(const Params& p, int bid, int nblk) {
    const int tidx_ = opaque_tid();
    const int lane = tidx_ & 63;
    const int gw = bid * (NT / 64) + (tidx_ >> 6), nw = nblk * (NT / 64);
    const int c0 = lane * 16;
    for (int row = gw; row < TL; row += nw) {
        const uint4* a0 = (const uint4*)(p.mixh + (size_t)row * 1024 + c0);
        const uint4* a1 = (const uint4*)(p.mixh + ((size_t)TL + row) * 1024 + c0);
        const uint4* gp = (const uint4*)(p.z + (size_t)row * ZS + (c0 < 512 ? C_MLO + c0 : C_GR + (c0 - 512)));
        const float* gn = c0 < 512 ? p.ml_norm_g + c0 : p.gla_norm_g + (c0 - 512);
        float s[16], gt[16];
#pragma unroll
        for (int q = 0; q < 2; ++q) {
            const uint4 u0 = a0[q], u1 = a1[q], ug = gp[q];
            const unsigned w0[4] = {u0.x, u0.y, u0.z, u0.w}, w1[4] = {u1.x, u1.y, u1.z, u1.w}, wg[4] = {ug.x, ug.y, ug.z, ug.w};
#pragma unroll
            for (int j = 0; j < 4; ++j) {
                s[q * 8 + 2 * j] = lo2f(w0[j]) + lo2f(w1[j]); s[q * 8 + 2 * j + 1] = hi2f(w0[j]) + hi2f(w1[j]);
                gt[q * 8 + 2 * j] = lo2f(wg[j]); gt[q * 8 + 2 * j + 1] = hi2f(wg[j]);
            }
        }
        float ss = 0.f;
#pragma unroll
        for (int j = 0; j < 16; ++j) ss += s[j] * s[j];
        ss += __shfl_xor(ss, 1); ss += __shfl_xor(ss, 2); ss += __shfl_xor(ss, 4);
        const float rstd = rsqrtf(ss * (1.f / 128.f) + EPS);
        unsigned o[8];
#pragma unroll
        for (int j = 0; j < 8; ++j) {
            float y0, y1;
            const float g0 = gt[2 * j], g1 = gt[2 * j + 1];
            if (c0 < 512) { y0 = sigm(g0); y1 = sigm(g1); } else { y0 = silu(g0); y1 = silu(g1); }
            y0 *= s[2 * j] * rstd * gn[2 * j]; y1 *= s[2 * j + 1] * rstd * gn[2 * j + 1];
            o[j] = pack2(y0, y1);
        }
        uint4* dst = (uint4*)(p.hbuf + (size_t)row * D + c0);
        dst[0] = make_uint4(o[0], o[1], o[2], o[3]); dst[1] = make_uint4(o[4], o[5], o[6], o[7]);
    }
}

__device__ void phase_norm2(const Params& p, int bid, int nblk) {
    const int tidx_ = opaque_tid();
    const int lane = tidx_ & 63;
    const int gw = bid * (NT / 64) + (tidx_ >> 6), nw = nblk * (NT / 64);
    for (int row = gw; row < TL; row += nw) {
        const float* src = p.out + (size_t)row * D;
        const float* md = p.mod + (row >> 11) * 6144;
        float4 v[4]; float ss = 0.f;
#pragma unroll
        for (int j = 0; j < 4; ++j) { v[j] = *(const float4*)(src + j * 256 + lane * 4); ss += v[j].x * v[j].x + v[j].y * v[j].y + v[j].z * v[j].z + v[j].w * v[j].w; }
        ss = wave_sum(ss);
        const float rstd = rsqrtf(ss * (1.f / 1024.f) + EPS);
#pragma unroll
        for (int j = 0; j < 4; ++j) {
            const int col = j * 256 + lane * 4;
            const float4 g = *(const float4*)(p.norm2_g + col), sc = *(const float4*)(md + 4096 + col), sh = *(const float4*)(md + 3072 + col);
            uint2 o;
            o.x = pack2(v[j].x * rstd * g.x * (1.f + sc.x) + sh.x, v[j].y * rstd * g.y * (1.f + sc.y) + sh.y);
            o.y = pack2(v[j].z * rstd * g.z * (1.f + sc.z) + sh.z, v[j].w * rstd * g.w * (1.f + sc.w) + sh.w);
            *(uint2*)(p.hbuf + (size_t)row * D + col) = o;
        }
    }
}

__device__ __forceinline__ unsigned fkey(float f) { const unsigned u = __float_as_uint(f); return (u & 0x80000000u) ? ~u : (u | 0x80000000u); }
__device__ __forceinline__ int mbcnt64(unsigned long long m) { return __builtin_amdgcn_mbcnt_hi((unsigned)(m >> 32), __builtin_amdgcn_mbcnt_lo((unsigned)m, 0)); }
#define LDS_FENCE() asm volatile("s_waitcnt lgkmcnt(0)" ::: "memory")

template <int NV>
__device__ __forceinline__ void wave_top16(const float (&val)[NV], const int (&tag)[NV], float* outv, int* outt) {
    unsigned u[NV];
#pragma unroll
    for (int v = 0; v < NV; ++v) u[v] = fkey(val[v]);
    unsigned T = 0;
    for (int bit = 31; bit >= 0; --bit) {
        const unsigned cand = T | (1u << bit);
        int cnt = 0;
#pragma unroll
        for (int v = 0; v < NV; ++v) cnt += __popcll(__ballot(u[v] >= cand));
        if (cnt >= 16) T = cand;
    }
    int base = 0;
#pragma unroll
    for (int v = 0; v < NV; ++v) {
        const bool gt = u[v] > T;
        const unsigned long long mk = __ballot(gt);
        const int pos = base + mbcnt64(mk);
        if (gt) { outv[pos] = val[v]; outt[pos] = tag[v]; }
        base += __popcll(mk);
    }
#pragma unroll
    for (int v = 0; v < NV; ++v) {
        const bool eq = u[v] == T;
        const unsigned long long mk = __ballot(eq);
        const int pos = base + mbcnt64(mk);
        if (eq && pos < 16) { outv[pos] = val[v]; outt[pos] = tag[v]; }
        base += __popcll(mk);
    }
}

__device__ void phase_topk(const Params& p, char* smem, int bid, int nblk) {
    const int tidx_ = opaque_tid();
    constexpr int KS = 136;
    bf16_t* keysL = (bf16_t*)smem;
    const int tid = tidx_, lane = tid & 63, w = tid >> 6;
    float* wsc = (float*)(smem + 2 * 128 * KS * 2) + w * 320;
    float* qrow = wsc; float* tops = wsc + 256; int* topi = (int*)(wsc + 288);
    constexpr int CH = 256;
    for (int item = bid; item < 8 * (TL / CH); item += nblk) {
        const int ph = item & 7, t0 = (item >> 3) * CH;
        __syncthreads();
        for (int e = tid; e < 2 * 128 * 16; e += NT) {
            const int r = e >> 4, ch = (e & 15) * 8;
            *(uint4*)(keysL + r * KS + ch) = *(const uint4*)(p.keysb + (size_t)ph * 2 * 128 * 128 + r * 128 + ch);
        }
        __syncthreads();
        for (int t = t0 + w; t < t0 + CH; t += NT / 64) {
            {
                const uint2 qq = *(const uint2*)(p.qbuf + (size_t)t * 2048 + ph * 256 + lane * 4);
                *(float4*)(qrow + lane * 4) = make_float4(lo2f(qq.x), hi2f(qq.x), lo2f(qq.y), hi2f(qq.y));
            }
            LDS_FENCE();
#pragma unroll
            for (int hh = 0; hh < 2; ++hh) {
                float s0 = 0.f, s1 = 0.f;
                const bf16_t* k0p = keysL + (hh * 128 + lane) * KS;
                const bf16_t* k1p = k0p + 64 * KS;
                const float* qp = qrow + hh * 128;
#pragma unroll 4
                for (int dc = 0; dc < 16; ++dc) {
                    const float4 qa = *(const float4*)(qp + dc * 8), qb = *(const float4*)(qp + dc * 8 + 4);
                    const uint4 ka = *(const uint4*)(k0p + dc * 8), kb = *(const uint4*)(k1p + dc * 8);
                    s0 += qa.x * lo2f(ka.x) + qa.y * hi2f(ka.x) + qa.z * lo2f(ka.y) + qa.w * hi2f(ka.y) + qb.x * lo2f(ka.z) + qb.y * hi2f(ka.z) + qb.z * lo2f(ka.w) + qb.w * hi2f(ka.w);
                    s1 += qa.x * lo2f(kb.x) + qa.y * hi2f(kb.x) + qa.z * lo2f(kb.y) + qa.w * hi2f(kb.y) + qb.x * lo2f(kb.z) + qb.y * hi2f(kb.z) + qb.z * lo2f(kb.w) + qb.w * hi2f(kb.w);
                }
                const float vv[2] = {s0, s1}; const int tg[2] = {lane, lane + 64};
                wave_top16<2>(vv, tg, tops + hh * 16, topi + hh * 16);
            }
            LDS_FENCE();
            float cv[4]; int ct[4];
#pragma unroll
            for (int j = 0; j < 4; ++j) { const int cidx = lane * 4 + j; cv[j] = tops[cidx >> 4] + tops[16 + (cidx & 15)]; ct[j] = cidx; }
            float* bs = qrow; int* bc = (int*)(qrow + 16);
            LDS_FENCE();
            wave_top16<4>(cv, ct, bs, bc);
            LDS_FENCE();
            const float sv = lane < 16 ? bs[lane] : -3.0e38f;
            const int cc = lane < 16 ? bc[lane] : 0;
            const float mx = wave_max(sv);
            const float ev = lane < 16 ? __expf(sv - mx) : 0.f;
            const float sm = wave_sum(ev);
            if (lane < 16) {
                const int idx = topi[cc >> 4] * 128 + topi[16 + (cc & 15)];
                p.pidx[(size_t)t * 128 + ph * 16 + lane] = idx;
                p.pgw[(size_t)t * 128 + ph * 16 + lane] = ev / sm;
            }
            LDS_FENCE();
        }
    }
    __syncthreads();
}

__device__ __forceinline__ void unpack8(const uint4 u, float* f) {
    f[0] = lo2f(u.x); f[1] = hi2f(u.x); f[2] = lo2f(u.y); f[3] = hi2f(u.y); f[4] = lo2f(u.z); f[5] = hi2f(u.z); f[6] = lo2f(u.w); f[7] = hi2f(u.w);
}
__device__ void phase_gather(const Params& p, int bid, int nblk) {
    const int tidx_ = opaque_tid();
    const int lane = tidx_ & 63;
    const int gw = bid * (NT / 64) + (tidx_ >> 6), nw = nblk * (NT / 64);
    for (int t = gw; t < TL; t += nw) {
        float hv[16];
        unpack8(*(const uint4*)(p.hbuf + (size_t)t * D + lane * 8), hv);
        unpack8(*(const uint4*)(p.hbuf + (size_t)t * D + 512 + lane * 8), hv + 8);
        const int ia = p.pidx[(size_t)t * 128 + lane], ib = p.pidx[(size_t)t * 128 + 64 + lane];
        const float ga = p.pgw[(size_t)t * 128 + lane], gb = p.pgw[(size_t)t * 128 + 64 + lane];
        float acc[16];
#pragma unroll
        for (int j = 0; j < 16; ++j) acc[j] = 0.f;
        for (int j0 = 0; j0 < 128; j0 += 4) {
            uint4 u0[4], u1[4], v0[4], v1[4]; float gj[4];
#pragma unroll
            for (int jj = 0; jj < 4; ++jj) {
                const int j = j0 + jj;
                const int e = j0 < 64 ? __builtin_amdgcn_readlane(ia, j & 63) : __builtin_amdgcn_readlane(ib, j & 63);
                const int gi = j0 < 64 ? __builtin_amdgcn_readlane(__float_as_int(ga), j & 63) : __builtin_amdgcn_readlane(__float_as_int(gb), j & 63);
                gj[jj] = __int_as_float(gi);
                const bf16_t* up = p.ub + (size_t)e * D + lane * 8;
                const bf16_t* vp = p.vb + (size_t)e * D + lane * 8;
                u0[jj] = *(const uint4*)up; u1[jj] = *(const uint4*)(up + 512);
                v0[jj] = *(const uint4*)vp; v1[jj] = *(const uint4*)(vp + 512);
            }
#pragma unroll
            for (int jj = 0; jj < 4; ++jj) {
                float uf[16];
                unpack8(u0[jj], uf); unpack8(u1[jj], uf + 8);
                float dot = 0.f;
#pragma unroll
                for (int q = 0; q < 16; ++q) dot += uf[q] * hv[q];
                dot = wave_sum(dot);
                const float act = 0.5f * dot * (1.f + erff(dot * 0.7071067811865476f)) * gj[jj];
                float vf[16];
                unpack8(v0[jj], vf); unpack8(v1[jj], vf + 8);
#pragma unroll
                for (int q = 0; q < 16; ++q) acc[q] += act * vf[q];
            }
        }
        float* orow = p.out + (size_t)t * D;
        const float* g2 = p.mod + (t >> 11) * 6144 + 5120;
        float y[16]; float ss = 0.f;
#pragma unroll
        for (int q = 0; q < 4; ++q) {
            const int col = (q >> 1) * 512 + lane * 8 + (q & 1) * 4;
            const float4 xv = *(const float4*)(orow + col), gv = *(const float4*)(g2 + col);
            y[q * 4 + 0] = xv.x + gv.x * acc[q * 4 + 0]; y[q * 4 + 1] = xv.y + gv.y * acc[q * 4 + 1];
            y[q * 4 + 2] = xv.z + gv.z * acc[q * 4 + 2]; y[q * 4 + 3] = xv.w + gv.w * acc[q * 4 + 3];
            ss += y[q * 4] * y[q * 4] + y[q * 4 + 1] * y[q * 4 + 1] + y[q * 4 + 2] * y[q * 4 + 2] + y[q * 4 + 3] * y[q * 4 + 3];
        }
        ss = wave_sum(ss);
        const float rstd = rsqrtf(ss * (1.f / 1024.f) + EPS);
#pragma unroll
        for (int q = 0; q < 4; ++q) {
            const int col = (q >> 1) * 512 + lane * 8 + (q & 1) * 4;
            const float4 gf = *(const float4*)(p.norm_f_g + col);
            *(float4*)(orow + col) = make_float4(y[q * 4] * rstd * gf.x, y[q * 4 + 1] * rstd * gf.y, y[q * 4 + 2] * rstd * gf.z, y[q * 4 + 3] * rstd * gf.w);
        }
    }
}

extern __shared__ __attribute__((aligned(16))) char dyn_smem[];

__device__ __forceinline__ void run_phase(const Params& p, int ph, char* smem, int bid, int nblk) {
    switch (ph) {
        case 0: phase_mod(p, smem, bid, nblk); phase_convert(p, smem, bid, nblk); break;
        case 1: phase_norm1(p, bid, nblk); break;
        case 2: { EpiInProj e{p.z, p.zg, p.gate_b}; gemm_phase(p.hbuf, p.winT, TT, PTP, 1024, e, smem, bid, nblk); } break;
        case 3: phase_mixers(p, smem, bid, nblk); break;
        case 4: phase_mixprep(p, bid, nblk); break;
        case 5: { EpiOutProj e{p.x, p.mod, p.out}; gemm_phase(p.hbuf, p.woutT, TL, 1024, 1024, e, smem, bid, nblk); } break;
        case 6: phase_norm2(p, bid, nblk); break;
        case 7: { EpiQ e{p.qbuf}; gemm_phase(p.hbuf, p.wqT, TL, 2048, 1024, e, smem, bid, nblk); } break;
        case 8: phase_topk(p, smem, bid, nblk); break;
        case 9: phase_gather(p, bid, nblk); break;
    }
}
constexpr int NPHASE = 10;

#if FUSED
__global__ void __launch_bounds__(NT, 2) mega_kernel(Params p) {
    cg::grid_group grid = cg::this_grid();
    for (int ph = 0; ph < NPHASE; ++ph) {
        run_phase(p, ph, dyn_smem, blockIdx.x, gridDim.x);
        if (ph + 1 < NPHASE) grid.sync();
    }
}
#else
template <int PH>
__global__ void __launch_bounds__(NT, 2) phase_kernel(Params p) { run_phase(p, PH, dyn_smem, blockIdx.x, gridDim.x); }
#endif

static inline char* carve(char*& cur, size_t bytes) { char* r = cur; cur += (bytes + 255) & ~(size_t)255; return r; }

extern "C" void kernel_launch(void* const* d_in, const int* in_sizes, int n_in, void* d_out, int out_size, void* d_ws, size_t ws_size, hipStream_t stream) {
    Params p{};
    p.x = (const float*)d_in[0]; p.c = (const float*)d_in[1]; p.ctx = (const float*)d_in[2]; p.c_ctx = (const float*)d_in[3];
    p.w_mod = (const float*)d_in[4]; p.b_mod = (const float*)d_in[5]; p.norm1_g = (const float*)d_in[6]; p.w_in = (const float*)d_in[7];
    p.conv_w = (const float*)d_in[8]; p.gate_b = (const float*)d_in[9]; p.ml_norm_g = (const float*)d_in[10]; p.lr_w2 = (const float*)d_in[11];
    p.alpha_b = (const float*)d_in[12]; p.gla_norm_g = (const float*)d_in[13]; p.w_out = (const float*)d_in[14]; p.norm2_g = (const float*)d_in[15];
    p.wq = (const float*)d_in[16]; p.keys = (const float*)d_in[17]; p.pu = (const float*)d_in[18]; p.pv = (const float*)d_in[19]; p.norm_f_g = (const float*)d_in[20];
    p.out = (float*)d_out;
    char* cur = (char*)d_ws;
    p.mod = (float*)carve(cur, (size_t)33 * 6144 * 4);
    p.winT = (bf16_t*)carve(cur, (size_t)PTP * 1024 * 2);
    p.woutT = (bf16_t*)carve(cur, (size_t)1024 * 1024 * 2);
    p.wqT = (bf16_t*)carve(cur, (size_t)2048 * 1024 * 2);
    p.keysb = (bf16_t*)carve(cur, (size_t)8 * 2 * 128 * 128 * 2);
    p.ub = (bf16_t*)carve(cur, (size_t)16384 * 1024 * 2);
    p.vb = (bf16_t*)carve(cur, (size_t)16384 * 1024 * 2);
    p.hbuf = (bf16_t*)carve(cur, (size_t)TT * 1024 * 2);
    p.z = (bf16_t*)carve(cur, (size_t)TT * ZS * 2);
    p.zg = (float*)carve(cur, (size_t)TT * 48 * 4);
    p.mixh = (bf16_t*)carve(cur, (size_t)2 * TL * 1024 * 2);
    p.qbuf = p.z;
    p.pidx = (int*)p.mixh;
    p.pgw = (float*)((char*)p.mixh + (size_t)TL * 128 * 4);
    if ((size_t)(cur - (char*)d_ws) > ws_size) { fprintf(stderr, "workspace too small: need %zu have %zu\n", (size_t)(cur - (char*)d_ws), ws_size); return; }
#if FUSED
    static int grid_blocks = 0;
    if (!grid_blocks) {
        int dev = 0, cus = 0, per_cu = 0;
        hipGetDevice(&dev);
        hipDeviceGetAttribute(&cus, hipDeviceAttributeMultiprocessorCount, dev);
        hipFuncSetAttribute((const void*)mega_kernel, hipFuncAttributeMaxDynamicSharedMemorySize, SMEM_BYTES);
        hipOccupancyMaxActiveBlocksPerMultiprocessor(&per_cu, mega_kernel, NT, SMEM_BYTES);
        if (per_cu > 2) per_cu = 2;
        grid_blocks = cus * per_cu;
    }
    void* args[] = {&p};
    hipError_t e = hipLaunchCooperativeKernel((void*)mega_kernel, dim3(grid_blocks), dim3(NT), args, SMEM_BYTES, stream);
    if (e != hipSuccess) fprintf(stderr, "cooperative launch failed: %s (grid %d)\n", hipGetErrorString(e), grid_blocks);
#else
    const int G = 512;
#define LAUNCH(PH) do { hipFuncSetAttribute((const void*)phase_kernel<PH>, hipFuncAttributeMaxDynamicSharedMemorySize, SMEM_BYTES); \
        hipLaunchKernelGGL(phase_kernel<PH>, dim3(G), dim3(NT), SMEM_BYTES, stream, p); } while (0)
    LAUNCH(0); LAUNCH(1); LAUNCH(2); LAUNCH(3); LAUNCH(4); LAUNCH(5); LAUNCH(6); LAUNCH(7); LAUNCH(8); LAUNCH(9);
#endif
}
```

```cpp
#include <hip/hip_runtime.h>
#include <hip/hip_cooperative_groups.h>
#include <cstdio>
#include <cstdint>
namespace cg = cooperative_groups;

#ifndef FUSED
#define FUSED 1
#endif
#define PROBE_REPEAT_MASK 0
#ifndef ML_CHUNKED
#define ML_CHUNKED 1
#endif
#ifndef GLA_CHUNKED
#define GLA_CHUNKED 1
#endif

typedef unsigned short bf16_t;
typedef short bf16x8 __attribute__((ext_vector_type(8)));
typedef float f32x4 __attribute__((ext_vector_type(4)));
typedef unsigned u32x4 __attribute__((ext_vector_type(4)));

constexpr int D = 1024, NB = 32, SEQ = 2048, CTX = 256;
constexpr int TL = NB * SEQ;
constexpr int TC = NB * CTX;
constexpr int TT = TL + TC;
constexpr int PT = 3632;
constexpr int PTP = 3840;
constexpr int ZS = 3632;
constexpr int C_MLQ = 0, C_MLK = 512, C_MLV = 1024, C_MLO = 1536, C_MLG = 2048, C_GQ = 2064, C_GK = 2320, C_GV = 2576, C_GR = 3088, C_LR = 3600;
constexpr int NT = 256;
constexpr int SMEM_BYTES = 80 * 1024;
constexpr float EPS = 1e-6f;

struct Params {
    const float *x, *c, *ctx, *c_ctx, *w_mod, *b_mod, *norm1_g, *w_in, *conv_w, *gate_b, *ml_norm_g, *lr_w2, *alpha_b, *gla_norm_g,
        *w_out, *norm2_g, *wq, *keys, *pu, *pv, *norm_f_g;
    float* out;
    float* mod;
    bf16_t* winT;
    bf16_t* woutT;
    bf16_t* wqT;
    bf16_t* keysb;
    bf16_t* ub;
    bf16_t* vb;
    bf16_t* hbuf;
    bf16_t* z;
    float* zg;
    bf16_t* mixh;
    bf16_t* qbuf;
    int* pidx;
    float* pgw;
};

__device__ __forceinline__ int opaque_tid() { int t = threadIdx.x; asm volatile("" : "+v"(t)); return t; }
__device__ __forceinline__ float bf2f(bf16_t v) { return __uint_as_float(((unsigned)v) << 16); }
__device__ __forceinline__ bf16_t f2bf(float f) { unsigned u = __float_as_uint(f); u += 0x7fffu + ((u >> 16) & 1u); return (bf16_t)(u >> 16); }
__device__ __forceinline__ unsigned pack2(float a, float b) { return (unsigned)f2bf(a) | ((unsigned)f2bf(b) << 16); }
__device__ __forceinline__ float lo2f(unsigned w) { return __uint_as_float(w << 16); }
__device__ __forceinline__ float hi2f(unsigned w) { return __uint_as_float(w & 0xffff0000u); }
__device__ __forceinline__ float wave_sum(float v) {
#pragma unroll
    for (int o = 32; o > 0; o >>= 1) v += __shfl_xor(v, o);
    return v;
}
__device__ __forceinline__ float wave_max(float v) {
#pragma unroll
    for (int o = 32; o > 0; o >>= 1) v = fmaxf(v, __shfl_xor(v, o));
    return v;
}
__device__ __forceinline__ float logsig(float x) { return fminf(x, 0.f) - log1pf(__expf(-fabsf(x))); }
__device__ __forceinline__ float silu(float x) { return x / (1.f + __expf(-x)); }
__device__ __forceinline__ float sigm(float x) { return 1.f / (1.f + __expf(-x)); }

__device__ void phase_mod(const Params& p, char* smem, int bid, int nblk) {
    const int tidx_ = opaque_tid();
    float* condL = (float*)smem;
    const int tid = tidx_, cl = tid & 63, ks = tid >> 6;
    for (int item = bid; item < 96; item += nblk) {
        const int col0 = item * 64, col = col0 + cl;
        float acc[33];
#pragma unroll
        for (int b = 0; b < 33; ++b) acc[b] = 0.f;
        for (int kc = 0; kc < 4; ++kc) {
            __syncthreads();
            for (int e = tid; e < 4 * 64 * 33; e += NT) {
                const int s = e / (64 * 33), kk = (e / 33) % 64, b = e % 33;
                const int k = s * 256 + kc * 64 + kk;
                const float cv = b < 32 ? p.c[b * 1024 + k] : p.c_ctx[k];
                condL[e] = silu(cv);
            }
            __syncthreads();
            for (int kk = 0; kk < 64; ++kk) {
                const int k = ks * 256 + kc * 64 + kk;
                const float w = p.w_mod[(size_t)k * 6144 + col];
                const float* cp = condL + (ks * 64 + kk) * 33;
#pragma unroll
                for (int b = 0; b < 33; ++b) acc[b] += w * cp[b];
            }
        }
        __syncthreads();
#pragma unroll
        for (int b = 0; b < 33; ++b) condL[(ks * 33 + b) * 64 + cl] = acc[b];
        __syncthreads();
        for (int e = tid; e < 33 * 64; e += NT) {
            const int b = e >> 6, cc = e & 63;
            float v = condL[(0 * 33 + b) * 64 + cc] + condL[(1 * 33 + b) * 64 + cc] + condL[(2 * 33 + b) * 64 + cc] + condL[(3 * 33 + b) * 64 + cc];
            p.mod[b * 6144 + col0 + cc] = v + p.b_mod[col0 + cc];
        }
        __syncthreads();
    }
}

__device__ void convT(const float* __restrict__ src, int K, int N, int Npad, bf16_t* __restrict__ dst, char* smem, int bid, int nblk) {
    const int tidx_ = opaque_tid();
    float* tile = (float*)smem;
    const int tid = tidx_;
    const int nk = K / 64, nn = Npad / 64;
    for (int t = bid; t < nk * nn; t += nblk) {
        const int k0 = (t % nk) * 64, n0 = (t / nk) * 64;
        __syncthreads();
#pragma unroll
        for (int r = 0; r < 16; ++r) {
            const int k = r * 4 + (tid >> 6), n = tid & 63;
            tile[k * 65 + n] = (n0 + n < N) ? src[(size_t)(k0 + k) * N + n0 + n] : 0.f;
        }
        __syncthreads();
#pragma unroll
        for (int r = 0; r < 16; ++r) {
            const int n = r * 4 + (tid >> 6), k = tid & 63;
            dst[(size_t)(n0 + n) * K + k0 + k] = f2bf(tile[k * 65 + n]);
        }
    }
    __syncthreads();
}
__device__ void conv_copy(const float* __restrict__ src, bf16_t* __restrict__ dst, size_t n, int gtid, int gthreads) {
    const size_t n4 = n / 4;
    for (size_t i = gtid; i < n4; i += gthreads) {
        const float4 v = ((const float4*)src)[i];
        uint2 o; o.x = pack2(v.x, v.y); o.y = pack2(v.z, v.w);
        ((uint2*)dst)[i] = o;
    }
}
__device__ void phase_convert(const Params& p, char* smem, int bid, int nblk) {
    const int tidx_ = opaque_tid();
    convT(p.w_in, 1024, PT, PTP, p.winT, smem, bid, nblk);
    convT(p.w_out, 1024, 1024, 1024, p.woutT, smem, bid, nblk);
    convT(p.wq, 1024, 2048, 2048, p.wqT, smem, bid, nblk);
    const int gtid = bid * NT + tidx_, gth = nblk * NT;
    conv_copy(p.keys, p.keysb, (size_t)8 * 2 * 128 * 128, gtid, gth);
    conv_copy(p.pu, p.ub, (size_t)16384 * 1024, gtid, gth);
    conv_copy(p.pv, p.vb, (size_t)16384 * 1024, gtid, gth);
}

__device__ void phase_norm1(const Params& p, int bid, int nblk) {
    const int tidx_ = opaque_tid();
    const int lane = tidx_ & 63;
    const int gw = bid * (NT / 64) + (tidx_ >> 6), nw = nblk * (NT / 64);
    for (int row = gw; row < TT; row += nw) {
        const float* src = row < TL ? p.x + (size_t)row * D : p.ctx + (size_t)(row - TL) * D;
        const float* md = p.mod + (row < TL ? (row >> 11) : 32) * 6144;
        float4 v[4]; float ss = 0.f;
#pragma unroll
        for (int j = 0; j < 4; ++j) { v[j] = *(const float4*)(src + j * 256 + lane * 4); ss += v[j].x * v[j].x + v[j].y * v[j].y + v[j].z * v[j].z + v[j].w * v[j].w; }
        ss = wave_sum(ss);
        const float rstd = rsqrtf(ss * (1.f / 1024.f) + EPS);
#pragma unroll
        for (int j = 0; j < 4; ++j) {
            const int col = j * 256 + lane * 4;
            const float4 g = *(const float4*)(p.norm1_g + col), sc = *(const float4*)(md + 1024 + col), sh = *(const float4*)(md + col);
            uint2 o;
            o.x = pack2(v[j].x * rstd * g.x * (1.f + sc.x) + sh.x, v[j].y * rstd * g.y * (1.f + sc.y) + sh.y);
            o.y = pack2(v[j].z * rstd * g.z * (1.f + sc.z) + sh.z, v[j].w * rstd * g.w * (1.f + sc.w) + sh.w);
            *(uint2*)(p.hbuf + (size_t)row * D + col) = o;
        }
    }
}

template <class Epi>
__device__ void gemm_phase(const bf16_t* __restrict__ A, const bf16_t* __restrict__ Bt, int M, int N, int K, const Epi& epi, char* smem, int bid, int nblk) {
    const int tidx_ = opaque_tid();
    constexpr int BM = 128, BN = 128, BK = 64, LS = 72;
    bf16_t* sA = (bf16_t*)smem;
    bf16_t* sB = sA + BM * LS;
    const int tid = tidx_, lane = tid & 63, w = tid >> 6, wr = w >> 1, wc = w & 1;
    const int nN = N / BN, ntiles = (M / BM) * nN;
    const int lr = tid >> 3, lc = (tid & 7) * 8;
    for (int tile = bid; tile < ntiles; tile += nblk) {
        const int tm = tile / nN, tn = tile % nN;
        const bf16_t* Ag = A + (size_t)(tm * BM) * K;
        const bf16_t* Bg = Bt + (size_t)(tn * BN) * K;
        f32x4 acc[4][4];
#pragma unroll
        for (int i = 0; i < 4; ++i)
#pragma unroll
            for (int j = 0; j < 4; ++j) acc[i][j] = (f32x4){0.f, 0.f, 0.f, 0.f};
        u32x4 ra[4], rb[4];
#pragma unroll
        for (int i = 0; i < 4; ++i) {
            ra[i] = *(const u32x4*)(Ag + (size_t)(lr + 32 * i) * K + lc);
            rb[i] = *(const u32x4*)(Bg + (size_t)(lr + 32 * i) * K + lc);
        }
        for (int k0 = 0; k0 < K; k0 += BK) {
            __syncthreads();
#pragma unroll
            for (int i = 0; i < 4; ++i) {
                *(u32x4*)(sA + (lr + 32 * i) * LS + lc) = ra[i];
                *(u32x4*)(sB + (lr + 32 * i) * LS + lc) = rb[i];
            }
            __syncthreads();
            {
                const int kn = (k0 + BK < K) ? k0 + BK : k0;
#pragma unroll
                for (int i = 0; i < 4; ++i) {
                    ra[i] = *(const u32x4*)(Ag + (size_t)(lr + 32 * i) * K + kn + lc);
                    rb[i] = *(const u32x4*)(Bg + (size_t)(lr + 32 * i) * K + kn + lc);
                }
            }
#pragma unroll
            for (int kk = 0; kk < 2; ++kk) {
                bf16x8 af[4], bfr[4];
#pragma unroll
                for (int i = 0; i < 4; ++i) {
                    af[i] = *(const bf16x8*)(sA + (wr * 64 + i * 16 + (lane & 15)) * LS + kk * 32 + (lane >> 4) * 8);
                    bfr[i] = *(const bf16x8*)(sB + (wc * 64 + i * 16 + (lane & 15)) * LS + kk * 32 + (lane >> 4) * 8);
                }
#pragma unroll
                for (int i = 0; i < 4; ++i)
#pragma unroll
                    for (int j = 0; j < 4; ++j) acc[i][j] = __builtin_amdgcn_mfma_f32_16x16x32_bf16(af[i], bfr[j], acc[i][j], 0, 0, 0);
            }
        }
#pragma unroll
        for (int i = 0; i < 4; ++i)
#pragma unroll
            for (int j = 0; j < 4; ++j)
#pragma unroll
                for (int r = 0; r < 4; ++r) {
                    const int row = tm * BM + wr * 64 + i * 16 + (lane >> 4) * 4 + r;
                    const int col = tn * BN + wc * 64 + j * 16 + (lane & 15);
                    epi(row, col, acc[i][j][r]);
                }
    }
    __syncthreads();
}

struct EpiInProj {
    bf16_t* z; float* zg; const float* gate_b;
    __device__ __forceinline__ void operator()(int row, int col, float v) const {
        if (col < C_MLG) z[(size_t)row * ZS + col] = f2bf(v);
        else if (col < C_GQ) zg[(size_t)row * 48 + (col - C_MLG)] = v + gate_b[col - C_MLG];
        else if (col < C_LR) z[(size_t)row * ZS + col] = f2bf(v);
        else if (col < PT) zg[(size_t)row * 48 + 16 + (col - C_LR)] = v;
    }
};
struct EpiOutProj {
    const float* x; const float* mod; float* out;
    __device__ __forceinline__ void operator()(int row, int col, float v) const {
        const size_t o = (size_t)row * D + col;
        out[o] = x[o] + mod[(row >> 11) * 6144 + 2048 + col] * v;
    }
};
struct EpiQ {
    bf16_t* q;
    __device__ __forceinline__ void operator()(int row, int col, float v) const { q[(size_t)row * 2048 + col] = f2bf(v); }
};


#define MFMA16(a, b, c) __builtin_amdgcn_mfma_f32_16x16x32_bf16((a), (b), (c), 0, 0, 0)
__device__ __forceinline__ void conv8(const Params& p, const bf16_t* zc, int col, bool vl, bool vr, float scl, float* y) {
    const u32x4 cc = *(const u32x4*)zc;
    u32x4 ll = (u32x4){0u, 0u, 0u, 0u}, rr = (u32x4){0u, 0u, 0u, 0u};
    if (vl) ll = *(const u32x4*)(zc - ZS);
    if (vr) rr = *(const u32x4*)(zc + ZS);
    const f32x4 w0a = *(const f32x4*)(p.conv_w + col), w0b = *(const f32x4*)(p.conv_w + col + 4);
    const f32x4 w1a = *(const f32x4*)(p.conv_w + 1024 + col), w1b = *(const f32x4*)(p.conv_w + 1024 + col + 4);
    const f32x4 w2a = *(const f32x4*)(p.conv_w + 2048 + col), w2b = *(const f32x4*)(p.conv_w + 2048 + col + 4);
    const float w0[8] = {w0a[0], w0a[1], w0a[2], w0a[3], w0b[0], w0b[1], w0b[2], w0b[3]};
    const float w1[8] = {w1a[0], w1a[1], w1a[2], w1a[3], w1b[0], w1b[1], w1b[2], w1b[3]};
    const float w2[8] = {w2a[0], w2a[1], w2a[2], w2a[3], w2b[0], w2b[1], w2b[2], w2b[3]};
#pragma unroll
    for (int j = 0; j < 4; ++j) {
        const float y0 = w0[2 * j] * lo2f(ll[j]) + w1[2 * j] * lo2f(cc[j]) + w2[2 * j] * lo2f(rr[j]);
        const float y1 = w0[2 * j + 1] * hi2f(ll[j]) + w1[2 * j + 1] * hi2f(cc[j]) + w2[2 * j + 1] * hi2f(rr[j]);
        y[2 * j] = silu(y0) * scl; y[2 * j + 1] = silu(y1) * scl;
    }
}

__device__ void mlstm_item_chunked(const Params& p, char* smem, int tid, int b, int h, int dir) {
    bf16_t* Qs = (bf16_t*)smem;
    bf16_t* Ks = Qs + 32 * 136;
    bf16_t* Ktw = Ks + 32 * 136;
    bf16_t* Vt = Ktw + 128 * 40;
    bf16_t* Ps = Vt + 144 * 40;
    bf16_t* Cb = Ps + 32 * 40;
    float* sg = (float*)(Cb + 144 * 136);
    float* sM = sg + 32; float* sinter = sg + 64; float* sfloor = sg + 96; float* sw = sg + 128; float* smisc = sg + 160;
    const int lane = tid & 63, w = __builtin_amdgcn_readfirstlane(tid >> 6), lr = lane & 15, lq = lane >> 4;
    for (int i = tid; i < 16 * 40; i += 256) Vt[128 * 40 + i] = 0x3f80;
    for (int i = tid; i < 144 * 136 / 2; i += 256) ((unsigned*)Cb)[i] = 0u;
    f32x4 CT[2][9];
#pragma unroll
    for (int i = 0; i < 2; ++i)
#pragma unroll
        for (int j = 0; j < 9; ++j) CT[i][j] = (f32x4){0.f, 0.f, 0.f, 0.f};
    float m_s = 0.f;
    __syncthreads();
    for (int bt = 0; bt < 72; ++bt) {
        const bool lat = bt >= 8;
        const int pos0 = lat ? (bt - 8) * 32 : bt * 32;
        const int seg = lat ? SEQ : CTX;
        const int nlo = dir ? seg - 32 - pos0 : pos0;
        const int rowbase = lat ? b * SEQ : TL + b * CTX;
        if (w == 0) {
            const int l = lane & 31;
            const int n = dir ? nlo + 31 - l : nlo + l;
            const float* gp = p.zg + (size_t)(rowbase + n) * 48 + dir * 8 + h;
            const float ig = gp[0], lf = logsig(gp[4]);
            float bsum = lf;
#pragma unroll
            for (int o = 1; o < 32; o <<= 1) { const float t = __shfl_up(bsum, o); if (l >= o) bsum += t; }
            const float g = ig - bsum;
            float cm = g;
#pragma unroll
            for (int o = 1; o < 32; o <<= 1) { const float t = __shfl_up(cm, o); if (l >= o) cm = fmaxf(cm, t); }
            const float M = fmaxf(m_s, cm);
            const float Ml = __shfl(M, 31), bl = __shfl(bsum, 31);
            if (lane < 32) {
                sg[l] = g; sM[l] = M; sinter[l] = __expf(m_s - M); sfloor[l] = __expf(-(bsum + M)); sw[l] = __expf(g - Ml);
                if (lane == 0) { smisc[0] = __expf(m_s - Ml); smisc[1] = bl + Ml; }
            }
        }
        __syncthreads();
        {
            const int l = tid & 31, c8 = tid >> 5;
            const int n = dir ? nlo + 31 - l : nlo + l;
            const bool vl = lat ? (((n - 1) >> 6) == (n >> 6)) : (n - 1 >= 0);
            const bool vr = lat ? (((n + 1) >> 6) == (n >> 6)) : (n + 1 < CTX);
            const bf16_t* zr = p.z + (size_t)(rowbase + n) * ZS;
            const float wl = sw[l];
#pragma unroll 1
            for (int r = 0; r < 2; ++r) {
                const int ec = c8 + 8 * r;
                float y[8];
                conv8(p, zr + C_MLK + h * 128 + ec * 8, C_MLK + h * 128 + ec * 8, vl, vr, 0.08838834764831845f, y);
                *(u32x4*)(Ks + l * 136 + ec * 8) = (u32x4){pack2(y[0], y[1]), pack2(y[2], y[3]), pack2(y[4], y[5]), pack2(y[6], y[7])};
#pragma unroll
                for (int j = 0; j < 8; ++j) Ktw[(ec * 8 + j) * 40 + l] = f2bf(y[j] * wl);
                if (lat) {
                    conv8(p, zr + C_MLQ + h * 128 + ec * 8, C_MLQ + h * 128 + ec * 8, vl, vr, 1.f, y);
                    *(u32x4*)(Qs + l * 136 + ec * 8) = (u32x4){pack2(y[0], y[1]), pack2(y[2], y[3]), pack2(y[4], y[5]), pack2(y[6], y[7])};
                }
                const u32x4 vv = *(const u32x4*)(zr + C_MLV + h * 128 + ec * 8);
#pragma unroll
                for (int j = 0; j < 4; ++j) { Vt[(ec * 8 + 2 * j) * 40 + l] = (bf16_t)(vv[j] & 0xffffu); Vt[(ec * 8 + 2 * j + 1) * 40 + l] = (bf16_t)(vv[j] >> 16); }
            }
        }
        __syncthreads();
        if (lat) {
            const int mi = w >> 1, ni = w & 1;
            f32x4 sa = (f32x4){0.f, 0.f, 0.f, 0.f};
            if (!(mi == 0 && ni == 1)) {
#pragma unroll
                for (int kk = 0; kk < 4; ++kk) {
                    const bf16x8 af = *(const bf16x8*)(Qs + (mi * 16 + lr) * 136 + kk * 32 + lq * 8);
                    const bf16x8 bf = *(const bf16x8*)(Ks + (ni * 16 + lr) * 136 + kk * 32 + lq * 8);
                    sa = MFMA16(af, bf, sa);
                }
            }
            const int sidx = ni * 16 + lr;
            const float gs = sg[sidx];
#pragma unroll
            for (int r = 0; r < 4; ++r) {
                const int t = mi * 16 + lq * 4 + r;
                const float pv = (sidx <= t) ? sa[r] * __expf(gs - sM[t]) : 0.f;
                Ps[t * 40 + sidx] = f2bf(pv);
            }
        }
        __syncthreads();
        if (lat) {
            const int nts[3] = {2 * w, 2 * w + 1, 8};
            f32x4 acc[2][3];
#pragma unroll
            for (int i = 0; i < 2; ++i)
#pragma unroll
                for (int j = 0; j < 3; ++j) acc[i][j] = (f32x4){0.f, 0.f, 0.f, 0.f};
#pragma unroll
            for (int kk = 0; kk < 4; ++kk) {
                bf16x8 af[2], bf[3];
#pragma unroll
                for (int i = 0; i < 2; ++i) af[i] = *(const bf16x8*)(Qs + (i * 16 + lr) * 136 + kk * 32 + lq * 8);
#pragma unroll
                for (int j = 0; j < 3; ++j) bf[j] = *(const bf16x8*)(Cb + (nts[j] * 16 + lr) * 136 + kk * 32 + lq * 8);
#pragma unroll
                for (int i = 0; i < 2; ++i)
#pragma unroll
                    for (int j = 0; j < 3; ++j) acc[i][j] = MFMA16(af[i], bf[j], acc[i][j]);
            }
#pragma unroll
            for (int i = 0; i < 2; ++i)
#pragma unroll
                for (int r = 0; r < 4; ++r) {
                    const float it = sinter[i * 16 + lq * 4 + r];
#pragma unroll
                    for (int j = 0; j < 3; ++j) acc[i][j][r] *= it;
                }
            {
                bf16x8 af[2], bf[3];
#pragma unroll
                for (int i = 0; i < 2; ++i) af[i] = *(const bf16x8*)(Ps + (i * 16 + lr) * 40 + lq * 8);
#pragma unroll
                for (int j = 0; j < 3; ++j) bf[j] = *(const bf16x8*)(Vt + (nts[j] * 16 + lr) * 40 + lq * 8);
#pragma unroll
                for (int i = 0; i < 2; ++i)
#pragma unroll
                    for (int j = 0; j < 3; ++j) acc[i][j] = MFMA16(af[i], bf[j], acc[i][j]);
            }
#pragma unroll
            for (int i = 0; i < 2; ++i)
#pragma unroll
                for (int r = 0; r < 4; ++r) {
                    const int t = i * 16 + lq * 4 + r;
                    const float dn = fmaxf(fabsf(acc[i][2][r]), sfloor[t]);
                    const float inv = 1.f / dn;
                    const int n = dir ? nlo + 31 - t : nlo + t;
                    bf16_t* orow = p.mixh + ((size_t)dir * TL + rowbase + n) * 1024 + h * 128;
#pragma unroll
                    for (int j = 0; j < 2; ++j) orow[nts[j] * 16 + lr] = f2bf(acc[i][j][r] * inv);
                }
        }
        __syncthreads();
        {
            const float a = smisc[0];
            bf16x8 af[2];
#pragma unroll
            for (int i = 0; i < 2; ++i) af[i] = *(const bf16x8*)(Ktw + ((2 * w + i) * 16 + lr) * 40 + lq * 8);
#pragma unroll
            for (int j = 0; j < 9; ++j) {
                const bf16x8 bf = *(const bf16x8*)(Vt + (j * 16 + lr) * 40 + lq * 8);
#pragma unroll
                for (int i = 0; i < 2; ++i) {
                    CT[i][j] = CT[i][j] * a;
                    CT[i][j] = MFMA16(af[i], bf, CT[i][j]);
                    uint2 pk; pk.x = pack2(CT[i][j][0], CT[i][j][1]); pk.y = pack2(CT[i][j][2], CT[i][j][3]);
                    *(uint2*)(Cb + (j * 16 + lr) * 136 + (2 * w + i) * 16 + lq * 4) = pk;
                }
            }
            m_s = smisc[1];
        }
        __syncthreads();
    }
}

__device__ void gla_item_chunked(const Params& p, char* smem, int tid, int b, int h, int dir) {
    bf16_t* Qd = (bf16_t*)smem;
    bf16_t* Qb = Qd + 32 * 72;
    bf16_t* Kd = Qb + 32 * 72;
    bf16_t* Kwt = Kd + 32 * 72;
    bf16_t* Vt = Kwt + 64 * 40;
    bf16_t* Ps = Vt + 128 * 40;
    bf16_t* Sb = Ps + 32 * 40;
    float* bc = (float*)(Sb + 128 * 72);
    const int lane = tid & 63, w = __builtin_amdgcn_readfirstlane(tid >> 6), lr = lane & 15, lq = lane >> 4;
    for (int i = tid; i < 128 * 72 / 2; i += 256) ((unsigned*)Sb)[i] = 0u;
    f32x4 S[8];
#pragma unroll
    for (int j = 0; j < 8; ++j) S[j] = (f32x4){0.f, 0.f, 0.f, 0.f};
    __syncthreads();
    for (int bt = 0; bt < 72; ++bt) {
        const bool lat = bt >= 8;
        const int pos0 = lat ? (bt - 8) * 32 : bt * 32;
        const int seg = lat ? SEQ : CTX;
        const int nlo = dir ? seg - 32 - pos0 : pos0;
        const int rowbase = lat ? b * SEQ : TL + b * CTX;
        {
            const int dd = tid & 63;
            float w2[16];
#pragma unroll
            for (int q = 0; q < 16; ++q) w2[q] = p.lr_w2[(dir * 16 + q) * 256 + h * 64 + dd];
            const float ab = p.alpha_b[dir * 256 + h * 64 + dd];
#pragma unroll
            for (int r = 0; r < 8; ++r) {
                const int l = (tid >> 6) + 4 * r;
                const int n = dir ? nlo + 31 - l : nlo + l;
                const float* lrp = p.zg + (size_t)(rowbase + n) * 48 + 16 + dir * 16;
                float al = ab;
#pragma unroll
                for (int q = 0; q < 16; ++q) al += lrp[q] * w2[q];
                bc[l * 64 + dd] = logsig(al) * (1.f / 16.f);
            }
        }
        __syncthreads();
        if (tid < 64) {
            float run = 0.f;
#pragma unroll 8
            for (int l = 0; l < 32; ++l) { run += bc[l * 64 + tid]; bc[l * 64 + tid] = run; }
        }
        __syncthreads();
        {
            const int l = tid & 31, dc = tid >> 5;
            const int n = dir ? nlo + 31 - l : nlo + l;
            const bf16_t* zr = p.z + (size_t)(rowbase + n) * ZS;
            float bl[8], rf[8], be[8];
#pragma unroll
            for (int j = 0; j < 8; ++j) { bl[j] = bc[l * 64 + dc * 8 + j]; rf[j] = bc[16 * 64 + dc * 8 + j]; be[j] = bc[31 * 64 + dc * 8 + j]; }
            {
                const u32x4 kk = *(const u32x4*)(zr + C_GK + h * 64 + dc * 8);
                float kf[8];
#pragma unroll
                for (int j = 0; j < 4; ++j) { kf[2 * j] = lo2f(kk[j]); kf[2 * j + 1] = hi2f(kk[j]); }
                float kd[8];
#pragma unroll
                for (int j = 0; j < 8; ++j) { kd[j] = kf[j] * __expf(rf[j] - bl[j]); Kwt[(dc * 8 + j) * 40 + l] = f2bf(kf[j] * __expf(be[j] - bl[j])); }
                *(u32x4*)(Kd + l * 72 + dc * 8) = (u32x4){pack2(kd[0], kd[1]), pack2(kd[2], kd[3]), pack2(kd[4], kd[5]), pack2(kd[6], kd[7])};
            }
            if (lat) {
                const u32x4 qq = *(const u32x4*)(zr + C_GQ + h * 64 + dc * 8);
                float qf[8];
#pragma unroll
                for (int j = 0; j < 4; ++j) { qf[2 * j] = lo2f(qq[j]) * 0.125f; qf[2 * j + 1] = hi2f(qq[j]) * 0.125f; }
                float qd[8], qb[8];
#pragma unroll
                for (int j = 0; j < 8; ++j) { qd[j] = qf[j] * __expf(bl[j] - rf[j]); qb[j] = qf[j] * __expf(bl[j]); }
                *(u32x4*)(Qd + l * 72 + dc * 8) = (u32x4){pack2(qd[0], qd[1]), pack2(qd[2], qd[3]), pack2(qd[4], qd[5]), pack2(qd[6], qd[7])};
                *(u32x4*)(Qb + l * 72 + dc * 8) = (u32x4){pack2(qb[0], qb[1]), pack2(qb[2], qb[3]), pack2(qb[4], qb[5]), pack2(qb[6], qb[7])};
            }
#pragma unroll
            for (int r = 0; r < 2; ++r) {
                const int ec = dc + 8 * r;
                const u32x4 vv = *(const u32x4*)(zr + C_GV + h * 128 + ec * 8);
#pragma unroll
                for (int j = 0; j < 4; ++j) { Vt[(ec * 8 + 2 * j) * 40 + l] = (bf16_t)(vv[j] & 0xffffu); Vt[(ec * 8 + 2 * j + 1) * 40 + l] = (bf16_t)(vv[j] >> 16); }
            }
        }
        __syncthreads();
        if (lat) {
            const int mi = w >> 1, ni = w & 1;
            f32x4 sa = (f32x4){0.f, 0.f, 0.f, 0.f};
            if (!(mi == 0 && ni == 1)) {
#pragma unroll
                for (int kk = 0; kk < 2; ++kk) {
                    const bf16x8 af = *(const bf16x8*)(Qd + (mi * 16 + lr) * 72 + kk * 32 + lq * 8);
                    const bf16x8 bf = *(const bf16x8*)(Kd + (ni * 16 + lr) * 72 + kk * 32 + lq * 8);
                    sa = MFMA16(af, bf, sa);
                }
            }
            const int sidx = ni * 16 + lr;
#pragma unroll
            for (int r = 0; r < 4; ++r) {
                const int t = mi * 16 + lq * 4 + r;
                Ps[t * 40 + sidx] = f2bf((sidx <= t) ? sa[r] : 0.f);
            }
        }
        __syncthreads();
        if (lat) {
            f32x4 acc[2][2];
#pragma unroll
            for (int i = 0; i < 2; ++i)
#pragma unroll
                for (int j = 0; j < 2; ++j) acc[i][j] = (f32x4){0.f, 0.f, 0.f, 0.f};
#pragma unroll
            for (int kk = 0; kk < 2; ++kk) {
                bf16x8 af[2], bf[2];
#pragma unroll
                for (int i = 0; i < 2; ++i) af[i] = *(const bf16x8*)(Qb + (i * 16 + lr) * 72 + kk * 32 + lq * 8);
#pragma unroll
                for (int j = 0; j < 2; ++j) bf[j] = *(const bf16x8*)(Sb + ((2 * w + j) * 16 + lr) * 72 + kk * 32 + lq * 8);
#pragma unroll
                for (int i = 0; i < 2; ++i)
#pragma unroll
                    for (int j = 0; j < 2; ++j) acc[i][j] = MFMA16(af[i], bf[j], acc[i][j]);
            }
            {
                bf16x8 af[2], bf[2];
#pragma unroll
                for (int i = 0; i < 2; ++i) af[i] = *(const bf16x8*)(Ps + (i * 16 + lr) * 40 + lq * 8);
#pragma unroll
                for (int j = 0; j < 2; ++j) bf[j] = *(const bf16x8*)(Vt + ((2 * w + j) * 16 + lr) * 40 + lq * 8);
#pragma unroll
                for (int i = 0; i < 2; ++i)
#pragma unroll
                    for (int j = 0; j < 2; ++j) acc[i][j] = MFMA16(af[i], bf[j], acc[i][j]);
            }
#pragma unroll
            for (int i = 0; i < 2; ++i)
#pragma unroll
                for (int r = 0; r < 4; ++r) {
                    const int t = i * 16 + lq * 4 + r;
                    const int n = dir ? nlo + 31 - t : nlo + t;
                    bf16_t* orow = p.mixh + ((size_t)dir * TL + rowbase + n) * 1024 + 512 + h * 128;
#pragma unroll
                    for (int j = 0; j < 2; ++j) orow[(2 * w + j) * 16 + lr] = f2bf(acc[i][j][r]);
                }
        }
        __syncthreads();
        {
            float rs[4];
#pragma unroll
            for (int r = 0; r < 4; ++r) rs[r] = __expf(bc[31 * 64 + w * 16 + lq * 4 + r]);
            const bf16x8 af = *(const bf16x8*)(Kwt + (w * 16 + lr) * 40 + lq * 8);
#pragma unroll
            for (int j = 0; j < 8; ++j) {
                const bf16x8 bf = *(const bf16x8*)(Vt + (j * 16 + lr) * 40 + lq * 8);
#pragma unroll
                for (int r = 0; r < 4; ++r) S[j][r] *= rs[r];
                S[j] = MFMA16(af, bf, S[j]);
                uint2 pk; pk.x = pack2(S[j][0], S[j][1]); pk.y = pack2(S[j][2], S[j][3]);
                *(uint2*)(Sb + (j * 16 + lr) * 72 + w * 16 + lq * 4) = pk;
            }
        }
        __syncthreads();
    }
}

__device__ void phase_mixers(const Params& p, char* smem, int bid, int nblk) {
    const int tidx_ = opaque_tid();
    float* L = (float*)smem;
    const int stid = tidx_, lane = stid & 63;
    for (int item = bid; item < 512; item += nblk) {
        const bool isml = item < 256;
        const int it = item & 255, b = it >> 3, h = (it >> 1) & 3, dir = it & 1;
#if ML_CHUNKED
        if (isml) { mlstm_item_chunked(p, smem, stid, b, h, dir); __syncthreads(); continue; }
#endif
#if GLA_CHUNKED
        if (!isml) { gla_item_chunked(p, smem, stid, b, h, dir); __syncthreads(); continue; }
#endif
#if !ML_CHUNKED
        if (isml) {
            float* qs = L; float* ks = L + 4096; float* vs = L + 8192; float* numb = L + 12288;
            float* igs = L + 16384; float* lfs = L + 16416; float* denp = L + 16448; float* mb = L + 16512;
            float C[64];
#pragma unroll
            for (int e = 0; e < 64; ++e) C[e] = 0.f;
            float nreg = 0.f, m = 0.f;
            const int d = stid >> 1, e0 = (stid & 1) * 64;
            for (int bt = 0; bt < 72; ++bt) {
                const bool lat = bt >= 8;
                const int pos0 = lat ? (bt - 8) * 32 : bt * 32;
                const int seg = lat ? SEQ : CTX;
                const int nlo = dir ? seg - 32 - pos0 : pos0;
                const int rowbase = lat ? b * SEQ : TL + b * CTX;
#pragma unroll
                for (int r = 0; r < 4; ++r) {
                    const int wi = stid + 256 * r, which = wi >> 9, i = (wi >> 4) & 31, ch = (wi & 15) * 8;
                    if (which == 0 && !lat) continue;
                    const int n = dir ? nlo + 31 - i : nlo + i;
                    const int col = which * 512 + h * 128 + ch;
                    const bool vl = lat ? (((n - 1) >> 6) == (n >> 6)) : (n - 1 >= 0);
                    const bool vr = lat ? (((n + 1) >> 6) == (n >> 6)) : (n + 1 < CTX);
                    const bf16_t* zc = p.z + (size_t)(rowbase + n) * ZS + col;
                    const uint4 cc = *(const uint4*)zc;
                    uint4 ll = make_uint4(0, 0, 0, 0), rr = make_uint4(0, 0, 0, 0);
                    if (vl) ll = *(const uint4*)(zc - ZS);
                    if (vr) rr = *(const uint4*)(zc + ZS);
                    const unsigned cw[4] = {cc.x, cc.y, cc.z, cc.w}, lw[4] = {ll.x, ll.y, ll.z, ll.w}, rw[4] = {rr.x, rr.y, rr.z, rr.w};
                    float* dst = (which ? ks : qs) + i * 128 + ch;
                    const float scl = which ? 0.08838834764831845f : 1.f;
#pragma unroll
                    for (int j = 0; j < 4; ++j) {
                        const int c0 = col + 2 * j;
                        const float y0 = p.conv_w[c0] * lo2f(lw[j]) + p.conv_w[1024 + c0] * lo2f(cw[j]) + p.conv_w[2048 + c0] * lo2f(rw[j]);
                        const float y1 = p.conv_w[c0 + 1] * hi2f(lw[j]) + p.conv_w[1024 + c0 + 1] * hi2f(cw[j]) + p.conv_w[2048 + c0 + 1] * hi2f(rw[j]);
                        dst[2 * j] = silu(y0) * scl; dst[2 * j + 1] = silu(y1) * scl;
                    }
                }
#pragma unroll
                for (int r = 0; r < 2; ++r) {
                    const int wi = stid + 256 * r, i = wi >> 4, ch = (wi & 15) * 8;
                    const int n = dir ? nlo + 31 - i : nlo + i;
                    const uint4 cc = *(const uint4*)(p.z + (size_t)(rowbase + n) * ZS + C_MLV + h * 128 + ch);
                    float* dst = vs + i * 128 + ch;
                    dst[0] = lo2f(cc.x); dst[1] = hi2f(cc.x); dst[2] = lo2f(cc.y); dst[3] = hi2f(cc.y);
                    dst[4] = lo2f(cc.z); dst[5] = hi2f(cc.z); dst[6] = lo2f(cc.w); dst[7] = hi2f(cc.w);
                }
                if (stid < 32) {
                    const int n = dir ? nlo + 31 - stid : nlo + stid;
                    const float* g = p.zg + (size_t)(rowbase + n) * 48 + dir * 8 + h;
                    igs[stid] = g[0]; lfs[stid] = logsig(g[4]);
                }
                __syncthreads();
                for (int i = 0; i < 32; ++i) {
                    const float lf = lfs[i], ig = igs[i];
                    const float mn = fmaxf(lf + m, ig);
                    const float a = __expf(lf + m - mn), bi = __expf(ig - mn);
                    m = mn;
                    const float vd = vs[i * 128 + d] * bi;
                    const float4* kp = (const float4*)(ks + i * 128 + e0);
                    const float4* qp = (const float4*)(qs + i * 128 + e0);
                    float num = 0.f;
#pragma unroll
                    for (int j = 0; j < 16; ++j) {
                        const float4 kv = kp[j];
                        C[4 * j + 0] = a * C[4 * j + 0] + vd * kv.x; C[4 * j + 1] = a * C[4 * j + 1] + vd * kv.y;
                        C[4 * j + 2] = a * C[4 * j + 2] + vd * kv.z; C[4 * j + 3] = a * C[4 * j + 3] + vd * kv.w;
                        if (lat) { const float4 qv = qp[j]; num += C[4 * j + 0] * qv.x + C[4 * j + 1] * qv.y + C[4 * j + 2] * qv.z + C[4 * j + 3] * qv.w; }
                    }
                    if (stid < 128) {
                        nreg = a * nreg + bi * ks[i * 128 + stid];
                        if (lat) { float pd = nreg * qs[i * 128 + stid]; pd = wave_sum(pd); if (lane == 0) denp[i * 2 + (stid >> 6)] = pd; }
                    }
                    if (lat) { num += __shfl_xor(num, 1); if (!(stid & 1)) numb[i * 128 + d] = num; }
                    if (stid == 0) mb[i] = m;
                }
                __syncthreads();
                if (lat) {
                    for (int idx = stid; idx < 4096; idx += 256) {
                        const int i = idx >> 7, dd = idx & 127;
                        const float den = denp[2 * i] + denp[2 * i + 1];
                        const float hv = numb[idx] / fmaxf(fabsf(den), __expf(-mb[i]));
                        const int n = dir ? nlo + 31 - i : nlo + i;
                        p.mixh[((size_t)dir * TL + rowbase + n) * 1024 + h * 128 + dd] = f2bf(hv);
                    }
                }
                __syncthreads();
            }
        }
#endif
#if !GLA_CHUNKED
        if (!isml) {
            float* qs = L; float* ks = L + 2048; float* dec = L + 4096; float* vs = L + 6144; float* ob = L + 10240;
            float S[32];
#pragma unroll
            for (int e = 0; e < 32; ++e) S[e] = 0.f;
            const int e = stid >> 1, d0 = (stid & 1) * 32;
            for (int bt = 0; bt < 72; ++bt) {
                const bool lat = bt >= 8;
                const int pos0 = lat ? (bt - 8) * 32 : bt * 32;
                const int seg = lat ? SEQ : CTX;
                const int nlo = dir ? seg - 32 - pos0 : pos0;
                const int rowbase = lat ? b * SEQ : TL + b * CTX;
#pragma unroll
                for (int r = 0; r < 2; ++r) {
                    const int wi = stid + 256 * r, which = wi >> 8, i = (wi >> 3) & 31, ch = (wi & 7) * 8;
                    if (which == 0 && !lat) continue;
                    const int n = dir ? nlo + 31 - i : nlo + i;
                    const uint4 cc = *(const uint4*)(p.z + (size_t)(rowbase + n) * ZS + (which ? C_GK : C_GQ) + h * 64 + ch);
                    float* dst = (which ? ks : qs) + i * 64 + ch;
                    const float scl = which ? 1.f : 0.125f;
                    dst[0] = lo2f(cc.x) * scl; dst[1] = hi2f(cc.x) * scl; dst[2] = lo2f(cc.y) * scl; dst[3] = hi2f(cc.y) * scl;
                    dst[4] = lo2f(cc.z) * scl; dst[5] = hi2f(cc.z) * scl; dst[6] = lo2f(cc.w) * scl; dst[7] = hi2f(cc.w) * scl;
                }
#pragma unroll
                for (int r = 0; r < 2; ++r) {
                    const int wi = stid + 256 * r, i = wi >> 4, ch = (wi & 15) * 8;
                    const int n = dir ? nlo + 31 - i : nlo + i;
                    const uint4 cc = *(const uint4*)(p.z + (size_t)(rowbase + n) * ZS + C_GV + h * 128 + ch);
                    float* dst = vs + i * 128 + ch;
                    dst[0] = lo2f(cc.x); dst[1] = hi2f(cc.x); dst[2] = lo2f(cc.y); dst[3] = hi2f(cc.y);
                    dst[4] = lo2f(cc.z); dst[5] = hi2f(cc.z); dst[6] = lo2f(cc.w); dst[7] = hi2f(cc.w);
                }
#pragma unroll
                for (int r = 0; r < 8; ++r) {
                    const int wi = stid + 256 * r, i = wi >> 6, dd = wi & 63;
                    const int n = dir ? nlo + 31 - i : nlo + i;
                    const float* lr = p.zg + (size_t)(rowbase + n) * 48 + 16 + dir * 16;
                    float al = p.alpha_b[dir * 256 + h * 64 + dd];
#pragma unroll
                    for (int q = 0; q < 16; ++q) al += lr[q] * p.lr_w2[(dir * 16 + q) * 256 + h * 64 + dd];
                    dec[i * 64 + dd] = __expf(logsig(al) * (1.f / 16.f));
                }
                __syncthreads();
                for (int i = 0; i < 32; ++i) {
                    const float ve = vs[i * 128 + e];
                    const float4* dp = (const float4*)(dec + i * 64 + d0);
                    const float4* kp = (const float4*)(ks + i * 64 + d0);
                    const float4* qp = (const float4*)(qs + i * 64 + d0);
                    float o = 0.f;
#pragma unroll
                    for (int j = 0; j < 8; ++j) {
                        const float4 dv = dp[j], kv = kp[j];
                        S[4 * j + 0] = dv.x * S[4 * j + 0] + kv.x * ve; S[4 * j + 1] = dv.y * S[4 * j + 1] + kv.y * ve;
                        S[4 * j + 2] = dv.z * S[4 * j + 2] + kv.z * ve; S[4 * j + 3] = dv.w * S[4 * j + 3] + kv.w * ve;
                        if (lat) { const float4 qv = qp[j]; o += qv.x * S[4 * j + 0] + qv.y * S[4 * j + 1] + qv.z * S[4 * j + 2] + qv.w * S[4 * j + 3]; }
                    }
                    if (lat) { o += __shfl_xor(o, 1); if (!(stid & 1)) ob[i * 128 + e] = o; }
                }
                __syncthreads();
                if (lat) {
                    for (int idx = stid; idx < 4096; idx += 256) {
                        const int i = idx >> 7, ee = idx & 127;
                        const int n = dir ? nlo + 31 - i : nlo + i;
                        p.mixh[((size_t)dir * TL + rowbase + n) * 1024 + 512 + h * 128 + ee] = f2bf(ob[idx]);
                    }
                }
                __syncthreads();
            }
        }
#endif
    }
}

__device__ void phase_mixprep(const Params& p, int bid, int nblk) {
    const int tidx_ = opaque_tid();
    const int lane = tidx_ & 63;
    const int gw = bid * (NT / 64) + (tidx_ >> 6), nw = nblk * (NT / 64);
    const int c0 = lane * 16;
    for (int row = gw; row < TL; row += nw) {
        const uint4* a0 = (const uint4*)(p.mixh + (size_t)row * 1024 + c0);
        const uint4* a1 = (const uint4*)(p.mixh + ((size_t)TL + row) * 1024 + c0);
        const uint4* gp = (const uint4*)(p.z + (size_t)row * ZS + (c0 < 512 ? C_MLO + c0 : C_GR + (c0 - 512)));
        const float* gn = c0 < 512 ? p.ml_norm_g + c0 : p.gla_norm_g + (c0 - 512);
        float s[16], gt[16];
#pragma unroll
        for (int q = 0; q < 2; ++q) {
            const uint4 u0 = a0[q], u1 = a1[q], ug = gp[q];
            const unsigned w0[4] = {u0.x, u0.y, u0.z, u0.w}, w1[4] = {u1.x, u1.y, u1.z, u1.w}, wg[4] = {ug.x, ug.y, ug.z, ug.w};
#pragma unroll
            for (int j = 0; j < 4; ++j) {
                s[q * 8 + 2 * j] = lo2f(w0[j]) + lo2f(w1[j]); s[q * 8 + 2 * j + 1] = hi2f(w0[j]) + hi2f(w1[j]);
                gt[q * 8 + 2 * j] = lo2f(wg[j]); gt[q * 8 + 2 * j + 1] = hi2f(wg[j]);
            }
        }
        float ss = 0.f;
#pragma unroll
        for (int j = 0; j < 16; ++j) ss += s[j] * s[j];
        ss += __shfl_xor(ss, 1); ss += __shfl_xor(ss, 2); ss += __shfl_xor(ss, 4);
        const float rstd = rsqrtf(ss * (1.f / 128.f) + EPS);
        unsigned o[8];
#pragma unroll
        for (int j = 0; j < 8; ++j) {
            float y0, y1;
            const float g0 = gt[2 * j], g1 = gt[2 * j + 1];
            if (c0 < 512) { y0 = sigm(g0); y1 = sigm(g1); } else { y0 = silu(g0); y1 = silu(g1); }
            y0 *= s[2 * j] * rstd * gn[2 * j]; y1 *= s[2 * j + 1] * rstd * gn[2 * j + 1];
            o[j] = pack2(y0, y1);
        }
        uint4* dst = (uint4*)(p.hbuf + (size_t)row * D + c0);
        dst[0] = make_uint4(o[0], o[1], o[2], o[3]); dst[1] = make_uint4(o[4], o[5], o[6], o[7]);
    }
}

__device__ void phase_norm2(const Params& p, int bid, int nblk) {
    const int tidx_ = opaque_tid();
    const int lane = tidx_ & 63;
    const int gw = bid * (NT / 64) + (tidx_ >> 6), nw = nblk * (NT / 64);
    for (int row = gw; row < TL; row += nw) {
        const float* src = p.out + (size_t)row * D;
        const float* md = p.mod + (row >> 11) * 6144;
        float4 v[4]; float ss = 0.f;
#pragma unroll
        for (int j = 0; j < 4; ++j) { v[j] = *(const float4*)(src + j * 256 + lane * 4); ss += v[j].x * v[j].x + v[j].y * v[j].y + v[j].z * v[j].z + v[j].w * v[j].w; }
        ss = wave_sum(ss);
        const float rstd = rsqrtf(ss * (1.f / 1024.f) + EPS);
#pragma unroll
        for (int j = 0; j < 4; ++j) {
            const int col = j * 256 + lane * 4;
            const float4 g = *(const float4*)(p.norm2_g + col), sc = *(const float4*)(md + 4096 + col), sh = *(const float4*)(md + 3072 + col);
            uint2 o;
            o.x = pack2(v[j].x * rstd * g.x * (1.f + sc.x) + sh.x, v[j].y * rstd * g.y * (1.f + sc.y) + sh.y);
            o.y = pack2(v[j].z * rstd * g.z * (1.f + sc.z) + sh.z, v[j].w * rstd * g.w * (1.f + sc.w) + sh.w);
            *(uint2*)(p.hbuf + (size_t)row * D + col) = o;
        }
    }
}

__device__ __forceinline__ unsigned fkey(float f) { const unsigned u = __float_as_uint(f); return (u & 0x80000000u) ? ~u : (u | 0x80000000u); }
__device__ __forceinline__ int mbcnt64(unsigned long long m) { return __builtin_amdgcn_mbcnt_hi((unsigned)(m >> 32), __builtin_amdgcn_mbcnt_lo((unsigned)m, 0)); }
#define LDS_FENCE() asm volatile("s_waitcnt lgkmcnt(0)" ::: "memory")

template <int NV>
__device__ __forceinline__ void wave_top16(const float (&val)[NV], const int (&tag)[NV], float* outv, int* outt) {
    unsigned u[NV];
#pragma unroll
    for (int v = 0; v < NV; ++v) u[v] = fkey(val[v]);
    unsigned T = 0;
    for (int bit = 31; bit >= 0; --bit) {
        const unsigned cand = T | (1u << bit);
        int cnt = 0;
#pragma unroll
        for (int v = 0; v < NV; ++v) cnt += __popcll(__ballot(u[v] >= cand));
        if (cnt >= 16) T = cand;
    }
    int base = 0;
#pragma unroll
    for (int v = 0; v < NV; ++v) {
        const bool gt = u[v] > T;
        const unsigned long long mk = __ballot(gt);
        const int pos = base + mbcnt64(mk);
        if (gt) { outv[pos] = val[v]; outt[pos] = tag[v]; }
        base += __popcll(mk);
    }
#pragma unroll
    for (int v = 0; v < NV; ++v) {
        const bool eq = u[v] == T;
        const unsigned long long mk = __ballot(eq);
        const int pos = base + mbcnt64(mk);
        if (eq && pos < 16) { outv[pos] = val[v]; outt[pos] = tag[v]; }
        base += __popcll(mk);
    }
}

__device__ void phase_topk(const Params& p, char* smem, int bid, int nblk) {
    const int tidx_ = opaque_tid();
    constexpr int KS = 136;
    bf16_t* keysL = (bf16_t*)smem;
    const int tid = tidx_, lane = tid & 63, w = tid >> 6;
    float* wsc = (float*)(smem + 2 * 128 * KS * 2) + w * 320;
    float* qrow = wsc; float* tops = wsc + 256; int* topi = (int*)(wsc + 288);
    constexpr int CH = 256;
    for (int item = bid; item < 8 * (TL / CH); item += nblk) {
        const int ph = item & 7, t0 = (item >> 3) * CH;
        __syncthreads();
        for (int e = tid; e < 2 * 128 * 16; e += NT) {
            const int r = e >> 4, ch = (e & 15) * 8;
            *(uint4*)(keysL + r * KS + ch) = *(const uint4*)(p.keysb + (size_t)ph * 2 * 128 * 128 + r * 128 + ch);
        }
        __syncthreads();
        for (int t = t0 + w; t < t0 + CH; t += NT / 64) {
            {
                const uint2 qq = *(const uint2*)(p.qbuf + (size_t)t * 2048 + ph * 256 + lane * 4);
                *(float4*)(qrow + lane * 4) = make_float4(lo2f(qq.x), hi2f(qq.x), lo2f(qq.y), hi2f(qq.y));
            }
            LDS_FENCE();
#pragma unroll
            for (int hh = 0; hh < 2; ++hh) {
                float s0 = 0.f, s1 = 0.f;
                const bf16_t* k0p = keysL + (hh * 128 + lane) * KS;
                const bf16_t* k1p = k0p + 64 * KS;
                const float* qp = qrow + hh * 128;
#pragma unroll 4
                for (int dc = 0; dc < 16; ++dc) {
                    const float4 qa = *(const float4*)(qp + dc * 8), qb = *(const float4*)(qp + dc * 8 + 4);
                    const uint4 ka = *(const uint4*)(k0p + dc * 8), kb = *(const uint4*)(k1p + dc * 8);
                    s0 += qa.x * lo2f(ka.x) + qa.y * hi2f(ka.x) + qa.z * lo2f(ka.y) + qa.w * hi2f(ka.y) + qb.x * lo2f(ka.z) + qb.y * hi2f(ka.z) + qb.z * lo2f(ka.w) + qb.w * hi2f(ka.w);
                    s1 += qa.x * lo2f(kb.x) + qa.y * hi2f(kb.x) + qa.z * lo2f(kb.y) + qa.w * hi2f(kb.y) + qb.x * lo2f(kb.z) + qb.y * hi2f(kb.z) + qb.z * lo2f(kb.w) + qb.w * hi2f(kb.w);
                }
                const float vv[2] = {s0, s1}; const int tg[2] = {lane, lane + 64};
                wave_top16<2>(vv, tg, tops + hh * 16, topi + hh * 16);
            }
            LDS_FENCE();
            float cv[4]; int ct[4];
#pragma unroll
            for (int j = 0; j < 4; ++j) { const int cidx = lane * 4 + j; cv[j] = tops[cidx >> 4] + tops[16 + (cidx & 15)]; ct[j] = cidx; }
            float* bs = qrow; int* bc = (int*)(qrow + 16);
            LDS_FENCE();
            wave_top16<4>(cv, ct, bs, bc);
            LDS_FENCE();
            const float sv = lane < 16 ? bs[lane] : -3.0e38f;
            const int cc = lane < 16 ? bc[lane] : 0;
            const float mx = wave_max(sv);
            const float ev = lane < 16 ? __expf(sv - mx) : 0.f;
            const float sm = wave_sum(ev);
            if (lane < 16) {
                const int idx = topi[cc >> 4] * 128 + topi[16 + (cc & 15)];
                p.pidx[(size_t)t * 128 + ph * 16 + lane] = idx;
                p.pgw[(size_t)t * 128 + ph * 16 + lane] = ev / sm;
            }
            LDS_FENCE();
        }
    }
    __syncthreads();
}

__device__ __forceinline__ void unpack8(const uint4 u, float* f) {
    f[0] = lo2f(u.x); f[1] = hi2f(u.x); f[2] = lo2f(u.y); f[3] = hi2f(u.y); f[4] = lo2f(u.z); f[5] = hi2f(u.z); f[6] = lo2f(u.w); f[7] = hi2f(u.w);
}
__device__ void phase_gather(const Params& p, int bid, int nblk) {
    const int tidx_ = opaque_tid();
    const int lane = tidx_ & 63;
    const int gw = bid * (NT / 64) + (tidx_ >> 6), nw = nblk * (NT / 64);
    for (int t = gw; t < TL; t += nw) {
        float hv[16];
        unpack8(*(const uint4*)(p.hbuf + (size_t)t * D + lane * 8), hv);
        unpack8(*(const uint4*)(p.hbuf + (size_t)t * D + 512 + lane * 8), hv + 8);
        const int ia = p.pidx[(size_t)t * 128 + lane], ib = p.pidx[(size_t)t * 128 + 64 + lane];
        const float ga = p.pgw[(size_t)t * 128 + lane], gb = p.pgw[(size_t)t * 128 + 64 + lane];
        float acc[16];
#pragma unroll
        for (int j = 0; j < 16; ++j) acc[j] = 0.f;
        for (int j0 = 0; j0 < 128; j0 += 4) {
            uint4 u0[4], u1[4], v0[4], v1[4]; float gj[4];
#pragma unroll
            for (int jj = 0; jj < 4; ++jj) {
                const int j = j0 + jj;
                const int e = j0 < 64 ? __builtin_amdgcn_readlane(ia, j & 63) : __builtin_amdgcn_readlane(ib, j & 63);
                const int gi = j0 < 64 ? __builtin_amdgcn_readlane(__float_as_int(ga), j & 63) : __builtin_amdgcn_readlane(__float_as_int(gb), j & 63);
                gj[jj] = __int_as_float(gi);
                const bf16_t* up = p.ub + (size_t)e * D + lane * 8;
                const bf16_t* vp = p.vb + (size_t)e * D + lane * 8;
                u0[jj] = *(const uint4*)up; u1[jj] = *(const uint4*)(up + 512);
                v0[jj] = *(const uint4*)vp; v1[jj] = *(const uint4*)(vp + 512);
            }
#pragma unroll
            for (int jj = 0; jj < 4; ++jj) {
                float uf[16];
                unpack8(u0[jj], uf); unpack8(u1[jj], uf + 8);
                float dot = 0.f;
#pragma unroll
                for (int q = 0; q < 16; ++q) dot += uf[q] * hv[q];
                dot = wave_sum(dot);
                const float act = 0.5f * dot * (1.f + erff(dot * 0.7071067811865476f)) * gj[jj];
                float vf[16];
                unpack8(v0[jj], vf); unpack8(v1[jj], vf + 8);
#pragma unroll
                for (int q = 0; q < 16; ++q) acc[q] += act * vf[q];
            }
        }
        float* orow = p.out + (size_t)t * D;
        const float* g2 = p.mod + (t >> 11) * 6144 + 5120;
        float y[16]; float ss = 0.f;
#pragma unroll
        for (int q = 0; q < 4; ++q) {
            const int col = (q >> 1) * 512 + lane * 8 + (q & 1) * 4;
            const float4 xv = *(const float4*)(orow + col), gv = *(const float4*)(g2 + col);
            y[q * 4 + 0] = xv.x + gv.x * acc[q * 4 + 0]; y[q * 4 + 1] = xv.y + gv.y * acc[q * 4 + 1];
            y[q * 4 + 2] = xv.z + gv.z * acc[q * 4 + 2]; y[q * 4 + 3] = xv.w + gv.w * acc[q * 4 + 3];
            ss += y[q * 4] * y[q * 4] + y[q * 4 + 1] * y[q * 4 + 1] + y[q * 4 + 2] * y[q * 4 + 2] + y[q * 4 + 3] * y[q * 4 + 3];
        }
        ss = wave_sum(ss);
        const float rstd = rsqrtf(ss * (1.f / 1024.f) + EPS);
#pragma unroll
        for (int q = 0; q < 4; ++q) {
            const int col = (q >> 1) * 512 + lane * 8 + (q & 1) * 4;
            const float4 gf = *(const float4*)(p.norm_f_g + col);
            *(float4*)(orow + col) = make_float4(y[q * 4] * rstd * gf.x, y[q * 4 + 1] * rstd * gf.y, y[q * 4 + 2] * rstd * gf.z, y[q * 4 + 3] * rstd * gf.w);
        }
    }
}

extern __shared__ __attribute__((aligned(16))) char dyn_smem[];

__device__ __forceinline__ void run_phase(const Params& p, int ph, char* smem, int bid, int nblk) {
    switch (ph) {
        case 0: phase_mod(p, smem, bid, nblk); phase_convert(p, smem, bid, nblk); break;
        case 1: phase_norm1(p, bid, nblk); break;
        case 2: { EpiInProj e{p.z, p.zg, p.gate_b}; gemm_phase(p.hbuf, p.winT, TT, PTP, 1024, e, smem, bid, nblk); } break;
        case 3: phase_mixers(p, smem, bid, nblk); break;
        case 4: phase_mixprep(p, bid, nblk); break;
        case 5: { EpiOutProj e{p.x, p.mod, p.out}; gemm_phase(p.hbuf, p.woutT, TL, 1024, 1024, e, smem, bid, nblk); } break;
        case 6: phase_norm2(p, bid, nblk); break;
        case 7: { EpiQ e{p.qbuf}; gemm_phase(p.hbuf, p.wqT, TL, 2048, 1024, e, smem, bid, nblk); } break;
        case 8: phase_topk(p, smem, bid, nblk); break;
        case 9: phase_gather(p, bid, nblk); break;
    }
}
#ifndef PHASE_MASK
#define PHASE_MASK 0x3ff
#endif
constexpr int NPHASE = 10;

#if FUSED
__global__ void __launch_bounds__(NT, 2) mega_kernel(Params p) {
    cg::grid_group grid = cg::this_grid();
#pragma nounroll
    for (int ph = 0; ph < NPHASE; ++ph) {
        if ((PHASE_MASK >> ph) & 1) run_phase(p, ph, dyn_smem, blockIdx.x, gridDim.x);
#if PROBE_REPEAT_MASK
        if ((PROBE_REPEAT_MASK >> ph) & 1) { grid.sync(); run_phase(p, ph, dyn_smem, blockIdx.x, gridDim.x); }
#endif
        if (ph + 1 < NPHASE) grid.sync();
    }
}
#else
template <int PH>
__global__ void __launch_bounds__(NT, 2) phase_kernel(Params p) { run_phase(p, PH, dyn_smem, blockIdx.x, gridDim.x); }
#endif

static inline char* carve(char*& cur, size_t bytes) { char* r = cur; cur += (bytes + 255) & ~(size_t)255; return r; }

extern "C" void kernel_launch(void* const* d_in, const int* in_sizes, int n_in, void* d_out, int out_size, void* d_ws, size_t ws_size, hipStream_t stream) {
    Params p{};
    p.x = (const float*)d_in[0]; p.c = (const float*)d_in[1]; p.ctx = (const float*)d_in[2]; p.c_ctx = (const float*)d_in[3];
    p.w_mod = (const float*)d_in[4]; p.b_mod = (const float*)d_in[5]; p.norm1_g = (const float*)d_in[6]; p.w_in = (const float*)d_in[7];
    p.conv_w = (const float*)d_in[8]; p.gate_b = (const float*)d_in[9]; p.ml_norm_g = (const float*)d_in[10]; p.lr_w2 = (const float*)d_in[11];
    p.alpha_b = (const float*)d_in[12]; p.gla_norm_g = (const float*)d_in[13]; p.w_out = (const float*)d_in[14]; p.norm2_g = (const float*)d_in[15];
    p.wq = (const float*)d_in[16]; p.keys = (const float*)d_in[17]; p.pu = (const float*)d_in[18]; p.pv = (const float*)d_in[19]; p.norm_f_g = (const float*)d_in[20];
    p.out = (float*)d_out;
    char* cur = (char*)d_ws;
    p.mod = (float*)carve(cur, (size_t)33 * 6144 * 4);
    p.winT = (bf16_t*)carve(cur, (size_t)PTP * 1024 * 2);
    p.woutT = (bf16_t*)carve(cur, (size_t)1024 * 1024 * 2);
    p.wqT = (bf16_t*)carve(cur, (size_t)2048 * 1024 * 2);
    p.keysb = (bf16_t*)carve(cur, (size_t)8 * 2 * 128 * 128 * 2);
    p.ub = (bf16_t*)carve(cur, (size_t)16384 * 1024 * 2);
    p.vb = (bf16_t*)carve(cur, (size_t)16384 * 1024 * 2);
    p.hbuf = (bf16_t*)carve(cur, (size_t)TT * 1024 * 2);
    p.z = (bf16_t*)carve(cur, (size_t)TT * ZS * 2);
    p.zg = (float*)carve(cur, (size_t)TT * 48 * 4);
    p.mixh = (bf16_t*)carve(cur, (size_t)2 * TL * 1024 * 2);
    p.qbuf = p.z;
    p.pidx = (int*)p.mixh;
    p.pgw = (float*)((char*)p.mixh + (size_t)TL * 128 * 4);
    if ((size_t)(cur - (char*)d_ws) > ws_size) { fprintf(stderr, "workspace too small: need %zu have %zu\n", (size_t)(cur - (char*)d_ws), ws_size); return; }
#if FUSED
    static int grid_blocks = 0;
    if (!grid_blocks) {
        int dev = 0, cus = 0, per_cu = 0;
        hipGetDevice(&dev);
        hipDeviceGetAttribute(&cus, hipDeviceAttributeMultiprocessorCount, dev);
        hipFuncSetAttribute((const void*)mega_kernel, hipFuncAttributeMaxDynamicSharedMemorySize, SMEM_BYTES);
        hipOccupancyMaxActiveBlocksPerMultiprocessor(&per_cu, mega_kernel, NT, SMEM_BYTES);
        if (per_cu > 2) per_cu = 2;
        grid_blocks = cus * per_cu;
    }
    void* args[] = {&p};
    hipError_t e = hipLaunchCooperativeKernel((void*)mega_kernel, dim3(grid_blocks), dim3(NT), args, SMEM_BYTES, stream);
    if (e != hipSuccess) fprintf(stderr, "cooperative launch failed: %s (grid %d)\n", hipGetErrorString(e), grid_blocks);
#else
    const int G = 512;
#define LAUNCH(PH) do { hipFuncSetAttribute((const void*)phase_kernel<PH>, hipFuncAttributeMaxDynamicSharedMemorySize, SMEM_BYTES); \
        hipLaunchKernelGGL(phase_kernel<PH>, dim3(G), dim3(NT), SMEM_BYTES, stream, p); } while (0)
    LAUNCH(0); LAUNCH(1); LAUNCH(2); LAUNCH(3); LAUNCH(4); LAUNCH(5); LAUNCH(6); LAUNCH(7); LAUNCH(8); LAUNCH(9);
#endif
}
```

```cpp
#include <hip/hip_runtime.h>
#include <hip/hip_cooperative_groups.h>
#include <cstdio>
#include <cstdint>
namespace cg = cooperative_groups;

#ifndef FUSED
#define FUSED 1
#endif
#define PROBE_REPEAT_MASK 0
#ifndef ML_CHUNKED
#define ML_CHUNKED 1
#endif
#ifndef GLA_CHUNKED
#define GLA_CHUNKED 1
#endif

typedef unsigned short bf16_t;
typedef short bf16x8 __attribute__((ext_vector_type(8)));
typedef float f32x4 __attribute__((ext_vector_type(4)));
typedef unsigned u32x4 __attribute__((ext_vector_type(4)));

constexpr int D = 1024, NB = 32, SEQ = 2048, CTX = 256;
constexpr int TL = NB * SEQ;
constexpr int TC = NB * CTX;
constexpr int TT = TL + TC;
constexpr int PT = 3632;
constexpr int PTP = 3840;
constexpr int ZS = 3632;
constexpr int C_MLQ = 0, C_MLK = 512, C_MLV = 1024, C_MLO = 1536, C_MLG = 2048, C_GQ = 2064, C_GK = 2320, C_GV = 2576, C_GR = 3088, C_LR = 3600;
constexpr int NT = 256;
constexpr int SMEM_BYTES = 80 * 1024;
constexpr float EPS = 1e-6f;

struct Params {
    const float *x, *c, *ctx, *c_ctx, *w_mod, *b_mod, *norm1_g, *w_in, *conv_w, *gate_b, *ml_norm_g, *lr_w2, *alpha_b, *gla_norm_g,
        *w_out, *norm2_g, *wq, *keys, *pu, *pv, *norm_f_g;
    float* out;
    float* mod;
    bf16_t* winT;
    bf16_t* woutT;
    bf16_t* wqT;
    bf16_t* keysb;
    unsigned char* u8;
    unsigned char* v8;
    float* usc;
    float* vsc;
    bf16_t* hbuf;
    bf16_t* z;
    float* zg;
    bf16_t* mixh;
    bf16_t* qbuf;
    int* pidx;
    float* pgw;
};

__device__ __forceinline__ int opaque_tid() { int t = threadIdx.x; asm volatile("" : "+v"(t)); return t; }
__device__ __forceinline__ float bf2f(bf16_t v) { return __uint_as_float(((unsigned)v) << 16); }
__device__ __forceinline__ bf16_t f2bf(float f) { unsigned u = __float_as_uint(f); u += 0x7fffu + ((u >> 16) & 1u); return (bf16_t)(u >> 16); }
__device__ __forceinline__ unsigned pack2(float a, float b) { return (unsigned)f2bf(a) | ((unsigned)f2bf(b) << 16); }
__device__ __forceinline__ float lo2f(unsigned w) { return __uint_as_float(w << 16); }
__device__ __forceinline__ float hi2f(unsigned w) { return __uint_as_float(w & 0xffff0000u); }
__device__ __forceinline__ float wave_sum(float v) {
#pragma unroll
    for (int o = 32; o > 0; o >>= 1) v += __shfl_xor(v, o);
    return v;
}
__device__ __forceinline__ float wave_max(float v) {
#pragma unroll
    for (int o = 32; o > 0; o >>= 1) v = fmaxf(v, __shfl_xor(v, o));
    return v;
}
__device__ __forceinline__ float logsig(float x) { return fminf(x, 0.f) - log1pf(__expf(-fabsf(x))); }
__device__ __forceinline__ float silu(float x) { return x / (1.f + __expf(-x)); }
__device__ __forceinline__ float sigm(float x) { return 1.f / (1.f + __expf(-x)); }

__device__ void phase_mod(const Params& p, char* smem, int bid, int nblk) {
    const int tidx_ = opaque_tid();
    float* condL = (float*)smem;
    const int tid = tidx_, cl = tid & 63, ks = tid >> 6;
    for (int item = bid; item < 96; item += nblk) {
        const int col0 = item * 64, col = col0 + cl;
        float acc[33];
#pragma unroll
        for (int b = 0; b < 33; ++b) acc[b] = 0.f;
        for (int kc = 0; kc < 4; ++kc) {
            __syncthreads();
            for (int e = tid; e < 4 * 64 * 33; e += NT) {
                const int s = e / (64 * 33), kk = (e / 33) % 64, b = e % 33;
                const int k = s * 256 + kc * 64 + kk;
                const float cv = b < 32 ? p.c[b * 1024 + k] : p.c_ctx[k];
                condL[e] = silu(cv);
            }
            __syncthreads();
            for (int kk = 0; kk < 64; ++kk) {
                const int k = ks * 256 + kc * 64 + kk;
                const float w = p.w_mod[(size_t)k * 6144 + col];
                const float* cp = condL + (ks * 64 + kk) * 33;
#pragma unroll
                for (int b = 0; b < 33; ++b) acc[b] += w * cp[b];
            }
        }
        __syncthreads();
#pragma unroll
        for (int b = 0; b < 33; ++b) condL[(ks * 33 + b) * 64 + cl] = acc[b];
        __syncthreads();
        for (int e = tid; e < 33 * 64; e += NT) {
            const int b = e >> 6, cc = e & 63;
            float v = condL[(0 * 33 + b) * 64 + cc] + condL[(1 * 33 + b) * 64 + cc] + condL[(2 * 33 + b) * 64 + cc] + condL[(3 * 33 + b) * 64 + cc];
            p.mod[b * 6144 + col0 + cc] = v + p.b_mod[col0 + cc];
        }
        __syncthreads();
    }
}

__device__ void convT(const float* __restrict__ src, int K, int N, int Npad, bf16_t* __restrict__ dst, char* smem, int bid, int nblk) {
    const int tidx_ = opaque_tid();
    float* tile = (float*)smem;
    const int tid = tidx_;
    const int nk = K / 64, nn = Npad / 64;
    for (int t = bid; t < nk * nn; t += nblk) {
        const int k0 = (t % nk) * 64, n0 = (t / nk) * 64;
        __syncthreads();
#pragma unroll
        for (int r = 0; r < 16; ++r) {
            const int k = r * 4 + (tid >> 6), n = tid & 63;
            tile[k * 65 + n] = (n0 + n < N) ? src[(size_t)(k0 + k) * N + n0 + n] : 0.f;
        }
        __syncthreads();
#pragma unroll
        for (int r = 0; r < 16; ++r) {
            const int n = r * 4 + (tid >> 6), k = tid & 63;
            dst[(size_t)(n0 + n) * K + k0 + k] = f2bf(tile[k * 65 + n]);
        }
    }
    __syncthreads();
}
__device__ void conv_copy(const float* __restrict__ src, bf16_t* __restrict__ dst, size_t n, int gtid, int gthreads) {
    const size_t n4 = n / 4;
    for (size_t i = gtid; i < n4; i += gthreads) {
        const float4 v = ((const float4*)src)[i];
        uint2 o; o.x = pack2(v.x, v.y); o.y = pack2(v.z, v.w);
        ((uint2*)dst)[i] = o;
    }
}
__device__ void phase_convert(const Params& p, char* smem, int bid, int nblk) {
    const int tidx_ = opaque_tid();
    convT(p.w_in, 1024, PT, PTP, p.winT, smem, bid, nblk);
    convT(p.w_out, 1024, 1024, 1024, p.woutT, smem, bid, nblk);
    convT(p.wq, 1024, 2048, 2048, p.wqT, smem, bid, nblk);
    const int gtid = bid * NT + tidx_, gth = nblk * NT;
    conv_copy(p.keys, p.keysb, (size_t)8 * 2 * 128 * 128, gtid, gth);
    {
        const int lane = tidx_ & 63;
        const int gw = bid * (NT / 64) + (tidx_ >> 6), nw = nblk * (NT / 64);
        for (int row = gw; row < 2 * 16384; row += nw) {
            const bool isv = row >= 16384;
            const int r = isv ? row - 16384 : row;
            const float* src = (isv ? p.pv : p.pu) + (size_t)r * 1024 + lane * 16;
            f32x4 v[4];
            float mx = 0.f;
#pragma unroll
            for (int q = 0; q < 4; ++q) { v[q] = *(const f32x4*)(src + 4 * q); mx = fmaxf(mx, fmaxf(fmaxf(fabsf(v[q][0]), fabsf(v[q][1])), fmaxf(fabsf(v[q][2]), fabsf(v[q][3])))); }
            mx = wave_max(mx);
            mx = fmaxf(mx, 1e-30f);
            const float sc = 440.f / mx;
            u32x4 o;
#pragma unroll
            for (int q = 0; q < 4; ++q) {
                int w = __builtin_amdgcn_cvt_pk_fp8_f32(v[q][0] * sc, v[q][1] * sc, 0, false);
                w = __builtin_amdgcn_cvt_pk_fp8_f32(v[q][2] * sc, v[q][3] * sc, w, true);
                o[q] = (unsigned)w;
            }
            *(u32x4*)((isv ? p.v8 : p.u8) + (size_t)r * 1024 + lane * 16) = o;
            if (lane == 0) (isv ? p.vsc : p.usc)[r] = mx * (1.f / 440.f);
        }
    }
}

__device__ void phase_norm1(const Params& p, int bid, int nblk) {
    const int tidx_ = opaque_tid();
    const int lane = tidx_ & 63;
    const int gw = bid * (NT / 64) + (tidx_ >> 6), nw = nblk * (NT / 64);
    for (int row = gw; row < TT; row += nw) {
        const float* src = row < TL ? p.x + (size_t)row * D : p.ctx + (size_t)(row - TL) * D;
        const float* md = p.mod + (row < TL ? (row >> 11) : 32) * 6144;
        float4 v[4]; float ss = 0.f;
#pragma unroll
        for (int j = 0; j < 4; ++j) { v[j] = *(const float4*)(src + j * 256 + lane * 4); ss += v[j].x * v[j].x + v[j].y * v[j].y + v[j].z * v[j].z + v[j].w * v[j].w; }
        ss = wave_sum(ss);
        const float rstd = rsqrtf(ss * (1.f / 1024.f) + EPS);
#pragma unroll
        for (int j = 0; j < 4; ++j) {
            const int col = j * 256 + lane * 4;
            const float4 g = *(const float4*)(p.norm1_g + col), sc = *(const float4*)(md + 1024 + col), sh = *(const float4*)(md + col);
            uint2 o;
            o.x = pack2(v[j].x * rstd * g.x * (1.f + sc.x) + sh.x, v[j].y * rstd * g.y * (1.f + sc.y) + sh.y);
            o.y = pack2(v[j].z * rstd * g.z * (1.f + sc.z) + sh.z, v[j].w * rstd * g.w * (1.f + sc.w) + sh.w);
            *(uint2*)(p.hbuf + (size_t)row * D + col) = o;
        }
    }
}

template <class Epi>
__device__ void gemm_phase(const bf16_t* __restrict__ A, const bf16_t* __restrict__ Bt, int M, int N, int K, const Epi& epi, char* smem, int bid, int nblk) {
    const int tidx_ = opaque_tid();
    constexpr int BM = 128, BN = 128, BK = 64, LS = 72;
    bf16_t* sA = (bf16_t*)smem;
    bf16_t* sB = sA + BM * LS;
    const int tid = tidx_, lane = tid & 63, w = tid >> 6, wr = w >> 1, wc = w & 1;
    const int nN = N / BN, ntiles = (M / BM) * nN;
    const int lr = tid >> 3, lc = (tid & 7) * 8;
    for (int tile = bid; tile < ntiles; tile += nblk) {
        const int tm = tile / nN, tn = tile % nN;
        const bf16_t* Ag = A + (size_t)(tm * BM) * K;
        const bf16_t* Bg = Bt + (size_t)(tn * BN) * K;
        f32x4 acc[4][4];
#pragma unroll
        for (int i = 0; i < 4; ++i)
#pragma unroll
            for (int j = 0; j < 4; ++j) acc[i][j] = (f32x4){0.f, 0.f, 0.f, 0.f};
        u32x4 ra[4], rb[4];
#pragma unroll
        for (int i = 0; i < 4; ++i) {
            ra[i] = *(const u32x4*)(Ag + (size_t)(lr + 32 * i) * K + lc);
            rb[i] = *(const u32x4*)(Bg + (size_t)(lr + 32 * i) * K + lc);
        }
        for (int k0 = 0; k0 < K; k0 += BK) {
            __syncthreads();
#pragma unroll
            for (int i = 0; i < 4; ++i) {
                *(u32x4*)(sA + (lr + 32 * i) * LS + lc) = ra[i];
                *(u32x4*)(sB + (lr + 32 * i) * LS + lc) = rb[i];
            }
            __syncthreads();
            {
                const int kn = (k0 + BK < K) ? k0 + BK : k0;
#pragma unroll
                for (int i = 0; i < 4; ++i) {
                    ra[i] = *(const u32x4*)(Ag + (size_t)(lr + 32 * i) * K + kn + lc);
                    rb[i] = *(const u32x4*)(Bg + (size_t)(lr + 32 * i) * K + kn + lc);
                }
            }
#pragma unroll
            for (int kk = 0; kk < 2; ++kk) {
                bf16x8 af[4], bfr[4];
#pragma unroll
                for (int i = 0; i < 4; ++i) {
                    af[i] = *(const bf16x8*)(sA + (wr * 64 + i * 16 + (lane & 15)) * LS + kk * 32 + (lane >> 4) * 8);
                    bfr[i] = *(const bf16x8*)(sB + (wc * 64 + i * 16 + (lane & 15)) * LS + kk * 32 + (lane >> 4) * 8);
                }
#pragma unroll
                for (int i = 0; i < 4; ++i)
#pragma unroll
                    for (int j = 0; j < 4; ++j) acc[i][j] = __builtin_amdgcn_mfma_f32_16x16x32_bf16(af[i], bfr[j], acc[i][j], 0, 0, 0);
            }
        }
#pragma unroll
        for (int i = 0; i < 4; ++i)
#pragma unroll
            for (int j = 0; j < 4; ++j)
#pragma unroll
                for (int r = 0; r < 4; ++r) {
                    const int row = tm * BM + wr * 64 + i * 16 + (lane >> 4) * 4 + r;
                    const int col = tn * BN + wc * 64 + j * 16 + (lane & 15);
                    epi(row, col, acc[i][j][r]);
                }
    }
    __syncthreads();
}

struct EpiInProj {
    bf16_t* z; float* zg; const float* gate_b;
    __device__ __forceinline__ void operator()(int row, int col, float v) const {
        if (col < C_MLG) z[(size_t)row * ZS + col] = f2bf(v);
        else if (col < C_GQ) zg[(size_t)row * 48 + (col - C_MLG)] = v + gate_b[col - C_MLG];
        else if (col < C_LR) z[(size_t)row * ZS + col] = f2bf(v);
        else if (col < PT) zg[(size_t)row * 48 + 16 + (col - C_LR)] = v;
    }
};
struct EpiOutProj {
    const float* x; const float* mod; float* out;
    __device__ __forceinline__ void operator()(int row, int col, float v) const {
        const size_t o = (size_t)row * D + col;
        out[o] = x[o] + mod[(row >> 11) * 6144 + 2048 + col] * v;
    }
};
struct EpiQ {
    bf16_t* q;
    __device__ __forceinline__ void operator()(int row, int col, float v) const { q[(size_t)row * 2048 + col] = f2bf(v); }
};


#define MFMA16(a, b, c) __builtin_amdgcn_mfma_f32_16x16x32_bf16((a), (b), (c), 0, 0, 0)
__device__ __forceinline__ void conv8(const Params& p, const bf16_t* zc, int col, bool vl, bool vr, float scl, float* y) {
    const u32x4 cc = *(const u32x4*)zc;
    u32x4 ll = (u32x4){0u, 0u, 0u, 0u}, rr = (u32x4){0u, 0u, 0u, 0u};
    if (vl) ll = *(const u32x4*)(zc - ZS);
    if (vr) rr = *(const u32x4*)(zc + ZS);
    const f32x4 w0a = *(const f32x4*)(p.conv_w + col), w0b = *(const f32x4*)(p.conv_w + col + 4);
    const f32x4 w1a = *(const f32x4*)(p.conv_w + 1024 + col), w1b = *(const f32x4*)(p.conv_w + 1024 + col + 4);
    const f32x4 w2a = *(const f32x4*)(p.conv_w + 2048 + col), w2b = *(const f32x4*)(p.conv_w + 2048 + col + 4);
    const float w0[8] = {w0a[0], w0a[1], w0a[2], w0a[3], w0b[0], w0b[1], w0b[2], w0b[3]};
    const float w1[8] = {w1a[0], w1a[1], w1a[2], w1a[3], w1b[0], w1b[1], w1b[2], w1b[3]};
    const float w2[8] = {w2a[0], w2a[1], w2a[2], w2a[3], w2b[0], w2b[1], w2b[2], w2b[3]};
#pragma unroll
    for (int j = 0; j < 4; ++j) {
        const float y0 = w0[2 * j] * lo2f(ll[j]) + w1[2 * j] * lo2f(cc[j]) + w2[2 * j] * lo2f(rr[j]);
        const float y1 = w0[2 * j + 1] * hi2f(ll[j]) + w1[2 * j + 1] * hi2f(cc[j]) + w2[2 * j + 1] * hi2f(rr[j]);
        y[2 * j] = silu(y0) * scl; y[2 * j + 1] = silu(y1) * scl;
    }
}

__device__ void mlstm_item_chunked(const Params& p, char* smem, int tid, int b, int h, int dir) {
    bf16_t* Qs = (bf16_t*)smem;
    bf16_t* Ks = Qs + 32 * 136;
    bf16_t* Ktw = Ks + 32 * 136;
    bf16_t* Vt = Ktw + 128 * 40;
    bf16_t* Ps = Vt + 144 * 40;
    bf16_t* Cb = Ps + 32 * 40;
    float* sg = (float*)(Cb + 144 * 136);
    float* sM = sg + 32; float* sinter = sg + 64; float* sfloor = sg + 96; float* sw = sg + 128; float* smisc = sg + 160;
    const int lane = tid & 63, w = __builtin_amdgcn_readfirstlane(tid >> 6), lr = lane & 15, lq = lane >> 4;
    for (int i = tid; i < 16 * 40; i += 256) Vt[128 * 40 + i] = 0x3f80;
    for (int i = tid; i < 144 * 136 / 2; i += 256) ((unsigned*)Cb)[i] = 0u;
    f32x4 CT[2][9];
#pragma unroll
    for (int i = 0; i < 2; ++i)
#pragma unroll
        for (int j = 0; j < 9; ++j) CT[i][j] = (f32x4){0.f, 0.f, 0.f, 0.f};
    float m_s = 0.f;
    __syncthreads();
    for (int bt = 0; bt < 72; ++bt) {
        const bool lat = bt >= 8;
        const int pos0 = lat ? (bt - 8) * 32 : bt * 32;
        const int seg = lat ? SEQ : CTX;
        const int nlo = dir ? seg - 32 - pos0 : pos0;
        const int rowbase = lat ? b * SEQ : TL + b * CTX;
        if (w == 0) {
            const int l = lane & 31;
            const int n = dir ? nlo + 31 - l : nlo + l;
            const float* gp = p.zg + (size_t)(rowbase + n) * 48 + dir * 8 + h;
            const float ig = gp[0], lf = logsig(gp[4]);
            float bsum = lf;
#pragma unroll
            for (int o = 1; o < 32; o <<= 1) { const float t = __shfl_up(bsum, o); if (l >= o) bsum += t; }
            const float g = ig - bsum;
            float cm = g;
#pragma unroll
            for (int o = 1; o < 32; o <<= 1) { const float t = __shfl_up(cm, o); if (l >= o) cm = fmaxf(cm, t); }
            const float M = fmaxf(m_s, cm);
            const float Ml = __shfl(M, 31), bl = __shfl(bsum, 31);
            if (lane < 32) {
                sg[l] = g; sM[l] = M; sinter[l] = __expf(m_s - M); sfloor[l] = __expf(-(bsum + M)); sw[l] = __expf(g - Ml);
                if (lane == 0) { smisc[0] = __expf(m_s - Ml); smisc[1] = bl + Ml; }
            }
        }
        __syncthreads();
        {
            const int l = tid & 31, c8 = tid >> 5;
            const int n = dir ? nlo + 31 - l : nlo + l;
            const bool vl = lat ? (((n - 1) >> 6) == (n >> 6)) : (n - 1 >= 0);
            const bool vr = lat ? (((n + 1) >> 6) == (n >> 6)) : (n + 1 < CTX);
            const bf16_t* zr = p.z + (size_t)(rowbase + n) * ZS;
            const float wl = sw[l];
#pragma unroll 1
            for (int r = 0; r < 2; ++r) {
                const int ec = c8 + 8 * r;
                float y[8];
                conv8(p, zr + C_MLK + h * 128 + ec * 8, C_MLK + h * 128 + ec * 8, vl, vr, 0.08838834764831845f, y);
                *(u32x4*)(Ks + l * 136 + ec * 8) = (u32x4){pack2(y[0], y[1]), pack2(y[2], y[3]), pack2(y[4], y[5]), pack2(y[6], y[7])};
#pragma unroll
                for (int j = 0; j < 8; ++j) Ktw[(ec * 8 + j) * 40 + l] = f2bf(y[j] * wl);
                if (lat) {
                    conv8(p, zr + C_MLQ + h * 128 + ec * 8, C_MLQ + h * 128 + ec * 8, vl, vr, 1.f, y);
                    *(u32x4*)(Qs + l * 136 + ec * 8) = (u32x4){pack2(y[0], y[1]), pack2(y[2], y[3]), pack2(y[4], y[5]), pack2(y[6], y[7])};
                }
                const u32x4 vv = *(const u32x4*)(zr + C_MLV + h * 128 + ec * 8);
#pragma unroll
                for (int j = 0; j < 4; ++j) { Vt[(ec * 8 + 2 * j) * 40 + l] = (bf16_t)(vv[j] & 0xffffu); Vt[(ec * 8 + 2 * j + 1) * 40 + l] = (bf16_t)(vv[j] >> 16); }
            }
        }
        __syncthreads();
        if (lat) {
            const int mi = w >> 1, ni = w & 1;
            f32x4 sa = (f32x4){0.f, 0.f, 0.f, 0.f};
            if (!(mi == 0 && ni == 1)) {
#pragma unroll
                for (int kk = 0; kk < 4; ++kk) {
                    const bf16x8 af = *(const bf16x8*)(Qs + (mi * 16 + lr) * 136 + kk * 32 + lq * 8);
                    const bf16x8 bf = *(const bf16x8*)(Ks + (ni * 16 + lr) * 136 + kk * 32 + lq * 8);
                    sa = MFMA16(af, bf, sa);
                }
            }
            const int sidx = ni * 16 + lr;
            const float gs = sg[sidx];
#pragma unroll
            for (int r = 0; r < 4; ++r) {
                const int t = mi * 16 + lq * 4 + r;
                const float pv = (sidx <= t) ? sa[r] * __expf(gs - sM[t]) : 0.f;
                Ps[t * 40 + sidx] = f2bf(pv);
            }
        }
        __syncthreads();
        if (lat) {
            const int nts[3] = {2 * w, 2 * w + 1, 8};
            f32x4 acc[2][3];
#pragma unroll
            for (int i = 0; i < 2; ++i)
#pragma unroll
                for (int j = 0; j < 3; ++j) acc[i][j] = (f32x4){0.f, 0.f, 0.f, 0.f};
#pragma unroll
            for (int kk = 0; kk < 4; ++kk) {
                bf16x8 af[2], bf[3];
#pragma unroll
                for (int i = 0; i < 2; ++i) af[i] = *(const bf16x8*)(Qs + (i * 16 + lr) * 136 + kk * 32 + lq * 8);
#pragma unroll
                for (int j = 0; j < 3; ++j) bf[j] = *(const bf16x8*)(Cb + (nts[j] * 16 + lr) * 136 + kk * 32 + lq * 8);
#pragma unroll
                for (int i = 0; i < 2; ++i)
#pragma unroll
                    for (int j = 0; j < 3; ++j) acc[i][j] = MFMA16(af[i], bf[j], acc[i][j]);
            }
#pragma unroll
            for (int i = 0; i < 2; ++i)
#pragma unroll
                for (int r = 0; r < 4; ++r) {
                    const float it = sinter[i * 16 + lq * 4 + r];
#pragma unroll
                    for (int j = 0; j < 3; ++j) acc[i][j][r] *= it;
                }
            {
                bf16x8 af[2], bf[3];
#pragma unroll
                for (int i = 0; i < 2; ++i) af[i] = *(const bf16x8*)(Ps + (i * 16 + lr) * 40 + lq * 8);
#pragma unroll
                for (int j = 0; j < 3; ++j) bf[j] = *(const bf16x8*)(Vt + (nts[j] * 16 + lr) * 40 + lq * 8);
#pragma unroll
                for (int i = 0; i < 2; ++i)
#pragma unroll
                    for (int j = 0; j < 3; ++j) acc[i][j] = MFMA16(af[i], bf[j], acc[i][j]);
            }
#pragma unroll
            for (int i = 0; i < 2; ++i)
#pragma unroll
                for (int r = 0; r < 4; ++r) {
                    const int t = i * 16 + lq * 4 + r;
                    const float dn = fmaxf(fabsf(acc[i][2][r]), sfloor[t]);
                    const float inv = 1.f / dn;
                    const int n = dir ? nlo + 31 - t : nlo + t;
                    bf16_t* orow = p.mixh + ((size_t)dir * TL + rowbase + n) * 1024 + h * 128;
#pragma unroll
                    for (int j = 0; j < 2; ++j) orow[nts[j] * 16 + lr] = f2bf(acc[i][j][r] * inv);
                }
        }
        __syncthreads();
        {
            const float a = smisc[0];
            bf16x8 af[2];
#pragma unroll
            for (int i = 0; i < 2; ++i) af[i] = *(const bf16x8*)(Ktw + ((2 * w + i) * 16 + lr) * 40 + lq * 8);
#pragma unroll
            for (int j = 0; j < 9; ++j) {
                const bf16x8 bf = *(const bf16x8*)(Vt + (j * 16 + lr) * 40 + lq * 8);
#pragma unroll
                for (int i = 0; i < 2; ++i) {
                    CT[i][j] = CT[i][j] * a;
                    CT[i][j] = MFMA16(af[i], bf, CT[i][j]);
                    uint2 pk; pk.x = pack2(CT[i][j][0], CT[i][j][1]); pk.y = pack2(CT[i][j][2], CT[i][j][3]);
                    *(uint2*)(Cb + (j * 16 + lr) * 136 + (2 * w + i) * 16 + lq * 4) = pk;
                }
            }
            m_s = smisc[1];
        }
        __syncthreads();
    }
}

__device__ void gla_item_chunked(const Params& p, char* smem, int tid, int b, int h, int dir) {
    bf16_t* Qd = (bf16_t*)smem;
    bf16_t* Qb = Qd + 32 * 72;
    bf16_t* Kd = Qb + 32 * 72;
    bf16_t* Kwt = Kd + 32 * 72;
    bf16_t* Vt = Kwt + 64 * 40;
    bf16_t* Ps = Vt + 128 * 40;
    bf16_t* Sb = Ps + 32 * 40;
    float* bc = (float*)(Sb + 128 * 72);
    const int lane = tid & 63, w = __builtin_amdgcn_readfirstlane(tid >> 6), lr = lane & 15, lq = lane >> 4;
    for (int i = tid; i < 128 * 72 / 2; i += 256) ((unsigned*)Sb)[i] = 0u;
    f32x4 S[8];
#pragma unroll
    for (int j = 0; j < 8; ++j) S[j] = (f32x4){0.f, 0.f, 0.f, 0.f};
    __syncthreads();
    for (int bt = 0; bt < 72; ++bt) {
        const bool lat = bt >= 8;
        const int pos0 = lat ? (bt - 8) * 32 : bt * 32;
        const int seg = lat ? SEQ : CTX;
        const int nlo = dir ? seg - 32 - pos0 : pos0;
        const int rowbase = lat ? b * SEQ : TL + b * CTX;
        {
            const int dd = tid & 63;
            float w2[16];
#pragma unroll
            for (int q = 0; q < 16; ++q) w2[q] = p.lr_w2[(dir * 16 + q) * 256 + h * 64 + dd];
            const float ab = p.alpha_b[dir * 256 + h * 64 + dd];
#pragma unroll
            for (int r = 0; r < 8; ++r) {
                const int l = (tid >> 6) + 4 * r;
                const int n = dir ? nlo + 31 - l : nlo + l;
                const float* lrp = p.zg + (size_t)(rowbase + n) * 48 + 16 + dir * 16;
                float al = ab;
#pragma unroll
                for (int q = 0; q < 16; ++q) al += lrp[q] * w2[q];
                bc[l * 64 + dd] = logsig(al) * (1.f / 16.f);
            }
        }
        __syncthreads();
        if (tid < 64) {
            float run = 0.f;
#pragma unroll 8
            for (int l = 0; l < 32; ++l) { run += bc[l * 64 + tid]; bc[l * 64 + tid] = run; }
        }
        __syncthreads();
        {
            const int l = tid & 31, dc = tid >> 5;
            const int n = dir ? nlo + 31 - l : nlo + l;
            const bf16_t* zr = p.z + (size_t)(rowbase + n) * ZS;
            float bl[8], rf[8], be[8];
#pragma unroll
            for (int j = 0; j < 8; ++j) { bl[j] = bc[l * 64 + dc * 8 + j]; rf[j] = bc[16 * 64 + dc * 8 + j]; be[j] = bc[31 * 64 + dc * 8 + j]; }
            {
                const u32x4 kk = *(const u32x4*)(zr + C_GK + h * 64 + dc * 8);
                float kf[8];
#pragma unroll
                for (int j = 0; j < 4; ++j) { kf[2 * j] = lo2f(kk[j]); kf[2 * j + 1] = hi2f(kk[j]); }
                float kd[8];
#pragma unroll
                for (int j = 0; j < 8; ++j) { kd[j] = kf[j] * __expf(rf[j] - bl[j]); Kwt[(dc * 8 + j) * 40 + l] = f2bf(kf[j] * __expf(be[j] - bl[j])); }
                *(u32x4*)(Kd + l * 72 + dc * 8) = (u32x4){pack2(kd[0], kd[1]), pack2(kd[2], kd[3]), pack2(kd[4], kd[5]), pack2(kd[6], kd[7])};
            }
            if (lat) {
                const u32x4 qq = *(const u32x4*)(zr + C_GQ + h * 64 + dc * 8);
                float qf[8];
#pragma unroll
                for (int j = 0; j < 4; ++j) { qf[2 * j] = lo2f(qq[j]) * 0.125f; qf[2 * j + 1] = hi2f(qq[j]) * 0.125f; }
                float qd[8], qb[8];
#pragma unroll
                for (int j = 0; j < 8; ++j) { qd[j] = qf[j] * __expf(bl[j] - rf[j]); qb[j] = qf[j] * __expf(bl[j]); }
                *(u32x4*)(Qd + l * 72 + dc * 8) = (u32x4){pack2(qd[0], qd[1]), pack2(qd[2], qd[3]), pack2(qd[4], qd[5]), pack2(qd[6], qd[7])};
                *(u32x4*)(Qb + l * 72 + dc * 8) = (u32x4){pack2(qb[0], qb[1]), pack2(qb[2], qb[3]), pack2(qb[4], qb[5]), pack2(qb[6], qb[7])};
            }
#pragma unroll
            for (int r = 0; r < 2; ++r) {
                const int ec = dc + 8 * r;
                const u32x4 vv = *(const u32x4*)(zr + C_GV + h * 128 + ec * 8);
#pragma unroll
                for (int j = 0; j < 4; ++j) { Vt[(ec * 8 + 2 * j) * 40 + l] = (bf16_t)(vv[j] & 0xffffu); Vt[(ec * 8 + 2 * j + 1) * 40 + l] = (bf16_t)(vv[j] >> 16); }
            }
        }
        __syncthreads();
        if (lat) {
            const int mi = w >> 1, ni = w & 1;
            f32x4 sa = (f32x4){0.f, 0.f, 0.f, 0.f};
            if (!(mi == 0 && ni == 1)) {
#pragma unroll
                for (int kk = 0; kk < 2; ++kk) {
                    const bf16x8 af = *(const bf16x8*)(Qd + (mi * 16 + lr) * 72 + kk * 32 + lq * 8);
                    const bf16x8 bf = *(const bf16x8*)(Kd + (ni * 16 + lr) * 72 + kk * 32 + lq * 8);
                    sa = MFMA16(af, bf, sa);
                }
            }
            const int sidx = ni * 16 + lr;
#pragma unroll
            for (int r = 0; r < 4; ++r) {
                const int t = mi * 16 + lq * 4 + r;
                Ps[t * 40 + sidx] = f2bf((sidx <= t) ? sa[r] : 0.f);
            }
        }
        __syncthreads();
        if (lat) {
            f32x4 acc[2][2];
#pragma unroll
            for (int i = 0; i < 2; ++i)
#pragma unroll
                for (int j = 0; j < 2; ++j) acc[i][j] = (f32x4){0.f, 0.f, 0.f, 0.f};
#pragma unroll
            for (int kk = 0; kk < 2; ++kk) {
                bf16x8 af[2], bf[2];
#pragma unroll
                for (int i = 0; i < 2; ++i) af[i] = *(const bf16x8*)(Qb + (i * 16 + lr) * 72 + kk * 32 + lq * 8);
#pragma unroll
                for (int j = 0; j < 2; ++j) bf[j] = *(const bf16x8*)(Sb + ((2 * w + j) * 16 + lr) * 72 + kk * 32 + lq * 8);
#pragma unroll
                for (int i = 0; i < 2; ++i)
#pragma unroll
                    for (int j = 0; j < 2; ++j) acc[i][j] = MFMA16(af[i], bf[j], acc[i][j]);
            }
            {
                bf16x8 af[2], bf[2];
#pragma unroll
                for (int i = 0; i < 2; ++i) af[i] = *(const bf16x8*)(Ps + (i * 16 + lr) * 40 + lq * 8);
#pragma unroll
                for (int j = 0; j < 2; ++j) bf[j] = *(const bf16x8*)(Vt + ((2 * w + j) * 16 + lr) * 40 + lq * 8);
#pragma unroll
                for (int i = 0; i < 2; ++i)
#pragma unroll
                    for (int j = 0; j < 2; ++j) acc[i][j] = MFMA16(af[i], bf[j], acc[i][j]);
            }
#pragma unroll
            for (int i = 0; i < 2; ++i)
#pragma unroll
                for (int r = 0; r < 4; ++r) {
                    const int t = i * 16 + lq * 4 + r;
                    const int n = dir ? nlo + 31 - t : nlo + t;
                    bf16_t* orow = p.mixh + ((size_t)dir * TL + rowbase + n) * 1024 + 512 + h * 128;
#pragma unroll
                    for (int j = 0; j < 2; ++j) orow[(2 * w + j) * 16 + lr] = f2bf(acc[i][j][r]);
                }
        }
        __syncthreads();
        {
            float rs[4];
#pragma unroll
            for (int r = 0; r < 4; ++r) rs[r] = __expf(bc[31 * 64 + w * 16 + lq * 4 + r]);
            const bf16x8 af = *(const bf16x8*)(Kwt + (w * 16 + lr) * 40 + lq * 8);
#pragma unroll
            for (int j = 0; j < 8; ++j) {
                const bf16x8 bf = *(const bf16x8*)(Vt + (j * 16 + lr) * 40 + lq * 8);
#pragma unroll
                for (int r = 0; r < 4; ++r) S[j][r] *= rs[r];
                S[j] = MFMA16(af, bf, S[j]);
                uint2 pk; pk.x = pack2(S[j][0], S[j][1]); pk.y = pack2(S[j][2], S[j][3]);
                *(uint2*)(Sb + (j * 16 + lr) * 72 + w * 16 + lq * 4) = pk;
            }
        }
        __syncthreads();
    }
}

__device__ void phase_mixers(const Params& p, char* smem, int bid, int nblk) {
    const int tidx_ = opaque_tid();
    float* L = (float*)smem;
    const int stid = tidx_, lane = stid & 63;
    for (int item = bid; item < 512; item += nblk) {
        const bool isml = item < 256;
        const int it = item & 255, b = it >> 3, h = (it >> 1) & 3, dir = it & 1;
#if ML_CHUNKED
        if (isml) { mlstm_item_chunked(p, smem, stid, b, h, dir); __syncthreads(); continue; }
#endif
#if GLA_CHUNKED
        if (!isml) { gla_item_chunked(p, smem, stid, b, h, dir); __syncthreads(); continue; }
#endif
#if !ML_CHUNKED
        if (isml) {
            float* qs = L; float* ks = L + 4096; float* vs = L + 8192; float* numb = L + 12288;
            float* igs = L + 16384; float* lfs = L + 16416; float* denp = L + 16448; float* mb = L + 16512;
            float C[64];
#pragma unroll
            for (int e = 0; e < 64; ++e) C[e] = 0.f;
            float nreg = 0.f, m = 0.f;
            const int d = stid >> 1, e0 = (stid & 1) * 64;
            for (int bt = 0; bt < 72; ++bt) {
                const bool lat = bt >= 8;
                const int pos0 = lat ? (bt - 8) * 32 : bt * 32;
                const int seg = lat ? SEQ : CTX;
                const int nlo = dir ? seg - 32 - pos0 : pos0;
                const int rowbase = lat ? b * SEQ : TL + b * CTX;
#pragma unroll
                for (int r = 0; r < 4; ++r) {
                    const int wi = stid + 256 * r, which = wi >> 9, i = (wi >> 4) & 31, ch = (wi & 15) * 8;
                    if (which == 0 && !lat) continue;
                    const int n = dir ? nlo + 31 - i : nlo + i;
                    const int col = which * 512 + h * 128 + ch;
                    const bool vl = lat ? (((n - 1) >> 6) == (n >> 6)) : (n - 1 >= 0);
                    const bool vr = lat ? (((n + 1) >> 6) == (n >> 6)) : (n + 1 < CTX);
                    const bf16_t* zc = p.z + (size_t)(rowbase + n) * ZS + col;
                    const uint4 cc = *(const uint4*)zc;
                    uint4 ll = make_uint4(0, 0, 0, 0), rr = make_uint4(0, 0, 0, 0);
                    if (vl) ll = *(const uint4*)(zc - ZS);
                    if (vr) rr = *(const uint4*)(zc + ZS);
                    const unsigned cw[4] = {cc.x, cc.y, cc.z, cc.w}, lw[4] = {ll.x, ll.y, ll.z, ll.w}, rw[4] = {rr.x, rr.y, rr.z, rr.w};
                    float* dst = (which ? ks : qs) + i * 128 + ch;
                    const float scl = which ? 0.08838834764831845f : 1.f;
#pragma unroll
                    for (int j = 0; j < 4; ++j) {
                        const int c0 = col + 2 * j;
                        const float y0 = p.conv_w[c0] * lo2f(lw[j]) + p.conv_w[1024 + c0] * lo2f(cw[j]) + p.conv_w[2048 + c0] * lo2f(rw[j]);
                        const float y1 = p.conv_w[c0 + 1] * hi2f(lw[j]) + p.conv_w[1024 + c0 + 1] * hi2f(cw[j]) + p.conv_w[2048 + c0 + 1] * hi2f(rw[j]);
                        dst[2 * j] = silu(y0) * scl; dst[2 * j + 1] = silu(y1) * scl;
                    }
                }
#pragma unroll
                for (int r = 0; r < 2; ++r) {
                    const int wi = stid + 256 * r, i = wi >> 4, ch = (wi & 15) * 8;
                    const int n = dir ? nlo + 31 - i : nlo + i;
                    const uint4 cc = *(const uint4*)(p.z + (size_t)(rowbase + n) * ZS + C_MLV + h * 128 + ch);
                    float* dst = vs + i * 128 + ch;
                    dst[0] = lo2f(cc.x); dst[1] = hi2f(cc.x); dst[2] = lo2f(cc.y); dst[3] = hi2f(cc.y);
                    dst[4] = lo2f(cc.z); dst[5] = hi2f(cc.z); dst[6] = lo2f(cc.w); dst[7] = hi2f(cc.w);
                }
                if (stid < 32) {
                    const int n = dir ? nlo + 31 - stid : nlo + stid;
                    const float* g = p.zg + (size_t)(rowbase + n) * 48 + dir * 8 + h;
                    igs[stid] = g[0]; lfs[stid] = logsig(g[4]);
                }
                __syncthreads();
                for (int i = 0; i < 32; ++i) {
                    const float lf = lfs[i], ig = igs[i];
                    const float mn = fmaxf(lf + m, ig);
                    const float a = __expf(lf + m - mn), bi = __expf(ig - mn);
                    m = mn;
                    const float vd = vs[i * 128 + d] * bi;
                    const float4* kp = (const float4*)(ks + i * 128 + e0);
                    const float4* qp = (const float4*)(qs + i * 128 + e0);
                    float num = 0.f;
#pragma unroll
                    for (int j = 0; j < 16; ++j) {
                        const float4 kv = kp[j];
                        C[4 * j + 0] = a * C[4 * j + 0] + vd * kv.x; C[4 * j + 1] = a * C[4 * j + 1] + vd * kv.y;
                        C[4 * j + 2] = a * C[4 * j + 2] + vd * kv.z; C[4 * j + 3] = a * C[4 * j + 3] + vd * kv.w;
                        if (lat) { const float4 qv = qp[j]; num += C[4 * j + 0] * qv.x + C[4 * j + 1] * qv.y + C[4 * j + 2] * qv.z + C[4 * j + 3] * qv.w; }
                    }
                    if (stid < 128) {
                        nreg = a * nreg + bi * ks[i * 128 + stid];
                        if (lat) { float pd = nreg * qs[i * 128 + stid]; pd = wave_sum(pd); if (lane == 0) denp[i * 2 + (stid >> 6)] = pd; }
                    }
                    if (lat) { num += __shfl_xor(num, 1); if (!(stid & 1)) numb[i * 128 + d] = num; }
                    if (stid == 0) mb[i] = m;
                }
                __syncthreads();
                if (lat) {
                    for (int idx = stid; idx < 4096; idx += 256) {
                        const int i = idx >> 7, dd = idx & 127;
                        const float den = denp[2 * i] + denp[2 * i + 1];
                        const float hv = numb[idx] / fmaxf(fabsf(den), __expf(-mb[i]));
                        const int n = dir ? nlo + 31 - i : nlo + i;
                        p.mixh[((size_t)dir * TL + rowbase + n) * 1024 + h * 128 + dd] = f2bf(hv);
                    }
                }
                __syncthreads();
            }
        }
#endif
#if !GLA_CHUNKED
        if (!isml) {
            float* qs = L; float* ks = L + 2048; float* dec = L + 4096; float* vs = L + 6144; float* ob = L + 10240;
            float S[32];
#pragma unroll
            for (int e = 0; e < 32; ++e) S[e] = 0.f;
            const int e = stid >> 1, d0 = (stid & 1) * 32;
            for (int bt = 0; bt < 72; ++bt) {
                const bool lat = bt >= 8;
                const int pos0 = lat ? (bt - 8) * 32 : bt * 32;
                const int seg = lat ? SEQ : CTX;
                const int nlo = dir ? seg - 32 - pos0 : pos0;
                const int rowbase = lat ? b * SEQ : TL + b * CTX;
#pragma unroll
                for (int r = 0; r < 2; ++r) {
                    const int wi = stid + 256 * r, which = wi >> 8, i = (wi >> 3) & 31, ch = (wi & 7) * 8;
                    if (which == 0 && !lat) continue;
                    const int n = dir ? nlo + 31 - i : nlo + i;
                    const uint4 cc = *(const uint4*)(p.z + (size_t)(rowbase + n) * ZS + (which ? C_GK : C_GQ) + h * 64 + ch);
                    float* dst = (which ? ks : qs) + i * 64 + ch;
                    const float scl = which ? 1.f : 0.125f;
                    dst[0] = lo2f(cc.x) * scl; dst[1] = hi2f(cc.x) * scl; dst[2] = lo2f(cc.y) * scl; dst[3] = hi2f(cc.y) * scl;
                    dst[4] = lo2f(cc.z) * scl; dst[5] = hi2f(cc.z) * scl; dst[6] = lo2f(cc.w) * scl; dst[7] = hi2f(cc.w) * scl;
                }
#pragma unroll
                for (int r = 0; r < 2; ++r) {
                    const int wi = stid + 256 * r, i = wi >> 4, ch = (wi & 15) * 8;
                    const int n = dir ? nlo + 31 - i : nlo + i;
                    const uint4 cc = *(const uint4*)(p.z + (size_t)(rowbase + n) * ZS + C_GV + h * 128 + ch);
                    float* dst = vs + i * 128 + ch;
                    dst[0] = lo2f(cc.x); dst[1] = hi2f(cc.x); dst[2] = lo2f(cc.y); dst[3] = hi2f(cc.y);
                    dst[4] = lo2f(cc.z); dst[5] = hi2f(cc.z); dst[6] = lo2f(cc.w); dst[7] = hi2f(cc.w);
                }
#pragma unroll
                for (int r = 0; r < 8; ++r) {
                    const int wi = stid + 256 * r, i = wi >> 6, dd = wi & 63;
                    const int n = dir ? nlo + 31 - i : nlo + i;
                    const float* lr = p.zg + (size_t)(rowbase + n) * 48 + 16 + dir * 16;
                    float al = p.alpha_b[dir * 256 + h * 64 + dd];
#pragma unroll
                    for (int q = 0; q < 16; ++q) al += lr[q] * p.lr_w2[(dir * 16 + q) * 256 + h * 64 + dd];
                    dec[i * 64 + dd] = __expf(logsig(al) * (1.f / 16.f));
                }
                __syncthreads();
                for (int i = 0; i < 32; ++i) {
                    const float ve = vs[i * 128 + e];
                    const float4* dp = (const float4*)(dec + i * 64 + d0);
                    const float4* kp = (const float4*)(ks + i * 64 + d0);
                    const float4* qp = (const float4*)(qs + i * 64 + d0);
                    float o = 0.f;
#pragma unroll
                    for (int j = 0; j < 8; ++j) {
                        const float4 dv = dp[j], kv = kp[j];
                        S[4 * j + 0] = dv.x * S[4 * j + 0] + kv.x * ve; S[4 * j + 1] = dv.y * S[4 * j + 1] + kv.y * ve;
                        S[4 * j + 2] = dv.z * S[4 * j + 2] + kv.z * ve; S[4 * j + 3] = dv.w * S[4 * j + 3] + kv.w * ve;
                        if (lat) { const float4 qv = qp[j]; o += qv.x * S[4 * j + 0] + qv.y * S[4 * j + 1] + qv.z * S[4 * j + 2] + qv.w * S[4 * j + 3]; }
                    }
                    if (lat) { o += __shfl_xor(o, 1); if (!(stid & 1)) ob[i * 128 + e] = o; }
                }
                __syncthreads();
                if (lat) {
                    for (int idx = stid; idx < 4096; idx += 256) {
                        const int i = idx >> 7, ee = idx & 127;
                        const int n = dir ? nlo + 31 - i : nlo + i;
                        p.mixh[((size_t)dir * TL + rowbase + n) * 1024 + 512 + h * 128 + ee] = f2bf(ob[idx]);
                    }
                }
                __syncthreads();
            }
        }
#endif
    }
}

__device__ void phase_mixprep(const Params& p, int bid, int nblk) {
    const int tidx_ = opaque_tid();
    const int lane = tidx_ & 63;
    const int gw = bid * (NT / 64) + (tidx_ >> 6), nw = nblk * (NT / 64);
    const int c0 = lane * 16;
    for (int row = gw; row < TL; row += nw) {
        const uint4* a0 = (const uint4*)(p.mixh + (size_t)row * 1024 + c0);
        const uint4* a1 = (const uint4*)(p.mixh + ((size_t)TL + row) * 1024 + c0);
        const uint4* gp = (const uint4*)(p.z + (size_t)row * ZS + (c0 < 512 ? C_MLO + c0 : C_GR + (c0 - 512)));
        const float* gn = c0 < 512 ? p.ml_norm_g + c0 : p.gla_norm_g + (c0 - 512);
        float s[16], gt[16];
#pragma unroll
        for (int q = 0; q < 2; ++q) {
            const uint4 u0 = a0[q], u1 = a1[q], ug = gp[q];
            const unsigned w0[4] = {u0.x, u0.y, u0.z, u0.w}, w1[4] = {u1.x, u1.y, u1.z, u1.w}, wg[4] = {ug.x, ug.y, ug.z, ug.w};
#pragma unroll
            for (int j = 0; j < 4; ++j) {
                s[q * 8 + 2 * j] = lo2f(w0[j]) + lo2f(w1[j]); s[q * 8 + 2 * j + 1] = hi2f(w0[j]) + hi2f(w1[j]);
                gt[q * 8 + 2 * j] = lo2f(wg[j]); gt[q * 8 + 2 * j + 1] = hi2f(wg[j]);
            }
        }
        float ss = 0.f;
#pragma unroll
        for (int j = 0; j < 16; ++j) ss += s[j] * s[j];
        ss += __shfl_xor(ss, 1); ss += __shfl_xor(ss, 2); ss += __shfl_xor(ss, 4);
        const float rstd = rsqrtf(ss * (1.f / 128.f) + EPS);
        unsigned o[8];
#pragma unroll
        for (int j = 0; j < 8; ++j) {
            float y0, y1;
            const float g0 = gt[2 * j], g1 = gt[2 * j + 1];
            if (c0 < 512) { y0 = sigm(g0); y1 = sigm(g1); } else { y0 = silu(g0); y1 = silu(g1); }
            y0 *= s[2 * j] * rstd * gn[2 * j]; y1 *= s[2 * j + 1] * rstd * gn[2 * j + 1];
            o[j] = pack2(y0, y1);
        }
        uint4* dst = (uint4*)(p.hbuf + (size_t)row * D + c0);
        dst[0] = make_uint4(o[0], o[1], o[2], o[3]); dst[1] = make_uint4(o[4], o[5], o[6], o[7]);
    }
}

__device__ void phase_norm2(const Params& p, int bid, int nblk) {
    const int tidx_ = opaque_tid();
    const int lane = tidx_ & 63;
    const int gw = bid * (NT / 64) + (tidx_ >> 6), nw = nblk * (NT / 64);
    for (int row = gw; row < TL; row += nw) {
        const float* src = p.out + (size_t)row * D;
        const float* md = p.mod + (row >> 11) * 6144;
        float4 v[4]; float ss = 0.f;
#pragma unroll
        for (int j = 0; j < 4; ++j) { v[j] = *(const float4*)(src + j * 256 + lane * 4); ss += v[j].x * v[j].x + v[j].y * v[j].y + v[j].z * v[j].z + v[j].w * v[j].w; }
        ss = wave_sum(ss);
        const float rstd = rsqrtf(ss * (1.f / 1024.f) + EPS);
#pragma unroll
        for (int j = 0; j < 4; ++j) {
            const int col = j * 256 + lane * 4;
            const float4 g = *(const float4*)(p.norm2_g + col), sc = *(const float4*)(md + 4096 + col), sh = *(const float4*)(md + 3072 + col);
            uint2 o;
            o.x = pack2(v[j].x * rstd * g.x * (1.f + sc.x) + sh.x, v[j].y * rstd * g.y * (1.f + sc.y) + sh.y);
            o.y = pack2(v[j].z * rstd * g.z * (1.f + sc.z) + sh.z, v[j].w * rstd * g.w * (1.f + sc.w) + sh.w);
            *(uint2*)(p.hbuf + (size_t)row * D + col) = o;
        }
    }
}

__device__ __forceinline__ unsigned fkey(float f) { const unsigned u = __float_as_uint(f); return (u & 0x80000000u) ? ~u : (u | 0x80000000u); }
__device__ __forceinline__ int mbcnt64(unsigned long long m) { return __builtin_amdgcn_mbcnt_hi((unsigned)(m >> 32), __builtin_amdgcn_mbcnt_lo((unsigned)m, 0)); }
#define LDS_FENCE() asm volatile("s_waitcnt lgkmcnt(0)" ::: "memory")

template <int NV>
__device__ __forceinline__ void wave_top16(const float (&val)[NV], const int (&tag)[NV], float* outv, int* outt) {
    unsigned u[NV];
#pragma unroll
    for (int v = 0; v < NV; ++v) u[v] = fkey(val[v]);
    unsigned T = 0;
    for (int bit = 31; bit >= 0; --bit) {
        const unsigned cand = T | (1u << bit);
        int cnt = 0;
#pragma unroll
        for (int v = 0; v < NV; ++v) cnt += __popcll(__ballot(u[v] >= cand));
        if (cnt >= 16) T = cand;
    }
    int base = 0;
#pragma unroll
    for (int v = 0; v < NV; ++v) {
        const bool gt = u[v] > T;
        const unsigned long long mk = __ballot(gt);
        const int pos = base + mbcnt64(mk);
        if (gt) { outv[pos] = val[v]; outt[pos] = tag[v]; }
        base += __popcll(mk);
    }
#pragma unroll
    for (int v = 0; v < NV; ++v) {
        const bool eq = u[v] == T;
        const unsigned long long mk = __ballot(eq);
        const int pos = base + mbcnt64(mk);
        if (eq && pos < 16) { outv[pos] = val[v]; outt[pos] = tag[v]; }
        base += __popcll(mk);
    }
}

__device__ void phase_topk(const Params& p, char* smem, int bid, int nblk) {
    const int tidx_ = opaque_tid();
    constexpr int KS = 136;
    bf16_t* keysL = (bf16_t*)smem;
    const int tid = tidx_, lane = tid & 63, w = tid >> 6;
    float* wsc = (float*)(smem + 2 * 128 * KS * 2) + w * 320;
    float* qrow = wsc; float* tops = wsc + 256; int* topi = (int*)(wsc + 288);
    constexpr int CH = 256;
    for (int item = bid; item < 8 * (TL / CH); item += nblk) {
        const int ph = item & 7, t0 = (item >> 3) * CH;
        __syncthreads();
        for (int e = tid; e < 2 * 128 * 16; e += NT) {
            const int r = e >> 4, ch = (e & 15) * 8;
            *(uint4*)(keysL + r * KS + ch) = *(const uint4*)(p.keysb + (size_t)ph * 2 * 128 * 128 + r * 128 + ch);
        }
        __syncthreads();
        for (int t = t0 + w; t < t0 + CH; t += NT / 64) {
            {
                const uint2 qq = *(const uint2*)(p.qbuf + (size_t)t * 2048 + ph * 256 + lane * 4);
                *(float4*)(qrow + lane * 4) = make_float4(lo2f(qq.x), hi2f(qq.x), lo2f(qq.y), hi2f(qq.y));
            }
            LDS_FENCE();
#pragma unroll
            for (int hh = 0; hh < 2; ++hh) {
                float s0 = 0.f, s1 = 0.f;
                const bf16_t* k0p = keysL + (hh * 128 + lane) * KS;
                const bf16_t* k1p = k0p + 64 * KS;
                const float* qp = qrow + hh * 128;
#pragma unroll 4
                for (int dc = 0; dc < 16; ++dc) {
                    const float4 qa = *(const float4*)(qp + dc * 8), qb = *(const float4*)(qp + dc * 8 + 4);
                    const uint4 ka = *(const uint4*)(k0p + dc * 8), kb = *(const uint4*)(k1p + dc * 8);
                    s0 += qa.x * lo2f(ka.x) + qa.y * hi2f(ka.x) + qa.z * lo2f(ka.y) + qa.w * hi2f(ka.y) + qb.x * lo2f(ka.z) + qb.y * hi2f(ka.z) + qb.z * lo2f(ka.w) + qb.w * hi2f(ka.w);
                    s1 += qa.x * lo2f(kb.x) + qa.y * hi2f(kb.x) + qa.z * lo2f(kb.y) + qa.w * hi2f(kb.y) + qb.x * lo2f(kb.z) + qb.y * hi2f(kb.z) + qb.z * lo2f(kb.w) + qb.w * hi2f(kb.w);
                }
                const float vv[2] = {s0, s1}; const int tg[2] = {lane, lane + 64};
                wave_top16<2>(vv, tg, tops + hh * 16, topi + hh * 16);
            }
            LDS_FENCE();
            float cv[4]; int ct[4];
#pragma unroll
            for (int j = 0; j < 4; ++j) { const int cidx = lane * 4 + j; cv[j] = tops[cidx >> 4] + tops[16 + (cidx & 15)]; ct[j] = cidx; }
            float* bs = qrow; int* bc = (int*)(qrow + 16);
            LDS_FENCE();
            wave_top16<4>(cv, ct, bs, bc);
            LDS_FENCE();
            const float sv = lane < 16 ? bs[lane] : -3.0e38f;
            const int cc = lane < 16 ? bc[lane] : 0;
            const float mx = wave_max(sv);
            const float ev = lane < 16 ? __expf(sv - mx) : 0.f;
            const float sm = wave_sum(ev);
            if (lane < 16) {
                const int idx = topi[cc >> 4] * 128 + topi[16 + (cc & 15)];
                p.pidx[(size_t)t * 128 + ph * 16 + lane] = idx;
                p.pgw[(size_t)t * 128 + ph * 16 + lane] = ev / sm;
            }
            LDS_FENCE();
        }
    }
    __syncthreads();
}

typedef float f32x2 __attribute__((ext_vector_type(2)));
template <int CTRL> __device__ __forceinline__ float dppf(float x) {
    return __uint_as_float(__builtin_amdgcn_update_dpp(0u, __float_as_uint(x), CTRL, 0xf, 0xf, false));
}
__device__ __forceinline__ float red4(float a, float b, float c, float d) {
    auto r = __builtin_amdgcn_permlane32_swap(__float_as_uint(a), __float_as_uint(b), false, false);
    const float ab = __uint_as_float(r[0]) + __uint_as_float(r[1]);
    auto q = __builtin_amdgcn_permlane32_swap(__float_as_uint(c), __float_as_uint(d), false, false);
    const float cd = __uint_as_float(q[0]) + __uint_as_float(q[1]);
    auto s = __builtin_amdgcn_permlane16_swap(__float_as_uint(ab), __float_as_uint(cd), false, false);
    float x = __uint_as_float(s[0]) + __uint_as_float(s[1]);
    x += dppf<0x128>(x); x += dppf<0x124>(x); x += dppf<0x4E>(x); x += dppf<0xB1>(x);
    return x;
}
__device__ __forceinline__ void dec16(const u32x4 w, float* f) {
#pragma unroll
    for (int q = 0; q < 4; ++q) {
        const f32x2 lo = __builtin_amdgcn_cvt_pk_f32_fp8((int)w[q], false), hi = __builtin_amdgcn_cvt_pk_f32_fp8((int)w[q], true);
        f[4 * q] = lo[0]; f[4 * q + 1] = lo[1]; f[4 * q + 2] = hi[0]; f[4 * q + 3] = hi[1];
    }
}
__device__ __forceinline__ void gload8(u32x4 (&buf)[8], const unsigned char* tab, int idxreg, int j0, int lane) {
#pragma unroll
    for (int jj = 0; jj < 8; ++jj) {
        const int e = __builtin_amdgcn_readlane(idxreg, j0 + jj);
        buf[jj] = *(const u32x4*)(tab + (size_t)e * 1024 + lane * 16);
    }
}
__device__ __forceinline__ float gdots8(const u32x4 (&buf)[8], const float (&hv)[16], float d, int j0, int lane) {
    float pt[8];
#pragma unroll
    for (int jj = 0; jj < 8; ++jj) {
        float f[16]; dec16(buf[jj], f);
        float a = 0.f;
#pragma unroll
        for (int k = 0; k < 16; ++k) a += f[k] * hv[k];
        pt[jj] = a;
    }
    const float x0 = red4(pt[0], pt[1], pt[2], pt[3]), x1 = red4(pt[4], pt[5], pt[6], pt[7]);
    int di = __float_as_int(d);
    di = (lane == j0 + 0) ? __builtin_amdgcn_readlane(__float_as_int(x0), 0) : di;
    di = (lane == j0 + 1) ? __builtin_amdgcn_readlane(__float_as_int(x0), 32) : di;
    di = (lane == j0 + 2) ? __builtin_amdgcn_readlane(__float_as_int(x0), 16) : di;
    di = (lane == j0 + 3) ? __builtin_amdgcn_readlane(__float_as_int(x0), 48) : di;
    di = (lane == j0 + 4) ? __builtin_amdgcn_readlane(__float_as_int(x1), 0) : di;
    di = (lane == j0 + 5) ? __builtin_amdgcn_readlane(__float_as_int(x1), 32) : di;
    di = (lane == j0 + 6) ? __builtin_amdgcn_readlane(__float_as_int(x1), 16) : di;
    di = (lane == j0 + 7) ? __builtin_amdgcn_readlane(__float_as_int(x1), 48) : di;
    return __int_as_float(di);
}
__device__ __forceinline__ void gaxpy8(const u32x4 (&buf)[8], float coef, float (&acc)[16], int j0) {
#pragma unroll
    for (int jj = 0; jj < 8; ++jj) {
        const float c = __int_as_float(__builtin_amdgcn_readlane(__float_as_int(coef), j0 + jj));
        float f[16]; dec16(buf[jj], f);
#pragma unroll
        for (int k = 0; k < 16; ++k) acc[k] += c * f[k];
    }
}
__device__ __forceinline__ float gather_dots(const unsigned char* tab, int idxreg, const float (&hv)[16], int lane) {
    float d = 0.f;
    u32x4 bufA[8], bufB[8];
    gload8(bufA, tab, idxreg, 0, lane);
#pragma unroll 1
    for (int g = 0; g < 8; g += 2) {
        gload8(bufB, tab, idxreg, (g + 1) * 8, lane);
        d = gdots8(bufA, hv, d, g * 8, lane);
        gload8(bufA, tab, idxreg, ((g + 2) & 7) * 8, lane);
        d = gdots8(bufB, hv, d, (g + 1) * 8, lane);
    }
    return d;
}
__device__ __forceinline__ void gather_axpy(const unsigned char* tab, int idxreg, float coef, float (&acc)[16], int lane) {
    u32x4 bufA[8], bufB[8];
    gload8(bufA, tab, idxreg, 0, lane);
#pragma unroll 1
    for (int g = 0; g < 8; g += 2) {
        gload8(bufB, tab, idxreg, (g + 1) * 8, lane);
        gaxpy8(bufA, coef, acc, g * 8);
        gload8(bufA, tab, idxreg, ((g + 2) & 7) * 8, lane);
        gaxpy8(bufB, coef, acc, (g + 1) * 8);
    }
}
__device__ __forceinline__ float gelu_exact(float x) { return 0.5f * x * (1.f + erff(x * 0.7071067811865476f)); }

__device__ void phase_gather(const Params& p, int bid, int nblk) {
    const int tidx_ = opaque_tid();
    const int lane = tidx_ & 63;
    const int gw = bid * (NT / 64) + (tidx_ >> 6), nw = nblk * (NT / 64);
    for (int t = gw; t < TL; t += nw) {
        float hv[16];
        {
            const u32x4 h0 = *(const u32x4*)(p.hbuf + (size_t)t * D + lane * 16), h1 = *(const u32x4*)(p.hbuf + (size_t)t * D + lane * 16 + 8);
#pragma unroll
            for (int q = 0; q < 4; ++q) { hv[2 * q] = lo2f(h0[q]); hv[2 * q + 1] = hi2f(h0[q]); hv[8 + 2 * q] = lo2f(h1[q]); hv[8 + 2 * q + 1] = hi2f(h1[q]); }
        }
        const int ia = p.pidx[(size_t)t * 128 + lane], ib = p.pidx[(size_t)t * 128 + 64 + lane];
        const float ga = p.pgw[(size_t)t * 128 + lane], gb = p.pgw[(size_t)t * 128 + 64 + lane];
        const float usA = p.usc[ia], usB = p.usc[ib], vsA = p.vsc[ia], vsB = p.vsc[ib];
        const float dA = gather_dots(p.u8, ia, hv, lane);
        const float dB = gather_dots(p.u8, ib, hv, lane);
        const float cA = gelu_exact(dA * usA) * ga * vsA, cB = gelu_exact(dB * usB) * gb * vsB;
        float acc[16];
#pragma unroll
        for (int j = 0; j < 16; ++j) acc[j] = 0.f;
        gather_axpy(p.v8, ia, cA, acc, lane);
        gather_axpy(p.v8, ib, cB, acc, lane);
        float* orow = p.out + (size_t)t * D + lane * 16;
        const float* g2 = p.mod + (t >> 11) * 6144 + 5120 + lane * 16;
        float y[16]; float ss = 0.f;
#pragma unroll
        for (int q = 0; q < 4; ++q) {
            const f32x4 xv = *(const f32x4*)(orow + 4 * q), gv = *(const f32x4*)(g2 + 4 * q);
#pragma unroll
            for (int k = 0; k < 4; ++k) { y[4 * q + k] = xv[k] + gv[k] * acc[4 * q + k]; ss += y[4 * q + k] * y[4 * q + k]; }
        }
        ss = wave_sum(ss);
        const float rstd = rsqrtf(ss * (1.f / 1024.f) + EPS);
#pragma unroll
        for (int q = 0; q < 4; ++q) {
            const f32x4 gf = *(const f32x4*)(p.norm_f_g + lane * 16 + 4 * q);
            *(f32x4*)(orow + 4 * q) = (f32x4){y[4 * q] * rstd * gf[0], y[4 * q + 1] * rstd * gf[1], y[4 * q + 2] * rstd * gf[2], y[4 * q + 3] * rstd * gf[3]};
        }
    }
}

extern __shared__ __attribute__((aligned(16))) char dyn_smem[];

__device__ __forceinline__ void run_phase(const Params& p, int ph, char* smem, int bid, int nblk) {
    switch (ph) {
        case 0: phase_mod(p, smem, bid, nblk); phase_convert(p, smem, bid, nblk); break;
        case 1: phase_norm1(p, bid, nblk); break;
        case 2: { EpiInProj e{p.z, p.zg, p.gate_b}; gemm_phase(p.hbuf, p.winT, TT, PTP, 1024, e, smem, bid, nblk); } break;
        case 3: phase_mixers(p, smem, bid, nblk); break;
        case 4: phase_mixprep(p, bid, nblk); break;
        case 5: { EpiOutProj e{p.x, p.mod, p.out}; gemm_phase(p.hbuf, p.woutT, TL, 1024, 1024, e, smem, bid, nblk); } break;
        case 6: phase_norm2(p, bid, nblk); break;
        case 7: { EpiQ e{p.qbuf}; gemm_phase(p.hbuf, p.wqT, TL, 2048, 1024, e, smem, bid, nblk); } break;
        case 8: phase_topk(p, smem, bid, nblk); break;
        case 9: phase_gather(p, bid, nblk); break;
    }
}
#ifndef PHASE_MASK
#define PHASE_MASK 0x3ff
#endif
constexpr int NPHASE = 10;

#if FUSED
__global__ void __launch_bounds__(NT, 2) mega_kernel(Params p) {
    cg::grid_group grid = cg::this_grid();
#pragma nounroll
    for (int ph = 0; ph < NPHASE; ++ph) {
        if ((PHASE_MASK >> ph) & 1) run_phase(p, ph, dyn_smem, blockIdx.x, gridDim.x);
#if PROBE_REPEAT_MASK
        if ((PROBE_REPEAT_MASK >> ph) & 1) { grid.sync(); run_phase(p, ph, dyn_smem, blockIdx.x, gridDim.x); }
#endif
        if (ph + 1 < NPHASE) grid.sync();
    }
}
#else
template <int PH>
__global__ void __launch_bounds__(NT, 2) phase_kernel(Params p) { run_phase(p, PH, dyn_smem, blockIdx.x, gridDim.x); }
#endif

static inline char* carve(char*& cur, size_t bytes) { char* r = cur; cur += (bytes + 255) & ~(size_t)255; return r; }

extern "C" void kernel_launch(void* const* d_in, const int* in_sizes, int n_in, void* d_out, int out_size, void* d_ws, size_t ws_size, hipStream_t stream) {
    Params p{};
    p.x = (const float*)d_in[0]; p.c = (const float*)d_in[1]; p.ctx = (const float*)d_in[2]; p.c_ctx = (const float*)d_in[3];
    p.w_mod = (const float*)d_in[4]; p.b_mod = (const float*)d_in[5]; p.norm1_g = (const float*)d_in[6]; p.w_in = (const float*)d_in[7];
    p.conv_w = (const float*)d_in[8]; p.gate_b = (const float*)d_in[9]; p.ml_norm_g = (const float*)d_in[10]; p.lr_w2 = (const float*)d_in[11];
    p.alpha_b = (const float*)d_in[12]; p.gla_norm_g = (const float*)d_in[13]; p.w_out = (const float*)d_in[14]; p.norm2_g = (const float*)d_in[15];
    p.wq = (const float*)d_in[16]; p.keys = (const float*)d_in[17]; p.pu = (const float*)d_in[18]; p.pv = (const float*)d_in[19]; p.norm_f_g = (const float*)d_in[20];
    p.out = (float*)d_out;
    char* cur = (char*)d_ws;
    p.mod = (float*)carve(cur, (size_t)33 * 6144 * 4);
    p.winT = (bf16_t*)carve(cur, (size_t)PTP * 1024 * 2);
    p.woutT = (bf16_t*)carve(cur, (size_t)1024 * 1024 * 2);
    p.wqT = (bf16_t*)carve(cur, (size_t)2048 * 1024 * 2);
    p.keysb = (bf16_t*)carve(cur, (size_t)8 * 2 * 128 * 128 * 2);
    p.u8 = (unsigned char*)carve(cur, (size_t)16384 * 1024);
    p.v8 = (unsigned char*)carve(cur, (size_t)16384 * 1024);
    p.usc = (float*)carve(cur, (size_t)16384 * 4);
    p.vsc = (float*)carve(cur, (size_t)16384 * 4);
    p.hbuf = (bf16_t*)carve(cur, (size_t)TT * 1024 * 2);
    p.z = (bf16_t*)carve(cur, (size_t)TT * ZS * 2);
    p.zg = (float*)carve(cur, (size_t)TT * 48 * 4);
    p.mixh = (bf16_t*)carve(cur, (size_t)2 * TL * 1024 * 2);
    p.qbuf = p.z;
    p.pidx = (int*)p.mixh;
    p.pgw = (float*)((char*)p.mixh + (size_t)TL * 128 * 4);
    if ((size_t)(cur - (char*)d_ws) > ws_size) { fprintf(stderr, "workspace too small: need %zu have %zu\n", (size_t)(cur - (char*)d_ws), ws_size); return; }
#if FUSED
    static int grid_blocks = 0;
    if (!grid_blocks) {
        int dev = 0, cus = 0, per_cu = 0;
        hipGetDevice(&dev);
        hipDeviceGetAttribute(&cus, hipDeviceAttributeMultiprocessorCount, dev);
        hipFuncSetAttribute((const void*)mega_kernel, hipFuncAttributeMaxDynamicSharedMemorySize, SMEM_BYTES);
        hipOccupancyMaxActiveBlocksPerMultiprocessor(&per_cu, mega_kernel, NT, SMEM_BYTES);
        if (per_cu > 2) per_cu = 2;
        grid_blocks = cus * per_cu;
    }
    void* args[] = {&p};
    hipError_t e = hipLaunchCooperativeKernel((void*)mega_kernel, dim3(grid_blocks), dim3(NT), args, SMEM_BYTES, stream);
    if (e != hipSuccess) fprintf(stderr, "cooperative launch failed: %s (grid %d)\n", hipGetErrorString(e), grid_blocks);
#else
    const int G = 512;
#define LAUNCH(PH) do { hipFuncSetAttribute((const void*)phase_kernel<PH>, hipFuncAttributeMaxDynamicSharedMemorySize, SMEM_BYTES); \
        hipLaunchKernelGGL(phase_kernel<PH>, dim3(G), dim3(NT), SMEM_BYTES, stream, p); } while (0)
    LAUNCH(0); LAUNCH(1); LAUNCH(2); LAUNCH(3); LAUNCH(4); LAUNCH(5); LAUNCH(6); LAUNCH(7); LAUNCH(8); LAUNCH(9);
#endif
}
```

```cpp
#include <hip/hip_runtime.h>
#include <hip/hip_cooperative_groups.h>
#include <cstdio>
#include <cstdint>
namespace cg = cooperative_groups;

#ifndef FUSED
#define FUSED 1
#endif
#define PROBE_REPEAT_MASK 0
#ifndef ML_CHUNKED
#define ML_CHUNKED 1
#endif
#ifndef GLA_CHUNKED
#define GLA_CHUNKED 1
#endif

typedef unsigned short bf16_t;
typedef short bf16x8 __attribute__((ext_vector_type(8)));
typedef float f32x4 __attribute__((ext_vector_type(4)));
typedef unsigned u32x4 __attribute__((ext_vector_type(4)));

constexpr int D = 1024, NB = 32, SEQ = 2048, CTX = 256;
constexpr int TL = NB * SEQ;
constexpr int TC = NB * CTX;
constexpr int TT = TL + TC;
constexpr int PT = 3632;
constexpr int PTP = 3840;
constexpr int ZS = 3632;
constexpr int C_MLQ = 0, C_MLK = 512, C_MLV = 1024, C_MLO = 1536, C_MLG = 2048, C_GQ = 2064, C_GK = 2320, C_GV = 2576, C_GR = 3088, C_LR = 3600;
constexpr int NT = 256;
constexpr int SMEM_BYTES = 80 * 1024;
constexpr float EPS = 1e-6f;

struct Params {
    const float *x, *c, *ctx, *c_ctx, *w_mod, *b_mod, *norm1_g, *w_in, *conv_w, *gate_b, *ml_norm_g, *lr_w2, *alpha_b, *gla_norm_g,
        *w_out, *norm2_g, *wq, *keys, *pu, *pv, *norm_f_g;
    float* out;
    float* mod;
    bf16_t* winT;
    bf16_t* woutT;
    bf16_t* wqT;
    bf16_t* keysb;
    unsigned char* u8;
    unsigned char* v8;
    float* usc;
    float* vsc;
    bf16_t* hbuf;
    bf16_t* z;
    float* zg;
    bf16_t* mixh;
    bf16_t* qbuf;
    int* pidx;
    float* pgw;
};

__device__ __forceinline__ int opaque_tid() { int t = threadIdx.x; asm volatile("" : "+v"(t)); return t; }
__device__ __forceinline__ float bf2f(bf16_t v) { return __uint_as_float(((unsigned)v) << 16); }
__device__ __forceinline__ bf16_t f2bf(float f) { unsigned u = __float_as_uint(f); u += 0x7fffu + ((u >> 16) & 1u); return (bf16_t)(u >> 16); }
__device__ __forceinline__ unsigned pack2(float a, float b) { return (unsigned)f2bf(a) | ((unsigned)f2bf(b) << 16); }
__device__ __forceinline__ float lo2f(unsigned w) { return __uint_as_float(w << 16); }
__device__ __forceinline__ float hi2f(unsigned w) { return __uint_as_float(w & 0xffff0000u); }
__device__ __forceinline__ float wave_sum(float v) {
#pragma unroll
    for (int o = 32; o > 0; o >>= 1) v += __shfl_xor(v, o);
    return v;
}
__device__ __forceinline__ float wave_max(float v) {
#pragma unroll
    for (int o = 32; o > 0; o >>= 1) v = fmaxf(v, __shfl_xor(v, o));
    return v;
}
__device__ __forceinline__ float logsig(float x) { return fminf(x, 0.f) - log1pf(__expf(-fabsf(x))); }
__device__ __forceinline__ float silu(float x) { return x / (1.f + __expf(-x)); }
__device__ __forceinline__ float sigm(float x) { return 1.f / (1.f + __expf(-x)); }

__device__ void phase_mod(const Params& p, char* smem, int bid, int nblk) {
    const int tidx_ = opaque_tid();
    float* condL = (float*)smem;
    const int tid = tidx_, cl = tid & 63, ks = tid >> 6;
    for (int item = bid; item < 96; item += nblk) {
        const int col0 = item * 64, col = col0 + cl;
        float acc[33];
#pragma unroll
        for (int b = 0; b < 33; ++b) acc[b] = 0.f;
        for (int kc = 0; kc < 4; ++kc) {
            __syncthreads();
            for (int e = tid; e < 4 * 64 * 33; e += NT) {
                const int s = e / (64 * 33), kk = (e / 33) % 64, b = e % 33;
                const int k = s * 256 + kc * 64 + kk;
                const float cv = b < 32 ? p.c[b * 1024 + k] : p.c_ctx[k];
                condL[e] = silu(cv);
            }
            __syncthreads();
            for (int kk = 0; kk < 64; ++kk) {
                const int k = ks * 256 + kc * 64 + kk;
                const float w = p.w_mod[(size_t)k * 6144 + col];
                const float* cp = condL + (ks * 64 + kk) * 33;
#pragma unroll
                for (int b = 0; b < 33; ++b) acc[b] += w * cp[b];
            }
        }
        __syncthreads();
#pragma unroll
        for (int b = 0; b < 33; ++b) condL[(ks * 33 + b) * 64 + cl] = acc[b];
        __syncthreads();
        for (int e = tid; e < 33 * 64; e += NT) {
            const int b = e >> 6, cc = e & 63;
            float v = condL[(0 * 33 + b) * 64 + cc] + condL[(1 * 33 + b) * 64 + cc] + condL[(2 * 33 + b) * 64 + cc] + condL[(3 * 33 + b) * 64 + cc];
            p.mod[b * 6144 + col0 + cc] = v + p.b_mod[col0 + cc];
        }
        __syncthreads();
    }
}

__device__ void convT(const float* __restrict__ src, int K, int N, int Npad, bf16_t* __restrict__ dst, char* smem, int bid, int nblk) {
    const int tidx_ = opaque_tid();
    float* tile = (float*)smem;
    const int tid = tidx_;
    const int nk = K / 64, nn = Npad / 64;
    for (int t = bid; t < nk * nn; t += nblk) {
        const int k0 = (t % nk) * 64, n0 = (t / nk) * 64;
        __syncthreads();
#pragma unroll
        for (int r = 0; r < 16; ++r) {
            const int k = r * 4 + (tid >> 6), n = tid & 63;
            tile[k * 65 + n] = (n0 + n < N) ? src[(size_t)(k0 + k) * N + n0 + n] : 0.f;
        }
        __syncthreads();
#pragma unroll
        for (int r = 0; r < 16; ++r) {
            const int n = r * 4 + (tid >> 6), k = tid & 63;
            dst[(size_t)(n0 + n) * K + k0 + k] = f2bf(tile[k * 65 + n]);
        }
    }
    __syncthreads();
}
__device__ void conv_copy(const float* __restrict__ src, bf16_t* __restrict__ dst, size_t n, int gtid, int gthreads) {
    const size_t n4 = n / 4;
    for (size_t i = gtid; i < n4; i += gthreads) {
        const float4 v = ((const float4*)src)[i];
        uint2 o; o.x = pack2(v.x, v.y); o.y = pack2(v.z, v.w);
        ((uint2*)dst)[i] = o;
    }
}
__device__ void phase_convert(const Params& p, char* smem, int bid, int nblk) {
    const int tidx_ = opaque_tid();
    convT(p.w_in, 1024, PT, PTP, p.winT, smem, bid, nblk);
    convT(p.w_out, 1024, 1024, 1024, p.woutT, smem, bid, nblk);
    convT(p.wq, 1024, 2048, 2048, p.wqT, smem, bid, nblk);
    const int gtid = bid * NT + tidx_, gth = nblk * NT;
    conv_copy(p.keys, p.keysb, (size_t)8 * 2 * 128 * 128, gtid, gth);
    {
        const int lane = tidx_ & 63;
        const int gw = bid * (NT / 64) + (tidx_ >> 6), nw = nblk * (NT / 64);
        for (int row = gw; row < 2 * 16384; row += nw) {
            const bool isv = row >= 16384;
            const int r = isv ? row - 16384 : row;
            const float* src = (isv ? p.pv : p.pu) + (size_t)r * 1024 + lane * 16;
            f32x4 v[4];
            float mx = 0.f;
#pragma unroll
            for (int q = 0; q < 4; ++q) { v[q] = *(const f32x4*)(src + 4 * q); mx = fmaxf(mx, fmaxf(fmaxf(fabsf(v[q][0]), fabsf(v[q][1])), fmaxf(fabsf(v[q][2]), fabsf(v[q][3])))); }
            mx = wave_max(mx);
            mx = fmaxf(mx, 1e-30f);
            const float sc = 440.f / mx;
            u32x4 o;
#pragma unroll
            for (int q = 0; q < 4; ++q) {
                int w = __builtin_amdgcn_cvt_pk_fp8_f32(v[q][0] * sc, v[q][1] * sc, 0, false);
                w = __builtin_amdgcn_cvt_pk_fp8_f32(v[q][2] * sc, v[q][3] * sc, w, true);
                o[q] = (unsigned)w;
            }
            *(u32x4*)((isv ? p.v8 : p.u8) + (size_t)r * 1024 + lane * 16) = o;
            if (lane == 0) (isv ? p.vsc : p.usc)[r] = mx * (1.f / 440.f);
        }
    }
}

__device__ void phase_norm1(const Params& p, int bid, int nblk) {
    const int tidx_ = opaque_tid();
    const int lane = tidx_ & 63;
    const int gw = bid * (NT / 64) + (tidx_ >> 6), nw = nblk * (NT / 64);
    for (int row = gw; row < TT; row += nw) {
        const float* src = row < TL ? p.x + (size_t)row * D : p.ctx + (size_t)(row - TL) * D;
        const float* md = p.mod + (row < TL ? (row >> 11) : 32) * 6144;
        float4 v[4]; float ss = 0.f;
#pragma unroll
        for (int j = 0; j < 4; ++j) { v[j] = *(const float4*)(src + j * 256 + lane * 4); ss += v[j].x * v[j].x + v[j].y * v[j].y + v[j].z * v[j].z + v[j].w * v[j].w; }
        ss = wave_sum(ss);
        const float rstd = rsqrtf(ss * (1.f / 1024.f) + EPS);
#pragma unroll
        for (int j = 0; j < 4; ++j) {
            const int col = j * 256 + lane * 4;
            const float4 g = *(const float4*)(p.norm1_g + col), sc = *(const float4*)(md + 1024 + col), sh = *(const float4*)(md + col);
            uint2 o;
            o.x = pack2(v[j].x * rstd * g.x * (1.f + sc.x) + sh.x, v[j].y * rstd * g.y * (1.f + sc.y) + sh.y);
            o.y = pack2(v[j].z * rstd * g.z * (1.f + sc.z) + sh.z, v[j].w * rstd * g.w * (1.f + sc.w) + sh.w);
            *(uint2*)(p.hbuf + (size_t)row * D + col) = o;
        }
    }
}

template <class Epi>
__device__ void gemm_phase(const bf16_t* __restrict__ A, const bf16_t* __restrict__ Bt, int M, int N, int K, const Epi& epi, char* smem, int bid, int nblk) {
    const int tidx_ = opaque_tid();
    constexpr int BM = 128, BN = 128, BK = 64, LS = 72;
    bf16_t* sA = (bf16_t*)smem;
    bf16_t* sB = sA + BM * LS;
    const int tid = tidx_, lane = tid & 63, w = tid >> 6, wr = w >> 1, wc = w & 1;
    const int nN = N / BN, ntiles = (M / BM) * nN;
    const int lr = tid >> 3, lc = (tid & 7) * 8;
    for (int tile = bid; tile < ntiles; tile += nblk) {
        const int tm = tile / nN, tn = tile % nN;
        const bf16_t* Ag = A + (size_t)(tm * BM) * K;
        const bf16_t* Bg = Bt + (size_t)(tn * BN) * K;
        f32x4 acc[4][4];
#pragma unroll
        for (int i = 0; i < 4; ++i)
#pragma unroll
            for (int j = 0; j < 4; ++j) acc[i][j] = (f32x4){0.f, 0.f, 0.f, 0.f};
        u32x4 ra[4], rb[4];
#pragma unroll
        for (int i = 0; i < 4; ++i) {
            ra[i] = *(const u32x4*)(Ag + (size_t)(lr + 32 * i) * K + lc);
            rb[i] = *(const u32x4*)(Bg + (size_t)(lr + 32 * i) * K + lc);
        }
        for (int k0 = 0; k0 < K; k0 += BK) {
            __syncthreads();
#pragma unroll
            for (int i = 0; i < 4; ++i) {
                *(u32x4*)(sA + (lr + 32 * i) * LS + lc) = ra[i];
                *(u32x4*)(sB + (lr + 32 * i) * LS + lc) = rb[i];
            }
            __syncthreads();
            {
                const int kn = (k0 + BK < K) ? k0 + BK : k0;
#pragma unroll
                for (int i = 0; i < 4; ++i) {
                    ra[i] = *(const u32x4*)(Ag + (size_t)(lr + 32 * i) * K + kn + lc);
                    rb[i] = *(const u32x4*)(Bg + (size_t)(lr + 32 * i) * K + kn + lc);
                }
            }
#pragma unroll
            for (int kk = 0; kk < 2; ++kk) {
                bf16x8 af[4], bfr[4];
#pragma unroll
                for (int i = 0; i < 4; ++i) {
                    af[i] = *(const bf16x8*)(sA + (wr * 64 + i * 16 + (lane & 15)) * LS + kk * 32 + (lane >> 4) * 8);
                    bfr[i] = *(const bf16x8*)(sB + (wc * 64 + i * 16 + (lane & 15)) * LS + kk * 32 + (lane >> 4) * 8);
                }
#pragma unroll
                for (int i = 0; i < 4; ++i)
#pragma unroll
                    for (int j = 0; j < 4; ++j) acc[i][j] = __builtin_amdgcn_mfma_f32_16x16x32_bf16(af[i], bfr[j], acc[i][j], 0, 0, 0);
            }
        }
#pragma unroll
        for (int i = 0; i < 4; ++i)
#pragma unroll
            for (int j = 0; j < 4; ++j)
#pragma unroll
                for (int r = 0; r < 4; ++r) {
                    const int row = tm * BM + wr * 64 + i * 16 + (lane >> 4) * 4 + r;
                    const int col = tn * BN + wc * 64 + j * 16 + (lane & 15);
                    epi(row, col, acc[i][j][r]);
                }
    }
    __syncthreads();
}

struct EpiInProj {
    bf16_t* z; float* zg; const float* gate_b;
    __device__ __forceinline__ void operator()(int row, int col, float v) const {
        if (col < C_MLG) z[(size_t)row * ZS + col] = f2bf(v);
        else if (col < C_GQ) zg[(size_t)row * 48 + (col - C_MLG)] = v + gate_b[col - C_MLG];
        else if (col < C_LR) z[(size_t)row * ZS + col] = f2bf(v);
        else if (col < PT) zg[(size_t)row * 48 + 16 + (col - C_LR)] = v;
    }
};
struct EpiOutProj {
    const float* x; const float* mod; float* out;
    __device__ __forceinline__ void operator()(int row, int col, float v) const {
        const size_t o = (size_t)row * D + col;
        out[o] = x[o] + mod[(row >> 11) * 6144 + 2048 + col] * v;
    }
};
struct EpiQ {
    bf16_t* q;
    __device__ __forceinline__ void operator()(int row, int col, float v) const { q[(size_t)row * 2048 + col] = f2bf(v); }
};


#define MFMA16(a, b, c) __builtin_amdgcn_mfma_f32_16x16x32_bf16((a), (b), (c), 0, 0, 0)
__device__ __forceinline__ void conv8(const Params& p, const bf16_t* zc, int col, bool vl, bool vr, float scl, float* y) {
    const u32x4 cc = *(const u32x4*)zc;
    u32x4 ll = (u32x4){0u, 0u, 0u, 0u}, rr = (u32x4){0u, 0u, 0u, 0u};
    if (vl) ll = *(const u32x4*)(zc - ZS);
    if (vr) rr = *(const u32x4*)(zc + ZS);
    const f32x4 w0a = *(const f32x4*)(p.conv_w + col), w0b = *(const f32x4*)(p.conv_w + col + 4);
    const f32x4 w1a = *(const f32x4*)(p.conv_w + 1024 + col), w1b = *(const f32x4*)(p.conv_w + 1024 + col + 4);
    const f32x4 w2a = *(const f32x4*)(p.conv_w + 2048 + col), w2b = *(const f32x4*)(p.conv_w + 2048 + col + 4);
    const float w0[8] = {w0a[0], w0a[1], w0a[2], w0a[3], w0b[0], w0b[1], w0b[2], w0b[3]};
    const float w1[8] = {w1a[0], w1a[1], w1a[2], w1a[3], w1b[0], w1b[1], w1b[2], w1b[3]};
    const float w2[8] = {w2a[0], w2a[1], w2a[2], w2a[3], w2b[0], w2b[1], w2b[2], w2b[3]};
#pragma unroll
    for (int j = 0; j < 4; ++j) {
        const float y0 = w0[2 * j] * lo2f(ll[j]) + w1[2 * j] * lo2f(cc[j]) + w2[2 * j] * lo2f(rr[j]);
        const float y1 = w0[2 * j + 1] * hi2f(ll[j]) + w1[2 * j + 1] * hi2f(cc[j]) + w2[2 * j + 1] * hi2f(rr[j]);
        y[2 * j] = silu(y0) * scl; y[2 * j + 1] = silu(y1) * scl;
    }
}

__device__ void mlstm_item_chunked(const Params& p, char* smem, int tid, int b, int h, int dir) {
    bf16_t* Qs = (bf16_t*)smem;
    bf16_t* Ks = Qs + 32 * 136;
    bf16_t* Ktw = Ks + 32 * 136;
    bf16_t* Vt = Ktw + 128 * 40;
    bf16_t* Ps = Vt + 144 * 40;
    bf16_t* Cb = Ps + 32 * 40;
    float* sg = (float*)(Cb + 144 * 136);
    float* sM = sg + 32; float* sinter = sg + 64; float* sfloor = sg + 96; float* sw = sg + 128; float* smisc = sg + 160;
    const int lane = tid & 63, w = __builtin_amdgcn_readfirstlane(tid >> 6), lr = lane & 15, lq = lane >> 4;
    for (int i = tid; i < 16 * 40; i += 256) Vt[128 * 40 + i] = 0x3f80;
    for (int i = tid; i < 144 * 136 / 2; i += 256) ((unsigned*)Cb)[i] = 0u;
    f32x4 CT[2][9];
#pragma unroll
    for (int i = 0; i < 2; ++i)
#pragma unroll
        for (int j = 0; j < 9; ++j) CT[i][j] = (f32x4){0.f, 0.f, 0.f, 0.f};
    float m_s = 0.f;
    __syncthreads();
    for (int bt = 0; bt < 72; ++bt) {
        const bool lat = bt >= 8;
        const int pos0 = lat ? (bt - 8) * 32 : bt * 32;
        const int seg = lat ? SEQ : CTX;
        const int nlo = dir ? seg - 32 - pos0 : pos0;
        const int rowbase = lat ? b * SEQ : TL + b * CTX;
        if (w == 0) {
            const int l = lane & 31;
            const int n = dir ? nlo + 31 - l : nlo + l;
            const float* gp = p.zg + (size_t)(rowbase + n) * 48 + dir * 8 + h;
            const float ig = gp[0], lf = logsig(gp[4]);
            float bsum = lf;
#pragma unroll
            for (int o = 1; o < 32; o <<= 1) { const float t = __shfl_up(bsum, o); if (l >= o) bsum += t; }
            const float g = ig - bsum;
            float cm = g;
#pragma unroll
            for (int o = 1; o < 32; o <<= 1) { const float t = __shfl_up(cm, o); if (l >= o) cm = fmaxf(cm, t); }
            const float M = fmaxf(m_s, cm);
            const float Ml = __shfl(M, 31), bl = __shfl(bsum, 31);
            if (lane < 32) {
                sg[l] = g; sM[l] = M; sinter[l] = __expf(m_s - M); sfloor[l] = __expf(-(bsum + M)); sw[l] = __expf(g - Ml);
                if (lane == 0) { smisc[0] = __expf(m_s - Ml); smisc[1] = bl + Ml; }
            }
        }
        __syncthreads();
        {
            const int l = tid & 31, c8 = tid >> 5;
            const int n = dir ? nlo + 31 - l : nlo + l;
            const bool vl = lat ? (((n - 1) >> 6) == (n >> 6)) : (n - 1 >= 0);
            const bool vr = lat ? (((n + 1) >> 6) == (n >> 6)) : (n + 1 < CTX);
            const bf16_t* zr = p.z + (size_t)(rowbase + n) * ZS;
            const float wl = sw[l];
#pragma unroll 1
            for (int r = 0; r < 2; ++r) {
                const int ec = c8 + 8 * r;
                float y[8];
                conv8(p, zr + C_MLK + h * 128 + ec * 8, C_MLK + h * 128 + ec * 8, vl, vr, 0.08838834764831845f, y);
                *(u32x4*)(Ks + l * 136 + ec * 8) = (u32x4){pack2(y[0], y[1]), pack2(y[2], y[3]), pack2(y[4], y[5]), pack2(y[6], y[7])};
#pragma unroll
                for (int j = 0; j < 8; ++j) Ktw[(ec * 8 + j) * 40 + l] = f2bf(y[j] * wl);
                if (lat) {
                    conv8(p, zr + C_MLQ + h * 128 + ec * 8, C_MLQ + h * 128 + ec * 8, vl, vr, 1.f, y);
                    *(u32x4*)(Qs + l * 136 + ec * 8) = (u32x4){pack2(y[0], y[1]), pack2(y[2], y[3]), pack2(y[4], y[5]), pack2(y[6], y[7])};
                }
                const u32x4 vv = *(const u32x4*)(zr + C_MLV + h * 128 + ec * 8);
#pragma unroll
                for (int j = 0; j < 4; ++j) { Vt[(ec * 8 + 2 * j) * 40 + l] = (bf16_t)(vv[j] & 0xffffu); Vt[(ec * 8 + 2 * j + 1) * 40 + l] = (bf16_t)(vv[j] >> 16); }
            }
        }
        __syncthreads();
        if (lat) {
            const int mi = w >> 1, ni = w & 1;
            f32x4 sa = (f32x4){0.f, 0.f, 0.f, 0.f};
            if (!(mi == 0 && ni == 1)) {
#pragma unroll
                for (int kk = 0; kk < 4; ++kk) {
                    const bf16x8 af = *(const bf16x8*)(Qs + (mi * 16 + lr) * 136 + kk * 32 + lq * 8);
                    const bf16x8 bf = *(const bf16x8*)(Ks + (ni * 16 + lr) * 136 + kk * 32 + lq * 8);
                    sa = MFMA16(af, bf, sa);
                }
            }
            const int sidx = ni * 16 + lr;
            const float gs = sg[sidx];
#pragma unroll
            for (int r = 0; r < 4; ++r) {
                const int t = mi * 16 + lq * 4 + r;
                const float pv = (sidx <= t) ? sa[r] * __expf(gs - sM[t]) : 0.f;
                Ps[t * 40 + sidx] = f2bf(pv);
            }
        }
        __syncthreads();
        if (lat) {
            const int nts[3] = {2 * w, 2 * w + 1, 8};
            f32x4 acc[2][3];
#pragma unroll
            for (int i = 0; i < 2; ++i)
#pragma unroll
                for (int j = 0; j < 3; ++j) acc[i][j] = (f32x4){0.f, 0.f, 0.f, 0.f};
#pragma unroll
            for (int kk = 0; kk < 4; ++kk) {
                bf16x8 af[2], bf[3];
#pragma unroll
                for (int i = 0; i < 2; ++i) af[i] = *(const bf16x8*)(Qs + (i * 16 + lr) * 136 + kk * 32 + lq * 8);
#pragma unroll
                for (int j = 0; j < 3; ++j) bf[j] = *(const bf16x8*)(Cb + (nts[j] * 16 + lr) * 136 + kk * 32 + lq * 8);
#pragma unroll
                for (int i = 0; i < 2; ++i)
#pragma unroll
                    for (int j = 0; j < 3; ++j) acc[i][j] = MFMA16(af[i], bf[j], acc[i][j]);
            }
#pragma unroll
            for (int i = 0; i < 2; ++i)
#pragma unroll
                for (int r = 0; r < 4; ++r) {
                    const float it = sinter[i * 16 + lq * 4 + r];
#pragma unroll
                    for (int j = 0; j < 3; ++j) acc[i][j][r] *= it;
                }
            {
                bf16x8 af[2], bf[3];
#pragma unroll
                for (int i = 0; i < 2; ++i) af[i] = *(const bf16x8*)(Ps + (i * 16 + lr) * 40 + lq * 8);
#pragma unroll
                for (int j = 0; j < 3; ++j) bf[j] = *(const bf16x8*)(Vt + (nts[j] * 16 + lr) * 40 + lq * 8);
#pragma unroll
                for (int i = 0; i < 2; ++i)
#pragma unroll
                    for (int j = 0; j < 3; ++j) acc[i][j] = MFMA16(af[i], bf[j], acc[i][j]);
            }
#pragma unroll
            for (int i = 0; i < 2; ++i)
#pragma unroll
                for (int r = 0; r < 4; ++r) {
                    const int t = i * 16 + lq * 4 + r;
                    const float dn = fmaxf(fabsf(acc[i][2][r]), sfloor[t]);
                    const float inv = 1.f / dn;
                    const int n = dir ? nlo + 31 - t : nlo + t;
                    bf16_t* orow = p.mixh + ((size_t)dir * TL + rowbase + n) * 1024 + h * 128;
#pragma unroll
                    for (int j = 0; j < 2; ++j) orow[nts[j] * 16 + lr] = f2bf(acc[i][j][r] * inv);
                }
        }
        __syncthreads();
        {
            const float a = smisc[0];
            bf16x8 af[2];
#pragma unroll
            for (int i = 0; i < 2; ++i) af[i] = *(const bf16x8*)(Ktw + ((2 * w + i) * 16 + lr) * 40 + lq * 8);
#pragma unroll
            for (int j = 0; j < 9; ++j) {
                const bf16x8 bf = *(const bf16x8*)(Vt + (j * 16 + lr) * 40 + lq * 8);
#pragma unroll
                for (int i = 0; i < 2; ++i) {
                    CT[i][j] = CT[i][j] * a;
                    CT[i][j] = MFMA16(af[i], bf, CT[i][j]);
                    uint2 pk; pk.x = pack2(CT[i][j][0], CT[i][j][1]); pk.y = pack2(CT[i][j][2], CT[i][j][3]);
                    *(uint2*)(Cb + (j * 16 + lr) * 136 + (2 * w + i) * 16 + lq * 4) = pk;
                }
            }
            m_s = smisc[1];
        }
        __syncthreads();
    }
}

__device__ void gla_item_chunked(const Params& p, char* smem, int tid, int b, int h, int dir) {
    bf16_t* Qd = (bf16_t*)smem;
    bf16_t* Qb = Qd + 32 * 72;
    bf16_t* Kd = Qb + 32 * 72;
    bf16_t* Kwt = Kd + 32 * 72;
    bf16_t* Vt = Kwt + 64 * 40;
    bf16_t* Ps = Vt + 128 * 40;
    bf16_t* Sb = Ps + 32 * 40;
    float* bc = (float*)(Sb + 128 * 72);
    const int lane = tid & 63, w = __builtin_amdgcn_readfirstlane(tid >> 6), lr = lane & 15, lq = lane >> 4;
    for (int i = tid; i < 128 * 72 / 2; i += 256) ((unsigned*)Sb)[i] = 0u;
    f32x4 S[8];
#pragma unroll
    for (int j = 0; j < 8; ++j) S[j] = (f32x4){0.f, 0.f, 0.f, 0.f};
    __syncthreads();
    for (int bt = 0; bt < 72; ++bt) {
        const bool lat = bt >= 8;
        const int pos0 = lat ? (bt - 8) * 32 : bt * 32;
        const int seg = lat ? SEQ : CTX;
        const int nlo = dir ? seg - 32 - pos0 : pos0;
        const int rowbase = lat ? b * SEQ : TL + b * CTX;
        {
            const int dd = tid & 63;
            float w2[16];
#pragma unroll
            for (int q = 0; q < 16; ++q) w2[q] = p.lr_w2[(dir * 16 + q) * 256 + h * 64 + dd];
            const float ab = p.alpha_b[dir * 256 + h * 64 + dd];
#pragma unroll
            for (int r = 0; r < 8; ++r) {
                const int l = (tid >> 6) + 4 * r;
                const int n = dir ? nlo + 31 - l : nlo + l;
                const float* lrp = p.zg + (size_t)(rowbase + n) * 48 + 16 + dir * 16;
                float al = ab;
#pragma unroll
                for (int q = 0; q < 16; ++q) al += lrp[q] * w2[q];
                bc[l * 64 + dd] = logsig(al) * (1.f / 16.f);
            }
        }
        __syncthreads();
        if (tid < 64) {
            float run = 0.f;
#pragma unroll 8
            for (int l = 0; l < 32; ++l) { run += bc[l * 64 + tid]; bc[l * 64 + tid] = run; }
        }
        __syncthreads();
        {
            const int l = tid & 31, dc = tid >> 5;
            const int n = dir ? nlo + 31 - l : nlo + l;
            const bf16_t* zr = p.z + (size_t)(rowbase + n) * ZS;
            float bl[8], rf[8], be[8];
#pragma unroll
            for (int j = 0; j < 8; ++j) { bl[j] = bc[l * 64 + dc * 8 + j]; rf[j] = bc[16 * 64 + dc * 8 + j]; be[j] = bc[31 * 64 + dc * 8 + j]; }
            {
                const u32x4 kk = *(const u32x4*)(zr + C_GK + h * 64 + dc * 8);
                float kf[8];
#pragma unroll
                for (int j = 0; j < 4; ++j) { kf[2 * j] = lo2f(kk[j]); kf[2 * j + 1] = hi2f(kk[j]); }
                float kd[8];
#pragma unroll
                for (int j = 0; j < 8; ++j) { kd[j] = kf[j] * __expf(rf[j] - bl[j]); Kwt[(dc * 8 + j) * 40 + l] = f2bf(kf[j] * __expf(be[j] - bl[j])); }
                *(u32x4*)(Kd + l * 72 + dc * 8) = (u32x4){pack2(kd[0], kd[1]), pack2(kd[2], kd[3]), pack2(kd[4], kd[5]), pack2(kd[6], kd[7])};
            }
            if (lat) {
                const u32x4 qq = *(const u32x4*)(zr + C_GQ + h * 64 + dc * 8);
                float qf[8];
#pragma unroll
                for (int j = 0; j < 4; ++j) { qf[2 * j] = lo2f(qq[j]) * 0.125f; qf[2 * j + 1] = hi2f(qq[j]) * 0.125f; }
                float qd[8], qb[8];
#pragma unroll
                for (int j = 0; j < 8; ++j) { qd[j] = qf[j] * __expf(bl[j] - rf[j]); qb[j] = qf[j] * __expf(bl[j]); }
                *(u32x4*)(Qd + l * 72 + dc * 8) = (u32x4){pack2(qd[0], qd[1]), pack2(qd[2], qd[3]), pack2(qd[4], qd[5]), pack2(qd[6], qd[7])};
                *(u32x4*)(Qb + l * 72 + dc * 8) = (u32x4){pack2(qb[0], qb[1]), pack2(qb[2], qb[3]), pack2(qb[4], qb[5]), pack2(qb[6], qb[7])};
            }
#pragma unroll
            for (int r = 0; r < 2; ++r) {
                const int ec = dc + 8 * r;
                const u32x4 vv = *(const u32x4*)(zr + C_GV + h * 128 + ec * 8);
#pragma unroll
                for (int j = 0; j < 4; ++j) { Vt[(ec * 8 + 2 * j) * 40 + l] = (bf16_t)(vv[j] & 0xffffu); Vt[(ec * 8 + 2 * j + 1) * 40 + l] = (bf16_t)(vv[j] >> 16); }
            }
        }
        __syncthreads();
        if (lat) {
            const int mi = w >> 1, ni = w & 1;
            f32x4 sa = (f32x4){0.f, 0.f, 0.f, 0.f};
            if (!(mi == 0 && ni == 1)) {
#pragma unroll
                for (int kk = 0; kk < 2; ++kk) {
                    const bf16x8 af = *(const bf16x8*)(Qd + (mi * 16 + lr) * 72 + kk * 32 + lq * 8);
                    const bf16x8 bf = *(const bf16x8*)(Kd + (ni * 16 + lr) * 72 + kk * 32 + lq * 8);
                    sa = MFMA16(af, bf, sa);
                }
            }
            const int sidx = ni * 16 + lr;
#pragma unroll
            for (int r = 0; r < 4; ++r) {
                const int t = mi * 16 + lq * 4 + r;
                Ps[t * 40 + sidx] = f2bf((sidx <= t) ? sa[r] : 0.f);
            }
        }
        __syncthreads();
        if (lat) {
            f32x4 acc[2][2];
#pragma unroll
            for (int i = 0; i < 2; ++i)
#pragma unroll
                for (int j = 0; j < 2; ++j) acc[i][j] = (f32x4){0.f, 0.f, 0.f, 0.f};
#pragma unroll
            for (int kk = 0; kk < 2; ++kk) {
                bf16x8 af[2], bf[2];
#pragma unroll
                for (int i = 0; i < 2; ++i) af[i] = *(const bf16x8*)(Qb + (i * 16 + lr) * 72 + kk * 32 + lq * 8);
#pragma unroll
                for (int j = 0; j < 2; ++j) bf[j] = *(const bf16x8*)(Sb + ((2 * w + j) * 16 + lr) * 72 + kk * 32 + lq * 8);
#pragma unroll
                for (int i = 0; i < 2; ++i)
#pragma unroll
                    for (int j = 0; j < 2; ++j) acc[i][j] = MFMA16(af[i], bf[j], acc[i][j]);
            }
            {
                bf16x8 af[2], bf[2];
#pragma unroll
                for (int i = 0; i < 2; ++i) af[i] = *(const bf16x8*)(Ps + (i * 16 + lr) * 40 + lq * 8);
#pragma unroll
                for (int j = 0; j < 2; ++j) bf[j] = *(const bf16x8*)(Vt + ((2 * w + j) * 16 + lr) * 40 + lq * 8);
#pragma unroll
                for (int i = 0; i < 2; ++i)
#pragma unroll
                    for (int j = 0; j < 2; ++j) acc[i][j] = MFMA16(af[i], bf[j], acc[i][j]);
            }
#pragma unroll
            for (int i = 0; i < 2; ++i)
#pragma unroll
                for (int r = 0; r < 4; ++r) {
                    const int t = i * 16 + lq * 4 + r;
                    const int n = dir ? nlo + 31 - t : nlo + t;
                    bf16_t* orow = p.mixh + ((size_t)dir * TL + rowbase + n) * 1024 + 512 + h * 128;
#pragma unroll
                    for (int j = 0; j < 2; ++j) orow[(2 * w + j) * 16 + lr] = f2bf(acc[i][j][r]);
                }
        }
        __syncthreads();
        {
            float rs[4];
#pragma unroll
            for (int r = 0; r < 4; ++r) rs[r] = __expf(bc[31 * 64 + w * 16 + lq * 4 + r]);
            const bf16x8 af = *(const bf16x8*)(Kwt + (w * 16 + lr) * 40 + lq * 8);
#pragma unroll
            for (int j = 0; j < 8; ++j) {
                const bf16x8 bf = *(const bf16x8*)(Vt + (j * 16 + lr) * 40 + lq * 8);
#pragma unroll
                for (int r = 0; r < 4; ++r) S[j][r] *= rs[r];
                S[j] = MFMA16(af, bf, S[j]);
                uint2 pk; pk.x = pack2(S[j][0], S[j][1]); pk.y = pack2(S[j][2], S[j][3]);
                *(uint2*)(Sb + (j * 16 + lr) * 72 + w * 16 + lq * 4) = pk;
            }
        }
        __syncthreads();
    }
}

__device__ void phase_mixers(const Params& p, char* smem, int bid, int nblk) {
    const int tidx_ = opaque_tid();
    float* L = (float*)smem;
    const int stid = tidx_, lane = stid & 63;
    for (int item = bid; item < 512; item += nblk) {
        const bool isml = item < 256;
        const int it = item & 255, b = it >> 3, h = (it >> 1) & 3, dir = it & 1;
#if ML_CHUNKED
        if (isml) { mlstm_item_chunked(p, smem, stid, b, h, dir); __syncthreads(); continue; }
#endif
#if GLA_CHUNKED
        if (!isml) { gla_item_chunked(p, smem, stid, b, h, dir); __syncthreads(); continue; }
#endif
#if !ML_CHUNKED
        if (isml) {
            float* qs = L; float* ks = L + 4096; float* vs = L + 8192; float* numb = L + 12288;
            float* igs = L + 16384; float* lfs = L + 16416; float* denp = L + 16448; float* mb = L + 16512;
            float C[64];
#pragma unroll
            for (int e = 0; e < 64; ++e) C[e] = 0.f;
            float nreg = 0.f, m = 0.f;
            const int d = stid >> 1, e0 = (stid & 1) * 64;
            for (int bt = 0; bt < 72; ++bt) {
                const bool lat = bt >= 8;
                const int pos0 = lat ? (bt - 8) * 32 : bt * 32;
                const int seg = lat ? SEQ : CTX;
                const int nlo = dir ? seg - 32 - pos0 : pos0;
                const int rowbase = lat ? b * SEQ : TL + b * CTX;
#pragma unroll
                for (int r = 0; r < 4; ++r) {
                    const int wi = stid + 256 * r, which = wi >> 9, i = (wi >> 4) & 31, ch = (wi & 15) * 8;
                    if (which == 0 && !lat) continue;
                    const int n = dir ? nlo + 31 - i : nlo + i;
                    const int col = which * 512 + h * 128 + ch;
                    const bool vl = lat ? (((n - 1) >> 6) == (n >> 6)) : (n - 1 >= 0);
                    const bool vr = lat ? (((n + 1) >> 6) == (n >> 6)) : (n + 1 < CTX);
                    const bf16_t* zc = p.z + (size_t)(rowbase + n) * ZS + col;
                    const uint4 cc = *(const uint4*)zc;
                    uint4 ll = make_uint4(0, 0, 0, 0), rr = make_uint4(0, 0, 0, 0);
                    if (vl) ll = *(const uint4*)(zc - ZS);
                    if (vr) rr = *(const uint4*)(zc + ZS);
                    const unsigned cw[4] = {cc.x, cc.y, cc.z, cc.w}, lw[4] = {ll.x, ll.y, ll.z, ll.w}, rw[4] = {rr.x, rr.y, rr.z, rr.w};
                    float* dst = (which ? ks : qs) + i * 128 + ch;
                    const float scl = which ? 0.08838834764831845f : 1.f;
#pragma unroll
                    for (int j = 0; j < 4; ++j) {
                        const int c0 = col + 2 * j;
                        const float y0 = p.conv_w[c0] * lo2f(lw[j]) + p.conv_w[1024 + c0] * lo2f(cw[j]) + p.conv_w[2048 + c0] * lo2f(rw[j]);
                        const float y1 = p.conv_w[c0 + 1] * hi2f(lw[j]) + p.conv_w[1024 + c0 + 1] * hi2f(cw[j]) + p.conv_w[2048 + c0 + 1] * hi2f(rw[j]);
                        dst[2 * j] = silu(y0) * scl; dst[2 * j + 1] = silu(y1) * scl;
                    }
                }
#pragma unroll
                for (int r = 0; r < 2; ++r) {
                    const int wi = stid + 256 * r, i = wi >> 4, ch = (wi & 15) * 8;
                    const int n = dir ? nlo + 31 - i : nlo + i;
                    const uint4 cc = *(const uint4*)(p.z + (size_t)(rowbase + n) * ZS + C_MLV + h * 128 + ch);
                    float* dst = vs + i * 128 + ch;
                    dst[0] = lo2f(cc.x); dst[1] = hi2f(cc.x); dst[2] = lo2f(cc.y); dst[3] = hi2f(cc.y);
                    dst[4] = lo2f(cc.z); dst[5] = hi2f(cc.z); dst[6] = lo2f(cc.w); dst[7] = hi2f(cc.w);
                }
                if (stid < 32) {
                    const int n = dir ? nlo + 31 - stid : nlo + stid;
                    const float* g = p.zg + (size_t)(rowbase + n) * 48 + dir * 8 + h;
                    igs[stid] = g[0]; lfs[stid] = logsig(g[4]);
                }
                __syncthreads();
                for (int i = 0; i < 32; ++i) {
                    const float lf = lfs[i], ig = igs[i];
                    const float mn = fmaxf(lf + m, ig);
                    const float a = __expf(lf + m - mn), bi = __expf(ig - mn);
                    m = mn;
                    const float vd = vs[i * 128 + d] * bi;
                    const float4* kp = (const float4*)(ks + i * 128 + e0);
                    const float4* qp = (const float4*)(qs + i * 128 + e0);
                    float num = 0.f;
#pragma unroll
                    for (int j = 0; j < 16; ++j) {
                        const float4 kv = kp[j];
                        C[4 * j + 0] = a * C[4 * j + 0] + vd * kv.x; C[4 * j + 1] = a * C[4 * j + 1] + vd * kv.y;
                        C[4 * j + 2] = a * C[4 * j + 2] + vd * kv.z; C[4 * j + 3] = a * C[4 * j + 3] + vd * kv.w;
                        if (lat) { const float4 qv = qp[j]; num += C[4 * j + 0] * qv.x + C[4 * j + 1] * qv.y + C[4 * j + 2] * qv.z + C[4 * j + 3] * qv.w; }
                    }
                    if (stid < 128) {
                        nreg = a * nreg + bi * ks[i * 128 + stid];
                        if (lat) { float pd = nreg * qs[i * 128 + stid]; pd = wave_sum(pd); if (lane == 0) denp[i * 2 + (stid >> 6)] = pd; }
                    }
                    if (lat) { num += __shfl_xor(num, 1); if (!(stid & 1)) numb[i * 128 + d] = num; }
                    if (stid == 0) mb[i] = m;
                }
                __syncthreads();
                if (lat) {
                    for (int idx = stid; idx < 4096; idx += 256) {
                        const int i = idx >> 7, dd = idx & 127;
                        const float den = denp[2 * i] + denp[2 * i + 1];
                        const float hv = numb[idx] / fmaxf(fabsf(den), __expf(-mb[i]));
                        const int n = dir ? nlo + 31 - i : nlo + i;
                        p.mixh[((size_t)dir * TL + rowbase + n) * 1024 + h * 128 + dd] = f2bf(hv);
                    }
                }
                __syncthreads();
            }
        }
#endif
#if !GLA_CHUNKED
        if (!isml) {
            float* qs = L; float* ks = L + 2048; float* dec = L + 4096; float* vs = L + 6144; float* ob = L + 10240;
            float S[32];
#pragma unroll
            for (int e = 0; e < 32; ++e) S[e] = 0.f;
            const int e = stid >> 1, d0 = (stid & 1) * 32;
            for (int bt = 0; bt < 72; ++bt) {
                const bool lat = bt >= 8;
                const int pos0 = lat ? (bt - 8) * 32 : bt * 32;
                const int seg = lat ? SEQ : CTX;
                const int nlo = dir ? seg - 32 - pos0 : pos0;
                const int rowbase = lat ? b * SEQ : TL + b * CTX;
#pragma unroll
                for (int r = 0; r < 2; ++r) {
                    const int wi = stid + 256 * r, which = wi >> 8, i = (wi >> 3) & 31, ch = (wi & 7) * 8;
                    if (which == 0 && !lat) continue;
                    const int n = dir ? nlo + 31 - i : nlo + i;
                    const uint4 cc = *(const uint4*)(p.z + (size_t)(rowbase + n) * ZS + (which ? C_GK : C_GQ) + h * 64 + ch);
                    float* dst = (which ? ks : qs) + i * 64 + ch;
                    const float scl = which ? 1.f : 0.125f;
                    dst[0] = lo2f(cc.x) * scl; dst[1] = hi2f(cc.x) * scl; dst[2] = lo2f(cc.y) * scl; dst[3] = hi2f(cc.y) * scl;
                    dst[4] = lo2f(cc.z) * scl; dst[5] = hi2f(cc.z) * scl; dst[6] = lo2f(cc.w) * scl; dst[7] = hi2f(cc.w) * scl;
                }
#pragma unroll
                for (int r = 0; r < 2; ++r) {
                    const int wi = stid + 256 * r, i = wi >> 4, ch = (wi & 15) * 8;
                    const int n = dir ? nlo + 31 - i : nlo + i;
                    const uint4 cc = *(const uint4*)(p.z + (size_t)(rowbase + n) * ZS + C_GV + h * 128 + ch);
                    float* dst = vs + i * 128 + ch;
                    dst[0] = lo2f(cc.x); dst[1] = hi2f(cc.x); dst[2] = lo2f(cc.y); dst[3] = hi2f(cc.y);
                    dst[4] = lo2f(cc.z); dst[5] = hi2f(cc.z); dst[6] = lo2f(cc.w); dst[7] = hi2f(cc.w);
                }
#pragma unroll
                for (int r = 0; r < 8; ++r) {
                    const int wi = stid + 256 * r, i = wi >> 6, dd = wi & 63;
                    const int n = dir ? nlo + 31 - i : nlo + i;
                    const float* lr = p.zg + (size_t)(rowbase + n) * 48 + 16 + dir * 16;
                    float al = p.alpha_b[dir * 256 + h * 64 + dd];
#pragma unroll
                    for (int q = 0; q < 16; ++q) al += lr[q] * p.lr_w2[(dir * 16 + q) * 256 + h * 64 + dd];
                    dec[i * 64 + dd] = __expf(logsig(al) * (1.f / 16.f));
                }
                __syncthreads();
                for (int i = 0; i < 32; ++i) {
                    const float ve = vs[i * 128 + e];
                    const float4* dp = (const float4*)(dec + i * 64 + d0);
                    const float4* kp = (const float4*)(ks + i * 64 + d0);
                    const float4* qp = (const float4*)(qs + i * 64 + d0);
                    float o = 0.f;
#pragma unroll
                    for (int j = 0; j < 8; ++j) {
                        const float4 dv = dp[j], kv = kp[j];
                        S[4 * j + 0] = dv.x * S[4 * j + 0] + kv.x * ve; S[4 * j + 1] = dv.y * S[4 * j + 1] + kv.y * ve;
                        S[4 * j + 2] = dv.z * S[4 * j + 2] + kv.z * ve; S[4 * j + 3] = dv.w * S[4 * j + 3] + kv.w * ve;
                        if (lat) { const float4 qv = qp[j]; o += qv.x * S[4 * j + 0] + qv.y * S[4 * j + 1] + qv.z * S[4 * j + 2] + qv.w * S[4 * j + 3]; }
                    }
                    if (lat) { o += __shfl_xor(o, 1); if (!(stid & 1)) ob[i * 128 + e] = o; }
                }
                __syncthreads();
                if (lat) {
                    for (int idx = stid; idx < 4096; idx += 256) {
                        const int i = idx >> 7, ee = idx & 127;
                        const int n = dir ? nlo + 31 - i : nlo + i;
                        p.mixh[((size_t)dir * TL + rowbase + n) * 1024 + 512 + h * 128 + ee] = f2bf(ob[idx]);
                    }
                }
                __syncthreads();
            }
        }
#endif
    }
}

__device__ void phase_mixprep(const Params& p, int bid, int nblk) {
    const int tidx_ = opaque_tid();
    const int lane = tidx_ & 63;
    const int gw = bid * (NT / 64) + (tidx_ >> 6), nw = nblk * (NT / 64);
    const int c0 = lane * 16;
    for (int row = gw; row < TL; row += nw) {
        const uint4* a0 = (const uint4*)(p.mixh + (size_t)row * 1024 + c0);
        const uint4* a1 = (const uint4*)(p.mixh + ((size_t)TL + row) * 1024 + c0);
        const uint4* gp = (const uint4*)(p.z + (size_t)row * ZS + (c0 < 512 ? C_MLO + c0 : C_GR + (c0 - 512)));
        const float* gn = c0 < 512 ? p.ml_norm_g + c0 : p.gla_norm_g + (c0 - 512);
        float s[16], gt[16];
#pragma unroll
        for (int q = 0; q < 2; ++q) {
            const uint4 u0 = a0[q], u1 = a1[q], ug = gp[q];
            const unsigned w0[4] = {u0.x, u0.y, u0.z, u0.w}, w1[4] = {u1.x, u1.y, u1.z, u1.w}, wg[4] = {ug.x, ug.y, ug.z, ug.w};
#pragma unroll
            for (int j = 0; j < 4; ++j) {
                s[q * 8 + 2 * j] = lo2f(w0[j]) + lo2f(w1[j]); s[q * 8 + 2 * j + 1] = hi2f(w0[j]) + hi2f(w1[j]);
                gt[q * 8 + 2 * j] = lo2f(wg[j]); gt[q * 8 + 2 * j + 1] = hi2f(wg[j]);
            }
        }
        float ss = 0.f;
#pragma unroll
        for (int j = 0; j < 16; ++j) ss += s[j] * s[j];
        ss += __shfl_xor(ss, 1); ss += __shfl_xor(ss, 2); ss += __shfl_xor(ss, 4);
        const float rstd = rsqrtf(ss * (1.f / 128.f) + EPS);
        unsigned o[8];
#pragma unroll
        for (int j = 0; j < 8; ++j) {
            float y0, y1;
            const float g0 = gt[2 * j], g1 = gt[2 * j + 1];
            if (c0 < 512) { y0 = sigm(g0); y1 = sigm(g1); } else { y0 = silu(g0); y1 = silu(g1); }
            y0 *= s[2 * j] * rstd * gn[2 * j]; y1 *= s[2 * j + 1] * rstd * gn[2 * j + 1];
            o[j] = pack2(y0, y1);
        }
        uint4* dst = (uint4*)(p.hbuf + (size_t)row * D + c0);
        dst[0] = make_uint4(o[0], o[1], o[2], o[3]); dst[1] = make_uint4(o[4], o[5], o[6], o[7]);
    }
}

__device__ void phase_norm2(const Params& p, int bid, int nblk) {
    const int tidx_ = opaque_tid();
    const int lane = tidx_ & 63;
    const int gw = bid * (NT / 64) + (tidx_ >> 6), nw = nblk * (NT / 64);
    for (int row = gw; row < TL; row += nw) {
        const float* src = p.out + (size_t)row * D;
        const float* md = p.mod + (row >> 11) * 6144;
        float4 v[4]; float ss = 0.f;
#pragma unroll
        for (int j = 0; j < 4; ++j) { v[j] = *(const float4*)(src + j * 256 + lane * 4); ss += v[j].x * v[j].x + v[j].y * v[j].y + v[j].z * v[j].z + v[j].w * v[j].w; }
        ss = wave_sum(ss);
        const float rstd = rsqrtf(ss * (1.f / 1024.f) + EPS);
#pragma unroll
        for (int j = 0; j < 4; ++j) {
            const int col = j * 256 + lane * 4;
            const float4 g = *(const float4*)(p.norm2_g + col), sc = *(const float4*)(md + 4096 + col), sh = *(const float4*)(md + 3072 + col);
            uint2 o;
            o.x = pack2(v[j].x * rstd * g.x * (1.f + sc.x) + sh.x, v[j].y * rstd * g.y * (1.f + sc.y) + sh.y);
            o.y = pack2(v[j].z * rstd * g.z * (1.f + sc.z) + sh.z, v[j].w * rstd * g.w * (1.f + sc.w) + sh.w);
            *(uint2*)(p.hbuf + (size_t)row * D + col) = o;
        }
    }
}

__device__ __forceinline__ unsigned fkey(float f) { const unsigned u = __float_as_uint(f); return (u & 0x80000000u) ? ~u : (u | 0x80000000u); }
__device__ __forceinline__ int mbcnt64(unsigned long long m) { return __builtin_amdgcn_mbcnt_hi((unsigned)(m >> 32), __builtin_amdgcn_mbcnt_lo((unsigned)m, 0)); }
#define LDS_FENCE() asm volatile("s_waitcnt lgkmcnt(0)" ::: "memory")

template <int NV>
__device__ __forceinline__ void wave_top16(const float (&val)[NV], const int (&tag)[NV], float* outv, int* outt) {
    unsigned u[NV];
#pragma unroll
    for (int v = 0; v < NV; ++v) u[v] = fkey(val[v]);
    unsigned T = 0;
    for (int bit = 31; bit >= 0; --bit) {
        const unsigned cand = T | (1u << bit);
        int cnt = 0;
#pragma unroll
        for (int v = 0; v < NV; ++v) cnt += __popcll(__ballot(u[v] >= cand));
        if (cnt >= 16) T = cand;
    }
    int base = 0;
#pragma unroll
    for (int v = 0; v < NV; ++v) {
        const bool gt = u[v] > T;
        const unsigned long long mk = __ballot(gt);
        const int pos = base + mbcnt64(mk);
        if (gt) { outv[pos] = val[v]; outt[pos] = tag[v]; }
        base += __popcll(mk);
    }
#pragma unroll
    for (int v = 0; v < NV; ++v) {
        const bool eq = u[v] == T;
        const unsigned long long mk = __ballot(eq);
        const int pos = base + mbcnt64(mk);
        if (eq && pos < 16) { outv[pos] = val[v]; outt[pos] = tag[v]; }
        base += __popcll(mk);
    }
}

template <int CTRL> __device__ __forceinline__ float dppx(float x) {
    return __uint_as_float(__builtin_amdgcn_update_dpp(0u, __float_as_uint(x), CTRL, 0xf, 0xf, false));
}
__device__ __forceinline__ float wave_max_fast(float x) {
    x = fmaxf(x, dppx<0x128>(x)); x = fmaxf(x, dppx<0x124>(x)); x = fmaxf(x, dppx<0x4E>(x)); x = fmaxf(x, dppx<0xB1>(x));
    auto s = __builtin_amdgcn_permlane16_swap(__float_as_uint(x), __float_as_uint(x), false, false);
    x = fmaxf(__uint_as_float(s[0]), __uint_as_float(s[1]));
    auto t = __builtin_amdgcn_permlane32_swap(__float_as_uint(x), __float_as_uint(x), false, false);
    return fmaxf(__uint_as_float(t[0]), __uint_as_float(t[1]));
}
__device__ __forceinline__ float wave_sum_fast(float x) {
    x += dppx<0x128>(x); x += dppx<0x124>(x); x += dppx<0x4E>(x); x += dppx<0xB1>(x);
    auto s = __builtin_amdgcn_permlane16_swap(__float_as_uint(x), __float_as_uint(x), false, false);
    x = __uint_as_float(s[0]) + __uint_as_float(s[1]);
    auto t = __builtin_amdgcn_permlane32_swap(__float_as_uint(x), __float_as_uint(x), false, false);
    return __uint_as_float(t[0]) + __uint_as_float(t[1]);
}
template <int NV>
__device__ __forceinline__ void wave_top16_bisect(const float (&val)[NV], const int (&tag)[NV], float* outv, int* outt) {
    float mx = val[0], mn = val[0];
#pragma unroll
    for (int v = 1; v < NV; ++v) { mx = fmaxf(mx, val[v]); mn = fminf(mn, val[v]); }
    float hi = wave_max_fast(mx), lo = -wave_max_fast(-mn);
    float mid = 0.f; bool ok = false;
    for (int it = 0; it < 40; ++it) {
        mid = 0.5f * (lo + hi);
        int cnt = 0;
#pragma unroll
        for (int v = 0; v < NV; ++v) cnt += __popcll(__ballot(val[v] > mid));
        if (cnt == 16) { ok = true; break; }
        if (cnt > 16) lo = mid; else hi = mid;
    }
    if (!ok) { wave_top16<NV>(val, tag, outv, outt); return; }
    int base = 0;
#pragma unroll
    for (int v = 0; v < NV; ++v) {
        const bool gt = val[v] > mid;
        const unsigned long long mk = __ballot(gt);
        const int pos = base + mbcnt64(mk);
        if (gt) { outv[pos] = val[v]; outt[pos] = tag[v]; }
        base += __popcll(mk);
    }
}

__device__ void phase_topk(const Params& p, char* smem, int bid, int nblk) {
    const int tidx_ = opaque_tid();
    const int tid = tidx_, lane = tid & 63, w = __builtin_amdgcn_readfirstlane(tid >> 6), lr = lane & 15, lq = lane >> 4;
    constexpr int SS = 260;
    float* sc = (float*)smem + w * (16 * SS);
    float* wsx = (float*)smem + 4 * 16 * SS + w * 96;
    float* tops = wsx; int* topi = (int*)(wsx + 32); float* bs = wsx + 64; int* bc = (int*)(wsx + 80);
    for (int item = bid; item < (TL / 64) * 8; item += nblk) {
        const int ph = item & 7, t0 = (item >> 3) * 64 + w * 16;
#pragma unroll
        for (int hh = 0; hh < 2; ++hh) {
            bf16x8 af[4];
#pragma unroll
            for (int kk = 0; kk < 4; ++kk) af[kk] = *(const bf16x8*)(p.qbuf + (size_t)(t0 + lr) * 2048 + ph * 256 + hh * 128 + kk * 32 + lq * 8);
            const bf16_t* kb = p.keysb + (size_t)((ph * 2 + hh) * 128 + lr) * 128 + lq * 8;
#pragma unroll
            for (int n = 0; n < 8; ++n) {
                f32x4 acc = (f32x4){0.f, 0.f, 0.f, 0.f};
#pragma unroll
                for (int kk = 0; kk < 4; ++kk) {
                    const bf16x8 bf = *(const bf16x8*)(kb + n * 16 * 128 + kk * 32);
                    acc = MFMA16(af[kk], bf, acc);
                }
#pragma unroll
                for (int r = 0; r < 4; ++r) sc[(lq * 4 + r) * SS + hh * 128 + n * 16 + lr] = acc[r];
            }
        }
        LDS_FENCE();
        for (int tt = 0; tt < 16; ++tt) {
            const int t = t0 + tt;
#pragma unroll
            for (int hh = 0; hh < 2; ++hh) {
                const float vv[2] = {sc[tt * SS + hh * 128 + lane], sc[tt * SS + hh * 128 + 64 + lane]};
                const int tg[2] = {lane, lane + 64};
                wave_top16_bisect<2>(vv, tg, tops + hh * 16, topi + hh * 16);
            }
            LDS_FENCE();
            float cv[4]; int ct[4];
#pragma unroll
            for (int j = 0; j < 4; ++j) { const int cidx = lane * 4 + j; cv[j] = tops[cidx >> 4] + tops[16 + (cidx & 15)]; ct[j] = cidx; }
            wave_top16_bisect<4>(cv, ct, bs, bc);
            LDS_FENCE();
            const float sv = lane < 16 ? bs[lane] : -3.0e38f;
            const int cc = lane < 16 ? bc[lane] : 0;
            const float mx = wave_max_fast(sv);
            const float ev = lane < 16 ? __expf(sv - mx) : 0.f;
            const float sm = wave_sum_fast(ev);
            if (lane < 16) {
                const int idx = topi[cc >> 4] * 128 + topi[16 + (cc & 15)];
                p.pidx[(size_t)t * 128 + ph * 16 + lane] = idx;
                p.pgw[(size_t)t * 128 + ph * 16 + lane] = ev / sm;
            }
            LDS_FENCE();
        }
    }
    __syncthreads();
}

typedef float f32x2 __attribute__((ext_vector_type(2)));
template <int CTRL> __device__ __forceinline__ float dppf(float x) {
    return __uint_as_float(__builtin_amdgcn_update_dpp(0u, __float_as_uint(x), CTRL, 0xf, 0xf, false));
}
__device__ __forceinline__ float red4(float a, float b, float c, float d) {
    auto r = __builtin_amdgcn_permlane32_swap(__float_as_uint(a), __float_as_uint(b), false, false);
    const float ab = __uint_as_float(r[0]) + __uint_as_float(r[1]);
    auto q = __builtin_amdgcn_permlane32_swap(__float_as_uint(c), __float_as_uint(d), false, false);
    const float cd = __uint_as_float(q[0]) + __uint_as_float(q[1]);
    auto s = __builtin_amdgcn_permlane16_swap(__float_as_uint(ab), __float_as_uint(cd), false, false);
    float x = __uint_as_float(s[0]) + __uint_as_float(s[1]);
    x += dppf<0x128>(x); x += dppf<0x124>(x); x += dppf<0x4E>(x); x += dppf<0xB1>(x);
    return x;
}
__device__ __forceinline__ void dec16(const u32x4 w, float* f) {
#pragma unroll
    for (int q = 0; q < 4; ++q) {
        const f32x2 lo = __builtin_amdgcn_cvt_pk_f32_fp8((int)w[q], false), hi = __builtin_amdgcn_cvt_pk_f32_fp8((int)w[q], true);
        f[4 * q] = lo[0]; f[4 * q + 1] = lo[1]; f[4 * q + 2] = hi[0]; f[4 * q + 3] = hi[1];
    }
}
__device__ __forceinline__ void gload8(u32x4 (&buf)[8], const unsigned char* tab, int idxreg, int j0, int lane) {
#pragma unroll
    for (int jj = 0; jj < 8; ++jj) {
        const int e = __builtin_amdgcn_readlane(idxreg, j0 + jj);
        buf[jj] = *(const u32x4*)(tab + (size_t)e * 1024 + lane * 16);
    }
}
__device__ __forceinline__ float gdots8(const u32x4 (&buf)[8], const float (&hv)[16], float d, int j0, int lane) {
    float pt[8];
#pragma unroll
    for (int jj = 0; jj < 8; ++jj) {
        float f[16]; dec16(buf[jj], f);
        float a = 0.f;
#pragma unroll
        for (int k = 0; k < 16; ++k) a += f[k] * hv[k];
        pt[jj] = a;
    }
    const float x0 = red4(pt[0], pt[1], pt[2], pt[3]), x1 = red4(pt[4], pt[5], pt[6], pt[7]);
    int di = __float_as_int(d);
    di = (lane == j0 + 0) ? __builtin_amdgcn_readlane(__float_as_int(x0), 0) : di;
    di = (lane == j0 + 1) ? __builtin_amdgcn_readlane(__float_as_int(x0), 32) : di;
    di = (lane == j0 + 2) ? __builtin_amdgcn_readlane(__float_as_int(x0), 16) : di;
    di = (lane == j0 + 3) ? __builtin_amdgcn_readlane(__float_as_int(x0), 48) : di;
    di = (lane == j0 + 4) ? __builtin_amdgcn_readlane(__float_as_int(x1), 0) : di;
    di = (lane == j0 + 5) ? __builtin_amdgcn_readlane(__float_as_int(x1), 32) : di;
    di = (lane == j0 + 6) ? __builtin_amdgcn_readlane(__float_as_int(x1), 16) : di;
    di = (lane == j0 + 7) ? __builtin_amdgcn_readlane(__float_as_int(x1), 48) : di;
    return __int_as_float(di);
}
__device__ __forceinline__ void gaxpy8(const u32x4 (&buf)[8], float coef, float (&acc)[16], int j0) {
#pragma unroll
    for (int jj = 0; jj < 8; ++jj) {
        const float c = __int_as_float(__builtin_amdgcn_readlane(__float_as_int(coef), j0 + jj));
        float f[16]; dec16(buf[jj], f);
#pragma unroll
        for (int k = 0; k < 16; ++k) acc[k] += c * f[k];
    }
}
__device__ __forceinline__ float gather_dots(const unsigned char* tab, int idxreg, const float (&hv)[16], int lane) {
    float d = 0.f;
    u32x4 bufA[8], bufB[8];
    gload8(bufA, tab, idxreg, 0, lane);
#pragma unroll 1
    for (int g = 0; g < 8; g += 2) {
        gload8(bufB, tab, idxreg, (g + 1) * 8, lane);
        d = gdots8(bufA, hv, d, g * 8, lane);
        gload8(bufA, tab, idxreg, ((g + 2) & 7) * 8, lane);
        d = gdots8(bufB, hv, d, (g + 1) * 8, lane);
    }
    return d;
}
__device__ __forceinline__ void gather_axpy(const unsigned char* tab, int idxreg, float coef, float (&acc)[16], int lane) {
    u32x4 bufA[8], bufB[8];
    gload8(bufA, tab, idxreg, 0, lane);
#pragma unroll 1
    for (int g = 0; g < 8; g += 2) {
        gload8(bufB, tab, idxreg, (g + 1) * 8, lane);
        gaxpy8(bufA, coef, acc, g * 8);
        gload8(bufA, tab, idxreg, ((g + 2) & 7) * 8, lane);
        gaxpy8(bufB, coef, acc, (g + 1) * 8);
    }
}
__device__ __forceinline__ float gelu_exact(float x) { return 0.5f * x * (1.f + erff(x * 0.7071067811865476f)); }

__device__ void phase_gather(const Params& p, int bid, int nblk) {
    const int tidx_ = opaque_tid();
    const int lane = tidx_ & 63;
    const int gw = bid * (NT / 64) + (tidx_ >> 6), nw = nblk * (NT / 64);
    for (int t = gw; t < TL; t += nw) {
        float hv[16];
        {
            const u32x4 h0 = *(const u32x4*)(p.hbuf + (size_t)t * D + lane * 16), h1 = *(const u32x4*)(p.hbuf + (size_t)t * D + lane * 16 + 8);
#pragma unroll
            for (int q = 0; q < 4; ++q) { hv[2 * q] = lo2f(h0[q]); hv[2 * q + 1] = hi2f(h0[q]); hv[8 + 2 * q] = lo2f(h1[q]); hv[8 + 2 * q + 1] = hi2f(h1[q]); }
        }
        const int ia = p.pidx[(size_t)t * 128 + lane], ib = p.pidx[(size_t)t * 128 + 64 + lane];
        const float ga = p.pgw[(size_t)t * 128 + lane], gb = p.pgw[(size_t)t * 128 + 64 + lane];
        const float usA = p.usc[ia], usB = p.usc[ib], vsA = p.vsc[ia], vsB = p.vsc[ib];
        const float dA = gather_dots(p.u8, ia, hv, lane);
        const float dB = gather_dots(p.u8, ib, hv, lane);
        const float cA = gelu_exact(dA * usA) * ga * vsA, cB = gelu_exact(dB * usB) * gb * vsB;
        float acc[16];
#pragma unroll
        for (int j = 0; j < 16; ++j) acc[j] = 0.f;
        gather_axpy(p.v8, ia, cA, acc, lane);
        gather_axpy(p.v8, ib, cB, acc, lane);
        float* orow = p.out + (size_t)t * D + lane * 16;
        const float* g2 = p.mod + (t >> 11) * 6144 + 5120 + lane * 16;
        float y[16]; float ss = 0.f;
#pragma unroll
        for (int q = 0; q < 4; ++q) {
            const f32x4 xv = *(const f32x4*)(orow + 4 * q), gv = *(const f32x4*)(g2 + 4 * q);
#pragma unroll
            for (int k = 0; k < 4; ++k) { y[4 * q + k] = xv[k] + gv[k] * acc[4 * q + k]; ss += y[4 * q + k] * y[4 * q + k]; }
        }
        ss = wave_sum(ss);
        const float rstd = rsqrtf(ss * (1.f / 1024.f) + EPS);
#pragma unroll
        for (int q = 0; q < 4; ++q) {
            const f32x4 gf = *(const f32x4*)(p.norm_f_g + lane * 16 + 4 * q);
            *(f32x4*)(orow + 4 * q) = (f32x4){y[4 * q] * rstd * gf[0], y[4 * q + 1] * rstd * gf[1], y[4 * q + 2] * rstd * gf[2], y[4 * q + 3] * rstd * gf[3]};
        }
    }
}

extern __shared__ __attribute__((aligned(16))) char dyn_smem[];

__device__ __forceinline__ void run_phase(const Params& p, int ph, char* smem, int bid, int nblk) {
    switch (ph) {
        case 0: phase_mod(p, smem, bid, nblk); phase_convert(p, smem, bid, nblk); break;
        case 1: phase_norm1(p, bid, nblk); break;
        case 2: { EpiInProj e{p.z, p.zg, p.gate_b}; gemm_phase(p.hbuf, p.winT, TT, PTP, 1024, e, smem, bid, nblk); } break;
        case 3: phase_mixers(p, smem, bid, nblk); break;
        case 4: phase_mixprep(p, bid, nblk); break;
        case 5: { EpiOutProj e{p.x, p.mod, p.out}; gemm_phase(p.hbuf, p.woutT, TL, 1024, 1024, e, smem, bid, nblk); } break;
        case 6: phase_norm2(p, bid, nblk); break;
        case 7: { EpiQ e{p.qbuf}; gemm_phase(p.hbuf, p.wqT, TL, 2048, 1024, e, smem, bid, nblk); } break;
        case 8: phase_topk(p, smem, bid, nblk); break;
        case 9: phase_gather(p, bid, nblk); break;
    }
}
#ifndef PHASE_MASK
#define PHASE_MASK 0x3ff
#endif
constexpr int NPHASE = 10;

#if FUSED
__global__ void __launch_bounds__(NT, 2) mega_kernel(Params p) {
    cg::grid_group grid = cg::this_grid();
#pragma nounroll
    for (int ph = 0; ph < NPHASE; ++ph) {
        if ((PHASE_MASK >> ph) & 1) run_phase(p, ph, dyn_smem, blockIdx.x, gridDim.x);
#if PROBE_REPEAT_MASK
        if ((PROBE_REPEAT_MASK >> ph) & 1) { grid.sync(); run_phase(p, ph, dyn_smem, blockIdx.x, gridDim.x); }
#endif
        if (ph + 1 < NPHASE) grid.sync();
    }
}
#else
template <int PH>
__global__ void __launch_bounds__(NT, 2) phase_kernel(Params p) { run_phase(p, PH, dyn_smem, blockIdx.x, gridDim.x); }
#endif

static inline char* carve(char*& cur, size_t bytes) { char* r = cur; cur += (bytes + 255) & ~(size_t)255; return r; }

extern "C" void kernel_launch(void* const* d_in, const int* in_sizes, int n_in, void* d_out, int out_size, void* d_ws, size_t ws_size, hipStream_t stream) {
    Params p{};
    p.x = (const float*)d_in[0]; p.c = (const float*)d_in[1]; p.ctx = (const float*)d_in[2]; p.c_ctx = (const float*)d_in[3];
    p.w_mod = (const float*)d_in[4]; p.b_mod = (const float*)d_in[5]; p.norm1_g = (const float*)d_in[6]; p.w_in = (const float*)d_in[7];
    p.conv_w = (const float*)d_in[8]; p.gate_b = (const float*)d_in[9]; p.ml_norm_g = (const float*)d_in[10]; p.lr_w2 = (const float*)d_in[11];
    p.alpha_b = (const float*)d_in[12]; p.gla_norm_g = (const float*)d_in[13]; p.w_out = (const float*)d_in[14]; p.norm2_g = (const float*)d_in[15];
    p.wq = (const float*)d_in[16]; p.keys = (const float*)d_in[17]; p.pu = (const float*)d_in[18]; p.pv = (const float*)d_in[19]; p.norm_f_g = (const float*)d_in[20];
    p.out = (float*)d_out;
    char* cur = (char*)d_ws;
    p.mod = (float*)carve(cur, (size_t)33 * 6144 * 4);
    p.winT = (bf16_t*)carve(cur, (size_t)PTP * 1024 * 2);
    p.woutT = (bf16_t*)carve(cur, (size_t)1024 * 1024 * 2);
    p.wqT = (bf16_t*)carve(cur, (size_t)2048 * 1024 * 2);
    p.keysb = (bf16_t*)carve(cur, (size_t)8 * 2 * 128 * 128 * 2);
    p.u8 = (unsigned char*)carve(cur, (size_t)16384 * 1024);
    p.v8 = (unsigned char*)carve(cur, (size_t)16384 * 1024);
    p.usc = (float*)carve(cur, (size_t)16384 * 4);
    p.vsc = (float*)carve(cur, (size_t)16384 * 4);
    p.hbuf = (bf16_t*)carve(cur, (size_t)TT * 1024 * 2);
    p.z = (bf16_t*)carve(cur, (size_t)TT * ZS * 2);
    p.zg = (float*)carve(cur, (size_t)TT * 48 * 4);
    p.mixh = (bf16_t*)carve(cur, (size_t)2 * TL * 1024 * 2);
    p.qbuf = p.z;
    p.pidx = (int*)p.mixh;
    p.pgw = (float*)((char*)p.mixh + (size_t)TL * 128 * 4);
    if ((size_t)(cur - (char*)d_ws) > ws_size) { fprintf(stderr, "workspace too small: need %zu have %zu\n", (size_t)(cur - (char*)d_ws), ws_size); return; }
#if FUSED
    static int grid_blocks = 0;
    if (!grid_blocks) {
        int dev = 0, cus = 0, per_cu = 0;
        hipGetDevice(&dev);
        hipDeviceGetAttribute(&cus, hipDeviceAttributeMultiprocessorCount, dev);
        hipFuncSetAttribute((const void*)mega_kernel, hipFuncAttributeMaxDynamicSharedMemorySize, SMEM_BYTES);
        hipOccupancyMaxActiveBlocksPerMultiprocessor(&per_cu, mega_kernel, NT, SMEM_BYTES);
        if (per_cu > 2) per_cu = 2;
        grid_blocks = cus * per_cu;
    }
    void* args[] = {&p};
    hipError_t e = hipLaunchCooperativeKernel((void*)mega_kernel, dim3(grid_blocks), dim3(NT), args, SMEM_BYTES, stream);
    if (e != hipSuccess) fprintf(stderr, "cooperative launch failed: %s (grid %d)\n", hipGetErrorString(e), grid_blocks);
#else
    const int G = 512;
#define LAUNCH(PH) do { hipFuncSetAttribute((const void*)phase_kernel<PH>, hipFuncAttributeMaxDynamicSharedMemorySize, SMEM_BYTES); \
        hipLaunchKernelGGL(phase_kernel<PH>, dim3(G), dim3(NT), SMEM_BYTES, stream, p); } while (0)
    LAUNCH(0); LAUNCH(1); LAUNCH(2); LAUNCH(3); LAUNCH(4); LAUNCH(5); LAUNCH(6); LAUNCH(7); LAUNCH(8); LAUNCH(9);
#endif
}
```

```cpp
#include <hip/hip_runtime.h>
#include <hip/hip_cooperative_groups.h>
#include <cstdio>
#include <cstdint>
namespace cg = cooperative_groups;

#ifndef FUSED
#define FUSED 1
#endif
#ifndef MIX_SAMEKIND
#define MIX_SAMEKIND 0
#endif
#ifndef ML_CHUNKED
#define ML_CHUNKED 1
#endif
#ifndef GLA_CHUNKED
#define GLA_CHUNKED 1
#endif

typedef unsigned short bf16_t;
typedef short bf16x8 __attribute__((ext_vector_type(8)));
typedef float f32x4 __attribute__((ext_vector_type(4)));
typedef unsigned u32x4 __attribute__((ext_vector_type(4)));

constexpr int D = 1024, NB = 32, SEQ = 2048, CTX = 256;
constexpr int TL = NB * SEQ;
constexpr int TC = NB * CTX;
constexpr int TT = TL + TC;
constexpr int PT = 3632;
constexpr int PTP = 3840;
constexpr int ZS = 3632;
constexpr int C_MLQ = 0, C_MLK = 512, C_MLV = 1024, C_MLO = 1536, C_MLG = 2048, C_GQ = 2064, C_GK = 2320, C_GV = 2576, C_GR = 3088, C_LR = 3600;
constexpr int NT = 512;
constexpr int SMEM_BYTES = 160 * 1024;
constexpr float EPS = 1e-6f;

struct Params {
    const float *x, *c, *ctx, *c_ctx, *w_mod, *b_mod, *norm1_g, *w_in, *conv_w, *gate_b, *ml_norm_g, *lr_w2, *alpha_b, *gla_norm_g,
        *w_out, *norm2_g, *wq, *keys, *pu, *pv, *norm_f_g;
    float* out;
    float* mod;
    bf16_t* winT;
    bf16_t* woutT;
    bf16_t* wqT;
    bf16_t* keysb;
    unsigned char* u8;
    unsigned char* v8;
    float* usc;
    float* vsc;
    bf16_t* hbuf;
    bf16_t* z;
    float* zg;
    bf16_t* mixh;
    bf16_t* qbuf;
    int* pidx;
    float* pgw;
    bf16_t* ybuf;
    unsigned* bar;
};

__device__ __forceinline__ int opaque_tid() { int t = threadIdx.x; asm volatile("" : "+v"(t)); return t; }
__device__ __forceinline__ float bf2f(bf16_t v) { return __uint_as_float(((unsigned)v) << 16); }
__device__ __forceinline__ bf16_t f2bf(float f) { unsigned u = __float_as_uint(f); u += 0x7fffu + ((u >> 16) & 1u); return (bf16_t)(u >> 16); }
__device__ __forceinline__ unsigned pack2(float a, float b) { return (unsigned)f2bf(a) | ((unsigned)f2bf(b) << 16); }
__device__ __forceinline__ float lo2f(unsigned w) { return __uint_as_float(w << 16); }
__device__ __forceinline__ float hi2f(unsigned w) { return __uint_as_float(w & 0xffff0000u); }
__device__ __forceinline__ float wave_sum(float v) {
#pragma unroll
    for (int o = 32; o > 0; o >>= 1) v += __shfl_xor(v, o);
    return v;
}
__device__ __forceinline__ float wave_max(float v) {
#pragma unroll
    for (int o = 32; o > 0; o >>= 1) v = fmaxf(v, __shfl_xor(v, o));
    return v;
}
template <int CTRL> __device__ __forceinline__ float dppx(float x) {
    return __uint_as_float(__builtin_amdgcn_update_dpp(0u, __float_as_uint(x), CTRL, 0xf, 0xf, false));
}
__device__ __forceinline__ float wave_max_fast(float x) {
    x = fmaxf(x, dppx<0x128>(x)); x = fmaxf(x, dppx<0x124>(x)); x = fmaxf(x, dppx<0x4E>(x)); x = fmaxf(x, dppx<0xB1>(x));
    auto s = __builtin_amdgcn_permlane16_swap(__float_as_uint(x), __float_as_uint(x), false, false);
    x = fmaxf(__uint_as_float(s[0]), __uint_as_float(s[1]));
    auto t = __builtin_amdgcn_permlane32_swap(__float_as_uint(x), __float_as_uint(x), false, false);
    return fmaxf(__uint_as_float(t[0]), __uint_as_float(t[1]));
}
__device__ __forceinline__ float wave_sum_fast(float x) {
    x += dppx<0x128>(x); x += dppx<0x124>(x); x += dppx<0x4E>(x); x += dppx<0xB1>(x);
    auto s = __builtin_amdgcn_permlane16_swap(__float_as_uint(x), __float_as_uint(x), false, false);
    x = __uint_as_float(s[0]) + __uint_as_float(s[1]);
    auto t = __builtin_amdgcn_permlane32_swap(__float_as_uint(x), __float_as_uint(x), false, false);
    return __uint_as_float(t[0]) + __uint_as_float(t[1]);
}
__device__ __forceinline__ float logsig(float x) { return fminf(x, 0.f) - __logf(1.f + __expf(-fabsf(x))); }
__device__ __forceinline__ float silu(float x) { return x / (1.f + __expf(-x)); }
__device__ __forceinline__ float sigm(float x) { return 1.f / (1.f + __expf(-x)); }

namespace pg8 {
#define PG8_LAS __attribute__((address_space(3)))
typedef unsigned short bf16_t;
typedef short bf16x8 __attribute__((ext_vector_type(8)));
typedef float f32x4 __attribute__((ext_vector_type(4)));
typedef unsigned u32x4 __attribute__((ext_vector_type(4)));
constexpr int BM = 256, BK = 64, HALF = 128, HTB = HALF * BK * 2  , STAGE_BYTES = 8 * HTB, NXCD = 8, WGM = 8;

__host__ __device__ __forceinline__ int lds_byte(int r, int c) { const int st = (r >> 4) * 2 + (c >> 5), rr = r & 15, cc = c & 31, ob = rr * 64 + cc * 2; return st * 1024 + (ob ^ (((ob >> 9) & 1) << 5)); }
__host__ __device__ __forceinline__ void stage_rc(int b, int& R, int& C) { const int st = b / 1024, sb = b % 1024, swz = sb ^ (((sb >> 9) & 1) << 5); R = (st >> 1) * 16 + swz / 64; C = (st & 1) * 32 + (swz % 64) / 2; }
__host__ __device__ __forceinline__ int perm32(int rho) { const int n = rho >> 4, i = rho & 15; return 8 * (i >> 2) + 4 * n + (i & 3); }

struct Unit { int pm, pn; };
struct Gemm { const bf16_t* A; const bf16_t* Bt; int M, N, K; };

struct StaticOrder {
    int nM, nN, nwg, G, c;
    __host__ __device__ void init(int M, int N, int G_, int c_) { nM = M / BM; nN = N / BM; nwg = nM * nN; G = G_; c = c_; }
    __host__ __device__ bool next(int i, Unit& u) const {
        const long L = (long)i * G + c; if (L >= nwg) return false;
        int wgid = (int)L; { const int q = nwg / NXCD, r = nwg % NXCD, xcd = wgid % NXCD, off = wgid / NXCD; wgid = (xcd < r ? xcd * (q + 1) : r * (q + 1) + (xcd - r) * q) + off; }
        const int nig = WGM * nN, gid = wgid / nig, fm = gid * WGM, gsz = (nM - fm) < WGM ? (nM - fm) : WGM;
        u.pm = fm + ((wgid % nig) % gsz); u.pn = (wgid % nig) / gsz; return true;
    }
    __device__ __forceinline__ void a_ready(const Unit&) const {}
    __device__ __forceinline__ void done(const Unit&) const {}
};
__device__ __forceinline__ unsigned cvt_pk_bf16(float lo, float hi) { unsigned r; asm volatile("v_cvt_pk_bf16_f32 %0, %1, %2" : "=v"(r) : "v"(lo), "v"(hi)); return r; }

template <class Epi, class Sched, bool STAMP = false>
__device__ __forceinline__ void gemm_phase(PG8_LAS unsigned char* lds, const Gemm g, const Sched& S, const Epi& E, unsigned long long* stamps) {
    const int tid = opaque_tid(), wid = __builtin_amdgcn_readfirstlane(tid >> 6), lane = tid & 63, wr = wid >> 2, wc = wid & 3, fr = lane & 15, fq = lane >> 4;
    const int K = g.K, nt = K / BK;
    int ts_lo = 0, ts_hi = 0, nts = 0; const unsigned long long rt_entry = STAMP ? (unsigned long long)wall_clock64() : 0ull;
#define PG8_STAMP() do { if (STAMP && wid == 0 && nts < 64) { const unsigned long long _c = (unsigned long long)clock64(); \
        ts_lo = (lane == nts) ? (int)(unsigned)_c : ts_lo; ts_hi = (lane == nts) ? (int)(unsigned)(_c >> 32) : ts_hi; ++nts; } } while (0)
    PG8_STAMP();
    unsigned voffA[2], voffB[2];
#pragma unroll
    for (int i = 0; i < 2; ++i) { int R, C; stage_rc(tid * 16 + i * 8192, R, C); const int Rb = Epi::PERM ? ((R & ~31) + perm32(R & 31)) : R;
        voffA[i] = (unsigned)(R * K + C) * 2u; voffB[i] = (unsigned)(Rb * K + C) * 2u; }
    const size_t kstep = (size_t)(BK * 2);
    const size_t hstep = (size_t)HALF * K * 2;
    const size_t tstep = 2 * hstep;
    const unsigned ldsw = (unsigned)wid * 1024u;
    const int aoff = lds_byte(wr * 64 + fr, fq * 8), boff = lds_byte(wc * 32 + fr, fq * 8);
#define PG8_SA(b, h) (((b) * 2 + (h)) * HTB)
#define PG8_SB(b, h) ((4 + (b) * 2 + (h)) * HTB)
#define PG8_STAGE(bufoff, gbase, voff) do { _Pragma("unroll") for (int _i = 0; _i < 2; ++_i) \
        __builtin_amdgcn_global_load_lds((const unsigned*)((const char*)(gbase) + (voff)[_i]), (PG8_LAS unsigned*)(lds + (bufoff) + ldsw + _i * 8192), 16, 0, 0); } while (0)
#define PG8_LDA(dst, b, h) do { _Pragma("unroll") for (int m = 0; m < 4; ++m) _Pragma("unroll") for (int k = 0; k < 2; ++k) dst[m][k] = *(const PG8_LAS bf16x8*)(lds + PG8_SA(b, h) + aoff + m * 2048 + k * 1024); } while (0)
#define PG8_LDB(dst, b, h) do { _Pragma("unroll") for (int n = 0; n < 2; ++n) _Pragma("unroll") for (int k = 0; k < 2; ++k) dst[n][k] = *(const PG8_LAS bf16x8*)(lds + PG8_SB(b, h) + boff + n * 2048 + k * 1024); } while (0)
#define PG8_MMA(ai, bj, At, Bt) do { __builtin_amdgcn_s_setprio(1); _Pragma("unroll") for (int m = 0; m < 4; ++m) _Pragma("unroll") for (int n = 0; n < 2; ++n) _Pragma("unroll") for (int k = 0; k < 2; ++k) \
        acc[ai][bj][m][n] = __builtin_amdgcn_mfma_f32_16x16x32_bf16(Bt[n][k], At[m][k], acc[ai][bj][m][n], 0, 0, 0); __builtin_amdgcn_s_setprio(0); } while (0)
#define PG8_WAIT_V(n) asm volatile("s_waitcnt vmcnt(" #n ")" ::: "memory")
#define PG8_WAIT_L(n) asm volatile("s_waitcnt lgkmcnt(" #n ")" ::: "memory")
#define PG8_BAR __builtin_amdgcn_s_barrier()
#define PG8_SCHED __builtin_amdgcn_sched_barrier(0)
    Unit cur, nxt; int ui = 0;
    if (!S.next(0, cur)) return;
    f32x4 acc[2][2][4][2];
#pragma unroll
    for (int a = 0; a < 2; ++a)
#pragma unroll
        for (int b = 0; b < 2; ++b)
#pragma unroll
            for (int m = 0; m < 4; ++m)
#pragma unroll
                for (int n = 0; n < 2; ++n) acc[a][b][m][n] = (f32x4){0.f, 0.f, 0.f, 0.f};
    bf16x8 At[4][2], B0[2][2], B1[2][2];
    const char* cA = (const char*)g.A + (size_t)cur.pm * tstep; const char* cB = (const char*)g.Bt + (size_t)cur.pn * tstep;
    S.a_ready(cur);
    PG8_STAGE(PG8_SB(0, 0), cB, voffB); PG8_STAGE(PG8_SA(0, 0), cA, voffA); PG8_STAGE(PG8_SB(0, 1), cB + hstep, voffB); PG8_STAGE(PG8_SA(0, 1), cA + hstep, voffA);
    if (wr == 1) PG8_BAR;
    PG8_WAIT_V(4); PG8_BAR;
    PG8_STAGE(PG8_SB(1, 0), cB + kstep, voffB); PG8_STAGE(PG8_SA(1, 0), cA + kstep, voffA); PG8_STAGE(PG8_SB(1, 1), cB + hstep + kstep, voffB);
    PG8_WAIT_V(6); PG8_BAR;
    PG8_STAMP();
    for (;;) {
        const bool has_next = S.next(ui + 1, nxt);
        const char* nA = has_next ? (const char*)g.A + (size_t)nxt.pm * tstep : cA; const char* nB = has_next ? (const char*)g.Bt + (size_t)nxt.pn * tstep : cB;
        for (int t = 0; t < nt; t += 2) {
            const bool last = (t == nt - 2);
            const char* a1 = cA + (size_t)(t + 1) * kstep;
            const char* a2 = last ? nA : cA + (size_t)(t + 2) * kstep; const char* b2 = last ? nB : cB + (size_t)(t + 2) * kstep;
            const char* a3 = a2 + kstep; const char* b3 = b2 + kstep;
            if (last && has_next) S.a_ready(nxt);
            PG8_LDB(B0, 0, 0); PG8_SCHED; PG8_LDA(At, 0, 0); PG8_STAGE(PG8_SA(1, 1), a1 + hstep, voffA);
            PG8_WAIT_L(8); PG8_BAR; PG8_WAIT_L(0); PG8_MMA(0, 0, At, B0); PG8_BAR; PG8_SCHED;
            PG8_LDB(B1, 0, 1); PG8_STAGE(PG8_SB(0, 0), b2, voffB);
            PG8_BAR; PG8_WAIT_L(0); PG8_MMA(0, 1, At, B1); PG8_BAR;
            PG8_LDA(At, 0, 1); PG8_STAGE(PG8_SA(0, 0), a2, voffA);
            PG8_BAR; PG8_WAIT_L(0); PG8_MMA(1, 0, At, B0); PG8_BAR; PG8_SCHED;
            PG8_STAGE(PG8_SB(0, 1), b2 + hstep, voffB);
            PG8_WAIT_V(6); PG8_BAR; PG8_MMA(1, 1, At, B1); PG8_BAR;
            PG8_LDB(B0, 1, 0); PG8_SCHED; PG8_LDA(At, 1, 0); PG8_STAGE(PG8_SA(0, 1), a2 + hstep, voffA);
            PG8_WAIT_L(8); PG8_BAR; PG8_WAIT_L(0); PG8_MMA(0, 0, At, B0); PG8_BAR; PG8_SCHED;
            PG8_LDB(B1, 1, 1); PG8_STAGE(PG8_SB(1, 0), b3, voffB);
            PG8_BAR; PG8_WAIT_L(0); PG8_MMA(0, 1, At, B1); PG8_BAR;
            PG8_LDA(At, 1, 1); PG8_STAGE(PG8_SA(1, 0), a3, voffA);
            PG8_BAR; PG8_WAIT_L(0); PG8_MMA(1, 0, At, B0); PG8_BAR; PG8_SCHED;
            PG8_STAGE(PG8_SB(1, 1), b3 + hstep, voffB);
            PG8_WAIT_V(6); PG8_BAR; PG8_MMA(1, 1, At, B1); PG8_BAR;
        }
        PG8_STAMP();
        if constexpr (!Epi::AFTER_DRAIN) { E(acc, cur, wr, wc, fr, fq); S.done(cur); }
        PG8_STAMP();
        if (!has_next) break;
#pragma unroll
        for (int a = 0; a < 2; ++a)
#pragma unroll
            for (int b = 0; b < 2; ++b)
#pragma unroll
                for (int m = 0; m < 4; ++m)
#pragma unroll
                    for (int n = 0; n < 2; ++n) acc[a][b][m][n] = (f32x4){0.f, 0.f, 0.f, 0.f};
        cur = nxt; cA = nA; cB = nB; ++ui;
    }
    PG8_WAIT_V(0);
    if (wr == 0) PG8_BAR;
    PG8_BAR;
    if constexpr (Epi::AFTER_DRAIN) { E.fused(acc, cur, wr, wc, fr, fq, lds, wid, lane); S.done(cur); }
    PG8_STAMP();
    if (STAMP && wid == 0) { stamps[lane] = lane < nts ? (((unsigned long long)(unsigned)ts_hi << 32) | (unsigned)ts_lo) : 0ull;
        if (lane == 62) stamps[62] = rt_entry; if (lane == 63) stamps[63] = (unsigned long long)wall_clock64(); }
#undef PG8_STAMP
#undef PG8_SA
#undef PG8_SB
#undef PG8_STAGE
#undef PG8_LDA
#undef PG8_LDB
#undef PG8_MMA
#undef PG8_WAIT_V
#undef PG8_WAIT_L
#undef PG8_BAR
#undef PG8_SCHED
}
}

__device__ void phase_mod(const Params& p, char* smem, int bid, int nblk) {
    const int tidx_ = opaque_tid();
    float* condL = (float*)smem;
    const int tid = tidx_, cl = tid & 63, ks = tid >> 6;
    for (int item = bid; item < 96; item += nblk) {
        const int col0 = item * 64, col = col0 + cl;
        float acc[33];
#pragma unroll
        for (int b = 0; b < 33; ++b) acc[b] = 0.f;
        for (int kc = 0; kc < 4; ++kc) {
            __syncthreads();
            for (int e = tid; e < 8 * 32 * 33; e += NT) {
                const int sl = e / (32 * 33), kk = (e / 33) % 32, b = e % 33;
                const int k = sl * 128 + kc * 32 + kk;
                const float cv = b < 32 ? p.c[b * 1024 + k] : p.c_ctx[k];
                condL[e] = silu(cv);
            }
            __syncthreads();
            for (int kk = 0; kk < 32; ++kk) {
                const int k = ks * 128 + kc * 32 + kk;
                const float w = p.w_mod[(size_t)k * 6144 + col];
                const float* cp = condL + (ks * 32 + kk) * 33;
#pragma unroll
                for (int b = 0; b < 33; ++b) acc[b] += w * cp[b];
            }
        }
        __syncthreads();
#pragma unroll
        for (int b = 0; b < 33; ++b) condL[(ks * 33 + b) * 64 + cl] = acc[b];
        __syncthreads();
        for (int e = tid; e < 33 * 64; e += NT) {
            const int b = e >> 6, cc = e & 63;
            float v = 0.f;
#pragma unroll
            for (int q = 0; q < 8; ++q) v += condL[(q * 33 + b) * 64 + cc];
            p.mod[b * 6144 + col0 + cc] = v + p.b_mod[col0 + cc];
        }
        __syncthreads();
    }
}

__device__ void convT(const float* __restrict__ src, int K, int N, int Npad, bf16_t* __restrict__ dst, char* smem, int bid, int nblk) {
    const int tidx_ = opaque_tid();
    float* tile = (float*)smem;
    const int tid = tidx_;
    const int nk = K / 64, nn = Npad / 64;
    for (int t = bid; t < nk * nn; t += nblk) {
        const int k0 = (t % nk) * 64, n0 = (t / nk) * 64;
        __syncthreads();
#pragma unroll
        for (int r = 0; r < 64 / (NT / 64); ++r) {
            const int k = r * (NT / 64) + (tid >> 6), n = tid & 63;
            tile[k * 65 + n] = (n0 + n < N) ? src[(size_t)(k0 + k) * N + n0 + n] : 0.f;
        }
        __syncthreads();
#pragma unroll
        for (int r = 0; r < 64 / (NT / 64); ++r) {
            const int n = r * (NT / 64) + (tid >> 6), k = tid & 63;
            dst[(size_t)(n0 + n) * K + k0 + k] = f2bf(tile[k * 65 + n]);
        }
    }
    __syncthreads();
}
__device__ void conv_copy(const float* __restrict__ src, bf16_t* __restrict__ dst, size_t n, int gtid, int gthreads) {
    const size_t n4 = n / 4;
    for (size_t i = gtid; i < n4; i += gthreads) {
        const float4 v = ((const float4*)src)[i];
        uint2 o; o.x = pack2(v.x, v.y); o.y = pack2(v.z, v.w);
        ((uint2*)dst)[i] = o;
    }
}
__device__ void phase_convert(const Params& p, char* smem, int bid, int nblk) {
    const int tidx_ = opaque_tid();
    convT(p.w_in, 1024, PT, PTP, p.winT, smem, bid, nblk);
    convT(p.w_out, 1024, 1024, 1024, p.woutT, smem, bid, nblk);
    convT(p.wq, 1024, 2048, 2048, p.wqT, smem, bid, nblk);
    const int gtid = bid * NT + tidx_, gth = nblk * NT;
    conv_copy(p.keys, p.keysb, (size_t)8 * 2 * 128 * 128, gtid, gth);
    {
        const int lane = tidx_ & 63;
        const int gw = bid * (NT / 64) + (tidx_ >> 6), nw = nblk * (NT / 64);
        for (int row = gw; row < 2 * 16384; row += nw) {
            const bool isv = row >= 16384;
            const int r = isv ? row - 16384 : row;
            const float* src = (isv ? p.pv : p.pu) + (size_t)r * 1024 + lane * 16;
            f32x4 v[4];
            float mx = 0.f;
#pragma unroll
            for (int q = 0; q < 4; ++q) { v[q] = *(const f32x4*)(src + 4 * q); mx = fmaxf(mx, fmaxf(fmaxf(fabsf(v[q][0]), fabsf(v[q][1])), fmaxf(fabsf(v[q][2]), fabsf(v[q][3])))); }
            mx = wave_max(mx);
            mx = fmaxf(mx, 1e-30f);
            const float sc = 7.5f / mx;
            unsigned c[16];
#pragma unroll
            for (int i = 0; i < 16; ++i) {
                const float x = v[i >> 2][i & 3] * sc, a = fabsf(x);
                const float code = a < 2.f ? rintf(a * 8.f) : (a < 4.f ? 8.f + rintf(a * 4.f) : 16.f + rintf(a * 2.f));
                unsigned ci = (unsigned)fminf(code, 31.f);
                c[i] = ci | (x < 0.f ? 32u : 0u);
            }
            unsigned long long lo = 0ull; unsigned hi = 0u;
#pragma unroll
            for (int i = 0; i < 10; ++i) lo |= (unsigned long long)c[i] << (6 * i);
            lo |= (unsigned long long)(c[10] & 0xfu) << 60;
            hi = c[10] >> 4;
#pragma unroll
            for (int i = 11; i < 16; ++i) hi |= c[i] << (2 + 6 * (i - 11));
            unsigned* dst = (unsigned*)((isv ? p.v8 : p.u8) + (size_t)r * 768 + lane * 12);
            dst[0] = (unsigned)lo; dst[1] = (unsigned)(lo >> 32); dst[2] = hi;
            if (lane == 0) (isv ? p.vsc : p.usc)[r] = mx * (1.f / 7.5f);
        }
    }
}

template <int R>
__device__ __forceinline__ void norm_rows(const float* __restrict__ srcbase, const float* __restrict__ src2, int nrows1, int nrows, const float* __restrict__ gvec,
                                          const float* __restrict__ mod, int sc_off, int sh_off, bf16_t* __restrict__ dst, int gw, int nw, int lane) {
    for (int row0 = gw; row0 < nrows; row0 += R * nw) {
        f32x4 v[R][4]; float ss[R];
#pragma unroll
        for (int r = 0; r < R; ++r) {
            const int row = min(row0 + r * nw, nrows - 1);
            const float* src = row < nrows1 ? srcbase + (size_t)row * D : src2 + (size_t)(row - nrows1) * D;
#pragma unroll
            for (int j = 0; j < 4; ++j) v[r][j] = *(const f32x4*)(src + j * 256 + lane * 4);
        }
#pragma unroll
        for (int r = 0; r < R; ++r) {
            float a = 0.f;
#pragma unroll
            for (int j = 0; j < 4; ++j) a += v[r][j][0] * v[r][j][0] + v[r][j][1] * v[r][j][1] + v[r][j][2] * v[r][j][2] + v[r][j][3] * v[r][j][3];
            ss[r] = a;
        }
#pragma unroll
        for (int r = 0; r < R; ++r) ss[r] = wave_sum_fast(ss[r]);
#pragma unroll
        for (int r = 0; r < R; ++r) {
            const int row = row0 + r * nw;
            if (row >= nrows) continue;
            const float rstd = rsqrtf(ss[r] * (1.f / 1024.f) + EPS);
            const float* md = mod + (row < TL ? (row >> 11) : 32) * 6144;
#pragma unroll
            for (int j = 0; j < 4; ++j) {
                const int col = j * 256 + lane * 4;
                const f32x4 g = *(const f32x4*)(gvec + col), sc = *(const f32x4*)(md + sc_off + col), sh = *(const f32x4*)(md + sh_off + col);
                uint2 o;
                o.x = pack2(v[r][j][0] * rstd * g[0] * (1.f + sc[0]) + sh[0], v[r][j][1] * rstd * g[1] * (1.f + sc[1]) + sh[1]);
                o.y = pack2(v[r][j][2] * rstd * g[2] * (1.f + sc[2]) + sh[2], v[r][j][3] * rstd * g[3] * (1.f + sc[3]) + sh[3]);
                *(uint2*)(dst + (size_t)row * D + col) = o;
            }
        }
    }
}
__device__ void phase_norm1(const Params& p, int bid, int nblk) {
    const int tidx_ = opaque_tid();
    norm_rows<4>(p.x, p.ctx, TL, TT, p.norm1_g, p.mod, 1024, 0, p.hbuf, bid * (NT / 64) + (tidx_ >> 6), nblk * (NT / 64), tidx_ & 63);
}

struct EpiZ {
    static constexpr bool PERM = true, AFTER_DRAIN = false;
    bf16_t* z; float* zg; const float* gate_b;
    __device__ __forceinline__ void operator()(const f32x4 (&acc)[2][2][4][2], const pg8::Unit& u, int wr, int wc, int fr, int fq) const {
        const int row0 = u.pm * 256 + wr * 64 + fr, colb = u.pn * 256 + wc * 32 + 8 * fq;
#pragma unroll
        for (int bj = 0; bj < 2; ++bj) {
            const int col = colb + bj * 128;
            if (col >= PT) continue;
            const bool isg = (col >= C_MLG && col < C_GQ), isl = (col >= C_LR);
#pragma unroll
            for (int ai = 0; ai < 2; ++ai)
#pragma unroll
                for (int m = 0; m < 4; ++m) {
                    const size_t row = (size_t)(row0 + ai * 128 + m * 16);
                    const f32x4 v0 = acc[ai][bj][m][0], v1 = acc[ai][bj][m][1];
                    if (isg) {
                        float* dst = zg + row * 48 + (col - C_MLG);
                        *(f32x4*)dst = v0 + *(const f32x4*)(gate_b + (col - C_MLG));
                        *(f32x4*)(dst + 4) = v1 + *(const f32x4*)(gate_b + (col - C_MLG) + 4);
                    } else if (isl) {
                        float* dst = zg + row * 48 + 16 + (col - C_LR);
                        *(f32x4*)dst = v0; *(f32x4*)(dst + 4) = v1;
                    } else {
                        u32x4 w; w.x = pg8::cvt_pk_bf16(v0[0], v0[1]); w.y = pg8::cvt_pk_bf16(v0[2], v0[3]); w.z = pg8::cvt_pk_bf16(v1[0], v1[1]); w.w = pg8::cvt_pk_bf16(v1[2], v1[3]);
                        *(u32x4*)(z + row * ZS + col) = w;
                    }
                }
        }
    }
};
struct EpiX1 {
    static constexpr bool PERM = false, AFTER_DRAIN = false;
    const float* x; const float* mod; float* out;
    __device__ __forceinline__ void operator()(const f32x4 (&acc)[2][2][4][2], const pg8::Unit& u, int wr, int wc, int fr, int fq) const {
        const int row0 = u.pm * 256 + wr * 64 + fr, col0 = u.pn * 256 + wc * 32 + 4 * fq;
#pragma unroll
        for (int ai = 0; ai < 2; ++ai)
#pragma unroll
            for (int m = 0; m < 4; ++m) {
                const int row = row0 + ai * 128 + m * 16;
                const float* g1 = mod + (row >> 11) * 6144 + 2048;
#pragma unroll
                for (int bj = 0; bj < 2; ++bj)
#pragma unroll
                    for (int n = 0; n < 2; ++n) {
                        const int col = col0 + bj * 128 + n * 16;
                        const size_t o = (size_t)row * D + col;
                        *(f32x4*)(out + o) = *(const f32x4*)(x + o) + *(const f32x4*)(g1 + col) * acc[ai][bj][m][n];
                    }
            }
    }
};
struct EpiY {
    static constexpr bool PERM = true, AFTER_DRAIN = false;
    bf16_t* y;
    __device__ __forceinline__ void operator()(const f32x4 (&acc)[2][2][4][2], const pg8::Unit& u, int wr, int wc, int fr, int fq) const {
        const int row0 = u.pm * 256 + wr * 64 + fr, colb = u.pn * 256 + wc * 32 + 8 * fq;
#pragma unroll
        for (int ai = 0; ai < 2; ++ai)
#pragma unroll
            for (int m = 0; m < 4; ++m) {
                bf16_t* rowp = y + (size_t)(row0 + ai * 128 + m * 16) * 1024 + colb;
#pragma unroll
                for (int bj = 0; bj < 2; ++bj) {
                    const f32x4 v0 = acc[ai][bj][m][0], v1 = acc[ai][bj][m][1];
                    u32x4 w; w.x = pg8::cvt_pk_bf16(v0[0], v0[1]); w.y = pg8::cvt_pk_bf16(v0[2], v0[3]); w.z = pg8::cvt_pk_bf16(v1[0], v1[1]); w.w = pg8::cvt_pk_bf16(v1[2], v1[3]);
                    *(u32x4*)(rowp + bj * 128) = w;
                }
            }
    }
};
struct EpiQb {
    static constexpr bool PERM = true, AFTER_DRAIN = false;
    bf16_t* q;
    __device__ __forceinline__ void operator()(const f32x4 (&acc)[2][2][4][2], const pg8::Unit& u, int wr, int wc, int fr, int fq) const {
        const int row0 = u.pm * 256 + wr * 64 + fr, colb = u.pn * 256 + wc * 32 + 8 * fq;
#pragma unroll
        for (int ai = 0; ai < 2; ++ai)
#pragma unroll
            for (int m = 0; m < 4; ++m) {
                bf16_t* rowp = q + (size_t)(row0 + ai * 128 + m * 16) * 2048 + colb;
#pragma unroll
                for (int bj = 0; bj < 2; ++bj) {
                    const f32x4 v0 = acc[ai][bj][m][0], v1 = acc[ai][bj][m][1];
                    u32x4 w; w.x = pg8::cvt_pk_bf16(v0[0], v0[1]); w.y = pg8::cvt_pk_bf16(v0[2], v0[3]); w.z = pg8::cvt_pk_bf16(v1[0], v1[1]); w.w = pg8::cvt_pk_bf16(v1[2], v1[3]);
                    *(u32x4*)(rowp + bj * 128) = w;
                }
            }
    }
};
template <class Epi>
__device__ __forceinline__ void gemm_run(const bf16_t* A, const bf16_t* Bt, int M, int N, int K, const Epi& e, char* smem, int bid, int nblk) {
    pg8::Gemm g{A, Bt, M, N, K};
    pg8::StaticOrder S; S.init(M, N, nblk, bid);
    pg8::gemm_phase<Epi, pg8::StaticOrder, false>((PG8_LAS unsigned char*)smem, g, S, e, nullptr);
}

#define MFMA16(a, b, c) __builtin_amdgcn_mfma_f32_16x16x32_bf16((a), (b), (c), 0, 0, 0)
__device__ __forceinline__ void conv8(const Params& p, const bf16_t* zc, int col, bool vl, bool vr, float scl, float* y) {
    const u32x4 cc = *(const u32x4*)zc;
    u32x4 ll = (u32x4){0u, 0u, 0u, 0u}, rr = (u32x4){0u, 0u, 0u, 0u};
    if (vl) ll = *(const u32x4*)(zc - ZS);
    if (vr) rr = *(const u32x4*)(zc + ZS);
    const f32x4 w0a = *(const f32x4*)(p.conv_w + col), w0b = *(const f32x4*)(p.conv_w + col + 4);
    const f32x4 w1a = *(const f32x4*)(p.conv_w + 1024 + col), w1b = *(const f32x4*)(p.conv_w + 1024 + col + 4);
    const f32x4 w2a = *(const f32x4*)(p.conv_w + 2048 + col), w2b = *(const f32x4*)(p.conv_w + 2048 + col + 4);
    const float w0[8] = {w0a[0], w0a[1], w0a[2], w0a[3], w0b[0], w0b[1], w0b[2], w0b[3]};
    const float w1[8] = {w1a[0], w1a[1], w1a[2], w1a[3], w1b[0], w1b[1], w1b[2], w1b[3]};
    const float w2[8] = {w2a[0], w2a[1], w2a[2], w2a[3], w2b[0], w2b[1], w2b[2], w2b[3]};
#pragma unroll
    for (int j = 0; j < 4; ++j) {
        const float y0 = w0[2 * j] * lo2f(ll[j]) + w1[2 * j] * lo2f(cc[j]) + w2[2 * j] * lo2f(rr[j]);
        const float y1 = w0[2 * j + 1] * hi2f(ll[j]) + w1[2 * j + 1] * hi2f(cc[j]) + w2[2 * j + 1] * hi2f(rr[j]);
        y[2 * j] = silu(y0) * scl; y[2 * j + 1] = silu(y1) * scl;
    }
}

template <int LBASE>
__device__ void mlstm_item_chunked(const Params& p, char* smem0, int tid, int b, int h, int dir) {
    char* smem = smem0 + LBASE;
    bf16_t* Qs = (bf16_t*)smem;
    bf16_t* Ks = Qs + 32 * 136;
    bf16_t* Ktw = Ks + 32 * 136;
    bf16_t* Vt = Ktw + 128 * 40;
    bf16_t* Ps = Vt + 144 * 40;
    bf16_t* Cb = Ps + 32 * 40;
    float* sg = (float*)(Cb + 144 * 136);
    float* sM = sg + 32; float* sinter = sg + 64; float* sfloor = sg + 96; float* sw = sg + 128; float* smisc = sg + 160;
    const int lane = tid & 63, w = __builtin_amdgcn_readfirstlane(tid >> 6), lr = lane & 15, lq = lane >> 4;
    for (int i = tid; i < 16 * 40; i += 256) Vt[128 * 40 + i] = 0x3f80;
    for (int i = tid; i < 144 * 136 / 2; i += 256) ((unsigned*)Cb)[i] = 0u;
    f32x4 CT[2][9];
#pragma unroll
    for (int i = 0; i < 2; ++i)
#pragma unroll
        for (int j = 0; j < 9; ++j) CT[i][j] = (f32x4){0.f, 0.f, 0.f, 0.f};
    float m_s = 0.f;
    u32x4 kr[2], qr[2], vr[2]; float g_ig = 0.f, g_f = 0.f;
#define ML_PREFETCH(BT) do { \
        const int bt_ = (BT); const bool lat_ = bt_ >= 8; const int pos0_ = lat_ ? (bt_ - 8) * 32 : bt_ * 32; \
        const int nlo_ = dir ? (lat_ ? SEQ : CTX) - 32 - pos0_ : pos0_; const int rowbase_ = lat_ ? b * SEQ : TL + b * CTX; \
        const int l_ = tid & 31, c8_ = tid >> 5; const size_t row_ = (size_t)(rowbase_ + (dir ? nlo_ + 31 - l_ : nlo_ + l_)); \
        _Pragma("unroll") for (int r_ = 0; r_ < 2; ++r_) { const int ec_ = c8_ + 8 * r_; \
            kr[r_] = *(const u32x4*)(p.hbuf + row_ * 1024 + 512 + h * 128 + ec_ * 8); \
            if (lat_) qr[r_] = *(const u32x4*)(p.hbuf + row_ * 1024 + h * 128 + ec_ * 8); \
            vr[r_] = *(const u32x4*)(p.z + row_ * ZS + C_MLV + h * 128 + ec_ * 8); } \
        if (w == 0) { const int lg_ = lane & 31; const float* gp_ = p.zg + (size_t)(rowbase_ + (dir ? nlo_ + 31 - lg_ : nlo_ + lg_)) * 48 + dir * 8 + h; g_ig = gp_[0]; g_f = gp_[4]; } \
    } while (0)
    qr[0] = (u32x4){0u, 0u, 0u, 0u}; qr[1] = qr[0];
    ML_PREFETCH(0);
    __syncthreads();
    for (int bt = 0; bt < 72; ++bt) {
        const bool lat = bt >= 8;
        const int pos0 = lat ? (bt - 8) * 32 : bt * 32;
        const int seg = lat ? SEQ : CTX;
        const int nlo = dir ? seg - 32 - pos0 : pos0;
        const int rowbase = lat ? b * SEQ : TL + b * CTX;
        if (w == 0) {
            const int l = lane & 31;
            const float ig = g_ig, lf = logsig(g_f);
            float bsum = lf;
            bsum += __uint_as_float(__builtin_amdgcn_update_dpp(0u, __float_as_uint(bsum), 0x111, 0xf, 0xf, false));
            bsum += __uint_as_float(__builtin_amdgcn_update_dpp(0u, __float_as_uint(bsum), 0x112, 0xf, 0xf, false));
            bsum += __uint_as_float(__builtin_amdgcn_update_dpp(0u, __float_as_uint(bsum), 0x114, 0xf, 0xf, false));
            bsum += __uint_as_float(__builtin_amdgcn_update_dpp(0u, __float_as_uint(bsum), 0x118, 0xf, 0xf, false));
            { const float r0 = __int_as_float(__builtin_amdgcn_readlane(__float_as_int(bsum), 15)); if (lane & 16) bsum += r0; }
            const float g = ig - bsum;
            float cm = g;
            const unsigned NEGINF = 0xff800000u;
            cm = fmaxf(cm, __uint_as_float(__builtin_amdgcn_update_dpp(NEGINF, __float_as_uint(cm), 0x111, 0xf, 0xf, false)));
            cm = fmaxf(cm, __uint_as_float(__builtin_amdgcn_update_dpp(NEGINF, __float_as_uint(cm), 0x112, 0xf, 0xf, false)));
            cm = fmaxf(cm, __uint_as_float(__builtin_amdgcn_update_dpp(NEGINF, __float_as_uint(cm), 0x114, 0xf, 0xf, false)));
            cm = fmaxf(cm, __uint_as_float(__builtin_amdgcn_update_dpp(NEGINF, __float_as_uint(cm), 0x118, 0xf, 0xf, false)));
            { const float r0 = __int_as_float(__builtin_amdgcn_readlane(__float_as_int(cm), 15)); if (lane & 16) cm = fmaxf(cm, r0); }
            const float M = fmaxf(m_s, cm);
            const float Ml = __int_as_float(__builtin_amdgcn_readlane(__float_as_int(M), 31)), bl = __int_as_float(__builtin_amdgcn_readlane(__float_as_int(bsum), 31));
            if (lane < 32) {
                sg[l] = g; sM[l] = M; sinter[l] = __expf(m_s - M); sfloor[l] = __expf(-(bsum + M)); sw[l] = __expf(g - Ml);
                if (lane == 0) { smisc[0] = __expf(m_s - Ml); smisc[1] = bl + Ml; }
            }
        }
        __syncthreads();
        {
            const int l = tid & 31, c8 = tid >> 5;
            const float wl = sw[l];
#pragma unroll
            for (int r = 0; r < 2; ++r) {
                const int ec = c8 + 8 * r;
                *(u32x4*)(Ks + l * 136 + ec * 8) = kr[r];
#pragma unroll
                for (int j = 0; j < 4; ++j) { Ktw[(ec * 8 + 2 * j) * 40 + l] = f2bf(lo2f(kr[r][j]) * wl); Ktw[(ec * 8 + 2 * j + 1) * 40 + l] = f2bf(hi2f(kr[r][j]) * wl); }
                if (lat) *(u32x4*)(Qs + l * 136 + ec * 8) = qr[r];
#pragma unroll
                for (int j = 0; j < 4; ++j) { Vt[(ec * 8 + 2 * j) * 40 + l] = (bf16_t)(vr[r][j] & 0xffffu); Vt[(ec * 8 + 2 * j + 1) * 40 + l] = (bf16_t)(vr[r][j] >> 16); }
            }
        }
        __syncthreads();
        if (bt + 1 < 72) ML_PREFETCH(bt + 1);
        if (lat) {
            const int mi = w >> 1, ni = w & 1;
            f32x4 sa = (f32x4){0.f, 0.f, 0.f, 0.f};
            if (!(mi == 0 && ni == 1)) {
#pragma unroll
                for (int kk = 0; kk < 4; ++kk) {
                    const bf16x8 af = *(const bf16x8*)(Qs + (mi * 16 + lr) * 136 + kk * 32 + lq * 8);
                    const bf16x8 bf = *(const bf16x8*)(Ks + (ni * 16 + lr) * 136 + kk * 32 + lq * 8);
                    sa = MFMA16(af, bf, sa);
                }
            }
            const int sidx = ni * 16 + lr;
            const float gs = sg[sidx];
#pragma unroll
            for (int r = 0; r < 4; ++r) {
                const int t = mi * 16 + lq * 4 + r;
                const float pv = (sidx <= t) ? sa[r] * __expf(gs - sM[t]) : 0.f;
                Ps[t * 40 + sidx] = f2bf(pv);
            }
        }
        __syncthreads();
        if (lat) {
            const int nts[3] = {2 * w, 2 * w + 1, 8};
            f32x4 acc[2][3];
#pragma unroll
            for (int i = 0; i < 2; ++i)
#pragma unroll
                for (int j = 0; j < 3; ++j) acc[i][j] = (f32x4){0.f, 0.f, 0.f, 0.f};
#pragma unroll 1
            for (int kk = 0; kk < 4; ++kk) {
                bf16x8 af[2], bf[3];
#pragma unroll
                for (int i = 0; i < 2; ++i) af[i] = *(const bf16x8*)(Qs + (i * 16 + lr) * 136 + kk * 32 + lq * 8);
#pragma unroll
                for (int j = 0; j < 3; ++j) bf[j] = *(const bf16x8*)(Cb + (nts[j] * 16 + lr) * 136 + kk * 32 + lq * 8);
#pragma unroll
                for (int i = 0; i < 2; ++i)
#pragma unroll
                    for (int j = 0; j < 3; ++j) acc[i][j] = MFMA16(af[i], bf[j], acc[i][j]);
            }
#pragma unroll
            for (int i = 0; i < 2; ++i)
#pragma unroll
                for (int r = 0; r < 4; ++r) {
                    const float it = sinter[i * 16 + lq * 4 + r];
#pragma unroll
                    for (int j = 0; j < 3; ++j) acc[i][j][r] *= it;
                }
            {
                bf16x8 af[2], bf[3];
#pragma unroll
                for (int i = 0; i < 2; ++i) af[i] = *(const bf16x8*)(Ps + (i * 16 + lr) * 40 + lq * 8);
#pragma unroll
                for (int j = 0; j < 3; ++j) bf[j] = *(const bf16x8*)(Vt + (nts[j] * 16 + lr) * 40 + lq * 8);
#pragma unroll
                for (int i = 0; i < 2; ++i)
#pragma unroll
                    for (int j = 0; j < 3; ++j) acc[i][j] = MFMA16(af[i], bf[j], acc[i][j]);
            }
#pragma unroll
            for (int i = 0; i < 2; ++i)
#pragma unroll
                for (int r = 0; r < 4; ++r) {
                    const int t = i * 16 + lq * 4 + r;
                    const float dn = fmaxf(fabsf(acc[i][2][r]), sfloor[t]);
                    const float inv = 1.f / dn;
                    const int n = dir ? nlo + 31 - t : nlo + t;
                    bf16_t* orow = p.mixh + ((size_t)dir * TL + rowbase + n) * 1024 + h * 128;
#pragma unroll
                    for (int j = 0; j < 2; ++j) orow[nts[j] * 16 + lr] = f2bf(acc[i][j][r] * inv);
                }
        }
        __syncthreads();
        {
            const float a = smisc[0];
            bf16x8 af[2];
#pragma unroll
            for (int i = 0; i < 2; ++i) af[i] = *(const bf16x8*)(Ktw + ((2 * w + i) * 16 + lr) * 40 + lq * 8);
#pragma unroll
            for (int j = 0; j < 9; ++j) {
                const bf16x8 bf = *(const bf16x8*)(Vt + (j * 16 + lr) * 40 + lq * 8);
#pragma unroll
                for (int i = 0; i < 2; ++i) {
                    CT[i][j] = CT[i][j] * a;
                    CT[i][j] = MFMA16(af[i], bf, CT[i][j]);
                    uint2 pk; pk.x = pack2(CT[i][j][0], CT[i][j][1]); pk.y = pack2(CT[i][j][2], CT[i][j][3]);
                    *(uint2*)(Cb + (j * 16 + lr) * 136 + (2 * w + i) * 16 + lq * 4) = pk;
                }
            }
            m_s = smisc[1];
        }
        __syncthreads();
        __syncthreads();
    }
}
#undef ML_PREFETCH

template <int LBASE>
__device__ void gla_item_chunked(const Params& p, char* smem0, int tid, int b, int h, int dir) {
    char* smem = smem0 + LBASE;
    bf16_t* Qd = (bf16_t*)smem;
    bf16_t* Qb = Qd + 32 * 72;
    bf16_t* Kd = Qb + 32 * 72;
    bf16_t* Kwt = Kd + 32 * 72;
    bf16_t* Vt = Kwt + 64 * 40;
    bf16_t* Ps = Vt + 128 * 40;
    bf16_t* Sb = Ps + 32 * 40;
    float* bc = (float*)(Sb + 128 * 72);
    float* w2s = bc + 32 * 64;
    const int lane = tid & 63, w = __builtin_amdgcn_readfirstlane(tid >> 6), lr = lane & 15, lq = lane >> 4;
    for (int i = tid; i < 128 * 72 / 2; i += 256) ((unsigned*)Sb)[i] = 0u;
    for (int i = tid; i < 16 * 64; i += 256) w2s[i] = p.lr_w2[(dir * 16 + (i >> 6)) * 256 + h * 64 + (i & 63)];
    if (tid < 64) w2s[16 * 64 + tid] = p.alpha_b[dir * 256 + h * 64 + tid];
    f32x4 S[8];
#pragma unroll
    for (int j = 0; j < 8; ++j) S[j] = (f32x4){0.f, 0.f, 0.f, 0.f};
    u32x4 kr, qr, vr[2]; f32x4 lrr[4];
#define GLA_PREFETCH(BT) do { \
        const int bt_ = (BT); const bool lat_ = bt_ >= 8; const int pos0_ = lat_ ? (bt_ - 8) * 32 : bt_ * 32; \
        const int nlo_ = dir ? (lat_ ? SEQ : CTX) - 32 - pos0_ : pos0_; const int rowbase_ = lat_ ? b * SEQ : TL + b * CTX; \
        { const int l_ = tid & 31, dc_ = tid >> 5; const size_t row_ = (size_t)(rowbase_ + (dir ? nlo_ + 31 - l_ : nlo_ + l_)); \
          kr = *(const u32x4*)(p.z + row_ * ZS + C_GK + h * 64 + dc_ * 8); \
          if (lat_) qr = *(const u32x4*)(p.z + row_ * ZS + C_GQ + h * 64 + dc_ * 8); \
          vr[0] = *(const u32x4*)(p.z + row_ * ZS + C_GV + h * 128 + dc_ * 8); vr[1] = *(const u32x4*)(p.z + row_ * ZS + C_GV + h * 128 + (dc_ + 8) * 8); } \
        { const int l_ = tid >> 3; const float* lp_ = p.zg + (size_t)(rowbase_ + (dir ? nlo_ + 31 - l_ : nlo_ + l_)) * 48 + 16 + dir * 16; \
          _Pragma("unroll") for (int q_ = 0; q_ < 4; ++q_) lrr[q_] = *(const f32x4*)(lp_ + 4 * q_); } \
    } while (0)
    qr = (u32x4){0u, 0u, 0u, 0u};
    GLA_PREFETCH(0);
    __syncthreads();
    for (int bt = 0; bt < 72; ++bt) {
        const bool lat = bt >= 8;
        const int pos0 = lat ? (bt - 8) * 32 : bt * 32;
        const int seg = lat ? SEQ : CTX;
        const int nlo = dir ? seg - 32 - pos0 : pos0;
        const int rowbase = lat ? b * SEQ : TL + b * CTX;
        {
            const int l = tid >> 3, d0 = (tid & 7) * 8;
            float al[8];
#pragma unroll
            for (int j = 0; j < 8; ++j) al[j] = w2s[16 * 64 + d0 + j];
#pragma unroll
            for (int q = 0; q < 16; ++q) {
                const float lv = lrr[q >> 2][q & 3];
                const f32x4 wa = *(const f32x4*)(w2s + q * 64 + d0), wb = *(const f32x4*)(w2s + q * 64 + d0 + 4);
                al[0] += lv * wa[0]; al[1] += lv * wa[1]; al[2] += lv * wa[2]; al[3] += lv * wa[3];
                al[4] += lv * wb[0]; al[5] += lv * wb[1]; al[6] += lv * wb[2]; al[7] += lv * wb[3];
            }
#pragma unroll
            for (int j = 0; j < 8; ++j) bc[l * 64 + d0 + j] = logsig(al[j]) * (1.f / 16.f);
        }
        __syncthreads();
        if (tid < 64) {
            float cv[32];
#pragma unroll
            for (int l = 0; l < 32; ++l) cv[l] = bc[l * 64 + tid];
#pragma unroll
            for (int l = 1; l < 32; ++l) cv[l] += cv[l - 1];
#pragma unroll
            for (int l = 0; l < 32; ++l) bc[l * 64 + tid] = cv[l];
        }
        __syncthreads();
        {
            const int l = tid & 31, dc = tid >> 5;
            float bl[8], rf[8], be[8];
#pragma unroll
            for (int j = 0; j < 8; ++j) { bl[j] = bc[l * 64 + dc * 8 + j]; rf[j] = bc[16 * 64 + dc * 8 + j]; be[j] = bc[31 * 64 + dc * 8 + j]; }
            {
                float kf[8];
#pragma unroll
                for (int j = 0; j < 4; ++j) { kf[2 * j] = lo2f(kr[j]); kf[2 * j + 1] = hi2f(kr[j]); }
                float kd[8];
#pragma unroll
                for (int j = 0; j < 8; ++j) { kd[j] = kf[j] * __expf(rf[j] - bl[j]); Kwt[(dc * 8 + j) * 40 + l] = f2bf(kf[j] * __expf(be[j] - bl[j])); }
                *(u32x4*)(Kd + l * 72 + dc * 8) = (u32x4){pack2(kd[0], kd[1]), pack2(kd[2], kd[3]), pack2(kd[4], kd[5]), pack2(kd[6], kd[7])};
            }
            if (lat) {
                float qf[8];
#pragma unroll
                for (int j = 0; j < 4; ++j) { qf[2 * j] = lo2f(qr[j]) * 0.125f; qf[2 * j + 1] = hi2f(qr[j]) * 0.125f; }
                float qd[8], qb[8];
#pragma unroll
                for (int j = 0; j < 8; ++j) { qd[j] = qf[j] * __expf(bl[j] - rf[j]); qb[j] = qf[j] * __expf(bl[j]); }
                *(u32x4*)(Qd + l * 72 + dc * 8) = (u32x4){pack2(qd[0], qd[1]), pack2(qd[2], qd[3]), pack2(qd[4], qd[5]), pack2(qd[6], qd[7])};
                *(u32x4*)(Qb + l * 72 + dc * 8) = (u32x4){pack2(qb[0], qb[1]), pack2(qb[2], qb[3]), pack2(qb[4], qb[5]), pack2(qb[6], qb[7])};
            }
#pragma unroll
            for (int r = 0; r < 2; ++r) {
                const int ec = dc + 8 * r;
#pragma unroll
                for (int j = 0; j < 4; ++j) { Vt[(ec * 8 + 2 * j) * 40 + l] = (bf16_t)(vr[r][j] & 0xffffu); Vt[(ec * 8 + 2 * j + 1) * 40 + l] = (bf16_t)(vr[r][j] >> 16); }
            }
        }
        __syncthreads();
        if (bt + 1 < 72) GLA_PREFETCH(bt + 1);
        if (lat) {
            const int mi = w >> 1, ni = w & 1;
            f32x4 sa = (f32x4){0.f, 0.f, 0.f, 0.f};
            if (!(mi == 0 && ni == 1)) {
#pragma unroll
                for (int kk = 0; kk < 2; ++kk) {
                    const bf16x8 af = *(const bf16x8*)(Qd + (mi * 16 + lr) * 72 + kk * 32 + lq * 8);
                    const bf16x8 bf = *(const bf16x8*)(Kd + (ni * 16 + lr) * 72 + kk * 32 + lq * 8);
                    sa = MFMA16(af, bf, sa);
                }
            }
            const int sidx = ni * 16 + lr;
#pragma unroll
            for (int r = 0; r < 4; ++r) {
                const int t = mi * 16 + lq * 4 + r;
                Ps[t * 40 + sidx] = f2bf((sidx <= t) ? sa[r] : 0.f);
            }
        }
        __syncthreads();
        if (lat) {
            f32x4 acc[2][2];
#pragma unroll
            for (int i = 0; i < 2; ++i)
#pragma unroll
                for (int j = 0; j < 2; ++j) acc[i][j] = (f32x4){0.f, 0.f, 0.f, 0.f};
#pragma unroll
            for (int kk = 0; kk < 2; ++kk) {
                bf16x8 af[2], bf[2];
#pragma unroll
                for (int i = 0; i < 2; ++i) af[i] = *(const bf16x8*)(Qb + (i * 16 + lr) * 72 + kk * 32 + lq * 8);
#pragma unroll
                for (int j = 0; j < 2; ++j) bf[j] = *(const bf16x8*)(Sb + ((2 * w + j) * 16 + lr) * 72 + kk * 32 + lq * 8);
#pragma unroll
                for (int i = 0; i < 2; ++i)
#pragma unroll
                    for (int j = 0; j < 2; ++j) acc[i][j] = MFMA16(af[i], bf[j], acc[i][j]);
            }
            {
                bf16x8 af[2], bf[2];
#pragma unroll
                for (int i = 0; i < 2; ++i) af[i] = *(const bf16x8*)(Ps + (i * 16 + lr) * 40 + lq * 8);
#pragma unroll
                for (int j = 0; j < 2; ++j) bf[j] = *(const bf16x8*)(Vt + ((2 * w + j) * 16 + lr) * 40 + lq * 8);
#pragma unroll
                for (int i = 0; i < 2; ++i)
#pragma unroll
                    for (int j = 0; j < 2; ++j) acc[i][j] = MFMA16(af[i], bf[j], acc[i][j]);
            }
#pragma unroll
            for (int i = 0; i < 2; ++i)
#pragma unroll
                for (int r = 0; r < 4; ++r) {
                    const int t = i * 16 + lq * 4 + r;
                    const int n = dir ? nlo + 31 - t : nlo + t;
                    bf16_t* orow = p.mixh + ((size_t)dir * TL + rowbase + n) * 1024 + 512 + h * 128;
#pragma unroll
                    for (int j = 0; j < 2; ++j) orow[(2 * w + j) * 16 + lr] = f2bf(acc[i][j][r]);
                }
        }
        __syncthreads();
        {
            float rs[4];
#pragma unroll
            for (int r = 0; r < 4; ++r) rs[r] = __expf(bc[31 * 64 + w * 16 + lq * 4 + r]);
            const bf16x8 af = *(const bf16x8*)(Kwt + (w * 16 + lr) * 40 + lq * 8);
#pragma unroll
            for (int j = 0; j < 8; ++j) {
                const bf16x8 bf = *(const bf16x8*)(Vt + (j * 16 + lr) * 40 + lq * 8);
#pragma unroll
                for (int r = 0; r < 4; ++r) S[j][r] *= rs[r];
                S[j] = MFMA16(af, bf, S[j]);
                uint2 pk; pk.x = pack2(S[j][0], S[j][1]); pk.y = pack2(S[j][2], S[j][3]);
                *(uint2*)(Sb + (j * 16 + lr) * 72 + w * 16 + lq * 4) = pk;
            }
        }
        __syncthreads();
    }
}
#undef GLA_PREFETCH

__device__ void phase_mlprep(const Params& p, int bid, int nblk) {
    const int tidx_ = opaque_tid();
    const int lane = tidx_ & 63;
    const int gw = bid * (NT / 64) + (tidx_ >> 6), nw = nblk * (NT / 64);
    const int c0 = lane * 16;
    float w0[16], w1[16], w2[16];
#pragma unroll
    for (int j = 0; j < 16; ++j) { w0[j] = p.conv_w[c0 + j]; w1[j] = p.conv_w[1024 + c0 + j]; w2[j] = p.conv_w[2048 + c0 + j]; }
    const float scl = c0 >= 512 ? 0.08838834764831845f : 1.f;
    constexpr int R = 2;
    for (int row0 = gw; row0 < TT; row0 += R * nw) {
        u32x4 cc[R][2], ll[R][2], rr[R][2];
#pragma unroll
        for (int r = 0; r < R; ++r) {
            const int row = min(row0 + r * nw, TT - 1);
            const bool lat = row < TL;
            const int n = lat ? (row & (SEQ - 1)) : ((row - TL) & (CTX - 1));
            const bool vl = lat ? ((n & 63) != 0) : (n != 0);
            const bool vr = lat ? ((n & 63) != 63) : (n != CTX - 1);
            const bf16_t* zc = p.z + (size_t)row * ZS + c0;
#pragma unroll
            for (int q = 0; q < 2; ++q) {
                cc[r][q] = *(const u32x4*)(zc + 8 * q);
                ll[r][q] = vl ? *(const u32x4*)(zc - ZS + 8 * q) : (u32x4){0u, 0u, 0u, 0u};
                rr[r][q] = vr ? *(const u32x4*)(zc + ZS + 8 * q) : (u32x4){0u, 0u, 0u, 0u};
            }
        }
#pragma unroll
        for (int r = 0; r < R; ++r) {
            const int row = row0 + r * nw;
            unsigned o[8];
#pragma unroll
            for (int q = 0; q < 2; ++q)
#pragma unroll
                for (int j = 0; j < 4; ++j) {
                    const int e = q * 8 + 2 * j;
                    const float y0 = w0[e] * lo2f(ll[r][q][j]) + w1[e] * lo2f(cc[r][q][j]) + w2[e] * lo2f(rr[r][q][j]);
                    const float y1 = w0[e + 1] * hi2f(ll[r][q][j]) + w1[e + 1] * hi2f(cc[r][q][j]) + w2[e + 1] * hi2f(rr[r][q][j]);
                    o[q * 4 + j] = pack2(silu(y0) * scl, silu(y1) * scl);
                }
            if (row < TT) {
                u32x4* dst = (u32x4*)(p.hbuf + (size_t)row * 1024 + c0);
                dst[0] = (u32x4){o[0], o[1], o[2], o[3]}; dst[1] = (u32x4){o[4], o[5], o[6], o[7]};
            }
        }
    }
}

__device__ void phase_mixers(const Params& p, char* smem, int bid, int nblk) {
    const int tidx_ = opaque_tid();
    const int sub = __builtin_amdgcn_readfirstlane(tidx_ >> 8), stid = tidx_ & 255;
#if MIX_SAMEKIND
    for (int pr = bid; pr < 256; pr += nblk) {
        const bool isml = pr < 128;
        const int it = ((pr & 127) << 1) + sub;
        const int b = it >> 3, h = (it >> 1) & 3, dir = it & 1;
        if (isml) { if (sub == 0) mlstm_item_chunked<0>(p, smem, stid, b, h, dir); else mlstm_item_chunked<81920>(p, smem, stid, b, h, dir); }
        else { if (sub == 0) gla_item_chunked<0>(p, smem, stid, b, h, dir); else gla_item_chunked<81920>(p, smem, stid, b, h, dir); }
        __syncthreads();
    }
#else
    for (int it = bid; it < 256; it += nblk) {
        const int b = it >> 3, h = (it >> 1) & 3, dir = it & 1;
        if (sub == 0) mlstm_item_chunked<0>(p, smem, stid, b, h, dir);
        else gla_item_chunked<81920>(p, smem, stid, b, h, dir);
        __syncthreads();
    }
#endif
}

__device__ void phase_mixprep(const Params& p, int bid, int nblk) {
    const int tidx_ = opaque_tid();
    const int lane = tidx_ & 63;
    const int gw = bid * (NT / 64) + (tidx_ >> 6), nw = nblk * (NT / 64);
    const int c0 = lane * 16;
    const float* gn = c0 < 512 ? p.ml_norm_g + c0 : p.gla_norm_g + (c0 - 512);
    float gnv[16];
#pragma unroll
    for (int j = 0; j < 16; ++j) gnv[j] = gn[j];
    constexpr int R = 4;
    for (int row0 = gw; row0 < TL; row0 += R * nw) {
        u32x4 u0[R][2], u1[R][2], ug[R][2];
#pragma unroll
        for (int r = 0; r < R; ++r) {
            const int row = min(row0 + r * nw, TL - 1);
            const u32x4* a0 = (const u32x4*)(p.mixh + (size_t)row * 1024 + c0);
            const u32x4* a1 = (const u32x4*)(p.mixh + ((size_t)TL + row) * 1024 + c0);
            const u32x4* gp = (const u32x4*)(p.z + (size_t)row * ZS + (c0 < 512 ? C_MLO + c0 : C_GR + (c0 - 512)));
#pragma unroll
            for (int q = 0; q < 2; ++q) { u0[r][q] = a0[q]; u1[r][q] = a1[q]; ug[r][q] = gp[q]; }
        }
#pragma unroll
        for (int r = 0; r < R; ++r) {
            const int row = row0 + r * nw;
            float sv[16], gt[16];
#pragma unroll
            for (int q = 0; q < 2; ++q)
#pragma unroll
                for (int j = 0; j < 4; ++j) {
                    sv[q * 8 + 2 * j] = lo2f(u0[r][q][j]) + lo2f(u1[r][q][j]); sv[q * 8 + 2 * j + 1] = hi2f(u0[r][q][j]) + hi2f(u1[r][q][j]);
                    gt[q * 8 + 2 * j] = lo2f(ug[r][q][j]); gt[q * 8 + 2 * j + 1] = hi2f(ug[r][q][j]);
                }
            float ss = 0.f;
#pragma unroll
            for (int j = 0; j < 16; ++j) ss += sv[j] * sv[j];
            ss += dppx<0xB1>(ss); ss += dppx<0x4E>(ss); ss += dppx<0x141>(ss);
            const float rstd = rsqrtf(ss * (1.f / 128.f) + EPS);
            unsigned o[8];
#pragma unroll
            for (int j = 0; j < 8; ++j) {
                float y0, y1;
                const float g0 = gt[2 * j], g1 = gt[2 * j + 1];
                if (c0 < 512) { y0 = sigm(g0); y1 = sigm(g1); } else { y0 = silu(g0); y1 = silu(g1); }
                y0 *= sv[2 * j] * rstd * gnv[2 * j]; y1 *= sv[2 * j + 1] * rstd * gnv[2 * j + 1];
                o[j] = pack2(y0, y1);
            }
            if (row < TL) {
                u32x4* dst = (u32x4*)(p.hbuf + (size_t)row * D + c0);
                dst[0] = (u32x4){o[0], o[1], o[2], o[3]}; dst[1] = (u32x4){o[4], o[5], o[6], o[7]};
            }
        }
    }
}

__device__ void phase_norm2(const Params& p, int bid, int nblk) {
    const int tidx_ = opaque_tid();
    const int lane = tidx_ & 63;
    const int gw = bid * (NT / 64) + (tidx_ >> 6), nw = nblk * (NT / 64);
    constexpr int R = 4;
    for (int row0 = gw; row0 < TL; row0 += R * nw) {
        f32x4 v[R][4]; uint2 yv[R][4];
#pragma unroll
        for (int r = 0; r < R; ++r) {
            const int row = min(row0 + r * nw, TL - 1);
#pragma unroll
            for (int j = 0; j < 4; ++j) { v[r][j] = *(const f32x4*)(p.x + (size_t)row * D + j * 256 + lane * 4); yv[r][j] = *(const uint2*)(p.ybuf + (size_t)row * D + j * 256 + lane * 4); }
        }
#pragma unroll
        for (int r = 0; r < R; ++r) {
            const int row = min(row0 + r * nw, TL - 1);
            const float* md = p.mod + (row >> 11) * 6144;
            float a = 0.f;
#pragma unroll
            for (int j = 0; j < 4; ++j) {
                const f32x4 g1 = *(const f32x4*)(md + 2048 + j * 256 + lane * 4);
                v[r][j][0] += g1[0] * lo2f(yv[r][j].x); v[r][j][1] += g1[1] * hi2f(yv[r][j].x); v[r][j][2] += g1[2] * lo2f(yv[r][j].y); v[r][j][3] += g1[3] * hi2f(yv[r][j].y);
                a += v[r][j][0] * v[r][j][0] + v[r][j][1] * v[r][j][1] + v[r][j][2] * v[r][j][2] + v[r][j][3] * v[r][j][3];
            }
            const float ss = wave_sum_fast(a);
            const float rstd = rsqrtf(ss * (1.f / 1024.f) + EPS);
            if (row0 + r * nw < TL) {
#pragma unroll
                for (int j = 0; j < 4; ++j) {
                    const int col = j * 256 + lane * 4;
                    const f32x4 g = *(const f32x4*)(p.norm2_g + col), sc = *(const f32x4*)(md + 4096 + col), sh = *(const f32x4*)(md + 3072 + col);
                    uint2 o;
                    o.x = pack2(v[r][j][0] * rstd * g[0] * (1.f + sc[0]) + sh[0], v[r][j][1] * rstd * g[1] * (1.f + sc[1]) + sh[1]);
                    o.y = pack2(v[r][j][2] * rstd * g[2] * (1.f + sc[2]) + sh[2], v[r][j][3] * rstd * g[3] * (1.f + sc[3]) + sh[3]);
                    *(uint2*)(p.hbuf + (size_t)row * D + col) = o;
                }
            }
        }
    }
}

__device__ __forceinline__ unsigned fkey(float f) { const unsigned u = __float_as_uint(f); return (u & 0x80000000u) ? ~u : (u | 0x80000000u); }
__device__ __forceinline__ int mbcnt64(unsigned long long m) { return __builtin_amdgcn_mbcnt_hi((unsigned)(m >> 32), __builtin_amdgcn_mbcnt_lo((unsigned)m, 0)); }
#define LDS_FENCE() asm volatile("s_waitcnt lgkmcnt(0)" ::: "memory")

template <int NV>
__device__ __forceinline__ void wave_top16(const float (&val)[NV], const int (&tag)[NV], float* outv, int* outt) {
    unsigned u[NV];
#pragma unroll
    for (int v = 0; v < NV; ++v) u[v] = fkey(val[v]);
    unsigned T = 0;
    for (int bit = 31; bit >= 0; --bit) {
        const unsigned cand = T | (1u << bit);
        int cnt = 0;
#pragma unroll
        for (int v = 0; v < NV; ++v) cnt += __popcll(__ballot(u[v] >= cand));
        if (cnt >= 16) T = cand;
    }
    int base = 0;
#pragma unroll
    for (int v = 0; v < NV; ++v) {
        const bool gt = u[v] > T;
        const unsigned long long mk = __ballot(gt);
        const int pos = base + mbcnt64(mk);
        if (gt) { outv[pos] = val[v]; outt[pos] = tag[v]; }
        base += __popcll(mk);
    }
#pragma unroll
    for (int v = 0; v < NV; ++v) {
        const bool eq = u[v] == T;
        const unsigned long long mk = __ballot(eq);
        const int pos = base + mbcnt64(mk);
        if (eq && pos < 16) { outv[pos] = val[v]; outt[pos] = tag[v]; }
        base += __popcll(mk);
    }
}

template <int NV>
__device__ __forceinline__ void wave_top16_bisect(const float (&val)[NV], const int (&tag)[NV], float* outv, int* outt) {
    float mx = val[0], mn = val[0];
#pragma unroll
    for (int v = 1; v < NV; ++v) { mx = fmaxf(mx, val[v]); mn = fminf(mn, val[v]); }
    float hi = wave_max_fast(mx), lo = -wave_max_fast(-mn);
    float mid = 0.f; bool ok = false;
    for (int it = 0; it < 40; ++it) {
        mid = 0.5f * (lo + hi);
        int cnt = 0;
#pragma unroll
        for (int v = 0; v < NV; ++v) cnt += __popcll(__ballot(val[v] > mid));
        if (cnt == 16) { ok = true; break; }
        if (cnt > 16) lo = mid; else hi = mid;
    }
    if (!ok) { wave_top16<NV>(val, tag, outv, outt); return; }
    int base = 0;
#pragma unroll
    for (int v = 0; v < NV; ++v) {
        const bool gt = val[v] > mid;
        const unsigned long long mk = __ballot(gt);
        const int pos = base + mbcnt64(mk);
        if (gt) { outv[pos] = val[v]; outt[pos] = tag[v]; }
        base += __popcll(mk);
    }
}

template <int CTRL> __device__ __forceinline__ unsigned dppu(unsigned x) { return __builtin_amdgcn_update_dpp(0u, x, CTRL, 0xf, 0xf, false); }
__device__ __forceinline__ unsigned row_max16u(unsigned x) { x = max(x, dppu<0x128>(x)); x = max(x, dppu<0x124>(x)); x = max(x, dppu<0x4E>(x)); return max(x, dppu<0xB1>(x)); }
__device__ __forceinline__ float row_max16(float x) { x = fmaxf(x, dppx<0x128>(x)); x = fmaxf(x, dppx<0x124>(x)); x = fmaxf(x, dppx<0x4E>(x)); return fmaxf(x, dppx<0xB1>(x)); }
__device__ __forceinline__ float row_sum16(float x) { x += dppx<0x128>(x); x += dppx<0x124>(x); x += dppx<0x4E>(x); return x + dppx<0xB1>(x); }
__device__ __forceinline__ unsigned key_of(float v, unsigned tag) { const unsigned b = (__float_as_uint(v) & 0xffffff00u) | tag; return (b & 0x80000000u) ? ~b : (b | 0x80000000u); }
__device__ __forceinline__ unsigned bits_of_key(unsigned k) { return (k & 0x80000000u) ? (k & 0x7fffffffu) : ~k; }
#define CE_DESC(i, j) do { const unsigned hi_ = max(u[i], u[j]), lo_ = min(u[i], u[j]); u[i] = hi_; u[j] = lo_; } while (0)
template <int N>
__device__ __forceinline__ unsigned tournament16(unsigned (&u)[N], int lr) {
    unsigned res = 0u;
#pragma unroll
    for (int k = 0; k < 16; ++k) {
        const unsigned m = row_max16u(u[0]);
        const bool wn = (u[0] == m);
        res = (lr == k) ? m : res;
#pragma unroll
        for (int i = 0; i < N - 1; ++i) u[i] = wn ? u[i + 1] : u[i];
        u[N - 1] = wn ? 0u : u[N - 1];
    }
    return res;
}

template <int N>
__device__ __forceinline__ void tournament16x2(unsigned (&ua)[N], unsigned (&ub)[N], int lr, unsigned& ra, unsigned& rb) {
    ra = 0u; rb = 0u;
#pragma unroll
    for (int k = 0; k < 16; ++k) {
        const unsigned ma = row_max16u(ua[0]), mb = row_max16u(ub[0]);
        const bool wa = (ua[0] == ma), wb = (ub[0] == mb);
        ra = (lr == k) ? ma : ra; rb = (lr == k) ? mb : rb;
#pragma unroll
        for (int i = 0; i < N - 1; ++i) { ua[i] = wa ? ua[i + 1] : ua[i]; ub[i] = wb ? ub[i + 1] : ub[i]; }
        ua[N - 1] = wa ? 0u : ua[N - 1]; ub[N - 1] = wb ? 0u : ub[N - 1];
    }
}
#define SORT8_DESC() do { CE_DESC(0, 1); CE_DESC(2, 3); CE_DESC(4, 5); CE_DESC(6, 7); CE_DESC(0, 2); CE_DESC(1, 3); CE_DESC(4, 6); CE_DESC(5, 7); CE_DESC(1, 2); CE_DESC(5, 6); \
        CE_DESC(0, 4); CE_DESC(1, 5); CE_DESC(2, 6); CE_DESC(3, 7); CE_DESC(2, 4); CE_DESC(3, 5); CE_DESC(1, 2); CE_DESC(3, 4); CE_DESC(5, 6); } while (0)

__device__ void phase_topk(const Params& p, char* smem, int bid, int nblk) {
    const int tidx_ = opaque_tid();
    const int tid = tidx_, lane = tid & 63, w = __builtin_amdgcn_readfirstlane(tid >> 6), lr = lane & 15, lq = lane >> 4;
    constexpr int SS = 260;
    constexpr int WS = 16 * SS + 512;
    float* sc = (float*)smem + w * WS;
    float* tv = sc + 16 * SS + lq * 64;
    int* ti = (int*)(tv + 32);
    for (int item = bid; item < (TL / (NT / 4)) * 8; item += nblk) {
        const int ph = item & 7, t0 = (item >> 3) * (NT / 4) + w * 16;
#pragma unroll
        for (int hh = 0; hh < 2; ++hh) {
            bf16x8 af[4];
#pragma unroll
            for (int kk = 0; kk < 4; ++kk) af[kk] = *(const bf16x8*)(p.qbuf + (size_t)(t0 + lr) * 2048 + ph * 256 + hh * 128 + kk * 32 + lq * 8);
            const bf16_t* kb = p.keysb + (size_t)((ph * 2 + hh) * 128 + lr) * 128 + lq * 8;
            f32x4 acc[8];
            bf16x8 b0[4], b1[4];
#pragma unroll
            for (int kk = 0; kk < 4; ++kk) b0[kk] = *(const bf16x8*)(kb + kk * 32);
#pragma unroll
            for (int n = 0; n < 8; n += 2) {
#pragma unroll
                for (int kk = 0; kk < 4; ++kk) b1[kk] = *(const bf16x8*)(kb + (n + 1) * 16 * 128 + kk * 32);
                acc[n] = (f32x4){0.f, 0.f, 0.f, 0.f};
#pragma unroll
                for (int kk = 0; kk < 4; ++kk) acc[n] = MFMA16(af[kk], b0[kk], acc[n]);
                if (n + 2 < 8) {
#pragma unroll
                    for (int kk = 0; kk < 4; ++kk) b0[kk] = *(const bf16x8*)(kb + (n + 2) * 16 * 128 + kk * 32);
                }
                acc[n + 1] = (f32x4){0.f, 0.f, 0.f, 0.f};
#pragma unroll
                for (int kk = 0; kk < 4; ++kk) acc[n + 1] = MFMA16(af[kk], b1[kk], acc[n + 1]);
            }
#pragma unroll
            for (int n = 0; n < 8; ++n)
#pragma unroll
                for (int r = 0; r < 4; ++r) sc[(lq * 4 + r) * SS + hh * 128 + n * 16 + lr] = acc[n][r];
        }
        LDS_FENCE();
        for (int ps2 = 0; ps2 < 2; ++ps2) {
            float a0[2];
#pragma unroll
            for (int pp = 0; pp < 2; ++pp) {
                const int tt = (ps2 * 2 + pp) * 4 + lq;
                float* tvp = tv + pp * 256; int* tip = ti + pp * 256;
                unsigned ua[8], ub[8];
#pragma unroll
                for (int j = 0; j < 8; ++j) { ua[j] = key_of(sc[tt * SS + lr + 16 * j], 255u - (unsigned)(lr + 16 * j)); ub[j] = key_of(sc[tt * SS + 128 + lr + 16 * j], 255u - (unsigned)(lr + 16 * j)); }
                { unsigned (&u)[8] = ua; SORT8_DESC(); }
                { unsigned (&u)[8] = ub; SORT8_DESC(); }
                unsigned ra, rb;
                tournament16x2<8>(ua, ub, lr, ra, rb);
                const unsigned ba = bits_of_key(ra), bb = bits_of_key(rb);
                a0[pp] = __uint_as_float(ba);
                tvp[lr] = __uint_as_float(ba); tip[lr] = 255 - (int)(ba & 0xffu);
                tvp[16 + lr] = __uint_as_float(bb); tip[16 + lr] = 255 - (int)(bb & 0xffu);
            }
            LDS_FENCE();
            unsigned ca[16], cb2[16];
#pragma unroll
            for (int pp = 0; pp < 2; ++pp) {
                const float* tvp = tv + pp * 256;
                const f32x4 b0 = *(const f32x4*)(tvp + 16), b1 = *(const f32x4*)(tvp + 20), b2 = *(const f32x4*)(tvp + 24), b3 = *(const f32x4*)(tvp + 28);
                const float bj[16] = {b0[0], b0[1], b0[2], b0[3], b1[0], b1[1], b1[2], b1[3], b2[0], b2[1], b2[2], b2[3], b3[0], b3[1], b3[2], b3[3]};
#pragma unroll
                for (int j = 0; j < 16; ++j) { const unsigned kx = key_of(a0[pp] + bj[j], 255u - (unsigned)(lr * 16 + j)); if (pp == 0) ca[j] = kx; else cb2[j] = kx; }
            }
            unsigned rca, rcb;
            tournament16x2<16>(ca, cb2, lr, rca, rcb);
#pragma unroll
            for (int pp = 0; pp < 2; ++pp) {
                const int t = t0 + (ps2 * 2 + pp) * 4 + lq;
                const int* tip = ti + pp * 256;
                const unsigned cb = bits_of_key(pp == 0 ? rca : rcb);
                const float sv = __uint_as_float(cb);
                const int tag = 255 - (int)(cb & 0xffu);
                const int idx = tip[tag >> 4] * 128 + tip[16 + (tag & 15)];
                const float mx = row_max16(sv);
                const float ev = __expf(sv - mx);
                const float sm = row_sum16(ev);
                p.pidx[(size_t)t * 128 + ph * 16 + lr] = idx;
                p.pgw[(size_t)t * 128 + ph * 16 + lr] = ev / sm;
            }
            LDS_FENCE();
        }
    }
    __syncthreads();
}

typedef float f32x2 __attribute__((ext_vector_type(2)));
template <int CTRL> __device__ __forceinline__ float dppf(float x) {
    return __uint_as_float(__builtin_amdgcn_update_dpp(0u, __float_as_uint(x), CTRL, 0xf, 0xf, false));
}
__device__ __forceinline__ float red4(float a, float b, float c, float d) {
    auto r = __builtin_amdgcn_permlane32_swap(__float_as_uint(a), __float_as_uint(b), false, false);
    const float ab = __uint_as_float(r[0]) + __uint_as_float(r[1]);
    auto q = __builtin_amdgcn_permlane32_swap(__float_as_uint(c), __float_as_uint(d), false, false);
    const float cd = __uint_as_float(q[0]) + __uint_as_float(q[1]);
    auto s = __builtin_amdgcn_permlane16_swap(__float_as_uint(ab), __float_as_uint(cd), false, false);
    float x = __uint_as_float(s[0]) + __uint_as_float(s[1]);
    x += dppf<0x128>(x); x += dppf<0x124>(x); x += dppf<0x4E>(x); x += dppf<0xB1>(x);
    return x;
}
typedef unsigned u32x3 __attribute__((ext_vector_type(3)));
typedef unsigned u32x6 __attribute__((ext_vector_type(6)));
typedef float f32x32 __attribute__((ext_vector_type(32)));
#ifndef GP
#define GP 8
#endif
struct GB { unsigned a[GP], b[GP], c[GP]; };
__device__ __forceinline__ f32x32 dec32(unsigned a0, unsigned a1, unsigned a2, unsigned b0, unsigned b1, unsigned b2) {
    const u32x6 sv = (u32x6){a0, a1, a2, b0, b1, b2};
    return __builtin_amdgcn_cvt_scalef32_pk32_f32_fp6(sv, 1.0f);
}
__device__ __forceinline__ void gloadN(GB& buf, const __amdgpu_buffer_rsrc_t tab, int idxreg, int j0, int lane) {
#pragma unroll
    for (int jj = 0; jj < GP; ++jj) {
        const int e = __builtin_amdgcn_readlane(idxreg, j0 + jj);
        const u32x3 t3 = __builtin_amdgcn_raw_buffer_load_b96(tab, lane * 12, e * 768, 0);
        buf.a[jj] = t3[0]; buf.b[jj] = t3[1]; buf.c[jj] = t3[2];
    }
}
__device__ __forceinline__ float gdotsN(const GB& buf, const float (&hv)[16], float d, int j0, int lane) {
    int di = __float_as_int(d);
    float chain = 0.f;
#pragma unroll
    for (int q = 0; q < GP / 4; ++q) {
        float pt[4];
#pragma unroll
        for (int h2 = 0; h2 < 2; ++h2) {
            const int jj = 4 * q + 2 * h2;
            unsigned w0 = buf.a[jj];
            asm volatile("" : "+v"(w0) : "v"(chain));
            const f32x32 f = dec32(w0, buf.b[jj], buf.c[jj], buf.a[jj + 1], buf.b[jj + 1], buf.c[jj + 1]);
            float a0 = 0.f, a1 = 0.f, c0 = 0.f, c1 = 0.f;
#pragma unroll
            for (int k = 0; k < 16; k += 2) { a0 += f[k] * hv[k]; a1 += f[k + 1] * hv[k + 1]; c0 += f[16 + k] * hv[k]; c1 += f[16 + k + 1] * hv[k + 1]; }
            pt[2 * h2] = a0 + a1; pt[2 * h2 + 1] = c0 + c1;
            chain = pt[2 * h2 + 1];
        }
        const float x0 = red4(pt[0], pt[1], pt[2], pt[3]);
        di = (lane == j0 + 4 * q + 0) ? __builtin_amdgcn_readlane(__float_as_int(x0), 0) : di;
        di = (lane == j0 + 4 * q + 1) ? __builtin_amdgcn_readlane(__float_as_int(x0), 32) : di;
        di = (lane == j0 + 4 * q + 2) ? __builtin_amdgcn_readlane(__float_as_int(x0), 16) : di;
        di = (lane == j0 + 4 * q + 3) ? __builtin_amdgcn_readlane(__float_as_int(x0), 48) : di;
    }
    return __int_as_float(di);
}
__device__ __forceinline__ void gaxpyN(const GB& buf, float coef, float (&acc)[16], int j0) {
#pragma unroll
    for (int jj = 0; jj < GP; jj += 2) {
        const float c0 = __int_as_float(__builtin_amdgcn_readlane(__float_as_int(coef), j0 + jj));
        const float c1 = __int_as_float(__builtin_amdgcn_readlane(__float_as_int(coef), j0 + jj + 1));
        unsigned w0 = buf.a[jj];
        asm volatile("" : "+v"(w0) : "v"(acc[15]));
        const f32x32 f = dec32(w0, buf.b[jj], buf.c[jj], buf.a[jj + 1], buf.b[jj + 1], buf.c[jj + 1]);
#pragma unroll
        for (int k = 0; k < 16; ++k) acc[k] += c0 * f[k] + c1 * f[16 + k];
    }
}
__device__ __forceinline__ float gather_dots(const __amdgpu_buffer_rsrc_t tab, int idxreg, const float (&hv)[16], int lane) {
    float d = 0.f;
    GB bufA, bufB;
    constexpr int NG = 64 / GP;
    gloadN(bufA, tab, idxreg, 0, lane);
#pragma unroll 1
    for (int g = 0; g < NG; g += 2) {
        gloadN(bufB, tab, idxreg, (g + 1) * GP, lane);
        d = gdotsN(bufA, hv, d, g * GP, lane);
        gloadN(bufA, tab, idxreg, ((g + 2) & (NG - 1)) * GP, lane);
        d = gdotsN(bufB, hv, d, (g + 1) * GP, lane);
    }
    return d;
}
__device__ __forceinline__ void gather_axpy(const __amdgpu_buffer_rsrc_t tab, int idxreg, float coef, float (&acc)[16], int lane) {
    GB bufA, bufB;
    constexpr int NG = 64 / GP;
    gloadN(bufA, tab, idxreg, 0, lane);
#pragma unroll 1
    for (int g = 0; g < NG; g += 2) {
        gloadN(bufB, tab, idxreg, (g + 1) * GP, lane);
        gaxpyN(bufA, coef, acc, g * GP);
        gloadN(bufA, tab, idxreg, ((g + 2) & (NG - 1)) * GP, lane);
        gaxpyN(bufB, coef, acc, (g + 1) * GP);
    }
}
__device__ __forceinline__ float gelu_exact(float x) { return 0.5f * x * (1.f + erff(x * 0.7071067811865476f)); }

__device__ void phase_gather(const Params& p, int bid, int nblk) {
    const int tidx_ = opaque_tid();
    const int lane = tidx_ & 63;
    const int gw = bid * (NT / 64) + (tidx_ >> 6), nw = nblk * (NT / 64);
    const __amdgpu_buffer_rsrc_t ursrc = __builtin_amdgcn_make_buffer_rsrc((void*)p.u8, (short)0, 16384 * 768, 0x00020000);
    const __amdgpu_buffer_rsrc_t vrsrc = __builtin_amdgcn_make_buffer_rsrc((void*)p.v8, (short)0, 16384 * 768, 0x00020000);
    for (int t = gw; t < TL; t += nw) {
        float hv[16];
        {
            const u32x4 h0 = *(const u32x4*)(p.hbuf + (size_t)t * D + lane * 16), h1 = *(const u32x4*)(p.hbuf + (size_t)t * D + lane * 16 + 8);
#pragma unroll
            for (int q = 0; q < 4; ++q) { hv[2 * q] = lo2f(h0[q]); hv[2 * q + 1] = hi2f(h0[q]); hv[8 + 2 * q] = lo2f(h1[q]); hv[8 + 2 * q + 1] = hi2f(h1[q]); }
        }
        const int ia = p.pidx[(size_t)t * 128 + lane], ib = p.pidx[(size_t)t * 128 + 64 + lane];
        const float ga = p.pgw[(size_t)t * 128 + lane], gb = p.pgw[(size_t)t * 128 + 64 + lane];
        const float usA = p.usc[ia], usB = p.usc[ib], vsA = p.vsc[ia], vsB = p.vsc[ib];
        const float dA = gather_dots(ursrc, ia, hv, lane);
        const float dB = gather_dots(ursrc, ib, hv, lane);
        const float cA = gelu_exact(dA * usA) * ga * vsA, cB = gelu_exact(dB * usB) * gb * vsB;
        float acc[16];
#pragma unroll
        for (int j = 0; j < 16; ++j) acc[j] = 0.f;
        gather_axpy(vrsrc, ia, cA, acc, lane);
        gather_axpy(vrsrc, ib, cB, acc, lane);
        float* orow = p.out + (size_t)t * D + lane * 16;
        const float* xrow = p.x + (size_t)t * D + lane * 16;
        const float* g1 = p.mod + (t >> 11) * 6144 + 2048 + lane * 16;
        const float* g2 = g1 + 3072;
        float yo[16];
        {
            const u32x4 y0 = *(const u32x4*)(p.ybuf + (size_t)t * D + lane * 16), y1 = *(const u32x4*)(p.ybuf + (size_t)t * D + lane * 16 + 8);
#pragma unroll
            for (int q = 0; q < 4; ++q) { yo[2 * q] = lo2f(y0[q]); yo[2 * q + 1] = hi2f(y0[q]); yo[8 + 2 * q] = lo2f(y1[q]); yo[8 + 2 * q + 1] = hi2f(y1[q]); }
        }
        float y[16]; float ss = 0.f;
#pragma unroll
        for (int q = 0; q < 4; ++q) {
            const f32x4 xv = *(const f32x4*)(xrow + 4 * q), gv = *(const f32x4*)(g2 + 4 * q), g1v = *(const f32x4*)(g1 + 4 * q);
#pragma unroll
            for (int k = 0; k < 4; ++k) { y[4 * q + k] = xv[k] + g1v[k] * yo[4 * q + k] + gv[k] * acc[4 * q + k]; ss += y[4 * q + k] * y[4 * q + k]; }
        }
        ss = wave_sum(ss);
        const float rstd = rsqrtf(ss * (1.f / 1024.f) + EPS);
#pragma unroll
        for (int q = 0; q < 4; ++q) {
            const f32x4 gf = *(const f32x4*)(p.norm_f_g + lane * 16 + 4 * q);
            *(f32x4*)(orow + 4 * q) = (f32x4){y[4 * q] * rstd * gf[0], y[4 * q + 1] * rstd * gf[1], y[4 * q + 2] * rstd * gf[2], y[4 * q + 3] * rstd * gf[3]};
        }
    }
}

extern __shared__ __attribute__((aligned(16))) char dyn_smem[];

__device__ __forceinline__ void run_phase(const Params& p, int ph, char* smem, int bid, int nblk) {
#ifdef ONLY_PHASE
    if (ph != ONLY_PHASE) return;
#endif
    switch (ph) {
        case 0: phase_mod(p, smem, bid, nblk); phase_convert(p, smem, bid, nblk); break;
        case 1: phase_norm1(p, bid, nblk); break;
        case 2: { EpiZ e{p.z, p.zg, p.gate_b}; gemm_run(p.hbuf, p.winT, TT, PTP, 1024, e, smem, bid, nblk); } break;
        case 3: phase_mlprep(p, bid, nblk); break;
        case 4: phase_mixers(p, smem, bid, nblk); break;
        case 5: phase_mixprep(p, bid, nblk); break;
        case 6: { EpiY e{p.ybuf}; gemm_run(p.hbuf, p.woutT, TL, 1024, 1024, e, smem, bid, nblk); } break;
        case 7: phase_norm2(p, bid, nblk); break;
        case 8: { EpiQb e{p.qbuf}; gemm_run(p.hbuf, p.wqT, TL, 2048, 1024, e, smem, bid, nblk); } break;
        case 9: phase_topk(p, smem, bid, nblk); break;
        case 10: phase_gather(p, bid, nblk); break;
    }
}
#ifndef PHASE_MASK
#define PHASE_MASK 0x7ff
#endif
constexpr int NPHASE = 11;

__device__ __forceinline__ void grid_barrier(unsigned* counter, unsigned target) {
    __syncthreads();
    if (threadIdx.x == 0) {
        __builtin_amdgcn_fence(__ATOMIC_RELEASE, "agent");
        asm volatile("s_waitcnt vmcnt(0)" ::: "memory");
        __hip_atomic_fetch_add(counter, 1u, __ATOMIC_RELAXED, __HIP_MEMORY_SCOPE_AGENT);
        while (__hip_atomic_load(counter, __ATOMIC_RELAXED, __HIP_MEMORY_SCOPE_AGENT) < target) __builtin_amdgcn_s_sleep(2);
        __builtin_amdgcn_fence(__ATOMIC_ACQUIRE, "agent");
        asm volatile("s_waitcnt vmcnt(0)" ::: "memory");
    }
    __syncthreads();
}
#if FUSED
#ifndef PROBE_REPEAT_PHASE
#define PROBE_REPEAT_PHASE (-1)
#endif
__global__ void __launch_bounds__(NT, 2) mega_kernel(Params p) {
    cg::grid_group grid = cg::this_grid();
    unsigned nbar = 0;
#define RUN_PHASE(PH) do { int nrep_ = (PROBE_REPEAT_PHASE == (PH)) ? 2 : 1; asm volatile("" : "+s"(nrep_)); \
        for (int r_ = 0; r_ < nrep_; ++r_) { run_phase(p, (PH), dyn_smem, blockIdx.x, gridDim.x); \
            if ((PH) == 0 && r_ == 0) grid.sync();   \
            else if ((PH) + 1 < NPHASE || r_ + 1 < nrep_) { ++nbar; grid_barrier(p.bar, nbar * gridDim.x); } } } while (0)
    RUN_PHASE(0); RUN_PHASE(1); RUN_PHASE(2); RUN_PHASE(3); RUN_PHASE(4); RUN_PHASE(5); RUN_PHASE(6); RUN_PHASE(7); RUN_PHASE(8); RUN_PHASE(9); RUN_PHASE(10);
#undef RUN_PHASE
}
#else
template <int PH>
__global__ void __launch_bounds__(NT, 2) phase_kernel(Params p) { run_phase(p, PH, dyn_smem, blockIdx.x, gridDim.x); }
#endif

static inline char* carve(char*& cur, size_t bytes) { char* r = cur; cur += (bytes + 255) & ~(size_t)255; return r; }

extern "C" void kernel_launch(void* const* d_in, const int* in_sizes, int n_in, void* d_out, int out_size, void* d_ws, size_t ws_size, hipStream_t stream) {
    Params p{};
    p.x = (const float*)d_in[0]; p.c = (const float*)d_in[1]; p.ctx = (const float*)d_in[2]; p.c_ctx = (const float*)d_in[3];
    p.w_mod = (const float*)d_in[4]; p.b_mod = (const float*)d_in[5]; p.norm1_g = (const float*)d_in[6]; p.w_in = (const float*)d_in[7];
    p.conv_w = (const float*)d_in[8]; p.gate_b = (const float*)d_in[9]; p.ml_norm_g = (const float*)d_in[10]; p.lr_w2 = (const float*)d_in[11];
    p.alpha_b = (const float*)d_in[12]; p.gla_norm_g = (const float*)d_in[13]; p.w_out = (const float*)d_in[14]; p.norm2_g = (const float*)d_in[15];
    p.wq = (const float*)d_in[16]; p.keys = (const float*)d_in[17]; p.pu = (const float*)d_in[18]; p.pv = (const float*)d_in[19]; p.norm_f_g = (const float*)d_in[20];
    p.out = (float*)d_out;
    char* cur = (char*)d_ws;
    p.mod = (float*)carve(cur, (size_t)33 * 6144 * 4);
    p.winT = (bf16_t*)carve(cur, (size_t)PTP * 1024 * 2);
    p.woutT = (bf16_t*)carve(cur, (size_t)1024 * 1024 * 2);
    p.wqT = (bf16_t*)carve(cur, (size_t)2048 * 1024 * 2);
    p.keysb = (bf16_t*)carve(cur, (size_t)8 * 2 * 128 * 128 * 2);
    p.u8 = (unsigned char*)carve(cur, (size_t)16384 * 768);
    p.v8 = (unsigned char*)carve(cur, (size_t)16384 * 768);
    p.usc = (float*)carve(cur, (size_t)16384 * 4);
    p.vsc = (float*)carve(cur, (size_t)16384 * 4);
    p.hbuf = (bf16_t*)carve(cur, (size_t)TT * 1024 * 2);
    p.z = (bf16_t*)carve(cur, (size_t)TT * ZS * 2);
    p.zg = (float*)carve(cur, (size_t)TT * 48 * 4);
    p.mixh = (bf16_t*)carve(cur, (size_t)2 * TL * 1024 * 2);
    p.bar = (unsigned*)carve(cur, 256);
    p.qbuf = p.z;
    p.pidx = (int*)p.mixh;
    p.pgw = (float*)((char*)p.mixh + (size_t)TL * 128 * 4);
    p.ybuf = p.mixh + (size_t)TL * 1024;
    if ((size_t)(cur - (char*)d_ws) > ws_size) { fprintf(stderr, "workspace too small: need %zu have %zu\n", (size_t)(cur - (char*)d_ws), ws_size); return; }
#if FUSED
    static int grid_blocks = 0;
    if (!grid_blocks) {
        int dev = 0, cus = 0, per_cu = 0;
        hipGetDevice(&dev);
        hipDeviceGetAttribute(&cus, hipDeviceAttributeMultiprocessorCount, dev);
        hipFuncSetAttribute((const void*)mega_kernel, hipFuncAttributeMaxDynamicSharedMemorySize, SMEM_BYTES);
        hipOccupancyMaxActiveBlocksPerMultiprocessor(&per_cu, mega_kernel, NT, SMEM_BYTES);
        if (per_cu > 1) per_cu = 1;
        grid_blocks = cus * per_cu;
    }
    hipMemsetAsync(p.bar, 0, 256, stream);
    void* args[] = {&p};
    hipError_t e = hipLaunchCooperativeKernel((void*)mega_kernel, dim3(grid_blocks), dim3(NT), args, SMEM_BYTES, stream);
    if (e != hipSuccess) fprintf(stderr, "cooperative launch failed: %s (grid %d)\n", hipGetErrorString(e), grid_blocks);
#else
    const int G = 512;
#define LAUNCH(PH) do { hipFuncSetAttribute((const void*)phase_kernel<PH>, hipFuncAttributeMaxDynamicSharedMemorySize, SMEM_BYTES); \
        hipLaunchKernelGGL(phase_kernel<PH>, dim3(G), dim3(NT), SMEM_BYTES, stream, p); } while (0)
    LAUNCH(0); LAUNCH(1); LAUNCH(2); LAUNCH(3); LAUNCH(4); LAUNCH(5); LAUNCH(6); LAUNCH(7); LAUNCH(8); LAUNCH(9);
#endif
}
```

```cpp
#include <hip/hip_runtime.h>
#include <hip/hip_cooperative_groups.h>
#include <cstdio>
#include <cstdint>
namespace cg = cooperative_groups;

#ifndef FUSED
#define FUSED 1
#endif
#ifndef MIX_SAMEKIND
#define MIX_SAMEKIND 0
#endif
#ifndef ML_CHUNKED
#define ML_CHUNKED 1
#endif
#ifndef GLA_CHUNKED
#define GLA_CHUNKED 1
#endif

typedef unsigned short bf16_t;
typedef short bf16x8 __attribute__((ext_vector_type(8)));
typedef float f32x4 __attribute__((ext_vector_type(4)));
typedef unsigned u32x4 __attribute__((ext_vector_type(4)));

constexpr int D = 1024, NB = 32, SEQ = 2048, CTX = 256;
constexpr int TL = NB * SEQ;
constexpr int TC = NB * CTX;
constexpr int TT = TL + TC;
constexpr int PT = 3632;
constexpr int PTP = 3840;
constexpr int ZS = 3632;
constexpr int C_MLQ = 0, C_MLK = 512, C_MLV = 1024, C_MLO = 1536, C_MLG = 2048, C_GQ = 2064, C_GK = 2320, C_GV = 2576, C_GR = 3088, C_LR = 3600;
constexpr int NT = 512;
constexpr int SMEM_BYTES = 160 * 1024;
constexpr float EPS = 1e-6f;

struct Params {
    const float *x, *c, *ctx, *c_ctx, *w_mod, *b_mod, *norm1_g, *w_in, *conv_w, *gate_b, *ml_norm_g, *lr_w2, *alpha_b, *gla_norm_g,
        *w_out, *norm2_g, *wq, *keys, *pu, *pv, *norm_f_g;
    float* out;
    float* mod;
    bf16_t* winT;
    bf16_t* woutT;
    bf16_t* wqT;
    bf16_t* keysb;
    unsigned char* u8;
    unsigned char* v8;
    float* usc;
    float* vsc;
    bf16_t* hbuf;
    bf16_t* z;
    float* zg;
    bf16_t* mixh;
    bf16_t* qbuf;
    int* pidx;
    float* pgw;
    bf16_t* ybuf;
    unsigned* bar;
};

__device__ __forceinline__ int opaque_tid() { int t = threadIdx.x; asm volatile("" : "+v"(t)); return t; }
__device__ __forceinline__ float bf2f(bf16_t v) { return __uint_as_float(((unsigned)v) << 16); }
__device__ __forceinline__ bf16_t f2bf(float f) { unsigned u = __float_as_uint(f); u += 0x7fffu + ((u >> 16) & 1u); return (bf16_t)(u >> 16); }
__device__ __forceinline__ unsigned pack2(float a, float b) { return (unsigned)f2bf(a) | ((unsigned)f2bf(b) << 16); }
__device__ __forceinline__ float lo2f(unsigned w) { return __uint_as_float(w << 16); }
__device__ __forceinline__ float hi2f(unsigned w) { return __uint_as_float(w & 0xffff0000u); }
__device__ __forceinline__ float wave_sum(float v) {
#pragma unroll
    for (int o = 32; o > 0; o >>= 1) v += __shfl_xor(v, o);
    return v;
}
__device__ __forceinline__ float wave_max(float v) {
#pragma unroll
    for (int o = 32; o > 0; o >>= 1) v = fmaxf(v, __shfl_xor(v, o));
    return v;
}
template <int CTRL> __device__ __forceinline__ float dppx(float x) {
    return __uint_as_float(__builtin_amdgcn_update_dpp(0u, __float_as_uint(x), CTRL, 0xf, 0xf, false));
}
__device__ __forceinline__ float wave_max_fast(float x) {
    x = fmaxf(x, dppx<0x128>(x)); x = fmaxf(x, dppx<0x124>(x)); x = fmaxf(x, dppx<0x4E>(x)); x = fmaxf(x, dppx<0xB1>(x));
    auto s = __builtin_amdgcn_permlane16_swap(__float_as_uint(x), __float_as_uint(x), false, false);
    x = fmaxf(__uint_as_float(s[0]), __uint_as_float(s[1]));
    auto t = __builtin_amdgcn_permlane32_swap(__float_as_uint(x), __float_as_uint(x), false, false);
    return fmaxf(__uint_as_float(t[0]), __uint_as_float(t[1]));
}
__device__ __forceinline__ float wave_sum_fast(float x) {
    x += dppx<0x128>(x); x += dppx<0x124>(x); x += dppx<0x4E>(x); x += dppx<0xB1>(x);
    auto s = __builtin_amdgcn_permlane16_swap(__float_as_uint(x), __float_as_uint(x), false, false);
    x = __uint_as_float(s[0]) + __uint_as_float(s[1]);
    auto t = __builtin_amdgcn_permlane32_swap(__float_as_uint(x), __float_as_uint(x), false, false);
    return __uint_as_float(t[0]) + __uint_as_float(t[1]);
}
__device__ __forceinline__ float logsig(float x) { return fminf(x, 0.f) - __logf(1.f + __expf(-fabsf(x))); }
__device__ __forceinline__ float silu(float x) { return x / (1.f + __expf(-x)); }
__device__ __forceinline__ float sigm(float x) { return 1.f / (1.f + __expf(-x)); }

namespace pg8 {
#define PG8_LAS __attribute__((address_space(3)))
typedef unsigned short bf16_t;
typedef short bf16x8 __attribute__((ext_vector_type(8)));
typedef float f32x4 __attribute__((ext_vector_type(4)));
typedef unsigned u32x4 __attribute__((ext_vector_type(4)));
constexpr int BM = 256, BK = 64, HALF = 128, HTB = HALF * BK * 2  , STAGE_BYTES = 8 * HTB, NXCD = 8, WGM = 8;

__host__ __device__ __forceinline__ int lds_byte(int r, int c) { const int st = (r >> 4) * 2 + (c >> 5), rr = r & 15, cc = c & 31, ob = rr * 64 + cc * 2; return st * 1024 + (ob ^ (((ob >> 9) & 1) << 5)); }
__host__ __device__ __forceinline__ void stage_rc(int b, int& R, int& C) { const int st = b / 1024, sb = b % 1024, swz = sb ^ (((sb >> 9) & 1) << 5); R = (st >> 1) * 16 + swz / 64; C = (st & 1) * 32 + (swz % 64) / 2; }
__host__ __device__ __forceinline__ int perm32(int rho) { const int n = rho >> 4, i = rho & 15; return 8 * (i >> 2) + 4 * n + (i & 3); }

struct Unit { int pm, pn; };
struct Gemm { const bf16_t* A; const bf16_t* Bt; int M, N, K; };

struct StaticOrder {
    int nM, nN, nwg, G, c;
    __host__ __device__ void init(int M, int N, int G_, int c_) { nM = M / BM; nN = N / BM; nwg = nM * nN; G = G_; c = c_; }
    __host__ __device__ bool next(int i, Unit& u) const {
        const long L = (long)i * G + c; if (L >= nwg) return false;
        int wgid = (int)L; { const int q = nwg / NXCD, r = nwg % NXCD, xcd = wgid % NXCD, off = wgid / NXCD; wgid = (xcd < r ? xcd * (q + 1) : r * (q + 1) + (xcd - r) * q) + off; }
        const int nig = WGM * nN, gid = wgid / nig, fm = gid * WGM, gsz = (nM - fm) < WGM ? (nM - fm) : WGM;
        u.pm = fm + ((wgid % nig) % gsz); u.pn = (wgid % nig) / gsz; return true;
    }
    __device__ __forceinline__ void a_ready(const Unit&) const {}
    __device__ __forceinline__ void done(const Unit&) const {}
};
__device__ __forceinline__ unsigned cvt_pk_bf16(float lo, float hi) { unsigned r; asm volatile("v_cvt_pk_bf16_f32 %0, %1, %2" : "=v"(r) : "v"(lo), "v"(hi)); return r; }

template <class Epi, class Sched, bool STAMP = false>
__device__ __forceinline__ void gemm_phase(PG8_LAS unsigned char* lds, const Gemm g, const Sched& S, const Epi& E, unsigned long long* stamps) {
    const int tid = opaque_tid(), wid = __builtin_amdgcn_readfirstlane(tid >> 6), lane = tid & 63, wr = wid >> 2, wc = wid & 3, fr = lane & 15, fq = lane >> 4;
    const int K = g.K, nt = K / BK;
    int ts_lo = 0, ts_hi = 0, nts = 0; const unsigned long long rt_entry = STAMP ? (unsigned long long)wall_clock64() : 0ull;
#define PG8_STAMP() do { if (STAMP && wid == 0 && nts < 64) { const unsigned long long _c = (unsigned long long)clock64(); \
        ts_lo = (lane == nts) ? (int)(unsigned)_c : ts_lo; ts_hi = (lane == nts) ? (int)(unsigned)(_c >> 32) : ts_hi; ++nts; } } while (0)
    PG8_STAMP();
    unsigned voffA[2], voffB[2];
#pragma unroll
    for (int i = 0; i < 2; ++i) { int R, C; stage_rc(tid * 16 + i * 8192, R, C); const int Rb = Epi::PERM ? ((R & ~31) + perm32(R & 31)) : R;
        voffA[i] = (unsigned)(R * K + C) * 2u; voffB[i] = (unsigned)(Rb * K + C) * 2u; }
    const size_t kstep = (size_t)(BK * 2);
    const size_t hstep = (size_t)HALF * K * 2;
    const size_t tstep = 2 * hstep;
    const unsigned ldsw = (unsigned)wid * 1024u;
    const int aoff = lds_byte(wr * 64 + fr, fq * 8), boff = lds_byte(wc * 32 + fr, fq * 8);
#define PG8_SA(b, h) (((b) * 2 + (h)) * HTB)
#define PG8_SB(b, h) ((4 + (b) * 2 + (h)) * HTB)
#define PG8_STAGE(bufoff, gbase, voff) do { _Pragma("unroll") for (int _i = 0; _i < 2; ++_i) \
        __builtin_amdgcn_global_load_lds((const unsigned*)((const char*)(gbase) + (voff)[_i]), (PG8_LAS unsigned*)(lds + (bufoff) + ldsw + _i * 8192), 16, 0, 0); } while (0)
#define PG8_LDA(dst, b, h) do { _Pragma("unroll") for (int m = 0; m < 4; ++m) _Pragma("unroll") for (int k = 0; k < 2; ++k) dst[m][k] = *(const PG8_LAS bf16x8*)(lds + PG8_SA(b, h) + aoff + m * 2048 + k * 1024); } while (0)
#define PG8_LDB(dst, b, h) do { _Pragma("unroll") for (int n = 0; n < 2; ++n) _Pragma("unroll") for (int k = 0; k < 2; ++k) dst[n][k] = *(const PG8_LAS bf16x8*)(lds + PG8_SB(b, h) + boff + n * 2048 + k * 1024); } while (0)
#define PG8_MMA(ai, bj, At, Bt) do { __builtin_amdgcn_s_setprio(1); _Pragma("unroll") for (int m = 0; m < 4; ++m) _Pragma("unroll") for (int n = 0; n < 2; ++n) _Pragma("unroll") for (int k = 0; k < 2; ++k) \
        acc[ai][bj][m][n] = __builtin_amdgcn_mfma_f32_16x16x32_bf16(Bt[n][k], At[m][k], acc[ai][bj][m][n], 0, 0, 0); __builtin_amdgcn_s_setprio(0); } while (0)
#define PG8_WAIT_V(n) asm volatile("s_waitcnt vmcnt(" #n ")" ::: "memory")
#define PG8_WAIT_L(n) asm volatile("s_waitcnt lgkmcnt(" #n ")" ::: "memory")
#define PG8_BAR __builtin_amdgcn_s_barrier()
#define PG8_SCHED __builtin_amdgcn_sched_barrier(0)
    Unit cur, nxt; int ui = 0;
    if (!S.next(0, cur)) return;
    f32x4 acc[2][2][4][2];
#pragma unroll
    for (int a = 0; a < 2; ++a)
#pragma unroll
        for (int b = 0; b < 2; ++b)
#pragma unroll
            for (int m = 0; m < 4; ++m)
#pragma unroll
                for (int n = 0; n < 2; ++n) acc[a][b][m][n] = (f32x4){0.f, 0.f, 0.f, 0.f};
    bf16x8 At[4][2], B0[2][2], B1[2][2];
    const char* cA = (const char*)g.A + (size_t)cur.pm * tstep; const char* cB = (const char*)g.Bt + (size_t)cur.pn * tstep;
    S.a_ready(cur);
    PG8_STAGE(PG8_SB(0, 0), cB, voffB); PG8_STAGE(PG8_SA(0, 0), cA, voffA); PG8_STAGE(PG8_SB(0, 1), cB + hstep, voffB); PG8_STAGE(PG8_SA(0, 1), cA + hstep, voffA);
    if (wr == 1) PG8_BAR;
    PG8_WAIT_V(4); PG8_BAR;
    PG8_STAGE(PG8_SB(1, 0), cB + kstep, voffB); PG8_STAGE(PG8_SA(1, 0), cA + kstep, voffA); PG8_STAGE(PG8_SB(1, 1), cB + hstep + kstep, voffB);
    PG8_WAIT_V(6); PG8_BAR;
    PG8_STAMP();
    for (;;) {
        const bool has_next = S.next(ui + 1, nxt);
        const char* nA = has_next ? (const char*)g.A + (size_t)nxt.pm * tstep : cA; const char* nB = has_next ? (const char*)g.Bt + (size_t)nxt.pn * tstep : cB;
        for (int t = 0; t < nt; t += 2) {
            const bool last = (t == nt - 2);
            const char* a1 = cA + (size_t)(t + 1) * kstep;
            const char* a2 = last ? nA : cA + (size_t)(t + 2) * kstep; const char* b2 = last ? nB : cB + (size_t)(t + 2) * kstep;
            const char* a3 = a2 + kstep; const char* b3 = b2 + kstep;
            if (last && has_next) S.a_ready(nxt);
            PG8_LDB(B0, 0, 0); PG8_SCHED; PG8_LDA(At, 0, 0); PG8_STAGE(PG8_SA(1, 1), a1 + hstep, voffA);
            PG8_WAIT_L(8); PG8_BAR; PG8_WAIT_L(0); PG8_MMA(0, 0, At, B0); PG8_BAR; PG8_SCHED;
            PG8_LDB(B1, 0, 1); PG8_STAGE(PG8_SB(0, 0), b2, voffB);
            PG8_BAR; PG8_WAIT_L(0); PG8_MMA(0, 1, At, B1); PG8_BAR;
            PG8_LDA(At, 0, 1); PG8_STAGE(PG8_SA(0, 0), a2, voffA);
            PG8_BAR; PG8_WAIT_L(0); PG8_MMA(1, 0, At, B0); PG8_BAR; PG8_SCHED;
            PG8_STAGE(PG8_SB(0, 1), b2 + hstep, voffB);
            PG8_WAIT_V(6); PG8_BAR; PG8_MMA(1, 1, At, B1); PG8_BAR;
            PG8_LDB(B0, 1, 0); PG8_SCHED; PG8_LDA(At, 1, 0); PG8_STAGE(PG8_SA(0, 1), a2 + hstep, voffA);
            PG8_WAIT_L(8); PG8_BAR; PG8_WAIT_L(0); PG8_MMA(0, 0, At, B0); PG8_BAR; PG8_SCHED;
            PG8_LDB(B1, 1, 1); PG8_STAGE(PG8_SB(1, 0), b3, voffB);
            PG8_BAR; PG8_WAIT_L(0); PG8_MMA(0, 1, At, B1); PG8_BAR;
            PG8_LDA(At, 1, 1); PG8_STAGE(PG8_SA(1, 0), a3, voffA);
            PG8_BAR; PG8_WAIT_L(0); PG8_MMA(1, 0, At, B0); PG8_BAR; PG8_SCHED;
            PG8_STAGE(PG8_SB(1, 1), b3 + hstep, voffB);
            PG8_WAIT_V(6); PG8_BAR; PG8_MMA(1, 1, At, B1); PG8_BAR;
        }
        PG8_STAMP();
        if constexpr (!Epi::AFTER_DRAIN) { E(acc, cur, wr, wc, fr, fq); S.done(cur); }
        PG8_STAMP();
        if (!has_next) break;
#pragma unroll
        for (int a = 0; a < 2; ++a)
#pragma unroll
            for (int b = 0; b < 2; ++b)
#pragma unroll
                for (int m = 0; m < 4; ++m)
#pragma unroll
                    for (int n = 0; n < 2; ++n) acc[a][b][m][n] = (f32x4){0.f, 0.f, 0.f, 0.f};
        cur = nxt; cA = nA; cB = nB; ++ui;
    }
    PG8_WAIT_V(0);
    if (wr == 0) PG8_BAR;
    PG8_BAR;
    if constexpr (Epi::AFTER_DRAIN) { E.fused(acc, cur, wr, wc, fr, fq, lds, wid, lane); S.done(cur); }
    PG8_STAMP();
    if (STAMP && wid == 0) { stamps[lane] = lane < nts ? (((unsigned long long)(unsigned)ts_hi << 32) | (unsigned)ts_lo) : 0ull;
        if (lane == 62) stamps[62] = rt_entry; if (lane == 63) stamps[63] = (unsigned long long)wall_clock64(); }
#undef PG8_STAMP
#undef PG8_SA
#undef PG8_SB
#undef PG8_STAGE
#undef PG8_LDA
#undef PG8_LDB
#undef PG8_MMA
#undef PG8_WAIT_V
#undef PG8_WAIT_L
#undef PG8_BAR
#undef PG8_SCHED
}
}

__device__ void phase_mod(const Params& p, char* smem, int bid, int nblk) {
    const int tidx_ = opaque_tid();
    float* condL = (float*)smem;
    const int tid = tidx_, cl = tid & 63, ks = tid >> 6;
    for (int item = bid; item < 96; item += nblk) {
        const int col0 = item * 64, col = col0 + cl;
        float acc[33];
#pragma unroll
        for (int b = 0; b < 33; ++b) acc[b] = 0.f;
        for (int kc = 0; kc < 4; ++kc) {
            __syncthreads();
            for (int e = tid; e < 8 * 32 * 33; e += NT) {
                const int sl = e / (32 * 33), kk = (e / 33) % 32, b = e % 33;
                const int k = sl * 128 + kc * 32 + kk;
                const float cv = b < 32 ? p.c[b * 1024 + k] : p.c_ctx[k];
                condL[e] = silu(cv);
            }
            __syncthreads();
            for (int kk = 0; kk < 32; ++kk) {
                const int k = ks * 128 + kc * 32 + kk;
                const float w = p.w_mod[(size_t)k * 6144 + col];
                const float* cp = condL + (ks * 32 + kk) * 33;
#pragma unroll
                for (int b = 0; b < 33; ++b) acc[b] += w * cp[b];
            }
        }
        __syncthreads();
#pragma unroll
        for (int b = 0; b < 33; ++b) condL[(ks * 33 + b) * 64 + cl] = acc[b];
        __syncthreads();
        for (int e = tid; e < 33 * 64; e += NT) {
            const int b = e >> 6, cc = e & 63;
            float v = 0.f;
#pragma unroll
            for (int q = 0; q < 8; ++q) v += condL[(q * 33 + b) * 64 + cc];
            p.mod[b * 6144 + col0 + cc] = v + p.b_mod[col0 + cc];
        }
        __syncthreads();
    }
}

__device__ void convT(const float* __restrict__ src, int K, int N, int Npad, bf16_t* __restrict__ dst, char* smem, int bid, int nblk) {
    const int tidx_ = opaque_tid();
    float* tile = (float*)smem;
    const int tid = tidx_;
    const int nk = K / 64, nn = Npad / 64;
    for (int t = bid; t < nk * nn; t += nblk) {
        const int k0 = (t % nk) * 64, n0 = (t / nk) * 64;
        __syncthreads();
#pragma unroll
        for (int r = 0; r < 64 / (NT / 64); ++r) {
            const int k = r * (NT / 64) + (tid >> 6), n = tid & 63;
            tile[k * 65 + n] = (n0 + n < N) ? src[(size_t)(k0 + k) * N + n0 + n] : 0.f;
        }
        __syncthreads();
#pragma unroll
        for (int r = 0; r < 64 / (NT / 64); ++r) {
            const int n = r * (NT / 64) + (tid >> 6), k = tid & 63;
            dst[(size_t)(n0 + n) * K + k0 + k] = f2bf(tile[k * 65 + n]);
        }
    }
    __syncthreads();
}
__device__ void conv_copy(const float* __restrict__ src, bf16_t* __restrict__ dst, size_t n, int gtid, int gthreads) {
    const size_t n4 = n / 4;
    for (size_t i = gtid; i < n4; i += gthreads) {
        const float4 v = ((const float4*)src)[i];
        uint2 o; o.x = pack2(v.x, v.y); o.y = pack2(v.z, v.w);
        ((uint2*)dst)[i] = o;
    }
}
__device__ void phase_convert(const Params& p, char* smem, int bid, int nblk) {
    const int tidx_ = opaque_tid();
    convT(p.w_in, 1024, PT, PTP, p.winT, smem, bid, nblk);
    convT(p.w_out, 1024, 1024, 1024, p.woutT, smem, bid, nblk);
    convT(p.wq, 1024, 2048, 2048, p.wqT, smem, bid, nblk);
    const int gtid = bid * NT + tidx_, gth = nblk * NT;
    conv_copy(p.keys, p.keysb, (size_t)8 * 2 * 128 * 128, gtid, gth);
    {
        const int lane = tidx_ & 63;
        const int gw = bid * (NT / 64) + (tidx_ >> 6), nw = nblk * (NT / 64);
        for (int row = gw; row < 2 * 16384; row += nw) {
            const bool isv = row >= 16384;
            const int r = isv ? row - 16384 : row;
            const float* src = (isv ? p.pv : p.pu) + (size_t)r * 1024 + lane * 16;
            f32x4 v[4];
            float mx = 0.f;
#pragma unroll
            for (int q = 0; q < 4; ++q) { v[q] = *(const f32x4*)(src + 4 * q); mx = fmaxf(mx, fmaxf(fmaxf(fabsf(v[q][0]), fabsf(v[q][1])), fmaxf(fabsf(v[q][2]), fabsf(v[q][3])))); }
            mx = wave_max(mx);
            mx = fmaxf(mx, 1e-30f);
            const float sc = 7.5f / mx;
            unsigned c[16];
#pragma unroll
            for (int i = 0; i < 16; ++i) {
                const float x = v[i >> 2][i & 3] * sc, a = fabsf(x);
                const float code = a < 2.f ? rintf(a * 8.f) : (a < 4.f ? 8.f + rintf(a * 4.f) : 16.f + rintf(a * 2.f));
                unsigned ci = (unsigned)fminf(code, 31.f);
                c[i] = ci | (x < 0.f ? 32u : 0u);
            }
            unsigned long long lo = 0ull; unsigned hi = 0u;
#pragma unroll
            for (int i = 0; i < 10; ++i) lo |= (unsigned long long)c[i] << (6 * i);
            lo |= (unsigned long long)(c[10] & 0xfu) << 60;
            hi = c[10] >> 4;
#pragma unroll
            for (int i = 11; i < 16; ++i) hi |= c[i] << (2 + 6 * (i - 11));
            unsigned* dst = (unsigned*)((isv ? p.v8 : p.u8) + (size_t)r * 768 + lane * 12);
            dst[0] = (unsigned)lo; dst[1] = (unsigned)(lo >> 32); dst[2] = hi;
            if (lane == 0) (isv ? p.vsc : p.usc)[r] = mx * (1.f / 7.5f);
        }
    }
}

template <int R>
__device__ __forceinline__ void norm_rows(const float* __restrict__ srcbase, const float* __restrict__ src2, int nrows1, int nrows, const float* __restrict__ gvec,
                                          const float* __restrict__ mod, int sc_off, int sh_off, bf16_t* __restrict__ dst, int gw, int nw, int lane) {
    for (int row0 = gw; row0 < nrows; row0 += R * nw) {
        f32x4 v[R][4]; float ss[R];
#pragma unroll
        for (int r = 0; r < R; ++r) {
            const int row = min(row0 + r * nw, nrows - 1);
            const float* src = row < nrows1 ? srcbase + (size_t)row * D : src2 + (size_t)(row - nrows1) * D;
#pragma unroll
            for (int j = 0; j < 4; ++j) v[r][j] = *(const f32x4*)(src + j * 256 + lane * 4);
        }
#pragma unroll
        for (int r = 0; r < R; ++r) {
            float a = 0.f;
#pragma unroll
            for (int j = 0; j < 4; ++j) a += v[r][j][0] * v[r][j][0] + v[r][j][1] * v[r][j][1] + v[r][j][2] * v[r][j][2] + v[r][j][3] * v[r][j][3];
            ss[r] = a;
        }
#pragma unroll
        for (int r = 0; r < R; ++r) ss[r] = wave_sum_fast(ss[r]);
#pragma unroll
        for (int r = 0; r < R; ++r) {
            const int row = row0 + r * nw;
            if (row >= nrows) continue;
            const float rstd = rsqrtf(ss[r] * (1.f / 1024.f) + EPS);
            const float* md = mod + (row < TL ? (row >> 11) : 32) * 6144;
#pragma unroll
            for (int j = 0; j < 4; ++j) {
                const int col = j * 256 + lane * 4;
                const f32x4 g = *(const f32x4*)(gvec + col), sc = *(const f32x4*)(md + sc_off + col), sh = *(const f32x4*)(md + sh_off + col);
                uint2 o;
                o.x = pack2(v[r][j][0] * rstd * g[0] * (1.f + sc[0]) + sh[0], v[r][j][1] * rstd * g[1] * (1.f + sc[1]) + sh[1]);
                o.y = pack2(v[r][j][2] * rstd * g[2] * (1.f + sc[2]) + sh[2], v[r][j][3] * rstd * g[3] * (1.f + sc[3]) + sh[3]);
                *(uint2*)(dst + (size_t)row * D + col) = o;
            }
        }
    }
}
template <int R, bool WITH_Y>
__device__ __forceinline__ void norm_span(const float* __restrict__ src, const bf16_t* __restrict__ ysrc, const float* __restrict__ gvec, const float* __restrict__ md,
                                          int sc_off, int sh_off, bf16_t* __restrict__ dst, int nr, int lane) {
    float A[16], B[16], G1[16];
#pragma unroll
    for (int q = 0; q < 2; ++q)
#pragma unroll
        for (int hq = 0; hq < 2; ++hq) {
            const int col = q * 512 + lane * 8 + hq * 4;
            const f32x4 g = *(const f32x4*)(gvec + col), sc = *(const f32x4*)(md + sc_off + col), sh = *(const f32x4*)(md + sh_off + col);
            f32x4 g1 = (f32x4){0.f, 0.f, 0.f, 0.f};
            if (WITH_Y) g1 = *(const f32x4*)(md + 2048 + col);
#pragma unroll
            for (int k = 0; k < 4; ++k) { A[q * 8 + hq * 4 + k] = g[k] * (1.f + sc[k]); B[q * 8 + hq * 4 + k] = sh[k]; G1[q * 8 + hq * 4 + k] = g1[k]; }
        }
    for (int i0 = 0; i0 < nr; i0 += R) {
        f32x4 v[R][4]; u32x4 yv[R][2];
#pragma unroll
        for (int r = 0; r < R; ++r) {
            const float* sp = src + (size_t)(i0 + r) * D + lane * 8;
            v[r][0] = *(const f32x4*)sp; v[r][1] = *(const f32x4*)(sp + 4); v[r][2] = *(const f32x4*)(sp + 512); v[r][3] = *(const f32x4*)(sp + 516);
            if (WITH_Y) { const bf16_t* yp = ysrc + (size_t)(i0 + r) * D + lane * 8; yv[r][0] = *(const u32x4*)yp; yv[r][1] = *(const u32x4*)(yp + 512); }
        }
        float ss[R];
#pragma unroll
        for (int r = 0; r < R; ++r) {
            if (WITH_Y) {
#pragma unroll
                for (int q = 0; q < 2; ++q)
#pragma unroll
                    for (int k = 0; k < 4; ++k) {
                        v[r][2 * q + (k >> 1)][(k & 1) * 2] += G1[q * 8 + 2 * k] * lo2f(yv[r][q][k]);
                        v[r][2 * q + (k >> 1)][(k & 1) * 2 + 1] += G1[q * 8 + 2 * k + 1] * hi2f(yv[r][q][k]);
                    }
            }
            float a = 0.f;
#pragma unroll
            for (int j = 0; j < 4; ++j) a += v[r][j][0] * v[r][j][0] + v[r][j][1] * v[r][j][1] + v[r][j][2] * v[r][j][2] + v[r][j][3] * v[r][j][3];
            ss[r] = a;
        }
#pragma unroll
        for (int r = 0; r < R; ++r) ss[r] = wave_sum_fast(ss[r]);
#pragma unroll
        for (int r = 0; r < R; ++r) {
            const float rstd = rsqrtf(ss[r] * (1.f / 1024.f) + EPS);
#pragma unroll
            for (int q = 0; q < 2; ++q) {
                float o[8];
#pragma unroll
                for (int k = 0; k < 8; ++k) o[k] = v[r][2 * q + (k >> 2)][k & 3] * rstd * A[q * 8 + k] + B[q * 8 + k];
                *(u32x4*)(dst + (size_t)(i0 + r) * D + q * 512 + lane * 8) = (u32x4){pack2(o[0], o[1]), pack2(o[2], o[3]), pack2(o[4], o[5]), pack2(o[6], o[7])};
            }
        }
    }
}
__device__ void phase_norm1(const Params& p, int bid, int nblk) {
    const int tidx_ = opaque_tid();
    const int lane = tidx_ & 63, gw = bid * (NT / 64) + (tidx_ >> 6), nw = nblk * (NT / 64);
    for (int sp = gw; sp < TL / 32; sp += nw)
        norm_span<4, false>(p.x + (size_t)sp * 32 * D, nullptr, p.norm1_g, p.mod + (sp >> 6) * 6144, 1024, 0, p.hbuf + (size_t)sp * 32 * D, 32, lane);
    for (int sp = gw; sp < TC / 4; sp += nw)
        norm_span<4, false>(p.ctx + (size_t)sp * 4 * D, nullptr, p.norm1_g, p.mod + 32 * 6144, 1024, 0, p.hbuf + (size_t)(TL + sp * 4) * D, 4, lane);
}

template <int CL, int CR> __device__ __forceinline__ float dpp_nb(float oldv, float cur) {
    return __uint_as_float(__builtin_amdgcn_update_dpp(__float_as_uint(oldv), __float_as_uint(cur), CL, 0xf, 0xf, false));
}
struct EpiZ {
    static constexpr bool PERM = true, AFTER_DRAIN = false;
    bf16_t* z; float* zg; const float* gate_b; const float* conv_w;
    __device__ __forceinline__ void operator()(const f32x4 (&acc)[2][2][4][2], const pg8::Unit& u, int wr, int wc, int fr, int fq) const {
        const int row0 = u.pm * 256 + wr * 64 + fr, colb = u.pn * 256 + wc * 32 + 8 * fq;
        if (u.pn < 4 && u.pm * 256 < TL) {
#pragma unroll
            for (int bj = 0; bj < 2; ++bj) {
                const int col = colb + bj * 128;
                const float scl = col >= 512 ? 0.08838834764831845f : 1.f;
                f32x4 w0[2], w1[2], w2[2];
#pragma unroll
                for (int n = 0; n < 2; ++n) { w0[n] = *(const f32x4*)(conv_w + col + 4 * n); w1[n] = *(const f32x4*)(conv_w + 1024 + col + 4 * n); w2[n] = *(const f32x4*)(conv_w + 2048 + col + 4 * n); }
#pragma unroll
                for (int ai = 0; ai < 2; ++ai) {
                    f32x4 o[4][2];
#pragma unroll
                    for (int n = 0; n < 2; ++n)
#pragma unroll
                        for (int m = 0; m < 4; ++m)
#pragma unroll
                            for (int c = 0; c < 4; ++c) {
                                const float cur = acc[ai][bj][m][n][c];
                                const float oL = m > 0 ? __uint_as_float(__builtin_amdgcn_update_dpp(0u, __float_as_uint(acc[ai][bj][m > 0 ? m - 1 : 0][n][c]), 0x121, 0xf, 0xf, false)) : 0.f;
                                const float oR = m < 3 ? __uint_as_float(__builtin_amdgcn_update_dpp(0u, __float_as_uint(acc[ai][bj][m < 3 ? m + 1 : 3][n][c]), 0x12F, 0xf, 0xf, false)) : 0.f;
                                const float L = __uint_as_float(__builtin_amdgcn_update_dpp(__float_as_uint(oL), __float_as_uint(cur), 0x111, 0xf, 0xf, false));
                                const float R = __uint_as_float(__builtin_amdgcn_update_dpp(__float_as_uint(oR), __float_as_uint(cur), 0x101, 0xf, 0xf, false));
                                o[m][n][c] = silu(w0[n][c] * L + w1[n][c] * cur + w2[n][c] * R) * scl;
                            }
#pragma unroll
                    for (int m = 0; m < 4; ++m) {
                        const size_t row = (size_t)(row0 + ai * 128 + m * 16);
                        const f32x4 v0 = o[m][0], v1 = o[m][1];
                        u32x4 w; w.x = pg8::cvt_pk_bf16(v0[0], v0[1]); w.y = pg8::cvt_pk_bf16(v0[2], v0[3]); w.z = pg8::cvt_pk_bf16(v1[0], v1[1]); w.w = pg8::cvt_pk_bf16(v1[2], v1[3]);
                        *(u32x4*)(z + row * ZS + col) = w;
                    }
                }
            }
            return;
        }
#pragma unroll
        for (int bj = 0; bj < 2; ++bj) {
            const int col = colb + bj * 128;
            if (col >= PT) continue;
            const bool isg = (col >= C_MLG && col < C_GQ), isl = (col >= C_LR);
#pragma unroll
            for (int ai = 0; ai < 2; ++ai)
#pragma unroll
                for (int m = 0; m < 4; ++m) {
                    const size_t row = (size_t)(row0 + ai * 128 + m * 16);
                    const f32x4 v0 = acc[ai][bj][m][0], v1 = acc[ai][bj][m][1];
                    if (isg) {
                        float* dst = zg + row * 48 + (col - C_MLG);
                        *(f32x4*)dst = v0 + *(const f32x4*)(gate_b + (col - C_MLG));
                        *(f32x4*)(dst + 4) = v1 + *(const f32x4*)(gate_b + (col - C_MLG) + 4);
                    } else if (isl) {
                        float* dst = zg + row * 48 + 16 + (col - C_LR);
                        *(f32x4*)dst = v0; *(f32x4*)(dst + 4) = v1;
                    } else {
                        u32x4 w; w.x = pg8::cvt_pk_bf16(v0[0], v0[1]); w.y = pg8::cvt_pk_bf16(v0[2], v0[3]); w.z = pg8::cvt_pk_bf16(v1[0], v1[1]); w.w = pg8::cvt_pk_bf16(v1[2], v1[3]);
                        *(u32x4*)(z + row * ZS + col) = w;
                    }
                }
        }
    }
};
struct EpiX1 {
    static constexpr bool PERM = false, AFTER_DRAIN = false;
    const float* x; const float* mod; float* out;
    __device__ __forceinline__ void operator()(const f32x4 (&acc)[2][2][4][2], const pg8::Unit& u, int wr, int wc, int fr, int fq) const {
        const int row0 = u.pm * 256 + wr * 64 + fr, col0 = u.pn * 256 + wc * 32 + 4 * fq;
#pragma unroll
        for (int ai = 0; ai < 2; ++ai)
#pragma unroll
            for (int m = 0; m < 4; ++m) {
                const int row = row0 + ai * 128 + m * 16;
                const float* g1 = mod + (row >> 11) * 6144 + 2048;
#pragma unroll
                for (int bj = 0; bj < 2; ++bj)
#pragma unroll
                    for (int n = 0; n < 2; ++n) {
                        const int col = col0 + bj * 128 + n * 16;
                        const size_t o = (size_t)row * D + col;
                        *(f32x4*)(out + o) = *(const f32x4*)(x + o) + *(const f32x4*)(g1 + col) * acc[ai][bj][m][n];
                    }
            }
    }
};
struct EpiY {
    static constexpr bool PERM = true, AFTER_DRAIN = false;
    bf16_t* y;
    __device__ __forceinline__ void operator()(const f32x4 (&acc)[2][2][4][2], const pg8::Unit& u, int wr, int wc, int fr, int fq) const {
        const int row0 = u.pm * 256 + wr * 64 + fr, colb = u.pn * 256 + wc * 32 + 8 * fq;
#pragma unroll
        for (int ai = 0; ai < 2; ++ai)
#pragma unroll
            for (int m = 0; m < 4; ++m) {
                bf16_t* rowp = y + (size_t)(row0 + ai * 128 + m * 16) * 1024 + colb;
#pragma unroll
                for (int bj = 0; bj < 2; ++bj) {
                    const f32x4 v0 = acc[ai][bj][m][0], v1 = acc[ai][bj][m][1];
                    u32x4 w; w.x = pg8::cvt_pk_bf16(v0[0], v0[1]); w.y = pg8::cvt_pk_bf16(v0[2], v0[3]); w.z = pg8::cvt_pk_bf16(v1[0], v1[1]); w.w = pg8::cvt_pk_bf16(v1[2], v1[3]);
                    *(u32x4*)(rowp + bj * 128) = w;
                }
            }
    }
};
struct EpiQb {
    static constexpr bool PERM = true, AFTER_DRAIN = false;
    bf16_t* q;
    __device__ __forceinline__ void operator()(const f32x4 (&acc)[2][2][4][2], const pg8::Unit& u, int wr, int wc, int fr, int fq) const {
        const int row0 = u.pm * 256 + wr * 64 + fr, colb = u.pn * 256 + wc * 32 + 8 * fq;
#pragma unroll
        for (int ai = 0; ai < 2; ++ai)
#pragma unroll
            for (int m = 0; m < 4; ++m) {
                bf16_t* rowp = q + (size_t)(row0 + ai * 128 + m * 16) * 2048 + colb;
#pragma unroll
                for (int bj = 0; bj < 2; ++bj) {
                    const f32x4 v0 = acc[ai][bj][m][0], v1 = acc[ai][bj][m][1];
                    u32x4 w; w.x = pg8::cvt_pk_bf16(v0[0], v0[1]); w.y = pg8::cvt_pk_bf16(v0[2], v0[3]); w.z = pg8::cvt_pk_bf16(v1[0], v1[1]); w.w = pg8::cvt_pk_bf16(v1[2], v1[3]);
                    *(u32x4*)(rowp + bj * 128) = w;
                }
            }
    }
};
template <class Epi>
__device__ __forceinline__ void gemm_run(const bf16_t* A, const bf16_t* Bt, int M, int N, int K, const Epi& e, char* smem, int bid, int nblk) {
    pg8::Gemm g{A, Bt, M, N, K};
    pg8::StaticOrder S; S.init(M, N, nblk, bid);
    pg8::gemm_phase<Epi, pg8::StaticOrder, false>((PG8_LAS unsigned char*)smem, g, S, e, nullptr);
}

#define MFMA16(a, b, c) __builtin_amdgcn_mfma_f32_16x16x32_bf16((a), (b), (c), 0, 0, 0)
__device__ __forceinline__ void conv8(const Params& p, const bf16_t* zc, int col, bool vl, bool vr, float scl, float* y) {
    const u32x4 cc = *(const u32x4*)zc;
    u32x4 ll = (u32x4){0u, 0u, 0u, 0u}, rr = (u32x4){0u, 0u, 0u, 0u};
    if (vl) ll = *(const u32x4*)(zc - ZS);
    if (vr) rr = *(const u32x4*)(zc + ZS);
    const f32x4 w0a = *(const f32x4*)(p.conv_w + col), w0b = *(const f32x4*)(p.conv_w + col + 4);
    const f32x4 w1a = *(const f32x4*)(p.conv_w + 1024 + col), w1b = *(const f32x4*)(p.conv_w + 1024 + col + 4);
    const f32x4 w2a = *(const f32x4*)(p.conv_w + 2048 + col), w2b = *(const f32x4*)(p.conv_w + 2048 + col + 4);
    const float w0[8] = {w0a[0], w0a[1], w0a[2], w0a[3], w0b[0], w0b[1], w0b[2], w0b[3]};
    const float w1[8] = {w1a[0], w1a[1], w1a[2], w1a[3], w1b[0], w1b[1], w1b[2], w1b[3]};
    const float w2[8] = {w2a[0], w2a[1], w2a[2], w2a[3], w2b[0], w2b[1], w2b[2], w2b[3]};
#pragma unroll
    for (int j = 0; j < 4; ++j) {
        const float y0 = w0[2 * j] * lo2f(ll[j]) + w1[2 * j] * lo2f(cc[j]) + w2[2 * j] * lo2f(rr[j]);
        const float y1 = w0[2 * j + 1] * hi2f(ll[j]) + w1[2 * j + 1] * hi2f(cc[j]) + w2[2 * j + 1] * hi2f(rr[j]);
        y[2 * j] = silu(y0) * scl; y[2 * j + 1] = silu(y1) * scl;
    }
}

template <int LBASE>
__device__ void mlstm_item_chunked(const Params& p, char* smem0, int tid, int b, int h, int dir) {
    char* smem = smem0 + LBASE;
    bf16_t* Qs = (bf16_t*)smem;
    bf16_t* Ks = Qs + 32 * 136;
    bf16_t* Ktw = Ks + 32 * 136;
    bf16_t* Vt = Ktw + 128 * 40;
    bf16_t* Ps = Vt + 144 * 40;
    bf16_t* Cb = Ps + 32 * 40;
    float* sg = (float*)(Cb + 144 * 136);
    float* sM = sg + 32; float* sinter = sg + 64; float* sfloor = sg + 96; float* sw = sg + 128; float* smisc = sg + 160;
    const int lane = tid & 63, w = __builtin_amdgcn_readfirstlane(tid >> 6), lr = lane & 15, lq = lane >> 4;
    for (int i = tid; i < 16 * 40; i += 256) Vt[128 * 40 + i] = 0x3f80;
    for (int i = tid; i < 144 * 136 / 2; i += 256) ((unsigned*)Cb)[i] = 0u;
    f32x4 CT[2][9];
#pragma unroll
    for (int i = 0; i < 2; ++i)
#pragma unroll
        for (int j = 0; j < 9; ++j) CT[i][j] = (f32x4){0.f, 0.f, 0.f, 0.f};
    float m_s = 0.f;
    u32x4 kr[2], qr[2], vr[2]; float g_ig = 0.f, g_f = 0.f;
#define ML_PREFETCH(BT) do { \
        const int bt_ = (BT); const bool lat_ = bt_ >= 8; const int pos0_ = lat_ ? (bt_ - 8) * 32 : bt_ * 32; \
        const int nlo_ = dir ? (lat_ ? SEQ : CTX) - 32 - pos0_ : pos0_; const int rowbase_ = lat_ ? b * SEQ : TL + b * CTX; \
        const int l_ = tid & 31, c8_ = tid >> 5; const size_t row_ = (size_t)(rowbase_ + (dir ? nlo_ + 31 - l_ : nlo_ + l_)); \
        _Pragma("unroll") for (int r_ = 0; r_ < 2; ++r_) { const int ec_ = c8_ + 8 * r_; \
            kr[r_] = lat_ ? *(const u32x4*)(p.z + row_ * ZS + C_MLK + h * 128 + ec_ * 8) : *(const u32x4*)(p.hbuf + row_ * 1024 + 512 + h * 128 + ec_ * 8); \
            if (lat_) qr[r_] = *(const u32x4*)(p.z + row_ * ZS + C_MLQ + h * 128 + ec_ * 8); \
            vr[r_] = *(const u32x4*)(p.z + row_ * ZS + C_MLV + h * 128 + ec_ * 8); } \
        if (w == 0) { const int lg_ = lane & 31; const float* gp_ = p.zg + (size_t)(rowbase_ + (dir ? nlo_ + 31 - lg_ : nlo_ + lg_)) * 48 + dir * 8 + h; g_ig = gp_[0]; g_f = gp_[4]; } \
    } while (0)
    qr[0] = (u32x4){0u, 0u, 0u, 0u}; qr[1] = qr[0];
    ML_PREFETCH(0);
    __syncthreads();
    for (int bt = 0; bt < 72; ++bt) {
        const bool lat = bt >= 8;
        const int pos0 = lat ? (bt - 8) * 32 : bt * 32;
        const int seg = lat ? SEQ : CTX;
        const int nlo = dir ? seg - 32 - pos0 : pos0;
        const int rowbase = lat ? b * SEQ : TL + b * CTX;
        if (w == 0) {
            const int l = lane & 31;
            const float ig = g_ig, lf = logsig(g_f);
            float bsum = lf;
            bsum += __uint_as_float(__builtin_amdgcn_update_dpp(0u, __float_as_uint(bsum), 0x111, 0xf, 0xf, false));
            bsum += __uint_as_float(__builtin_amdgcn_update_dpp(0u, __float_as_uint(bsum), 0x112, 0xf, 0xf, false));
            bsum += __uint_as_float(__builtin_amdgcn_update_dpp(0u, __float_as_uint(bsum), 0x114, 0xf, 0xf, false));
            bsum += __uint_as_float(__builtin_amdgcn_update_dpp(0u, __float_as_uint(bsum), 0x118, 0xf, 0xf, false));
            { const float r0 = __int_as_float(__builtin_amdgcn_readlane(__float_as_int(bsum), 15)); if (lane & 16) bsum += r0; }
            const float g = ig - bsum;
            float cm = g;
            const unsigned NEGINF = 0xff800000u;
            cm = fmaxf(cm, __uint_as_float(__builtin_amdgcn_update_dpp(NEGINF, __float_as_uint(cm), 0x111, 0xf, 0xf, false)));
            cm = fmaxf(cm, __uint_as_float(__builtin_amdgcn_update_dpp(NEGINF, __float_as_uint(cm), 0x112, 0xf, 0xf, false)));
            cm = fmaxf(cm, __uint_as_float(__builtin_amdgcn_update_dpp(NEGINF, __float_as_uint(cm), 0x114, 0xf, 0xf, false)));
            cm = fmaxf(cm, __uint_as_float(__builtin_amdgcn_update_dpp(NEGINF, __float_as_uint(cm), 0x118, 0xf, 0xf, false)));
            { const float r0 = __int_as_float(__builtin_amdgcn_readlane(__float_as_int(cm), 15)); if (lane & 16) cm = fmaxf(cm, r0); }
            const float M = fmaxf(m_s, cm);
            const float Ml = __int_as_float(__builtin_amdgcn_readlane(__float_as_int(M), 31)), bl = __int_as_float(__builtin_amdgcn_readlane(__float_as_int(bsum), 31));
            if (lane < 32) {
                sg[l] = g; sM[l] = M; sinter[l] = __expf(m_s - M); sfloor[l] = __expf(-(bsum + M)); sw[l] = __expf(g - Ml);
                if (lane == 0) { smisc[0] = __expf(m_s - Ml); smisc[1] = bl + Ml; }
            }
        }
        __syncthreads();
        {
            const int l = tid & 31, c8 = tid >> 5;
            const float wl = sw[l];
#pragma unroll
            for (int r = 0; r < 2; ++r) {
                const int ec = c8 + 8 * r;
                *(u32x4*)(Ks + l * 136 + ec * 8) = kr[r];
#pragma unroll
                for (int j = 0; j < 4; ++j) { Ktw[(ec * 8 + 2 * j) * 40 + l] = f2bf(lo2f(kr[r][j]) * wl); Ktw[(ec * 8 + 2 * j + 1) * 40 + l] = f2bf(hi2f(kr[r][j]) * wl); }
                if (lat) *(u32x4*)(Qs + l * 136 + ec * 8) = qr[r];
#pragma unroll
                for (int j = 0; j < 4; ++j) { Vt[(ec * 8 + 2 * j) * 40 + l] = (bf16_t)(vr[r][j] & 0xffffu); Vt[(ec * 8 + 2 * j + 1) * 40 + l] = (bf16_t)(vr[r][j] >> 16); }
            }
        }
        __syncthreads();
        if (bt + 1 < 72) ML_PREFETCH(bt + 1);
        if (lat) {
            const int mi = w >> 1, ni = w & 1;
            f32x4 sa = (f32x4){0.f, 0.f, 0.f, 0.f};
            if (!(mi == 0 && ni == 1)) {
#pragma unroll
                for (int kk = 0; kk < 4; ++kk) {
                    const bf16x8 af = *(const bf16x8*)(Qs + (mi * 16 + lr) * 136 + kk * 32 + lq * 8);
                    const bf16x8 bf = *(const bf16x8*)(Ks + (ni * 16 + lr) * 136 + kk * 32 + lq * 8);
                    sa = MFMA16(af, bf, sa);
                }
            }
            const int sidx = ni * 16 + lr;
            const float gs = sg[sidx];
#pragma unroll
            for (int r = 0; r < 4; ++r) {
                const int t = mi * 16 + lq * 4 + r;
                const float pv = (sidx <= t) ? sa[r] * __expf(gs - sM[t]) : 0.f;
                Ps[t * 40 + sidx] = f2bf(pv);
            }
        }
        __syncthreads();
        if (lat) {
            const int nts[3] = {2 * w, 2 * w + 1, 8};
            f32x4 acc[2][3];
#pragma unroll
            for (int i = 0; i < 2; ++i)
#pragma unroll
                for (int j = 0; j < 3; ++j) acc[i][j] = (f32x4){0.f, 0.f, 0.f, 0.f};
#pragma unroll 1
            for (int kk = 0; kk < 4; ++kk) {
                bf16x8 af[2], bf[3];
#pragma unroll
                for (int i = 0; i < 2; ++i) af[i] = *(const bf16x8*)(Qs + (i * 16 + lr) * 136 + kk * 32 + lq * 8);
#pragma unroll
                for (int j = 0; j < 3; ++j) bf[j] = *(const bf16x8*)(Cb + (nts[j] * 16 + lr) * 136 + kk * 32 + lq * 8);
#pragma unroll
                for (int i = 0; i < 2; ++i)
#pragma unroll
                    for (int j = 0; j < 3; ++j) acc[i][j] = MFMA16(af[i], bf[j], acc[i][j]);
            }
#pragma unroll
            for (int i = 0; i < 2; ++i)
#pragma unroll
                for (int r = 0; r < 4; ++r) {
                    const float it = sinter[i * 16 + lq * 4 + r];
#pragma unroll
                    for (int j = 0; j < 3; ++j) acc[i][j][r] *= it;
                }
            {
                bf16x8 af[2], bf[3];
#pragma unroll
                for (int i = 0; i < 2; ++i) af[i] = *(const bf16x8*)(Ps + (i * 16 + lr) * 40 + lq * 8);
#pragma unroll
                for (int j = 0; j < 3; ++j) bf[j] = *(const bf16x8*)(Vt + (nts[j] * 16 + lr) * 40 + lq * 8);
#pragma unroll
                for (int i = 0; i < 2; ++i)
#pragma unroll
                    for (int j = 0; j < 3; ++j) acc[i][j] = MFMA16(af[i], bf[j], acc[i][j]);
            }
#pragma unroll
            for (int i = 0; i < 2; ++i)
#pragma unroll
                for (int r = 0; r < 4; ++r) {
                    const int t = i * 16 + lq * 4 + r;
                    const float dn = fmaxf(fabsf(acc[i][2][r]), sfloor[t]);
                    const float inv = 1.f / dn;
                    const int n = dir ? nlo + 31 - t : nlo + t;
                    bf16_t* orow = p.mixh + ((size_t)dir * TL + rowbase + n) * 1024 + h * 128;
#pragma unroll
                    for (int j = 0; j < 2; ++j) orow[nts[j] * 16 + lr] = f2bf(acc[i][j][r] * inv);
                }
        }
        __syncthreads();
        {
            const float a = smisc[0];
            bf16x8 af[2];
#pragma unroll
            for (int i = 0; i < 2; ++i) af[i] = *(const bf16x8*)(Ktw + ((2 * w + i) * 16 + lr) * 40 + lq * 8);
#pragma unroll
            for (int j = 0; j < 9; ++j) {
                const bf16x8 bf = *(const bf16x8*)(Vt + (j * 16 + lr) * 40 + lq * 8);
#pragma unroll
                for (int i = 0; i < 2; ++i) {
                    CT[i][j] = CT[i][j] * a;
                    CT[i][j] = MFMA16(af[i], bf, CT[i][j]);
                    uint2 pk; pk.x = pack2(CT[i][j][0], CT[i][j][1]); pk.y = pack2(CT[i][j][2], CT[i][j][3]);
                    *(uint2*)(Cb + (j * 16 + lr) * 136 + (2 * w + i) * 16 + lq * 4) = pk;
                }
            }
            m_s = smisc[1];
        }
        __syncthreads();
        __syncthreads();
    }
}
#undef ML_PREFETCH

template <int LBASE>
__device__ void gla_item_chunked(const Params& p, char* smem0, int tid, int b, int h, int dir) {
    char* smem = smem0 + LBASE;
    bf16_t* Qd = (bf16_t*)smem;
    bf16_t* Qb = Qd + 32 * 72;
    bf16_t* Kd = Qb + 32 * 72;
    bf16_t* Kwt = Kd + 32 * 72;
    bf16_t* Vt = Kwt + 64 * 40;
    bf16_t* Ps = Vt + 128 * 40;
    bf16_t* Sb = Ps + 32 * 40;
    float* bc = (float*)(Sb + 128 * 72);
    float* w2s = bc + 32 * 64;
    const int lane = tid & 63, w = __builtin_amdgcn_readfirstlane(tid >> 6), lr = lane & 15, lq = lane >> 4;
    for (int i = tid; i < 128 * 72 / 2; i += 256) ((unsigned*)Sb)[i] = 0u;
    for (int i = tid; i < 16 * 64; i += 256) w2s[i] = p.lr_w2[(dir * 16 + (i >> 6)) * 256 + h * 64 + (i & 63)];
    if (tid < 64) w2s[16 * 64 + tid] = p.alpha_b[dir * 256 + h * 64 + tid];
    f32x4 S[8];
#pragma unroll
    for (int j = 0; j < 8; ++j) S[j] = (f32x4){0.f, 0.f, 0.f, 0.f};
    u32x4 kr, qr, vr[2]; f32x4 lrr[4];
#define GLA_PREFETCH(BT) do { \
        const int bt_ = (BT); const bool lat_ = bt_ >= 8; const int pos0_ = lat_ ? (bt_ - 8) * 32 : bt_ * 32; \
        const int nlo_ = dir ? (lat_ ? SEQ : CTX) - 32 - pos0_ : pos0_; const int rowbase_ = lat_ ? b * SEQ : TL + b * CTX; \
        { const int l_ = tid & 31, dc_ = tid >> 5; const size_t row_ = (size_t)(rowbase_ + (dir ? nlo_ + 31 - l_ : nlo_ + l_)); \
          kr = *(const u32x4*)(p.z + row_ * ZS + C_GK + h * 64 + dc_ * 8); \
          if (lat_) qr = *(const u32x4*)(p.z + row_ * ZS + C_GQ + h * 64 + dc_ * 8); \
          vr[0] = *(const u32x4*)(p.z + row_ * ZS + C_GV + h * 128 + dc_ * 8); vr[1] = *(const u32x4*)(p.z + row_ * ZS + C_GV + h * 128 + (dc_ + 8) * 8); } \
        { const int l_ = tid >> 3; const float* lp_ = p.zg + (size_t)(rowbase_ + (dir ? nlo_ + 31 - l_ : nlo_ + l_)) * 48 + 16 + dir * 16; \
          _Pragma("unroll") for (int q_ = 0; q_ < 4; ++q_) lrr[q_] = *(const f32x4*)(lp_ + 4 * q_); } \
    } while (0)
    qr = (u32x4){0u, 0u, 0u, 0u};
    GLA_PREFETCH(0);
    __syncthreads();
    for (int bt = 0; bt < 72; ++bt) {
        const bool lat = bt >= 8;
        const int pos0 = lat ? (bt - 8) * 32 : bt * 32;
        const int seg = lat ? SEQ : CTX;
        const int nlo = dir ? seg - 32 - pos0 : pos0;
        const int rowbase = lat ? b * SEQ : TL + b * CTX;
        {
            const int l = tid >> 3, d0 = (tid & 7) * 8;
            float al[8];
#pragma unroll
            for (int j = 0; j < 8; ++j) al[j] = w2s[16 * 64 + d0 + j];
#pragma unroll
            for (int q = 0; q < 16; ++q) {
                const float lv = lrr[q >> 2][q & 3];
                const f32x4 wa = *(const f32x4*)(w2s + q * 64 + d0), wb = *(const f32x4*)(w2s + q * 64 + d0 + 4);
                al[0] += lv * wa[0]; al[1] += lv * wa[1]; al[2] += lv * wa[2]; al[3] += lv * wa[3];
                al[4] += lv * wb[0]; al[5] += lv * wb[1]; al[6] += lv * wb[2]; al[7] += lv * wb[3];
            }
#pragma unroll
            for (int j = 0; j < 8; ++j) bc[l * 64 + d0 + j] = logsig(al[j]) * (1.f / 16.f);
        }
        __syncthreads();
        if (tid < 64) {
            float cv[32];
#pragma unroll
            for (int l = 0; l < 32; ++l) cv[l] = bc[l * 64 + tid];
#pragma unroll
            for (int l = 1; l < 32; ++l) cv[l] += cv[l - 1];
#pragma unroll
            for (int l = 0; l < 32; ++l) bc[l * 64 + tid] = cv[l];
        }
        __syncthreads();
        {
            const int l = tid & 31, dc = tid >> 5;
            float bl[8], rf[8], be[8];
#pragma unroll
            for (int j = 0; j < 8; ++j) { bl[j] = bc[l * 64 + dc * 8 + j]; rf[j] = bc[16 * 64 + dc * 8 + j]; be[j] = bc[31 * 64 + dc * 8 + j]; }
            {
                float kf[8];
#pragma unroll
                for (int j = 0; j < 4; ++j) { kf[2 * j] = lo2f(kr[j]); kf[2 * j + 1] = hi2f(kr[j]); }
                float kd[8];
#pragma unroll
                for (int j = 0; j < 8; ++j) { kd[j] = kf[j] * __expf(rf[j] - bl[j]); Kwt[(dc * 8 + j) * 40 + l] = f2bf(kf[j] * __expf(be[j] - bl[j])); }
                *(u32x4*)(Kd + l * 72 + dc * 8) = (u32x4){pack2(kd[0], kd[1]), pack2(kd[2], kd[3]), pack2(kd[4], kd[5]), pack2(kd[6], kd[7])};
            }
            if (lat) {
                float qf[8];
#pragma unroll
                for (int j = 0; j < 4; ++j) { qf[2 * j] = lo2f(qr[j]) * 0.125f; qf[2 * j + 1] = hi2f(qr[j]) * 0.125f; }
                float qd[8], qb[8];
#pragma unroll
                for (int j = 0; j < 8; ++j) { qd[j] = qf[j] * __expf(bl[j] - rf[j]); qb[j] = qf[j] * __expf(bl[j]); }
                *(u32x4*)(Qd + l * 72 + dc * 8) = (u32x4){pack2(qd[0], qd[1]), pack2(qd[2], qd[3]), pack2(qd[4], qd[5]), pack2(qd[6], qd[7])};
                *(u32x4*)(Qb + l * 72 + dc * 8) = (u32x4){pack2(qb[0], qb[1]), pack2(qb[2], qb[3]), pack2(qb[4], qb[5]), pack2(qb[6], qb[7])};
            }
#pragma unroll
            for (int r = 0; r < 2; ++r) {
                const int ec = dc + 8 * r;
#pragma unroll
                for (int j = 0; j < 4; ++j) { Vt[(ec * 8 + 2 * j) * 40 + l] = (bf16_t)(vr[r][j] & 0xffffu); Vt[(ec * 8 + 2 * j + 1) * 40 + l] = (bf16_t)(vr[r][j] >> 16); }
            }
        }
        __syncthreads();
        if (bt + 1 < 72) GLA_PREFETCH(bt + 1);
        if (lat) {
            const int mi = w >> 1, ni = w & 1;
            f32x4 sa = (f32x4){0.f, 0.f, 0.f, 0.f};
            if (!(mi == 0 && ni == 1)) {
#pragma unroll
                for (int kk = 0; kk < 2; ++kk) {
                    const bf16x8 af = *(const bf16x8*)(Qd + (mi * 16 + lr) * 72 + kk * 32 + lq * 8);
                    const bf16x8 bf = *(const bf16x8*)(Kd + (ni * 16 + lr) * 72 + kk * 32 + lq * 8);
                    sa = MFMA16(af, bf, sa);
                }
            }
            const int sidx = ni * 16 + lr;
#pragma unroll
            for (int r = 0; r < 4; ++r) {
                const int t = mi * 16 + lq * 4 + r;
                Ps[t * 40 + sidx] = f2bf((sidx <= t) ? sa[r] : 0.f);
            }
        }
        __syncthreads();
        if (lat) {
            f32x4 acc[2][2];
#pragma unroll
            for (int i = 0; i < 2; ++i)
#pragma unroll
                for (int j = 0; j < 2; ++j) acc[i][j] = (f32x4){0.f, 0.f, 0.f, 0.f};
#pragma unroll
            for (int kk = 0; kk < 2; ++kk) {
                bf16x8 af[2], bf[2];
#pragma unroll
                for (int i = 0; i < 2; ++i) af[i] = *(const bf16x8*)(Qb + (i * 16 + lr) * 72 + kk * 32 + lq * 8);
#pragma unroll
                for (int j = 0; j < 2; ++j) bf[j] = *(const bf16x8*)(Sb + ((2 * w + j) * 16 + lr) * 72 + kk * 32 + lq * 8);
#pragma unroll
                for (int i = 0; i < 2; ++i)
#pragma unroll
                    for (int j = 0; j < 2; ++j) acc[i][j] = MFMA16(af[i], bf[j], acc[i][j]);
            }
            {
                bf16x8 af[2], bf[2];
#pragma unroll
                for (int i = 0; i < 2; ++i) af[i] = *(const bf16x8*)(Ps + (i * 16 + lr) * 40 + lq * 8);
#pragma unroll
                for (int j = 0; j < 2; ++j) bf[j] = *(const bf16x8*)(Vt + ((2 * w + j) * 16 + lr) * 40 + lq * 8);
#pragma unroll
                for (int i = 0; i < 2; ++i)
#pragma unroll
                    for (int j = 0; j < 2; ++j) acc[i][j] = MFMA16(af[i], bf[j], acc[i][j]);
            }
#pragma unroll
            for (int i = 0; i < 2; ++i)
#pragma unroll
                for (int r = 0; r < 4; ++r) {
                    const int t = i * 16 + lq * 4 + r;
                    const int n = dir ? nlo + 31 - t : nlo + t;
                    bf16_t* orow = p.mixh + ((size_t)dir * TL + rowbase + n) * 1024 + 512 + h * 128;
#pragma unroll
                    for (int j = 0; j < 2; ++j) orow[(2 * w + j) * 16 + lr] = f2bf(acc[i][j][r]);
                }
        }
        __syncthreads();
        {
            float rs[4];
#pragma unroll
            for (int r = 0; r < 4; ++r) rs[r] = __expf(bc[31 * 64 + w * 16 + lq * 4 + r]);
            const bf16x8 af = *(const bf16x8*)(Kwt + (w * 16 + lr) * 40 + lq * 8);
#pragma unroll
            for (int j = 0; j < 8; ++j) {
                const bf16x8 bf = *(const bf16x8*)(Vt + (j * 16 + lr) * 40 + lq * 8);
#pragma unroll
                for (int r = 0; r < 4; ++r) S[j][r] *= rs[r];
                S[j] = MFMA16(af, bf, S[j]);
                uint2 pk; pk.x = pack2(S[j][0], S[j][1]); pk.y = pack2(S[j][2], S[j][3]);
                *(uint2*)(Sb + (j * 16 + lr) * 72 + w * 16 + lq * 4) = pk;
            }
        }
        __syncthreads();
    }
}
#undef GLA_PREFETCH

__device__ void phase_mlprep(const Params& p, int bid, int nblk) {
    const int tidx_ = opaque_tid();
    const int lane = tidx_ & 63;
    const int gw = bid * (NT / 64) + (tidx_ >> 6), nw = nblk * (NT / 64);
    const int c0 = lane * 16;
    float w0[16], w1[16], w2[16];
#pragma unroll
    for (int j = 0; j < 16; ++j) { w0[j] = p.conv_w[c0 + j]; w1[j] = p.conv_w[1024 + c0 + j]; w2[j] = p.conv_w[2048 + c0 + j]; }
    const float scl = c0 >= 512 ? 0.08838834764831845f : 1.f;
    constexpr int R = 2;
    for (int row0 = TL + gw; row0 < TT; row0 += R * nw) {
        u32x4 cc[R][2], ll[R][2], rr[R][2];
#pragma unroll
        for (int r = 0; r < R; ++r) {
            const int row = min(row0 + r * nw, TT - 1);
            const bool lat = row < TL;
            const int n = lat ? (row & (SEQ - 1)) : ((row - TL) & (CTX - 1));
            const bool vl = lat ? ((n & 63) != 0) : (n != 0);
            const bool vr = lat ? ((n & 63) != 63) : (n != CTX - 1);
            const bf16_t* zc = p.z + (size_t)row * ZS + c0;
#pragma unroll
            for (int q = 0; q < 2; ++q) {
                cc[r][q] = *(const u32x4*)(zc + 8 * q);
                ll[r][q] = vl ? *(const u32x4*)(zc - ZS + 8 * q) : (u32x4){0u, 0u, 0u, 0u};
                rr[r][q] = vr ? *(const u32x4*)(zc + ZS + 8 * q) : (u32x4){0u, 0u, 0u, 0u};
            }
        }
#pragma unroll
        for (int r = 0; r < R; ++r) {
            const int row = row0 + r * nw;
            unsigned o[8];
#pragma unroll
            for (int q = 0; q < 2; ++q)
#pragma unroll
                for (int j = 0; j < 4; ++j) {
                    const int e = q * 8 + 2 * j;
                    const float y0 = w0[e] * lo2f(ll[r][q][j]) + w1[e] * lo2f(cc[r][q][j]) + w2[e] * lo2f(rr[r][q][j]);
                    const float y1 = w0[e + 1] * hi2f(ll[r][q][j]) + w1[e + 1] * hi2f(cc[r][q][j]) + w2[e + 1] * hi2f(rr[r][q][j]);
                    o[q * 4 + j] = pack2(silu(y0) * scl, silu(y1) * scl);
                }
            if (row < TT) {
                u32x4* dst = (u32x4*)(p.hbuf + (size_t)row * 1024 + c0);
                dst[0] = (u32x4){o[0], o[1], o[2], o[3]}; dst[1] = (u32x4){o[4], o[5], o[6], o[7]};
            }
        }
    }
}

__device__ void phase_mixers(const Params& p, char* smem, int bid, int nblk) {
    const int tidx_ = opaque_tid();
    const int sub = __builtin_amdgcn_readfirstlane(tidx_ >> 8), stid = tidx_ & 255;
#if MIX_SAMEKIND
    for (int pr = bid; pr < 256; pr += nblk) {
        const bool isml = pr < 128;
        const int it = ((pr & 127) << 1) + sub;
        const int b = it >> 3, h = (it >> 1) & 3, dir = it & 1;
        if (isml) { if (sub == 0) mlstm_item_chunked<0>(p, smem, stid, b, h, dir); else mlstm_item_chunked<81920>(p, smem, stid, b, h, dir); }
        else { if (sub == 0) gla_item_chunked<0>(p, smem, stid, b, h, dir); else gla_item_chunked<81920>(p, smem, stid, b, h, dir); }
        __syncthreads();
    }
#else
    for (int it = bid; it < 256; it += nblk) {
        const int b = it >> 3, h = (it >> 1) & 3, dir = it & 1;
        if (sub == 0) mlstm_item_chunked<0>(p, smem, stid, b, h, dir);
        else gla_item_chunked<81920>(p, smem, stid, b, h, dir);
        __syncthreads();
    }
#endif
}

__device__ void phase_mixprep(const Params& p, int bid, int nblk) {
    const int tidx_ = opaque_tid();
    const int lane = tidx_ & 63;
    const int gw = bid * (NT / 64) + (tidx_ >> 6), nw = nblk * (NT / 64);
    const int c0 = lane * 16;
    const float* gn = c0 < 512 ? p.ml_norm_g + c0 : p.gla_norm_g + (c0 - 512);
    float gnv[16];
#pragma unroll
    for (int j = 0; j < 16; ++j) gnv[j] = gn[j];
    constexpr int R = 4;
    for (int row0 = gw; row0 < TL; row0 += R * nw) {
        u32x4 u0[R][2], u1[R][2], ug[R][2];
#pragma unroll
        for (int r = 0; r < R; ++r) {
            const int row = min(row0 + r * nw, TL - 1);
            const u32x4* a0 = (const u32x4*)(p.mixh + (size_t)row * 1024 + c0);
            const u32x4* a1 = (const u32x4*)(p.mixh + ((size_t)TL + row) * 1024 + c0);
            const u32x4* gp = (const u32x4*)(p.z + (size_t)row * ZS + (c0 < 512 ? C_MLO + c0 : C_GR + (c0 - 512)));
#pragma unroll
            for (int q = 0; q < 2; ++q) { u0[r][q] = a0[q]; u1[r][q] = a1[q]; ug[r][q] = gp[q]; }
        }
#pragma unroll
        for (int r = 0; r < R; ++r) {
            const int row = row0 + r * nw;
            float sv[16], gt[16];
#pragma unroll
            for (int q = 0; q < 2; ++q)
#pragma unroll
                for (int j = 0; j < 4; ++j) {
                    sv[q * 8 + 2 * j] = lo2f(u0[r][q][j]) + lo2f(u1[r][q][j]); sv[q * 8 + 2 * j + 1] = hi2f(u0[r][q][j]) + hi2f(u1[r][q][j]);
                    gt[q * 8 + 2 * j] = lo2f(ug[r][q][j]); gt[q * 8 + 2 * j + 1] = hi2f(ug[r][q][j]);
                }
            float ss = 0.f;
#pragma unroll
            for (int j = 0; j < 16; ++j) ss += sv[j] * sv[j];
            ss += dppx<0xB1>(ss); ss += dppx<0x4E>(ss); ss += dppx<0x141>(ss);
            const float rstd = rsqrtf(ss * (1.f / 128.f) + EPS);
            unsigned o[8];
#pragma unroll
            for (int j = 0; j < 8; ++j) {
                float y0, y1;
                const float g0 = gt[2 * j], g1 = gt[2 * j + 1];
                if (c0 < 512) { y0 = sigm(g0); y1 = sigm(g1); } else { y0 = silu(g0); y1 = silu(g1); }
                y0 *= sv[2 * j] * rstd * gnv[2 * j]; y1 *= sv[2 * j + 1] * rstd * gnv[2 * j + 1];
                o[j] = pack2(y0, y1);
            }
            if (row < TL) {
                u32x4* dst = (u32x4*)(p.hbuf + (size_t)row * D + c0);
                dst[0] = (u32x4){o[0], o[1], o[2], o[3]}; dst[1] = (u32x4){o[4], o[5], o[6], o[7]};
            }
        }
    }
}

__device__ void phase_norm2(const Params& p, int bid, int nblk) {
    const int tidx_ = opaque_tid();
    const int lane = tidx_ & 63, gw = bid * (NT / 64) + (tidx_ >> 6), nw = nblk * (NT / 64);
    for (int sp = gw; sp < TL / 32; sp += nw)
        norm_span<4, true>(p.x + (size_t)sp * 32 * D, p.ybuf + (size_t)sp * 32 * D, p.norm2_g, p.mod + (sp >> 6) * 6144, 4096, 3072, p.hbuf + (size_t)sp * 32 * D, 32, lane);
}

__device__ __forceinline__ unsigned fkey(float f) { const unsigned u = __float_as_uint(f); return (u & 0x80000000u) ? ~u : (u | 0x80000000u); }
__device__ __forceinline__ int mbcnt64(unsigned long long m) { return __builtin_amdgcn_mbcnt_hi((unsigned)(m >> 32), __builtin_amdgcn_mbcnt_lo((unsigned)m, 0)); }
#define LDS_FENCE() asm volatile("s_waitcnt lgkmcnt(0)" ::: "memory")

template <int NV>
__device__ __forceinline__ void wave_top16(const float (&val)[NV], const int (&tag)[NV], float* outv, int* outt) {
    unsigned u[NV];
#pragma unroll
    for (int v = 0; v < NV; ++v) u[v] = fkey(val[v]);
    unsigned T = 0;
    for (int bit = 31; bit >= 0; --bit) {
        const unsigned cand = T | (1u << bit);
        int cnt = 0;
#pragma unroll
        for (int v = 0; v < NV; ++v) cnt += __popcll(__ballot(u[v] >= cand));
        if (cnt >= 16) T = cand;
    }
    int base = 0;
#pragma unroll
    for (int v = 0; v < NV; ++v) {
        const bool gt = u[v] > T;
        const unsigned long long mk = __ballot(gt);
        const int pos = base + mbcnt64(mk);
        if (gt) { outv[pos] = val[v]; outt[pos] = tag[v]; }
        base += __popcll(mk);
    }
#pragma unroll
    for (int v = 0; v < NV; ++v) {
        const bool eq = u[v] == T;
        const unsigned long long mk = __ballot(eq);
        const int pos = base + mbcnt64(mk);
        if (eq && pos < 16) { outv[pos] = val[v]; outt[pos] = tag[v]; }
        base += __popcll(mk);
    }
}

template <int NV>
__device__ __forceinline__ void wave_top16_bisect(const float (&val)[NV], const int (&tag)[NV], float* outv, int* outt) {
    float mx = val[0], mn = val[0];
#pragma unroll
    for (int v = 1; v < NV; ++v) { mx = fmaxf(mx, val[v]); mn = fminf(mn, val[v]); }
    float hi = wave_max_fast(mx), lo = -wave_max_fast(-mn);
    float mid = 0.f; bool ok = false;
    for (int it = 0; it < 40; ++it) {
        mid = 0.5f * (lo + hi);
        int cnt = 0;
#pragma unroll
        for (int v = 0; v < NV; ++v) cnt += __popcll(__ballot(val[v] > mid));
        if (cnt == 16) { ok = true; break; }
        if (cnt > 16) lo = mid; else hi = mid;
    }
    if (!ok) { wave_top16<NV>(val, tag, outv, outt); return; }
    int base = 0;
#pragma unroll
    for (int v = 0; v < NV; ++v) {
        const bool gt = val[v] > mid;
        const unsigned long long mk = __ballot(gt);
        const int pos = base + mbcnt64(mk);
        if (gt) { outv[pos] = val[v]; outt[pos] = tag[v]; }
        base += __popcll(mk);
    }
}

template <int CTRL> __device__ __forceinline__ unsigned dppu(unsigned x) { return __builtin_amdgcn_update_dpp(0u, x, CTRL, 0xf, 0xf, false); }
__device__ __forceinline__ unsigned row_max16u(unsigned x) { x = max(x, dppu<0x128>(x)); x = max(x, dppu<0x124>(x)); x = max(x, dppu<0x4E>(x)); return max(x, dppu<0xB1>(x)); }
__device__ __forceinline__ float row_max16(float x) { x = fmaxf(x, dppx<0x128>(x)); x = fmaxf(x, dppx<0x124>(x)); x = fmaxf(x, dppx<0x4E>(x)); return fmaxf(x, dppx<0xB1>(x)); }
__device__ __forceinline__ float row_sum16(float x) { x += dppx<0x128>(x); x += dppx<0x124>(x); x += dppx<0x4E>(x); return x + dppx<0xB1>(x); }
__device__ __forceinline__ unsigned key_of(float v, unsigned tag) { const unsigned b = (__float_as_uint(v) & 0xffffff00u) | tag; return (b & 0x80000000u) ? ~b : (b | 0x80000000u); }
__device__ __forceinline__ unsigned bits_of_key(unsigned k) { return (k & 0x80000000u) ? (k & 0x7fffffffu) : ~k; }
#define CE_DESC(i, j) do { const unsigned hi_ = max(u[i], u[j]), lo_ = min(u[i], u[j]); u[i] = hi_; u[j] = lo_; } while (0)
template <int N>
__device__ __forceinline__ unsigned tournament16(unsigned (&u)[N], int lr) {
    unsigned res = 0u;
#pragma unroll
    for (int k = 0; k < 16; ++k) {
        const unsigned m = row_max16u(u[0]);
        const bool wn = (u[0] == m);
        res = (lr == k) ? m : res;
#pragma unroll
        for (int i = 0; i < N - 1; ++i) u[i] = wn ? u[i + 1] : u[i];
        u[N - 1] = wn ? 0u : u[N - 1];
    }
    return res;
}

template <int N>
__device__ __forceinline__ void tournament16x2(unsigned (&ua)[N], unsigned (&ub)[N], int lr, unsigned& ra, unsigned& rb) {
    ra = 0u; rb = 0u;
#pragma unroll
    for (int k = 0; k < 16; ++k) {
        const unsigned ma = row_max16u(ua[0]), mb = row_max16u(ub[0]);
        const bool wa = (ua[0] == ma), wb = (ub[0] == mb);
        ra = (lr == k) ? ma : ra; rb = (lr == k) ? mb : rb;
#pragma unroll
        for (int i = 0; i < N - 1; ++i) { ua[i] = wa ? ua[i + 1] : ua[i]; ub[i] = wb ? ub[i + 1] : ub[i]; }
        ua[N - 1] = wa ? 0u : ua[N - 1]; ub[N - 1] = wb ? 0u : ub[N - 1];
    }
}
#define SORT8_DESC() do { CE_DESC(0, 1); CE_DESC(2, 3); CE_DESC(4, 5); CE_DESC(6, 7); CE_DESC(0, 2); CE_DESC(1, 3); CE_DESC(4, 6); CE_DESC(5, 7); CE_DESC(1, 2); CE_DESC(5, 6); \
        CE_DESC(0, 4); CE_DESC(1, 5); CE_DESC(2, 6); CE_DESC(3, 7); CE_DESC(2, 4); CE_DESC(3, 5); CE_DESC(1, 2); CE_DESC(3, 4); CE_DESC(5, 6); } while (0)

__device__ void phase_topk(const Params& p, char* smem, int bid, int nblk) {
    const int tidx_ = opaque_tid();
    const int tid = tidx_, lane = tid & 63, w = __builtin_amdgcn_readfirstlane(tid >> 6), lr = lane & 15, lq = lane >> 4;
    constexpr int SS = 260;
    constexpr int WS = 16 * SS + 512;
    float* sc = (float*)smem + w * WS;
    float* tv = sc + 16 * SS + lq * 64;
    int* ti = (int*)(tv + 32);
    for (int item = bid; item < (TL / (NT / 4)) * 8; item += nblk) {
        const int ph = item & 7, t0 = (item >> 3) * (NT / 4) + w * 16;
#pragma unroll
        for (int hh = 0; hh < 2; ++hh) {
            bf16x8 af[4];
#pragma unroll
            for (int kk = 0; kk < 4; ++kk) af[kk] = *(const bf16x8*)(p.qbuf + (size_t)(t0 + lr) * 2048 + ph * 256 + hh * 128 + kk * 32 + lq * 8);
            const bf16_t* kb = p.keysb + (size_t)((ph * 2 + hh) * 128 + lr) * 128 + lq * 8;
            f32x4 acc[8];
            bf16x8 b0[4], b1[4];
#pragma unroll
            for (int kk = 0; kk < 4; ++kk) b0[kk] = *(const bf16x8*)(kb + kk * 32);
#pragma unroll
            for (int n = 0; n < 8; n += 2) {
#pragma unroll
                for (int kk = 0; kk < 4; ++kk) b1[kk] = *(const bf16x8*)(kb + (n + 1) * 16 * 128 + kk * 32);
                acc[n] = (f32x4){0.f, 0.f, 0.f, 0.f};
#pragma unroll
                for (int kk = 0; kk < 4; ++kk) acc[n] = MFMA16(af[kk], b0[kk], acc[n]);
                if (n + 2 < 8) {
#pragma unroll
                    for (int kk = 0; kk < 4; ++kk) b0[kk] = *(const bf16x8*)(kb + (n + 2) * 16 * 128 + kk * 32);
                }
                acc[n + 1] = (f32x4){0.f, 0.f, 0.f, 0.f};
#pragma unroll
                for (int kk = 0; kk < 4; ++kk) acc[n + 1] = MFMA16(af[kk], b1[kk], acc[n + 1]);
            }
#pragma unroll
            for (int n = 0; n < 8; ++n)
#pragma unroll
                for (int r = 0; r < 4; ++r) sc[(lq * 4 + r) * SS + hh * 128 + n * 16 + lr] = acc[n][r];
        }
        LDS_FENCE();
        for (int ps2 = 0; ps2 < 2; ++ps2) {
            float a0[2];
#pragma unroll
            for (int pp = 0; pp < 2; ++pp) {
                const int tt = (ps2 * 2 + pp) * 4 + lq;
                float* tvp = tv + pp * 256; int* tip = ti + pp * 256;
                unsigned ua[8], ub[8];
#pragma unroll
                for (int j = 0; j < 8; ++j) { ua[j] = key_of(sc[tt * SS + lr + 16 * j], 255u - (unsigned)(lr + 16 * j)); ub[j] = key_of(sc[tt * SS + 128 + lr + 16 * j], 255u - (unsigned)(lr + 16 * j)); }
                { unsigned (&u)[8] = ua; SORT8_DESC(); }
                { unsigned (&u)[8] = ub; SORT8_DESC(); }
                unsigned ra, rb;
                tournament16x2<8>(ua, ub, lr, ra, rb);
                const unsigned ba = bits_of_key(ra), bb = bits_of_key(rb);
                a0[pp] = __uint_as_float(ba);
                tvp[lr] = __uint_as_float(ba); tip[lr] = 255 - (int)(ba & 0xffu);
                tvp[16 + lr] = __uint_as_float(bb); tip[16 + lr] = 255 - (int)(bb & 0xffu);
            }
            LDS_FENCE();
            unsigned ca[16], cb2[16];
#pragma unroll
            for (int pp = 0; pp < 2; ++pp) {
                const float* tvp = tv + pp * 256;
                const f32x4 b0 = *(const f32x4*)(tvp + 16), b1 = *(const f32x4*)(tvp + 20), b2 = *(const f32x4*)(tvp + 24), b3 = *(const f32x4*)(tvp + 28);
                const float bj[16] = {b0[0], b0[1], b0[2], b0[3], b1[0], b1[1], b1[2], b1[3], b2[0], b2[1], b2[2], b2[3], b3[0], b3[1], b3[2], b3[3]};
#pragma unroll
                for (int j = 0; j < 16; ++j) { const unsigned kx = key_of(a0[pp] + bj[j], 255u - (unsigned)(lr * 16 + j)); if (pp == 0) ca[j] = kx; else cb2[j] = kx; }
            }
            unsigned rca, rcb;
            tournament16x2<16>(ca, cb2, lr, rca, rcb);
#pragma unroll
            for (int pp = 0; pp < 2; ++pp) {
                const int t = t0 + (ps2 * 2 + pp) * 4 + lq;
                const int* tip = ti + pp * 256;
                const unsigned cb = bits_of_key(pp == 0 ? rca : rcb);
                const float sv = __uint_as_float(cb);
                const int tag = 255 - (int)(cb & 0xffu);
                const int idx = tip[tag >> 4] * 128 + tip[16 + (tag & 15)];
                const float mx = row_max16(sv);
                const float ev = __expf(sv - mx);
                const float sm = row_sum16(ev);
                p.pidx[(size_t)t * 128 + ph * 16 + lr] = idx;
                p.pgw[(size_t)t * 128 + ph * 16 + lr] = ev / sm;
            }
            LDS_FENCE();
        }
    }
    __syncthreads();
}

typedef float f32x2 __attribute__((ext_vector_type(2)));
template <int CTRL> __device__ __forceinline__ float dppf(float x) {
    return __uint_as_float(__builtin_amdgcn_update_dpp(0u, __float_as_uint(x), CTRL, 0xf, 0xf, false));
}
__device__ __forceinline__ float red4(float a, float b, float c, float d) {
    auto r = __builtin_amdgcn_permlane32_swap(__float_as_uint(a), __float_as_uint(b), false, false);
    const float ab = __uint_as_float(r[0]) + __uint_as_float(r[1]);
    auto q = __builtin_amdgcn_permlane32_swap(__float_as_uint(c), __float_as_uint(d), false, false);
    const float cd = __uint_as_float(q[0]) + __uint_as_float(q[1]);
    auto s = __builtin_amdgcn_permlane16_swap(__float_as_uint(ab), __float_as_uint(cd), false, false);
    float x = __uint_as_float(s[0]) + __uint_as_float(s[1]);
    x += dppf<0x128>(x); x += dppf<0x124>(x); x += dppf<0x4E>(x); x += dppf<0xB1>(x);
    return x;
}
typedef unsigned u32x3 __attribute__((ext_vector_type(3)));
typedef unsigned u32x6 __attribute__((ext_vector_type(6)));
typedef float f32x32 __attribute__((ext_vector_type(32)));
#ifndef GP
#define GP 8
#endif
struct GB { unsigned a[GP], b[GP], c[GP]; };
__device__ __forceinline__ f32x32 dec32(unsigned a0, unsigned a1, unsigned a2, unsigned b0, unsigned b1, unsigned b2) {
    const u32x6 sv = (u32x6){a0, a1, a2, b0, b1, b2};
    return __builtin_amdgcn_cvt_scalef32_pk32_f32_fp6(sv, 1.0f);
}
__device__ __forceinline__ void gloadN(GB& buf, const __amdgpu_buffer_rsrc_t tab, int idxreg, int j0, int lane) {
#pragma unroll
    for (int jj = 0; jj < GP; ++jj) {
        const int e = __builtin_amdgcn_readlane(idxreg, j0 + jj);
        const u32x3 t3 = __builtin_amdgcn_raw_buffer_load_b96(tab, lane * 12, e * 768, 0);
        buf.a[jj] = t3[0]; buf.b[jj] = t3[1]; buf.c[jj] = t3[2];
    }
}
__device__ __forceinline__ float gdotsN(const GB& buf, const float (&hv)[16], float d, int j0, int lane) {
    int di = __float_as_int(d);
    float chain = 0.f;
#pragma unroll
    for (int q = 0; q < GP / 4; ++q) {
        float pt[4];
#pragma unroll
        for (int h2 = 0; h2 < 2; ++h2) {
            const int jj = 4 * q + 2 * h2;
            unsigned w0 = buf.a[jj];
            asm volatile("" : "+v"(w0) : "v"(chain));
            const f32x32 f = dec32(w0, buf.b[jj], buf.c[jj], buf.a[jj + 1], buf.b[jj + 1], buf.c[jj + 1]);
            float a0 = 0.f, a1 = 0.f, c0 = 0.f, c1 = 0.f;
#pragma unroll
            for (int k = 0; k < 16; k += 2) { a0 += f[k] * hv[k]; a1 += f[k + 1] * hv[k + 1]; c0 += f[16 + k] * hv[k]; c1 += f[16 + k + 1] * hv[k + 1]; }
            pt[2 * h2] = a0 + a1; pt[2 * h2 + 1] = c0 + c1;
            chain = pt[2 * h2 + 1];
        }
        const float x0 = red4(pt[0], pt[1], pt[2], pt[3]);
        di = (lane == j0 + 4 * q + 0) ? __builtin_amdgcn_readlane(__float_as_int(x0), 0) : di;
        di = (lane == j0 + 4 * q + 1) ? __builtin_amdgcn_readlane(__float_as_int(x0), 32) : di;
        di = (lane == j0 + 4 * q + 2) ? __builtin_amdgcn_readlane(__float_as_int(x0), 16) : di;
        di = (lane == j0 + 4 * q + 3) ? __builtin_amdgcn_readlane(__float_as_int(x0), 48) : di;
    }
    return __int_as_float(di);
}
__device__ __forceinline__ void gaxpyN(const GB& buf, float coef, float (&acc)[16], int j0) {
#pragma unroll
    for (int jj = 0; jj < GP; jj += 2) {
        const float c0 = __int_as_float(__builtin_amdgcn_readlane(__float_as_int(coef), j0 + jj));
        const float c1 = __int_as_float(__builtin_amdgcn_readlane(__float_as_int(coef), j0 + jj + 1));
        unsigned w0 = buf.a[jj];
        asm volatile("" : "+v"(w0) : "v"(acc[15]));
        const f32x32 f = dec32(w0, buf.b[jj], buf.c[jj], buf.a[jj + 1], buf.b[jj + 1], buf.c[jj + 1]);
#pragma unroll
        for (int k = 0; k < 16; ++k) acc[k] += c0 * f[k] + c1 * f[16 + k];
    }
}
__device__ __forceinline__ float gather_dots(const __amdgpu_buffer_rsrc_t tab, int idxreg, const float (&hv)[16], int lane) {
    float d = 0.f;
    GB bufA, bufB;
    constexpr int NG = 64 / GP;
    gloadN(bufA, tab, idxreg, 0, lane);
#pragma unroll 1
    for (int g = 0; g < NG; g += 2) {
        gloadN(bufB, tab, idxreg, (g + 1) * GP, lane);
        d = gdotsN(bufA, hv, d, g * GP, lane);
        gloadN(bufA, tab, idxreg, ((g + 2) & (NG - 1)) * GP, lane);
        d = gdotsN(bufB, hv, d, (g + 1) * GP, lane);
    }
    return d;
}
__device__ __forceinline__ void gather_axpy(const __amdgpu_buffer_rsrc_t tab, int idxreg, float coef, float (&acc)[16], int lane) {
    GB bufA, bufB;
    constexpr int NG = 64 / GP;
    gloadN(bufA, tab, idxreg, 0, lane);
#pragma unroll 1
    for (int g = 0; g < NG; g += 2) {
        gloadN(bufB, tab, idxreg, (g + 1) * GP, lane);
        gaxpyN(bufA, coef, acc, g * GP);
        gloadN(bufA, tab, idxreg, ((g + 2) & (NG - 1)) * GP, lane);
        gaxpyN(bufB, coef, acc, (g + 1) * GP);
    }
}
__device__ __forceinline__ float gelu_exact(float x) { return 0.5f * x * (1.f + erff(x * 0.7071067811865476f)); }

__device__ void phase_gather(const Params& p, int bid, int nblk) {
    const int tidx_ = opaque_tid();
    const int lane = tidx_ & 63;
    const int gw = bid * (NT / 64) + (tidx_ >> 6), nw = nblk * (NT / 64);
    const __amdgpu_buffer_rsrc_t ursrc = __builtin_amdgcn_make_buffer_rsrc((void*)p.u8, (short)0, 16384 * 768, 0x00020000);
    const __amdgpu_buffer_rsrc_t vrsrc = __builtin_amdgcn_make_buffer_rsrc((void*)p.v8, (short)0, 16384 * 768, 0x00020000);
    for (int t = gw; t < TL; t += nw) {
        float hv[16];
        {
            const u32x4 h0 = *(const u32x4*)(p.hbuf + (size_t)t * D + lane * 16), h1 = *(const u32x4*)(p.hbuf + (size_t)t * D + lane * 16 + 8);
#pragma unroll
            for (int q = 0; q < 4; ++q) { hv[2 * q] = lo2f(h0[q]); hv[2 * q + 1] = hi2f(h0[q]); hv[8 + 2 * q] = lo2f(h1[q]); hv[8 + 2 * q + 1] = hi2f(h1[q]); }
        }
        const int ia = p.pidx[(size_t)t * 128 + lane], ib = p.pidx[(size_t)t * 128 + 64 + lane];
        const float ga = p.pgw[(size_t)t * 128 + lane], gb = p.pgw[(size_t)t * 128 + 64 + lane];
        const float usA = p.usc[ia], usB = p.usc[ib], vsA = p.vsc[ia], vsB = p.vsc[ib];
        const float dA = gather_dots(ursrc, ia, hv, lane);
        const float dB = gather_dots(ursrc, ib, hv, lane);
        const float cA = gelu_exact(dA * usA) * ga * vsA, cB = gelu_exact(dB * usB) * gb * vsB;
        float acc[16];
#pragma unroll
        for (int j = 0; j < 16; ++j) acc[j] = 0.f;
        gather_axpy(vrsrc, ia, cA, acc, lane);
        gather_axpy(vrsrc, ib, cB, acc, lane);
        float* orow = p.out + (size_t)t * D + lane * 16;
        const float* xrow = p.x + (size_t)t * D + lane * 16;
        const float* g1 = p.mod + (t >> 11) * 6144 + 2048 + lane * 16;
        const float* g2 = g1 + 3072;
        float yo[16];
        {
            const u32x4 y0 = *(const u32x4*)(p.ybuf + (size_t)t * D + lane * 16), y1 = *(const u32x4*)(p.ybuf + (size_t)t * D + lane * 16 + 8);
#pragma unroll
            for (int q = 0; q < 4; ++q) { yo[2 * q] = lo2f(y0[q]); yo[2 * q + 1] = hi2f(y0[q]); yo[8 + 2 * q] = lo2f(y1[q]); yo[8 + 2 * q + 1] = hi2f(y1[q]); }
        }
        float y[16]; float ss = 0.f;
#pragma unroll
        for (int q = 0; q < 4; ++q) {
            const f32x4 xv = *(const f32x4*)(xrow + 4 * q), gv = *(const f32x4*)(g2 + 4 * q), g1v = *(const f32x4*)(g1 + 4 * q);
#pragma unroll
            for (int k = 0; k < 4; ++k) { y[4 * q + k] = xv[k] + g1v[k] * yo[4 * q + k] + gv[k] * acc[4 * q + k]; ss += y[4 * q + k] * y[4 * q + k]; }
        }
        ss = wave_sum(ss);
        const float rstd = rsqrtf(ss * (1.f / 1024.f) + EPS);
#pragma unroll
        for (int q = 0; q < 4; ++q) {
            const f32x4 gf = *(const f32x4*)(p.norm_f_g + lane * 16 + 4 * q);
            *(f32x4*)(orow + 4 * q) = (f32x4){y[4 * q] * rstd * gf[0], y[4 * q + 1] * rstd * gf[1], y[4 * q + 2] * rstd * gf[2], y[4 * q + 3] * rstd * gf[3]};
        }
    }
}

extern __shared__ __attribute__((aligned(16))) char dyn_smem[];

__device__ __forceinline__ void run_phase(const Params& p, int ph, char* smem, int bid, int nblk) {
#ifdef ONLY_PHASE
    if (ph != ONLY_PHASE) return;
#endif
    switch (ph) {
        case 0: phase_mod(p, smem, bid, nblk); phase_convert(p, smem, bid, nblk); break;
        case 1: phase_norm1(p, bid, nblk); break;
        case 2: { EpiZ e{p.z, p.zg, p.gate_b, p.conv_w}; gemm_run(p.hbuf, p.winT, TT, PTP, 1024, e, smem, bid, nblk); } break;
        case 3: phase_mlprep(p, bid, nblk); break;
        case 4: phase_mixers(p, smem, bid, nblk); break;
        case 5: phase_mixprep(p, bid, nblk); break;
        case 6: { EpiY e{p.ybuf}; gemm_run(p.hbuf, p.woutT, TL, 1024, 1024, e, smem, bid, nblk); } break;
        case 7: phase_norm2(p, bid, nblk); break;
        case 8: { EpiQb e{p.qbuf}; gemm_run(p.hbuf, p.wqT, TL, 2048, 1024, e, smem, bid, nblk); } break;
        case 9: phase_topk(p, smem, bid, nblk); break;
        case 10: phase_gather(p, bid, nblk); break;
    }
}
#ifndef PHASE_MASK
#define PHASE_MASK 0x7ff
#endif
constexpr int NPHASE = 11;

__device__ __forceinline__ void grid_barrier(unsigned* counter, unsigned target) {
    __syncthreads();
    if (threadIdx.x == 0) {
        __builtin_amdgcn_fence(__ATOMIC_RELEASE, "agent");
        asm volatile("s_waitcnt vmcnt(0)" ::: "memory");
        __hip_atomic_fetch_add(counter, 1u, __ATOMIC_RELAXED, __HIP_MEMORY_SCOPE_AGENT);
        while (__hip_atomic_load(counter, __ATOMIC_RELAXED, __HIP_MEMORY_SCOPE_AGENT) < target) __builtin_amdgcn_s_sleep(2);
        __builtin_amdgcn_fence(__ATOMIC_ACQUIRE, "agent");
        asm volatile("s_waitcnt vmcnt(0)" ::: "memory");
    }
    __syncthreads();
}
#if FUSED
#ifndef PROBE_REPEAT_PHASE
#define PROBE_REPEAT_PHASE (-1)
#endif
__global__ void __launch_bounds__(NT, 2) mega_kernel(Params p) {
    cg::grid_group grid = cg::this_grid();
    unsigned nbar = 0;
#define RUN_PHASE(PH) do { int nrep_ = (PROBE_REPEAT_PHASE == (PH)) ? 2 : 1; asm volatile("" : "+s"(nrep_)); \
        for (int r_ = 0; r_ < nrep_; ++r_) { run_phase(p, (PH), dyn_smem, blockIdx.x, gridDim.x); \
            if ((PH) == 0 && r_ == 0) grid.sync();   \
            else if ((PH) + 1 < NPHASE || r_ + 1 < nrep_) { ++nbar; grid_barrier(p.bar, nbar * gridDim.x); } } } while (0)
    RUN_PHASE(0); RUN_PHASE(1); RUN_PHASE(2); RUN_PHASE(3); RUN_PHASE(4); RUN_PHASE(5); RUN_PHASE(6); RUN_PHASE(7); RUN_PHASE(8); RUN_PHASE(9); RUN_PHASE(10);
#undef RUN_PHASE
}
#else
template <int PH>
__global__ void __launch_bounds__(NT, 2) phase_kernel(Params p) { run_phase(p, PH, dyn_smem, blockIdx.x, gridDim.x); }
#endif

static inline char* carve(char*& cur, size_t bytes) { char* r = cur; cur += (bytes + 255) & ~(size_t)255; return r; }

extern "C" void kernel_launch(void* const* d_in, const int* in_sizes, int n_in, void* d_out, int out_size, void* d_ws, size_t ws_size, hipStream_t stream) {
    Params p{};
    p.x = (const float*)d_in[0]; p.c = (const float*)d_in[1]; p.ctx = (const float*)d_in[2]; p.c_ctx = (const float*)d_in[3];
    p.w_mod = (const float*)d_in[4]; p.b_mod = (const float*)d_in[5]; p.norm1_g = (const float*)d_in[6]; p.w_in = (const float*)d_in[7];
    p.conv_w = (const float*)d_in[8]; p.gate_b = (const float*)d_in[9]; p.ml_norm_g = (const float*)d_in[10]; p.lr_w2 = (const float*)d_in[11];
    p.alpha_b = (const float*)d_in[12]; p.gla_norm_g = (const float*)d_in[13]; p.w_out = (const float*)d_in[14]; p.norm2_g = (const float*)d_in[15];
    p.wq = (const float*)d_in[16]; p.keys = (const float*)d_in[17]; p.pu = (const float*)d_in[18]; p.pv = (const float*)d_in[19]; p.norm_f_g = (const float*)d_in[20];
    p.out = (float*)d_out;
    char* cur = (char*)d_ws;
    p.mod = (float*)carve(cur, (size_t)33 * 6144 * 4);
    p.winT = (bf16_t*)carve(cur, (size_t)PTP * 1024 * 2);
    p.woutT = (bf16_t*)carve(cur, (size_t)1024 * 1024 * 2);
    p.wqT = (bf16_t*)carve(cur, (size_t)2048 * 1024 * 2);
    p.keysb = (bf16_t*)carve(cur, (size_t)8 * 2 * 128 * 128 * 2);
    p.u8 = (unsigned char*)carve(cur, (size_t)16384 * 768);
    p.v8 = (unsigned char*)carve(cur, (size_t)16384 * 768);
    p.usc = (float*)carve(cur, (size_t)16384 * 4);
    p.vsc = (float*)carve(cur, (size_t)16384 * 4);
    p.hbuf = (bf16_t*)carve(cur, (size_t)TT * 1024 * 2);
    p.z = (bf16_t*)carve(cur, (size_t)TT * ZS * 2);
    p.zg = (float*)carve(cur, (size_t)TT * 48 * 4);
    p.mixh = (bf16_t*)carve(cur, (size_t)2 * TL * 1024 * 2);
    p.bar = (unsigned*)carve(cur, 256);
    p.qbuf = p.z;
    p.pidx = (int*)p.mixh;
    p.pgw = (float*)((char*)p.mixh + (size_t)TL * 128 * 4);
    p.ybuf = p.mixh + (size_t)TL * 1024;
    if ((size_t)(cur - (char*)d_ws) > ws_size) { fprintf(stderr, "workspace too small: need %zu have %zu\n", (size_t)(cur - (char*)d_ws), ws_size); return; }
#if FUSED
    static int grid_blocks = 0;
    if (!grid_blocks) {
        int dev = 0, cus = 0, per_cu = 0;
        hipGetDevice(&dev);
        hipDeviceGetAttribute(&cus, hipDeviceAttributeMultiprocessorCount, dev);
        hipFuncSetAttribute((const void*)mega_kernel, hipFuncAttributeMaxDynamicSharedMemorySize, SMEM_BYTES);
        hipOccupancyMaxActiveBlocksPerMultiprocessor(&per_cu, mega_kernel, NT, SMEM_BYTES);
        if (per_cu > 1) per_cu = 1;
        grid_blocks = cus * per_cu;
    }
    hipMemsetAsync(p.bar, 0, 256, stream);
    void* args[] = {&p};
    hipError_t e = hipLaunchCooperativeKernel((void*)mega_kernel, dim3(grid_blocks), dim3(NT), args, SMEM_BYTES, stream);
    if (e != hipSuccess) fprintf(stderr, "cooperative launch failed: %s (grid %d)\n", hipGetErrorString(e), grid_blocks);
#else
    const int G = 512;
#define LAUNCH(PH) do { hipFuncSetAttribute((const void*)phase_kernel<PH>, hipFuncAttributeMaxDynamicSharedMemorySize, SMEM_BYTES); \
        hipLaunchKernelGGL(phase_kernel<PH>, dim3(G), dim3(NT), SMEM_BYTES, stream, p); } while (0)
    LAUNCH(0); LAUNCH(1); LAUNCH(2); LAUNCH(3); LAUNCH(4); LAUNCH(5); LAUNCH(6); LAUNCH(7); LAUNCH(8); LAUNCH(9);
#endif
}
```

```cpp
#include <hip/hip_runtime.h>
#include <hip/hip_cooperative_groups.h>
#include <cstdio>
#include <cstdint>
namespace cg = cooperative_groups;

#ifndef FUSED
#define FUSED 1
#endif
#ifndef MIX_SAMEKIND
#define MIX_SAMEKIND 0
#endif
#ifndef ML_CHUNKED
#define ML_CHUNKED 1
#endif
#ifndef GLA_CHUNKED
#define GLA_CHUNKED 1
#endif

typedef unsigned short bf16_t;
typedef short bf16x8 __attribute__((ext_vector_type(8)));
typedef float f32x4 __attribute__((ext_vector_type(4)));
typedef unsigned u32x4 __attribute__((ext_vector_type(4)));

constexpr int D = 1024, NB = 32, SEQ = 2048, CTX = 256;
constexpr int TL = NB * SEQ;
constexpr int TC = NB * CTX;
constexpr int TT = TL + TC;
constexpr int PT = 3632;
constexpr int PTP = 3840;
constexpr int ZS = 3632;
constexpr int C_MLQ = 0, C_MLK = 512, C_MLV = 1024, C_MLO = 1536, C_MLG = 2048, C_GQ = 2064, C_GK = 2320, C_GV = 2576, C_GR = 3088, C_LR = 3600;
constexpr int NT = 512;
constexpr int SMEM_BYTES = 160 * 1024;
constexpr float EPS = 1e-6f;

struct Params {
    const float *x, *c, *ctx, *c_ctx, *w_mod, *b_mod, *norm1_g, *w_in, *conv_w, *gate_b, *ml_norm_g, *lr_w2, *alpha_b, *gla_norm_g,
        *w_out, *norm2_g, *wq, *keys, *pu, *pv, *norm_f_g;
    float* out;
    float* mod;
    bf16_t* winT;
    bf16_t* woutT;
    bf16_t* wqT;
    bf16_t* keysb;
    unsigned char* u8;
    unsigned char* v8;
    float* usc;
    float* vsc;
    bf16_t* hbuf;
    bf16_t* z;
    float* zg;
    bf16_t* mixh;
    bf16_t* qbuf;
    int* pidx;
    float* pgw;
    bf16_t* ybuf;
    unsigned* bar;
};

__device__ __forceinline__ int opaque_tid() { int t = threadIdx.x; asm volatile("" : "+v"(t)); return t; }
__device__ __forceinline__ float bf2f(bf16_t v) { return __uint_as_float(((unsigned)v) << 16); }
__device__ __forceinline__ bf16_t f2bf(float f) { unsigned u = __float_as_uint(f); u += 0x7fffu + ((u >> 16) & 1u); return (bf16_t)(u >> 16); }
__device__ __forceinline__ unsigned pack2(float a, float b) { return (unsigned)f2bf(a) | ((unsigned)f2bf(b) << 16); }
__device__ __forceinline__ float lo2f(unsigned w) { return __uint_as_float(w << 16); }
__device__ __forceinline__ float hi2f(unsigned w) { return __uint_as_float(w & 0xffff0000u); }
__device__ __forceinline__ float wave_sum(float v) {
#pragma unroll
    for (int o = 32; o > 0; o >>= 1) v += __shfl_xor(v, o);
    return v;
}
__device__ __forceinline__ float wave_max(float v) {
#pragma unroll
    for (int o = 32; o > 0; o >>= 1) v = fmaxf(v, __shfl_xor(v, o));
    return v;
}
template <int CTRL> __device__ __forceinline__ float dppx(float x) {
    return __uint_as_float(__builtin_amdgcn_update_dpp(0u, __float_as_uint(x), CTRL, 0xf, 0xf, false));
}
__device__ __forceinline__ float wave_max_fast(float x) {
    x = fmaxf(x, dppx<0x128>(x)); x = fmaxf(x, dppx<0x124>(x)); x = fmaxf(x, dppx<0x4E>(x)); x = fmaxf(x, dppx<0xB1>(x));
    auto s = __builtin_amdgcn_permlane16_swap(__float_as_uint(x), __float_as_uint(x), false, false);
    x = fmaxf(__uint_as_float(s[0]), __uint_as_float(s[1]));
    auto t = __builtin_amdgcn_permlane32_swap(__float_as_uint(x), __float_as_uint(x), false, false);
    return fmaxf(__uint_as_float(t[0]), __uint_as_float(t[1]));
}
__device__ __forceinline__ float wave_sum_fast(float x) {
    x += dppx<0x128>(x); x += dppx<0x124>(x); x += dppx<0x4E>(x); x += dppx<0xB1>(x);
    auto s = __builtin_amdgcn_permlane16_swap(__float_as_uint(x), __float_as_uint(x), false, false);
    x = __uint_as_float(s[0]) + __uint_as_float(s[1]);
    auto t = __builtin_amdgcn_permlane32_swap(__float_as_uint(x), __float_as_uint(x), false, false);
    return __uint_as_float(t[0]) + __uint_as_float(t[1]);
}
__device__ __forceinline__ float logsig(float x) { return fminf(x, 0.f) - __logf(1.f + __expf(-fabsf(x))); }
__device__ __forceinline__ float silu(float x) { return x / (1.f + __expf(-x)); }
__device__ __forceinline__ float sigm(float x) { return 1.f / (1.f + __expf(-x)); }

namespace pg8 {
#define PG8_LAS __attribute__((address_space(3)))
typedef unsigned short bf16_t;
typedef short bf16x8 __attribute__((ext_vector_type(8)));
typedef float f32x4 __attribute__((ext_vector_type(4)));
typedef unsigned u32x4 __attribute__((ext_vector_type(4)));
constexpr int BM = 256, BK = 64, HALF = 128, HTB = HALF * BK * 2  , STAGE_BYTES = 8 * HTB, NXCD = 8, WGM = 8;

__host__ __device__ __forceinline__ int lds_byte(int r, int c) { const int st = (r >> 4) * 2 + (c >> 5), rr = r & 15, cc = c & 31, ob = rr * 64 + cc * 2; return st * 1024 + (ob ^ (((ob >> 9) & 1) << 5)); }
__host__ __device__ __forceinline__ void stage_rc(int b, int& R, int& C) { const int st = b / 1024, sb = b % 1024, swz = sb ^ (((sb >> 9) & 1) << 5); R = (st >> 1) * 16 + swz / 64; C = (st & 1) * 32 + (swz % 64) / 2; }
__host__ __device__ __forceinline__ int perm32(int rho) { const int n = rho >> 4, i = rho & 15; return 8 * (i >> 2) + 4 * n + (i & 3); }

struct Unit { int pm, pn; };
struct Gemm { const bf16_t* A; const bf16_t* Bt; int M, N, K; };

struct StaticOrder {
    int nM, nN, nwg, G, c;
    __host__ __device__ void init(int M, int N, int G_, int c_) { nM = M / BM; nN = N / BM; nwg = nM * nN; G = G_; c = c_; }
    __host__ __device__ bool next(int i, Unit& u) const {
        const long L = (long)i * G + c; if (L >= nwg) return false;
        int wgid = (int)L; { const int q = nwg / NXCD, r = nwg % NXCD, xcd = wgid % NXCD, off = wgid / NXCD; wgid = (xcd < r ? xcd * (q + 1) : r * (q + 1) + (xcd - r) * q) + off; }
        const int nig = WGM * nN, gid = wgid / nig, fm = gid * WGM, gsz = (nM - fm) < WGM ? (nM - fm) : WGM;
        u.pm = fm + ((wgid % nig) % gsz); u.pn = (wgid % nig) / gsz; return true;
    }
    __device__ __forceinline__ void a_ready(const Unit&) const {}
    __device__ __forceinline__ void done(const Unit&) const {}
};
__device__ __forceinline__ unsigned cvt_pk_bf16(float lo, float hi) { unsigned r; asm volatile("v_cvt_pk_bf16_f32 %0, %1, %2" : "=v"(r) : "v"(lo), "v"(hi)); return r; }

template <class Epi, class Sched, bool STAMP = false>
__device__ __forceinline__ void gemm_phase(PG8_LAS unsigned char* lds, const Gemm g, const Sched& S, const Epi& E, unsigned long long* stamps) {
    const int tid = opaque_tid(), wid = __builtin_amdgcn_readfirstlane(tid >> 6), lane = tid & 63, wr = wid >> 2, wc = wid & 3, fr = lane & 15, fq = lane >> 4;
    const int K = g.K, nt = K / BK;
    int ts_lo = 0, ts_hi = 0, nts = 0; const unsigned long long rt_entry = STAMP ? (unsigned long long)wall_clock64() : 0ull;
#define PG8_STAMP() do { if (STAMP && wid == 0 && nts < 64) { const unsigned long long _c = (unsigned long long)clock64(); \
        ts_lo = (lane == nts) ? (int)(unsigned)_c : ts_lo; ts_hi = (lane == nts) ? (int)(unsigned)(_c >> 32) : ts_hi; ++nts; } } while (0)
    PG8_STAMP();
    unsigned voffA[2], voffB[2];
#pragma unroll
    for (int i = 0; i < 2; ++i) { int R, C; stage_rc(tid * 16 + i * 8192, R, C); const int Rb = Epi::PERM ? ((R & ~31) + perm32(R & 31)) : R;
        voffA[i] = (unsigned)(R * K + C) * 2u; voffB[i] = (unsigned)(Rb * K + C) * 2u; }
    const size_t kstep = (size_t)(BK * 2);
    const size_t hstep = (size_t)HALF * K * 2;
    const size_t tstep = 2 * hstep;
    const unsigned ldsw = (unsigned)wid * 1024u;
    const int aoff = lds_byte(wr * 64 + fr, fq * 8), boff = lds_byte(wc * 32 + fr, fq * 8);
#define PG8_SA(b, h) (((b) * 2 + (h)) * HTB)
#define PG8_SB(b, h) ((4 + (b) * 2 + (h)) * HTB)
#define PG8_STAGE(bufoff, gbase, voff) do { _Pragma("unroll") for (int _i = 0; _i < 2; ++_i) \
        __builtin_amdgcn_global_load_lds((const unsigned*)((const char*)(gbase) + (voff)[_i]), (PG8_LAS unsigned*)(lds + (bufoff) + ldsw + _i * 8192), 16, 0, 0); } while (0)
#define PG8_LDA(dst, b, h) do { _Pragma("unroll") for (int m = 0; m < 4; ++m) _Pragma("unroll") for (int k = 0; k < 2; ++k) dst[m][k] = *(const PG8_LAS bf16x8*)(lds + PG8_SA(b, h) + aoff + m * 2048 + k * 1024); } while (0)
#define PG8_LDB(dst, b, h) do { _Pragma("unroll") for (int n = 0; n < 2; ++n) _Pragma("unroll") for (int k = 0; k < 2; ++k) dst[n][k] = *(const PG8_LAS bf16x8*)(lds + PG8_SB(b, h) + boff + n * 2048 + k * 1024); } while (0)
#define PG8_MMA(ai, bj, At, Bt) do { __builtin_amdgcn_s_setprio(1); _Pragma("unroll") for (int m = 0; m < 4; ++m) _Pragma("unroll") for (int n = 0; n < 2; ++n) _Pragma("unroll") for (int k = 0; k < 2; ++k) \
        acc[ai][bj][m][n] = __builtin_amdgcn_mfma_f32_16x16x32_bf16(Bt[n][k], At[m][k], acc[ai][bj][m][n], 0, 0, 0); __builtin_amdgcn_s_setprio(0); } while (0)
#define PG8_WAIT_V(n) asm volatile("s_waitcnt vmcnt(" #n ")" ::: "memory")
#define PG8_WAIT_L(n) asm volatile("s_waitcnt lgkmcnt(" #n ")" ::: "memory")
#define PG8_BAR __builtin_amdgcn_s_barrier()
#define PG8_SCHED __builtin_amdgcn_sched_barrier(0)
    Unit cur, nxt; int ui = 0;
    if (!S.next(0, cur)) return;
    f32x4 acc[2][2][4][2];
#pragma unroll
    for (int a = 0; a < 2; ++a)
#pragma unroll
        for (int b = 0; b < 2; ++b)
#pragma unroll
            for (int m = 0; m < 4; ++m)
#pragma unroll
                for (int n = 0; n < 2; ++n) acc[a][b][m][n] = (f32x4){0.f, 0.f, 0.f, 0.f};
    bf16x8 At[4][2], B0[2][2], B1[2][2];
    const char* cA = (const char*)g.A + (size_t)cur.pm * tstep; const char* cB = (const char*)g.Bt + (size_t)cur.pn * tstep;
    S.a_ready(cur);
    PG8_STAGE(PG8_SB(0, 0), cB, voffB); PG8_STAGE(PG8_SA(0, 0), cA, voffA); PG8_STAGE(PG8_SB(0, 1), cB + hstep, voffB); PG8_STAGE(PG8_SA(0, 1), cA + hstep, voffA);
    if (wr == 1) PG8_BAR;
    PG8_WAIT_V(4); PG8_BAR;
    PG8_STAGE(PG8_SB(1, 0), cB + kstep, voffB); PG8_STAGE(PG8_SA(1, 0), cA + kstep, voffA); PG8_STAGE(PG8_SB(1, 1), cB + hstep + kstep, voffB);
    PG8_WAIT_V(6); PG8_BAR;
    PG8_STAMP();
    for (;;) {
        const bool has_next = S.next(ui + 1, nxt);
        const char* nA = has_next ? (const char*)g.A + (size_t)nxt.pm * tstep : cA; const char* nB = has_next ? (const char*)g.Bt + (size_t)nxt.pn * tstep : cB;
        for (int t = 0; t < nt; t += 2) {
            const bool last = (t == nt - 2);
            const char* a1 = cA + (size_t)(t + 1) * kstep;
            const char* a2 = last ? nA : cA + (size_t)(t + 2) * kstep; const char* b2 = last ? nB : cB + (size_t)(t + 2) * kstep;
            const char* a3 = a2 + kstep; const char* b3 = b2 + kstep;
            if (last && has_next) S.a_ready(nxt);
            PG8_LDB(B0, 0, 0); PG8_SCHED; PG8_LDA(At, 0, 0); PG8_STAGE(PG8_SA(1, 1), a1 + hstep, voffA);
            PG8_WAIT_L(8); PG8_BAR; PG8_WAIT_L(0); PG8_MMA(0, 0, At, B0); PG8_BAR; PG8_SCHED;
            PG8_LDB(B1, 0, 1); PG8_STAGE(PG8_SB(0, 0), b2, voffB);
            PG8_BAR; PG8_WAIT_L(0); PG8_MMA(0, 1, At, B1); PG8_BAR;
            PG8_LDA(At, 0, 1); PG8_STAGE(PG8_SA(0, 0), a2, voffA);
            PG8_BAR; PG8_WAIT_L(0); PG8_MMA(1, 0, At, B0); PG8_BAR; PG8_SCHED;
            PG8_STAGE(PG8_SB(0, 1), b2 + hstep, voffB);
            PG8_WAIT_V(6); PG8_BAR; PG8_MMA(1, 1, At, B1); PG8_BAR;
            PG8_LDB(B0, 1, 0); PG8_SCHED; PG8_LDA(At, 1, 0); PG8_STAGE(PG8_SA(0, 1), a2 + hstep, voffA);
            PG8_WAIT_L(8); PG8_BAR; PG8_WAIT_L(0); PG8_MMA(0, 0, At, B0); PG8_BAR; PG8_SCHED;
            PG8_LDB(B1, 1, 1); PG8_STAGE(PG8_SB(1, 0), b3, voffB);
            PG8_BAR; PG8_WAIT_L(0); PG8_MMA(0, 1, At, B1); PG8_BAR;
            PG8_LDA(At, 1, 1); PG8_STAGE(PG8_SA(1, 0), a3, voffA);
            PG8_BAR; PG8_WAIT_L(0); PG8_MMA(1, 0, At, B0); PG8_BAR; PG8_SCHED;
            PG8_STAGE(PG8_SB(1, 1), b3 + hstep, voffB);
            PG8_WAIT_V(6); PG8_BAR; PG8_MMA(1, 1, At, B1); PG8_BAR;
        }
        PG8_STAMP();
        if constexpr (!Epi::AFTER_DRAIN) { E(acc, cur, wr, wc, fr, fq); S.done(cur); }
        PG8_STAMP();
        if (!has_next) break;
#pragma unroll
        for (int a = 0; a < 2; ++a)
#pragma unroll
            for (int b = 0; b < 2; ++b)
#pragma unroll
                for (int m = 0; m < 4; ++m)
#pragma unroll
                    for (int n = 0; n < 2; ++n) acc[a][b][m][n] = (f32x4){0.f, 0.f, 0.f, 0.f};
        cur = nxt; cA = nA; cB = nB; ++ui;
    }
    PG8_WAIT_V(0);
    if (wr == 0) PG8_BAR;
    PG8_BAR;
    if constexpr (Epi::AFTER_DRAIN) { E.fused(acc, cur, wr, wc, fr, fq, lds, wid, lane); S.done(cur); }
    PG8_STAMP();
    if (STAMP && wid == 0) { stamps[lane] = lane < nts ? (((unsigned long long)(unsigned)ts_hi << 32) | (unsigned)ts_lo) : 0ull;
        if (lane == 62) stamps[62] = rt_entry; if (lane == 63) stamps[63] = (unsigned long long)wall_clock64(); }
#undef PG8_STAMP
#undef PG8_SA
#undef PG8_SB
#undef PG8_STAGE
#undef PG8_LDA
#undef PG8_LDB
#undef PG8_MMA
#undef PG8_WAIT_V
#undef PG8_WAIT_L
#undef PG8_BAR
#undef PG8_SCHED
}
}

__device__ void phase_mod(const Params& p, char* smem, int bid, int nblk) {
    const int tidx_ = opaque_tid();
    float* condL = (float*)smem;
    const int tid = tidx_, cl = tid & 63, ks = tid >> 6;
    for (int item = bid; item < 96; item += nblk) {
        const int col0 = item * 64, col = col0 + cl;
        float acc[33];
#pragma unroll
        for (int b = 0; b < 33; ++b) acc[b] = 0.f;
        for (int kc = 0; kc < 4; ++kc) {
            __syncthreads();
            for (int e = tid; e < 8 * 32 * 33; e += NT) {
                const int sl = e / (32 * 33), kk = (e / 33) % 32, b = e % 33;
                const int k = sl * 128 + kc * 32 + kk;
                const float cv = b < 32 ? p.c[b * 1024 + k] : p.c_ctx[k];
                condL[e] = silu(cv);
            }
            __syncthreads();
            for (int kk = 0; kk < 32; ++kk) {
                const int k = ks * 128 + kc * 32 + kk;
                const float w = p.w_mod[(size_t)k * 6144 + col];
                const float* cp = condL + (ks * 32 + kk) * 33;
#pragma unroll
                for (int b = 0; b < 33; ++b) acc[b] += w * cp[b];
            }
        }
        __syncthreads();
#pragma unroll
        for (int b = 0; b < 33; ++b) condL[(ks * 33 + b) * 64 + cl] = acc[b];
        __syncthreads();
        for (int e = tid; e < 33 * 64; e += NT) {
            const int b = e >> 6, cc = e & 63;
            float v = 0.f;
#pragma unroll
            for (int q = 0; q < 8; ++q) v += condL[(q * 33 + b) * 64 + cc];
            p.mod[b * 6144 + col0 + cc] = v + p.b_mod[col0 + cc];
        }
        __syncthreads();
    }
}

__device__ void convT(const float* __restrict__ src, int K, int N, int Npad, bf16_t* __restrict__ dst, char* smem, int bid, int nblk) {
    const int tidx_ = opaque_tid();
    float* tile = (float*)smem;
    const int tid = tidx_;
    const int nk = K / 64, nn = Npad / 64;
    for (int t = bid; t < nk * nn; t += nblk) {
        const int k0 = (t % nk) * 64, n0 = (t / nk) * 64;
        __syncthreads();
#pragma unroll
        for (int r = 0; r < 64 / (NT / 64); ++r) {
            const int k = r * (NT / 64) + (tid >> 6), n = tid & 63;
            tile[k * 65 + n] = (n0 + n < N) ? src[(size_t)(k0 + k) * N + n0 + n] : 0.f;
        }
        __syncthreads();
#pragma unroll
        for (int r = 0; r < 64 / (NT / 64); ++r) {
            const int n = r * (NT / 64) + (tid >> 6), k = tid & 63;
            dst[(size_t)(n0 + n) * K + k0 + k] = f2bf(tile[k * 65 + n]);
        }
    }
    __syncthreads();
}
__device__ void conv_copy(const float* __restrict__ src, bf16_t* __restrict__ dst, size_t n, int gtid, int gthreads) {
    const size_t n4 = n / 4;
    for (size_t i = gtid; i < n4; i += gthreads) {
        const float4 v = ((const float4*)src)[i];
        uint2 o; o.x = pack2(v.x, v.y); o.y = pack2(v.z, v.w);
        ((uint2*)dst)[i] = o;
    }
}
__device__ void phase_convert(const Params& p, char* smem, int bid, int nblk) {
    const int tidx_ = opaque_tid();
    convT(p.w_in, 1024, PT, PTP, p.winT, smem, bid, nblk);
    convT(p.w_out, 1024, 1024, 1024, p.woutT, smem, bid, nblk);
    convT(p.wq, 1024, 2048, 2048, p.wqT, smem, bid, nblk);
    const int gtid = bid * NT + tidx_, gth = nblk * NT;
    conv_copy(p.keys, p.keysb, (size_t)8 * 2 * 128 * 128, gtid, gth);
    {
        const int lane = tidx_ & 63;
        const int gw = bid * (NT / 64) + (tidx_ >> 6), nw = nblk * (NT / 64);
        for (int row = gw; row < 2 * 16384; row += nw) {
            const bool isv = row >= 16384;
            const int r = isv ? row - 16384 : row;
            const float* src = (isv ? p.pv : p.pu) + (size_t)r * 1024 + lane * 16;
            f32x4 v[4];
            float mx = 0.f;
#pragma unroll
            for (int q = 0; q < 4; ++q) { v[q] = *(const f32x4*)(src + 4 * q); mx = fmaxf(mx, fmaxf(fmaxf(fabsf(v[q][0]), fabsf(v[q][1])), fmaxf(fabsf(v[q][2]), fabsf(v[q][3])))); }
            mx = wave_max(mx);
            mx = fmaxf(mx, 1e-30f);
            const float sc = 7.5f / mx;
            unsigned c[16];
#pragma unroll
            for (int i = 0; i < 16; ++i) {
                const float x = v[i >> 2][i & 3] * sc, a = fabsf(x);
                const float code = a < 2.f ? rintf(a * 8.f) : (a < 4.f ? 8.f + rintf(a * 4.f) : 16.f + rintf(a * 2.f));
                unsigned ci = (unsigned)fminf(code, 31.f);
                c[i] = ci | (x < 0.f ? 32u : 0u);
            }
            unsigned long long lo = 0ull; unsigned hi = 0u;
#pragma unroll
            for (int i = 0; i < 10; ++i) lo |= (unsigned long long)c[i] << (6 * i);
            lo |= (unsigned long long)(c[10] & 0xfu) << 60;
            hi = c[10] >> 4;
#pragma unroll
            for (int i = 11; i < 16; ++i) hi |= c[i] << (2 + 6 * (i - 11));
            unsigned* dst = (unsigned*)((isv ? p.v8 : p.u8) + (size_t)r * 768 + lane * 12);
            dst[0] = (unsigned)lo; dst[1] = (unsigned)(lo >> 32); dst[2] = hi;
            if (lane == 0) (isv ? p.vsc : p.usc)[r] = mx * (1.f / 7.5f);
        }
    }
}

template <int R>
__device__ __forceinline__ void norm_rows(const float* __restrict__ srcbase, const float* __restrict__ src2, int nrows1, int nrows, const float* __restrict__ gvec,
                                          const float* __restrict__ mod, int sc_off, int sh_off, bf16_t* __restrict__ dst, int gw, int nw, int lane) {
    for (int row0 = gw; row0 < nrows; row0 += R * nw) {
        f32x4 v[R][4]; float ss[R];
#pragma unroll
        for (int r = 0; r < R; ++r) {
            const int row = min(row0 + r * nw, nrows - 1);
            const float* src = row < nrows1 ? srcbase + (size_t)row * D : src2 + (size_t)(row - nrows1) * D;
#pragma unroll
            for (int j = 0; j < 4; ++j) v[r][j] = *(const f32x4*)(src + j * 256 + lane * 4);
        }
#pragma unroll
        for (int r = 0; r < R; ++r) {
            float a = 0.f;
#pragma unroll
            for (int j = 0; j < 4; ++j) a += v[r][j][0] * v[r][j][0] + v[r][j][1] * v[r][j][1] + v[r][j][2] * v[r][j][2] + v[r][j][3] * v[r][j][3];
            ss[r] = a;
        }
#pragma unroll
        for (int r = 0; r < R; ++r) ss[r] = wave_sum_fast(ss[r]);
#pragma unroll
        for (int r = 0; r < R; ++r) {
            const int row = row0 + r * nw;
            if (row >= nrows) continue;
            const float rstd = rsqrtf(ss[r] * (1.f / 1024.f) + EPS);
            const float* md = mod + (row < TL ? (row >> 11) : 32) * 6144;
#pragma unroll
            for (int j = 0; j < 4; ++j) {
                const int col = j * 256 + lane * 4;
                const f32x4 g = *(const f32x4*)(gvec + col), sc = *(const f32x4*)(md + sc_off + col), sh = *(const f32x4*)(md + sh_off + col);
                uint2 o;
                o.x = pack2(v[r][j][0] * rstd * g[0] * (1.f + sc[0]) + sh[0], v[r][j][1] * rstd * g[1] * (1.f + sc[1]) + sh[1]);
                o.y = pack2(v[r][j][2] * rstd * g[2] * (1.f + sc[2]) + sh[2], v[r][j][3] * rstd * g[3] * (1.f + sc[3]) + sh[3]);
                *(uint2*)(dst + (size_t)row * D + col) = o;
            }
        }
    }
}
template <int R, bool WITH_Y>
__device__ __forceinline__ void norm_span(const float* __restrict__ src, const bf16_t* __restrict__ ysrc, const float* __restrict__ gvec, const float* __restrict__ md,
                                          int sc_off, int sh_off, bf16_t* __restrict__ dst, int nr, int lane) {
    float A[16], B[16], G1[16];
#pragma unroll
    for (int q = 0; q < 2; ++q)
#pragma unroll
        for (int hq = 0; hq < 2; ++hq) {
            const int col = q * 512 + lane * 8 + hq * 4;
            const f32x4 g = *(const f32x4*)(gvec + col), sc = *(const f32x4*)(md + sc_off + col), sh = *(const f32x4*)(md + sh_off + col);
            f32x4 g1 = (f32x4){0.f, 0.f, 0.f, 0.f};
            if (WITH_Y) g1 = *(const f32x4*)(md + 2048 + col);
#pragma unroll
            for (int k = 0; k < 4; ++k) { A[q * 8 + hq * 4 + k] = g[k] * (1.f + sc[k]); B[q * 8 + hq * 4 + k] = sh[k]; G1[q * 8 + hq * 4 + k] = g1[k]; }
        }
    for (int i0 = 0; i0 < nr; i0 += R) {
        f32x4 v[R][4]; u32x4 yv[R][2];
#pragma unroll
        for (int r = 0; r < R; ++r) {
            const float* sp = src + (size_t)(i0 + r) * D + lane * 8;
            v[r][0] = *(const f32x4*)sp; v[r][1] = *(const f32x4*)(sp + 4); v[r][2] = *(const f32x4*)(sp + 512); v[r][3] = *(const f32x4*)(sp + 516);
            if (WITH_Y) { const bf16_t* yp = ysrc + (size_t)(i0 + r) * D + lane * 8; yv[r][0] = *(const u32x4*)yp; yv[r][1] = *(const u32x4*)(yp + 512); }
        }
        float ss[R];
#pragma unroll
        for (int r = 0; r < R; ++r) {
            if (WITH_Y) {
#pragma unroll
                for (int q = 0; q < 2; ++q)
#pragma unroll
                    for (int k = 0; k < 4; ++k) {
                        v[r][2 * q + (k >> 1)][(k & 1) * 2] += G1[q * 8 + 2 * k] * lo2f(yv[r][q][k]);
                        v[r][2 * q + (k >> 1)][(k & 1) * 2 + 1] += G1[q * 8 + 2 * k + 1] * hi2f(yv[r][q][k]);
                    }
            }
            float a = 0.f;
#pragma unroll
            for (int j = 0; j < 4; ++j) a += v[r][j][0] * v[r][j][0] + v[r][j][1] * v[r][j][1] + v[r][j][2] * v[r][j][2] + v[r][j][3] * v[r][j][3];
            ss[r] = a;
        }
#pragma unroll
        for (int r = 0; r < R; ++r) ss[r] = wave_sum_fast(ss[r]);
#pragma unroll
        for (int r = 0; r < R; ++r) {
            const float rstd = rsqrtf(ss[r] * (1.f / 1024.f) + EPS);
#pragma unroll
            for (int q = 0; q < 2; ++q) {
                float o[8];
#pragma unroll
                for (int k = 0; k < 8; ++k) o[k] = v[r][2 * q + (k >> 2)][k & 3] * rstd * A[q * 8 + k] + B[q * 8 + k];
                *(u32x4*)(dst + (size_t)(i0 + r) * D + q * 512 + lane * 8) = (u32x4){pack2(o[0], o[1]), pack2(o[2], o[3]), pack2(o[4], o[5]), pack2(o[6], o[7])};
            }
        }
    }
}
__device__ void phase_norm1(const Params& p, int bid, int nblk) {
    const int tidx_ = opaque_tid();
    const int lane = tidx_ & 63, gw = bid * (NT / 64) + (tidx_ >> 6), nw = nblk * (NT / 64);
    for (int sp = gw; sp < TL / 32; sp += nw)
        norm_span<4, false>(p.x + (size_t)sp * 32 * D, nullptr, p.norm1_g, p.mod + (sp >> 6) * 6144, 1024, 0, p.hbuf + (size_t)sp * 32 * D, 32, lane);
    for (int sp = gw; sp < TC / 4; sp += nw)
        norm_span<4, false>(p.ctx + (size_t)sp * 4 * D, nullptr, p.norm1_g, p.mod + 32 * 6144, 1024, 0, p.hbuf + (size_t)(TL + sp * 4) * D, 4, lane);
}

template <int CL, int CR> __device__ __forceinline__ float dpp_nb(float oldv, float cur) {
    return __uint_as_float(__builtin_amdgcn_update_dpp(__float_as_uint(oldv), __float_as_uint(cur), CL, 0xf, 0xf, false));
}
struct EpiZ {
    static constexpr bool PERM = true, AFTER_DRAIN = false;
    bf16_t* z; float* zg; const float* gate_b; const float* conv_w;
    __device__ __forceinline__ void operator()(const f32x4 (&acc)[2][2][4][2], const pg8::Unit& u, int wr, int wc, int fr, int fq) const {
        const int row0 = u.pm * 256 + wr * 64 + fr, colb = u.pn * 256 + wc * 32 + 8 * fq;
        if (u.pn < 4 && u.pm * 256 < TL) {
#pragma unroll
            for (int bj = 0; bj < 2; ++bj) {
                const int col = colb + bj * 128;
                const float scl = col >= 512 ? 0.08838834764831845f : 1.f;
                f32x4 w0[2], w1[2], w2[2];
#pragma unroll
                for (int n = 0; n < 2; ++n) { w0[n] = *(const f32x4*)(conv_w + col + 4 * n); w1[n] = *(const f32x4*)(conv_w + 1024 + col + 4 * n); w2[n] = *(const f32x4*)(conv_w + 2048 + col + 4 * n); }
#pragma unroll
                for (int ai = 0; ai < 2; ++ai) {
                    f32x4 o[4][2];
#pragma unroll
                    for (int n = 0; n < 2; ++n)
#pragma unroll
                        for (int m = 0; m < 4; ++m)
#pragma unroll
                            for (int c = 0; c < 4; ++c) {
                                const float cur = acc[ai][bj][m][n][c];
                                const float oL = m > 0 ? __uint_as_float(__builtin_amdgcn_update_dpp(0u, __float_as_uint(acc[ai][bj][m > 0 ? m - 1 : 0][n][c]), 0x121, 0xf, 0xf, false)) : 0.f;
                                const float oR = m < 3 ? __uint_as_float(__builtin_amdgcn_update_dpp(0u, __float_as_uint(acc[ai][bj][m < 3 ? m + 1 : 3][n][c]), 0x12F, 0xf, 0xf, false)) : 0.f;
                                const float L = __uint_as_float(__builtin_amdgcn_update_dpp(__float_as_uint(oL), __float_as_uint(cur), 0x111, 0xf, 0xf, false));
                                const float R = __uint_as_float(__builtin_amdgcn_update_dpp(__float_as_uint(oR), __float_as_uint(cur), 0x101, 0xf, 0xf, false));
                                o[m][n][c] = silu(w0[n][c] * L + w1[n][c] * cur + w2[n][c] * R) * scl;
                            }
#pragma unroll
                    for (int m = 0; m < 4; ++m) {
                        const size_t row = (size_t)(row0 + ai * 128 + m * 16);
                        const f32x4 v0 = o[m][0], v1 = o[m][1];
                        u32x4 w; w.x = pg8::cvt_pk_bf16(v0[0], v0[1]); w.y = pg8::cvt_pk_bf16(v0[2], v0[3]); w.z = pg8::cvt_pk_bf16(v1[0], v1[1]); w.w = pg8::cvt_pk_bf16(v1[2], v1[3]);
                        *(u32x4*)(z + row * ZS + col) = w;
                    }
                }
            }
            return;
        }
#pragma unroll
        for (int bj = 0; bj < 2; ++bj) {
            const int col = colb + bj * 128;
            if (col >= PT) continue;
            const bool isg = (col >= C_MLG && col < C_GQ), isl = (col >= C_LR);
#pragma unroll
            for (int ai = 0; ai < 2; ++ai)
#pragma unroll
                for (int m = 0; m < 4; ++m) {
                    const size_t row = (size_t)(row0 + ai * 128 + m * 16);
                    const f32x4 v0 = acc[ai][bj][m][0], v1 = acc[ai][bj][m][1];
                    if (isg) {
                        float* dst = zg + row * 48 + (col - C_MLG);
                        *(f32x4*)dst = v0 + *(const f32x4*)(gate_b + (col - C_MLG));
                        *(f32x4*)(dst + 4) = v1 + *(const f32x4*)(gate_b + (col - C_MLG) + 4);
                    } else if (isl) {
                        float* dst = zg + row * 48 + 16 + (col - C_LR);
                        *(f32x4*)dst = v0; *(f32x4*)(dst + 4) = v1;
                    } else {
                        u32x4 w; w.x = pg8::cvt_pk_bf16(v0[0], v0[1]); w.y = pg8::cvt_pk_bf16(v0[2], v0[3]); w.z = pg8::cvt_pk_bf16(v1[0], v1[1]); w.w = pg8::cvt_pk_bf16(v1[2], v1[3]);
                        *(u32x4*)(z + row * ZS + col) = w;
                    }
                }
        }
    }
};
struct EpiX1 {
    static constexpr bool PERM = false, AFTER_DRAIN = false;
    const float* x; const float* mod; float* out;
    __device__ __forceinline__ void operator()(const f32x4 (&acc)[2][2][4][2], const pg8::Unit& u, int wr, int wc, int fr, int fq) const {
        const int row0 = u.pm * 256 + wr * 64 + fr, col0 = u.pn * 256 + wc * 32 + 4 * fq;
#pragma unroll
        for (int ai = 0; ai < 2; ++ai)
#pragma unroll
            for (int m = 0; m < 4; ++m) {
                const int row = row0 + ai * 128 + m * 16;
                const float* g1 = mod + (row >> 11) * 6144 + 2048;
#pragma unroll
                for (int bj = 0; bj < 2; ++bj)
#pragma unroll
                    for (int n = 0; n < 2; ++n) {
                        const int col = col0 + bj * 128 + n * 16;
                        const size_t o = (size_t)row * D + col;
                        *(f32x4*)(out + o) = *(const f32x4*)(x + o) + *(const f32x4*)(g1 + col) * acc[ai][bj][m][n];
                    }
            }
    }
};
struct EpiY {
    static constexpr bool PERM = true, AFTER_DRAIN = false;
    bf16_t* y;
    __device__ __forceinline__ void operator()(const f32x4 (&acc)[2][2][4][2], const pg8::Unit& u, int wr, int wc, int fr, int fq) const {
        const int row0 = u.pm * 256 + wr * 64 + fr, colb = u.pn * 256 + wc * 32 + 8 * fq;
#pragma unroll
        for (int ai = 0; ai < 2; ++ai)
#pragma unroll
            for (int m = 0; m < 4; ++m) {
                bf16_t* rowp = y + (size_t)(row0 + ai * 128 + m * 16) * 1024 + colb;
#pragma unroll
                for (int bj = 0; bj < 2; ++bj) {
                    const f32x4 v0 = acc[ai][bj][m][0], v1 = acc[ai][bj][m][1];
                    u32x4 w; w.x = pg8::cvt_pk_bf16(v0[0], v0[1]); w.y = pg8::cvt_pk_bf16(v0[2], v0[3]); w.z = pg8::cvt_pk_bf16(v1[0], v1[1]); w.w = pg8::cvt_pk_bf16(v1[2], v1[3]);
                    *(u32x4*)(rowp + bj * 128) = w;
                }
            }
    }
};
struct EpiQb {
    static constexpr bool PERM = true, AFTER_DRAIN = false;
    bf16_t* q;
    __device__ __forceinline__ void operator()(const f32x4 (&acc)[2][2][4][2], const pg8::Unit& u, int wr, int wc, int fr, int fq) const {
        const int row0 = u.pm * 256 + wr * 64 + fr, colb = u.pn * 256 + wc * 32 + 8 * fq;
#pragma unroll
        for (int ai = 0; ai < 2; ++ai)
#pragma unroll
            for (int m = 0; m < 4; ++m) {
                bf16_t* rowp = q + (size_t)(row0 + ai * 128 + m * 16) * 2048 + colb;
#pragma unroll
                for (int bj = 0; bj < 2; ++bj) {
                    const f32x4 v0 = acc[ai][bj][m][0], v1 = acc[ai][bj][m][1];
                    u32x4 w; w.x = pg8::cvt_pk_bf16(v0[0], v0[1]); w.y = pg8::cvt_pk_bf16(v0[2], v0[3]); w.z = pg8::cvt_pk_bf16(v1[0], v1[1]); w.w = pg8::cvt_pk_bf16(v1[2], v1[3]);
                    *(u32x4*)(rowp + bj * 128) = w;
                }
            }
    }
};
template <class Epi>
__device__ __forceinline__ void gemm_run(const bf16_t* A, const bf16_t* Bt, int M, int N, int K, const Epi& e, char* smem, int bid, int nblk) {
    pg8::Gemm g{A, Bt, M, N, K};
    pg8::StaticOrder S; S.init(M, N, nblk, bid);
    pg8::gemm_phase<Epi, pg8::StaticOrder, false>((PG8_LAS unsigned char*)smem, g, S, e, nullptr);
}

#define MFMA16(a, b, c) __builtin_amdgcn_mfma_f32_16x16x32_bf16((a), (b), (c), 0, 0, 0)
__device__ __forceinline__ void conv8(const Params& p, const bf16_t* zc, int col, bool vl, bool vr, float scl, float* y) {
    const u32x4 cc = *(const u32x4*)zc;
    u32x4 ll = (u32x4){0u, 0u, 0u, 0u}, rr = (u32x4){0u, 0u, 0u, 0u};
    if (vl) ll = *(const u32x4*)(zc - ZS);
    if (vr) rr = *(const u32x4*)(zc + ZS);
    const f32x4 w0a = *(const f32x4*)(p.conv_w + col), w0b = *(const f32x4*)(p.conv_w + col + 4);
    const f32x4 w1a = *(const f32x4*)(p.conv_w + 1024 + col), w1b = *(const f32x4*)(p.conv_w + 1024 + col + 4);
    const f32x4 w2a = *(const f32x4*)(p.conv_w + 2048 + col), w2b = *(const f32x4*)(p.conv_w + 2048 + col + 4);
    const float w0[8] = {w0a[0], w0a[1], w0a[2], w0a[3], w0b[0], w0b[1], w0b[2], w0b[3]};
    const float w1[8] = {w1a[0], w1a[1], w1a[2], w1a[3], w1b[0], w1b[1], w1b[2], w1b[3]};
    const float w2[8] = {w2a[0], w2a[1], w2a[2], w2a[3], w2b[0], w2b[1], w2b[2], w2b[3]};
#pragma unroll
    for (int j = 0; j < 4; ++j) {
        const float y0 = w0[2 * j] * lo2f(ll[j]) + w1[2 * j] * lo2f(cc[j]) + w2[2 * j] * lo2f(rr[j]);
        const float y1 = w0[2 * j + 1] * hi2f(ll[j]) + w1[2 * j + 1] * hi2f(cc[j]) + w2[2 * j + 1] * hi2f(rr[j]);
        y[2 * j] = silu(y0) * scl; y[2 * j + 1] = silu(y1) * scl;
    }
}

template <int LBASE>
__device__ void mlstm_item_chunked(const Params& p, char* smem0, int tid, int b, int h, int dir) {
    char* smem = smem0 + LBASE;
    bf16_t* Qs = (bf16_t*)smem;
    bf16_t* Ks = Qs + 32 * 136;
    bf16_t* Ktw = Ks + 32 * 136;
    bf16_t* Vt = Ktw + 128 * 40;
    bf16_t* Ps = Vt + 144 * 40;
    bf16_t* Cb = Ps + 32 * 40;
    float* sg = (float*)(Cb + 144 * 136);
    float* sM = sg + 32; float* sinter = sg + 64; float* sfloor = sg + 96; float* sw = sg + 128; float* smisc = sg + 160;
    const int lane = tid & 63, w = __builtin_amdgcn_readfirstlane(tid >> 6), lr = lane & 15, lq = lane >> 4;
    for (int i = tid; i < 16 * 40; i += 256) Vt[128 * 40 + i] = 0x3f80;
    for (int i = tid; i < 144 * 136 / 2; i += 256) ((unsigned*)Cb)[i] = 0u;
    f32x4 CT[2][9];
#pragma unroll
    for (int i = 0; i < 2; ++i)
#pragma unroll
        for (int j = 0; j < 9; ++j) CT[i][j] = (f32x4){0.f, 0.f, 0.f, 0.f};
    float m_s = 0.f;
    u32x4 kr[2], qr[2], vr[2]; float g_ig = 0.f, g_f = 0.f;
#define ML_PREFETCH(BT) do { \
        const int bt_ = (BT); const bool lat_ = bt_ >= 8; const int pos0_ = lat_ ? (bt_ - 8) * 32 : bt_ * 32; \
        const int nlo_ = dir ? (lat_ ? SEQ : CTX) - 32 - pos0_ : pos0_; const int rowbase_ = lat_ ? b * SEQ : TL + b * CTX; \
        const int l_ = tid & 31, c8_ = tid >> 5; const size_t row_ = (size_t)(rowbase_ + (dir ? nlo_ + 31 - l_ : nlo_ + l_)); \
        _Pragma("unroll") for (int r_ = 0; r_ < 2; ++r_) { const int ec_ = c8_ + 8 * r_; \
            kr[r_] = lat_ ? *(const u32x4*)(p.z + row_ * ZS + C_MLK + h * 128 + ec_ * 8) : *(const u32x4*)(p.hbuf + row_ * 1024 + 512 + h * 128 + ec_ * 8); \
            if (lat_) qr[r_] = *(const u32x4*)(p.z + row_ * ZS + C_MLQ + h * 128 + ec_ * 8); \
            vr[r_] = *(const u32x4*)(p.z + row_ * ZS + C_MLV + h * 128 + ec_ * 8); } \
        if (w == 0) { const int lg_ = lane & 31; const float* gp_ = p.zg + (size_t)(rowbase_ + (dir ? nlo_ + 31 - lg_ : nlo_ + lg_)) * 48 + dir * 8 + h; g_ig = gp_[0]; g_f = gp_[4]; } \
    } while (0)
    qr[0] = (u32x4){0u, 0u, 0u, 0u}; qr[1] = qr[0];
    ML_PREFETCH(0);
    __syncthreads();
    for (int bt = 0; bt < 72; ++bt) {
        const bool lat = bt >= 8;
        const int pos0 = lat ? (bt - 8) * 32 : bt * 32;
        const int seg = lat ? SEQ : CTX;
        const int nlo = dir ? seg - 32 - pos0 : pos0;
        const int rowbase = lat ? b * SEQ : TL + b * CTX;
        if (w == 0) {
            const int l = lane & 31;
            const float ig = g_ig, lf = logsig(g_f);
            float bsum = lf;
            bsum += __uint_as_float(__builtin_amdgcn_update_dpp(0u, __float_as_uint(bsum), 0x111, 0xf, 0xf, false));
            bsum += __uint_as_float(__builtin_amdgcn_update_dpp(0u, __float_as_uint(bsum), 0x112, 0xf, 0xf, false));
            bsum += __uint_as_float(__builtin_amdgcn_update_dpp(0u, __float_as_uint(bsum), 0x114, 0xf, 0xf, false));
            bsum += __uint_as_float(__builtin_amdgcn_update_dpp(0u, __float_as_uint(bsum), 0x118, 0xf, 0xf, false));
            { const float r0 = __int_as_float(__builtin_amdgcn_readlane(__float_as_int(bsum), 15)); if (lane & 16) bsum += r0; }
            const float g = ig - bsum;
            float cm = g;
            const unsigned NEGINF = 0xff800000u;
            cm = fmaxf(cm, __uint_as_float(__builtin_amdgcn_update_dpp(NEGINF, __float_as_uint(cm), 0x111, 0xf, 0xf, false)));
            cm = fmaxf(cm, __uint_as_float(__builtin_amdgcn_update_dpp(NEGINF, __float_as_uint(cm), 0x112, 0xf, 0xf, false)));
            cm = fmaxf(cm, __uint_as_float(__builtin_amdgcn_update_dpp(NEGINF, __float_as_uint(cm), 0x114, 0xf, 0xf, false)));
            cm = fmaxf(cm, __uint_as_float(__builtin_amdgcn_update_dpp(NEGINF, __float_as_uint(cm), 0x118, 0xf, 0xf, false)));
            { const float r0 = __int_as_float(__builtin_amdgcn_readlane(__float_as_int(cm), 15)); if (lane & 16) cm = fmaxf(cm, r0); }
            const float M = fmaxf(m_s, cm);
            const float Ml = __int_as_float(__builtin_amdgcn_readlane(__float_as_int(M), 31)), bl = __int_as_float(__builtin_amdgcn_readlane(__float_as_int(bsum), 31));
            if (lane < 32) {
                sg[l] = g; sM[l] = M; sinter[l] = __expf(m_s - M); sfloor[l] = __expf(-(bsum + M)); sw[l] = __expf(g - Ml);
                if (lane == 0) { smisc[0] = __expf(m_s - Ml); smisc[1] = bl + Ml; }
            }
        }
        __syncthreads();
        {
            const int l = tid & 31, c8 = tid >> 5;
            const float wl = sw[l];
#pragma unroll
            for (int r = 0; r < 2; ++r) {
                const int ec = c8 + 8 * r;
                *(u32x4*)(Ks + l * 136 + ec * 8) = kr[r];
#pragma unroll
                for (int j = 0; j < 4; ++j) { Ktw[(ec * 8 + 2 * j) * 40 + l] = f2bf(lo2f(kr[r][j]) * wl); Ktw[(ec * 8 + 2 * j + 1) * 40 + l] = f2bf(hi2f(kr[r][j]) * wl); }
                if (lat) *(u32x4*)(Qs + l * 136 + ec * 8) = qr[r];
#pragma unroll
                for (int j = 0; j < 4; ++j) { Vt[(ec * 8 + 2 * j) * 40 + l] = (bf16_t)(vr[r][j] & 0xffffu); Vt[(ec * 8 + 2 * j + 1) * 40 + l] = (bf16_t)(vr[r][j] >> 16); }
            }
        }
        __syncthreads();
        if (bt + 1 < 72) ML_PREFETCH(bt + 1);
        if (lat) {
            const int mi = w >> 1, ni = w & 1;
            f32x4 sa = (f32x4){0.f, 0.f, 0.f, 0.f};
            if (!(mi == 0 && ni == 1)) {
#pragma unroll
                for (int kk = 0; kk < 4; ++kk) {
                    const bf16x8 af = *(const bf16x8*)(Qs + (mi * 16 + lr) * 136 + kk * 32 + lq * 8);
                    const bf16x8 bf = *(const bf16x8*)(Ks + (ni * 16 + lr) * 136 + kk * 32 + lq * 8);
                    sa = MFMA16(af, bf, sa);
                }
            }
            const int sidx = ni * 16 + lr;
            const float gs = sg[sidx];
#pragma unroll
            for (int r = 0; r < 4; ++r) {
                const int t = mi * 16 + lq * 4 + r;
                const float pv = (sidx <= t) ? sa[r] * __expf(gs - sM[t]) : 0.f;
                Ps[t * 40 + sidx] = f2bf(pv);
            }
        }
        __syncthreads();
        if (lat) {
            const int nts[3] = {2 * w, 2 * w + 1, 8};
            f32x4 acc[2][3];
#pragma unroll
            for (int i = 0; i < 2; ++i)
#pragma unroll
                for (int j = 0; j < 3; ++j) acc[i][j] = (f32x4){0.f, 0.f, 0.f, 0.f};
#pragma unroll 1
            for (int kk = 0; kk < 4; ++kk) {
                bf16x8 af[2], bf[3];
#pragma unroll
                for (int i = 0; i < 2; ++i) af[i] = *(const bf16x8*)(Qs + (i * 16 + lr) * 136 + kk * 32 + lq * 8);
#pragma unroll
                for (int j = 0; j < 3; ++j) bf[j] = *(const bf16x8*)(Cb + (nts[j] * 16 + lr) * 136 + kk * 32 + lq * 8);
#pragma unroll
                for (int i = 0; i < 2; ++i)
#pragma unroll
                    for (int j = 0; j < 3; ++j) acc[i][j] = MFMA16(af[i], bf[j], acc[i][j]);
            }
#pragma unroll
            for (int i = 0; i < 2; ++i)
#pragma unroll
                for (int r = 0; r < 4; ++r) {
                    const float it = sinter[i * 16 + lq * 4 + r];
#pragma unroll
                    for (int j = 0; j < 3; ++j) acc[i][j][r] *= it;
                }
            {
                bf16x8 af[2], bf[3];
#pragma unroll
                for (int i = 0; i < 2; ++i) af[i] = *(const bf16x8*)(Ps + (i * 16 + lr) * 40 + lq * 8);
#pragma unroll
                for (int j = 0; j < 3; ++j) bf[j] = *(const bf16x8*)(Vt + (nts[j] * 16 + lr) * 40 + lq * 8);
#pragma unroll
                for (int i = 0; i < 2; ++i)
#pragma unroll
                    for (int j = 0; j < 3; ++j) acc[i][j] = MFMA16(af[i], bf[j], acc[i][j]);
            }
#pragma unroll
            for (int i = 0; i < 2; ++i)
#pragma unroll
                for (int r = 0; r < 4; ++r) {
                    const int t = i * 16 + lq * 4 + r;
                    const float dn = fmaxf(fabsf(acc[i][2][r]), sfloor[t]);
                    const float inv = 1.f / dn;
                    const int n = dir ? nlo + 31 - t : nlo + t;
                    bf16_t* orow = p.mixh + ((size_t)dir * TL + rowbase + n) * 1024 + h * 128;
#pragma unroll
                    for (int j = 0; j < 2; ++j) orow[nts[j] * 16 + lr] = f2bf(acc[i][j][r] * inv);
                }
        }
        __syncthreads();
        {
            const float a = smisc[0];
            bf16x8 af[2];
#pragma unroll
            for (int i = 0; i < 2; ++i) af[i] = *(const bf16x8*)(Ktw + ((2 * w + i) * 16 + lr) * 40 + lq * 8);
#pragma unroll
            for (int j = 0; j < 9; ++j) {
                const bf16x8 bf = *(const bf16x8*)(Vt + (j * 16 + lr) * 40 + lq * 8);
#pragma unroll
                for (int i = 0; i < 2; ++i) {
                    CT[i][j] = CT[i][j] * a;
                    CT[i][j] = MFMA16(af[i], bf, CT[i][j]);
                    uint2 pk; pk.x = pack2(CT[i][j][0], CT[i][j][1]); pk.y = pack2(CT[i][j][2], CT[i][j][3]);
                    *(uint2*)(Cb + (j * 16 + lr) * 136 + (2 * w + i) * 16 + lq * 4) = pk;
                }
            }
            m_s = smisc[1];
        }
        __syncthreads();
        __syncthreads();
    }
}
#undef ML_PREFETCH

template <int LBASE>
__device__ void gla_item_chunked(const Params& p, char* smem0, int tid, int b, int h, int dir) {
    char* smem = smem0 + LBASE;
    bf16_t* Qd = (bf16_t*)smem;
    bf16_t* Qb = Qd + 32 * 72;
    bf16_t* Kd = Qb + 32 * 72;
    bf16_t* Kwt = Kd + 32 * 72;
    bf16_t* Vt = Kwt + 64 * 40;
    bf16_t* Ps = Vt + 128 * 40;
    bf16_t* Sb = Ps + 32 * 40;
    float* bc = (float*)(Sb + 128 * 72);
    float* w2s = bc + 32 * 64;
    const int lane = tid & 63, w = __builtin_amdgcn_readfirstlane(tid >> 6), lr = lane & 15, lq = lane >> 4;
    for (int i = tid; i < 128 * 72 / 2; i += 256) ((unsigned*)Sb)[i] = 0u;
    for (int i = tid; i < 16 * 64; i += 256) w2s[i] = p.lr_w2[(dir * 16 + (i >> 6)) * 256 + h * 64 + (i & 63)];
    if (tid < 64) w2s[16 * 64 + tid] = p.alpha_b[dir * 256 + h * 64 + tid];
    f32x4 S[8];
#pragma unroll
    for (int j = 0; j < 8; ++j) S[j] = (f32x4){0.f, 0.f, 0.f, 0.f};
    u32x4 kr, qr, vr[2]; f32x4 lrr[4];
#define GLA_PREFETCH(BT) do { \
        const int bt_ = (BT); const bool lat_ = bt_ >= 8; const int pos0_ = lat_ ? (bt_ - 8) * 32 : bt_ * 32; \
        const int nlo_ = dir ? (lat_ ? SEQ : CTX) - 32 - pos0_ : pos0_; const int rowbase_ = lat_ ? b * SEQ : TL + b * CTX; \
        { const int l_ = tid & 31, dc_ = tid >> 5; const size_t row_ = (size_t)(rowbase_ + (dir ? nlo_ + 31 - l_ : nlo_ + l_)); \
          kr = *(const u32x4*)(p.z + row_ * ZS + C_GK + h * 64 + dc_ * 8); \
          if (lat_) qr = *(const u32x4*)(p.z + row_ * ZS + C_GQ + h * 64 + dc_ * 8); \
          vr[0] = *(const u32x4*)(p.z + row_ * ZS + C_GV + h * 128 + dc_ * 8); vr[1] = *(const u32x4*)(p.z + row_ * ZS + C_GV + h * 128 + (dc_ + 8) * 8); } \
        { const int l_ = tid >> 3; const float* lp_ = p.zg + (size_t)(rowbase_ + (dir ? nlo_ + 31 - l_ : nlo_ + l_)) * 48 + 16 + dir * 16; \
          _Pragma("unroll") for (int q_ = 0; q_ < 4; ++q_) lrr[q_] = *(const f32x4*)(lp_ + 4 * q_); } \
    } while (0)
    qr = (u32x4){0u, 0u, 0u, 0u};
    GLA_PREFETCH(0);
    __syncthreads();
    for (int bt = 0; bt < 72; ++bt) {
        const bool lat = bt >= 8;
        const int pos0 = lat ? (bt - 8) * 32 : bt * 32;
        const int seg = lat ? SEQ : CTX;
        const int nlo = dir ? seg - 32 - pos0 : pos0;
        const int rowbase = lat ? b * SEQ : TL + b * CTX;
        {
            const int l = tid >> 3, d0 = (tid & 7) * 8;
            float al[8];
#pragma unroll
            for (int j = 0; j < 8; ++j) al[j] = w2s[16 * 64 + d0 + j];
#pragma unroll
            for (int q = 0; q < 16; ++q) {
                const float lv = lrr[q >> 2][q & 3];
                const f32x4 wa = *(const f32x4*)(w2s + q * 64 + d0), wb = *(const f32x4*)(w2s + q * 64 + d0 + 4);
                al[0] += lv * wa[0]; al[1] += lv * wa[1]; al[2] += lv * wa[2]; al[3] += lv * wa[3];
                al[4] += lv * wb[0]; al[5] += lv * wb[1]; al[6] += lv * wb[2]; al[7] += lv * wb[3];
            }
#pragma unroll
            for (int j = 0; j < 8; ++j) bc[l * 64 + d0 + j] = logsig(al[j]) * (1.f / 16.f);
        }
        __syncthreads();
        if (tid < 64) {
            float cv[32];
#pragma unroll
            for (int l = 0; l < 32; ++l) cv[l] = bc[l * 64 + tid];
#pragma unroll
            for (int l = 1; l < 32; ++l) cv[l] += cv[l - 1];
#pragma unroll
            for (int l = 0; l < 32; ++l) bc[l * 64 + tid] = cv[l];
        }
        __syncthreads();
        {
            const int l = tid & 31, dc = tid >> 5;
            float bl[8], rf[8], be[8];
#pragma unroll
            for (int j = 0; j < 8; ++j) { bl[j] = bc[l * 64 + dc * 8 + j]; rf[j] = bc[16 * 64 + dc * 8 + j]; be[j] = bc[31 * 64 + dc * 8 + j]; }
            {
                float kf[8];
#pragma unroll
                for (int j = 0; j < 4; ++j) { kf[2 * j] = lo2f(kr[j]); kf[2 * j + 1] = hi2f(kr[j]); }
                float kd[8];
#pragma unroll
                for (int j = 0; j < 8; ++j) { kd[j] = kf[j] * __expf(rf[j] - bl[j]); Kwt[(dc * 8 + j) * 40 + l] = f2bf(kf[j] * __expf(be[j] - bl[j])); }
                *(u32x4*)(Kd + l * 72 + dc * 8) = (u32x4){pack2(kd[0], kd[1]), pack2(kd[2], kd[3]), pack2(kd[4], kd[5]), pack2(kd[6], kd[7])};
            }
            if (lat) {
                float qf[8];
#pragma unroll
                for (int j = 0; j < 4; ++j) { qf[2 * j] = lo2f(qr[j]) * 0.125f; qf[2 * j + 1] = hi2f(qr[j]) * 0.125f; }
                float qd[8], qb[8];
#pragma unroll
                for (int j = 0; j < 8; ++j) { qd[j] = qf[j] * __expf(bl[j] - rf[j]); qb[j] = qf[j] * __expf(bl[j]); }
                *(u32x4*)(Qd + l * 72 + dc * 8) = (u32x4){pack2(qd[0], qd[1]), pack2(qd[2], qd[3]), pack2(qd[4], qd[5]), pack2(qd[6], qd[7])};
                *(u32x4*)(Qb + l * 72 + dc * 8) = (u32x4){pack2(qb[0], qb[1]), pack2(qb[2], qb[3]), pack2(qb[4], qb[5]), pack2(qb[6], qb[7])};
            }
#pragma unroll
            for (int r = 0; r < 2; ++r) {
                const int ec = dc + 8 * r;
#pragma unroll
                for (int j = 0; j < 4; ++j) { Vt[(ec * 8 + 2 * j) * 40 + l] = (bf16_t)(vr[r][j] & 0xffffu); Vt[(ec * 8 + 2 * j + 1) * 40 + l] = (bf16_t)(vr[r][j] >> 16); }
            }
        }
        __syncthreads();
        if (bt + 1 < 72) GLA_PREFETCH(bt + 1);
        if (lat) {
            const int mi = w >> 1, ni = w & 1;
            f32x4 sa = (f32x4){0.f, 0.f, 0.f, 0.f};
            if (!(mi == 0 && ni == 1)) {
#pragma unroll
                for (int kk = 0; kk < 2; ++kk) {
                    const bf16x8 af = *(const bf16x8*)(Qd + (mi * 16 + lr) * 72 + kk * 32 + lq * 8);
                    const bf16x8 bf = *(const bf16x8*)(Kd + (ni * 16 + lr) * 72 + kk * 32 + lq * 8);
                    sa = MFMA16(af, bf, sa);
                }
            }
            const int sidx = ni * 16 + lr;
#pragma unroll
            for (int r = 0; r < 4; ++r) {
                const int t = mi * 16 + lq * 4 + r;
                Ps[t * 40 + sidx] = f2bf((sidx <= t) ? sa[r] : 0.f);
            }
        }
        __syncthreads();
        if (lat) {
            f32x4 acc[2][2];
#pragma unroll
            for (int i = 0; i < 2; ++i)
#pragma unroll
                for (int j = 0; j < 2; ++j) acc[i][j] = (f32x4){0.f, 0.f, 0.f, 0.f};
#pragma unroll
            for (int kk = 0; kk < 2; ++kk) {
                bf16x8 af[2], bf[2];
#pragma unroll
                for (int i = 0; i < 2; ++i) af[i] = *(const bf16x8*)(Qb + (i * 16 + lr) * 72 + kk * 32 + lq * 8);
#pragma unroll
                for (int j = 0; j < 2; ++j) bf[j] = *(const bf16x8*)(Sb + ((2 * w + j) * 16 + lr) * 72 + kk * 32 + lq * 8);
#pragma unroll
                for (int i = 0; i < 2; ++i)
#pragma unroll
                    for (int j = 0; j < 2; ++j) acc[i][j] = MFMA16(af[i], bf[j], acc[i][j]);
            }
            {
                bf16x8 af[2], bf[2];
#pragma unroll
                for (int i = 0; i < 2; ++i) af[i] = *(const bf16x8*)(Ps + (i * 16 + lr) * 40 + lq * 8);
#pragma unroll
                for (int j = 0; j < 2; ++j) bf[j] = *(const bf16x8*)(Vt + ((2 * w + j) * 16 + lr) * 40 + lq * 8);
#pragma unroll
                for (int i = 0; i < 2; ++i)
#pragma unroll
                    for (int j = 0; j < 2; ++j) acc[i][j] = MFMA16(af[i], bf[j], acc[i][j]);
            }
#pragma unroll
            for (int i = 0; i < 2; ++i)
#pragma unroll
                for (int r = 0; r < 4; ++r) {
                    const int t = i * 16 + lq * 4 + r;
                    const int n = dir ? nlo + 31 - t : nlo + t;
                    bf16_t* orow = p.mixh + ((size_t)dir * TL + rowbase + n) * 1024 + 512 + h * 128;
#pragma unroll
                    for (int j = 0; j < 2; ++j) orow[(2 * w + j) * 16 + lr] = f2bf(acc[i][j][r]);
                }
        }
        __syncthreads();
        {
            float rs[4];
#pragma unroll
            for (int r = 0; r < 4; ++r) rs[r] = __expf(bc[31 * 64 + w * 16 + lq * 4 + r]);
            const bf16x8 af = *(const bf16x8*)(Kwt + (w * 16 + lr) * 40 + lq * 8);
#pragma unroll
            for (int j = 0; j < 8; ++j) {
                const bf16x8 bf = *(const bf16x8*)(Vt + (j * 16 + lr) * 40 + lq * 8);
#pragma unroll
                for (int r = 0; r < 4; ++r) S[j][r] *= rs[r];
                S[j] = MFMA16(af, bf, S[j]);
                uint2 pk; pk.x = pack2(S[j][0], S[j][1]); pk.y = pack2(S[j][2], S[j][3]);
                *(uint2*)(Sb + (j * 16 + lr) * 72 + w * 16 + lq * 4) = pk;
            }
        }
        __syncthreads();
    }
}
#undef GLA_PREFETCH

__device__ void phase_mlprep(const Params& p, int bid, int nblk) {
    const int tidx_ = opaque_tid();
    const int lane = tidx_ & 63;
    const int gw = bid * (NT / 64) + (tidx_ >> 6), nw = nblk * (NT / 64);
    const int c0 = lane * 16;
    float w0[16], w1[16], w2[16];
#pragma unroll
    for (int j = 0; j < 16; ++j) { w0[j] = p.conv_w[c0 + j]; w1[j] = p.conv_w[1024 + c0 + j]; w2[j] = p.conv_w[2048 + c0 + j]; }
    const float scl = c0 >= 512 ? 0.08838834764831845f : 1.f;
    constexpr int R = 2;
    for (int row0 = TL + gw; row0 < TT; row0 += R * nw) {
        u32x4 cc[R][2], ll[R][2], rr[R][2];
#pragma unroll
        for (int r = 0; r < R; ++r) {
            const int row = min(row0 + r * nw, TT - 1);
            const bool lat = row < TL;
            const int n = lat ? (row & (SEQ - 1)) : ((row - TL) & (CTX - 1));
            const bool vl = lat ? ((n & 63) != 0) : (n != 0);
            const bool vr = lat ? ((n & 63) != 63) : (n != CTX - 1);
            const bf16_t* zc = p.z + (size_t)row * ZS + c0;
#pragma unroll
            for (int q = 0; q < 2; ++q) {
                cc[r][q] = *(const u32x4*)(zc + 8 * q);
                ll[r][q] = vl ? *(const u32x4*)(zc - ZS + 8 * q) : (u32x4){0u, 0u, 0u, 0u};
                rr[r][q] = vr ? *(const u32x4*)(zc + ZS + 8 * q) : (u32x4){0u, 0u, 0u, 0u};
            }
        }
#pragma unroll
        for (int r = 0; r < R; ++r) {
            const int row = row0 + r * nw;
            unsigned o[8];
#pragma unroll
            for (int q = 0; q < 2; ++q)
#pragma unroll
                for (int j = 0; j < 4; ++j) {
                    const int e = q * 8 + 2 * j;
                    const float y0 = w0[e] * lo2f(ll[r][q][j]) + w1[e] * lo2f(cc[r][q][j]) + w2[e] * lo2f(rr[r][q][j]);
                    const float y1 = w0[e + 1] * hi2f(ll[r][q][j]) + w1[e + 1] * hi2f(cc[r][q][j]) + w2[e + 1] * hi2f(rr[r][q][j]);
                    o[q * 4 + j] = pack2(silu(y0) * scl, silu(y1) * scl);
                }
            if (row < TT) {
                u32x4* dst = (u32x4*)(p.hbuf + (size_t)row * 1024 + c0);
                dst[0] = (u32x4){o[0], o[1], o[2], o[3]}; dst[1] = (u32x4){o[4], o[5], o[6], o[7]};
            }
        }
    }
}

__device__ void phase_mixers(const Params& p, char* smem, int bid, int nblk) {
    const int tidx_ = opaque_tid();
    const int sub = __builtin_amdgcn_readfirstlane(tidx_ >> 8), stid = tidx_ & 255;
#if MIX_SAMEKIND
    for (int pr = bid; pr < 256; pr += nblk) {
        const bool isml = pr < 128;
        const int it = ((pr & 127) << 1) + sub;
        const int b = it >> 3, h = (it >> 1) & 3, dir = it & 1;
        if (isml) { if (sub == 0) mlstm_item_chunked<0>(p, smem, stid, b, h, dir); else mlstm_item_chunked<81920>(p, smem, stid, b, h, dir); }
        else { if (sub == 0) gla_item_chunked<0>(p, smem, stid, b, h, dir); else gla_item_chunked<81920>(p, smem, stid, b, h, dir); }
        __syncthreads();
    }
#else
    for (int it = bid; it < 256; it += nblk) {
        const int b = it >> 3, h = (it >> 1) & 3, dir = it & 1;
        if (sub == 0) mlstm_item_chunked<0>(p, smem, stid, b, h, dir);
        else gla_item_chunked<81920>(p, smem, stid, b, h, dir);
        __syncthreads();
    }
#endif
}

__device__ void phase_mixprep(const Params& p, int bid, int nblk) {
    const int tidx_ = opaque_tid();
    const int lane = tidx_ & 63;
    const int gw = bid * (NT / 64) + (tidx_ >> 6), nw = nblk * (NT / 64);
    const int c0 = lane * 16;
    const float* gn = c0 < 512 ? p.ml_norm_g + c0 : p.gla_norm_g + (c0 - 512);
    float gnv[16];
#pragma unroll
    for (int j = 0; j < 16; ++j) gnv[j] = gn[j];
    constexpr int R = 4;
    for (int row0 = gw; row0 < TL; row0 += R * nw) {
        u32x4 u0[R][2], u1[R][2], ug[R][2];
#pragma unroll
        for (int r = 0; r < R; ++r) {
            const int row = min(row0 + r * nw, TL - 1);
            const u32x4* a0 = (const u32x4*)(p.mixh + (size_t)row * 1024 + c0);
            const u32x4* a1 = (const u32x4*)(p.mixh + ((size_t)TL + row) * 1024 + c0);
            const u32x4* gp = (const u32x4*)(p.z + (size_t)row * ZS + (c0 < 512 ? C_MLO + c0 : C_GR + (c0 - 512)));
#pragma unroll
            for (int q = 0; q < 2; ++q) { u0[r][q] = a0[q]; u1[r][q] = a1[q]; ug[r][q] = gp[q]; }
        }
#pragma unroll
        for (int r = 0; r < R; ++r) {
            const int row = row0 + r * nw;
            float sv[16], gt[16];
#pragma unroll
            for (int q = 0; q < 2; ++q)
#pragma unroll
                for (int j = 0; j < 4; ++j) {
                    sv[q * 8 + 2 * j] = lo2f(u0[r][q][j]) + lo2f(u1[r][q][j]); sv[q * 8 + 2 * j + 1] = hi2f(u0[r][q][j]) + hi2f(u1[r][q][j]);
                    gt[q * 8 + 2 * j] = lo2f(ug[r][q][j]); gt[q * 8 + 2 * j + 1] = hi2f(ug[r][q][j]);
                }
            float ss = 0.f;
#pragma unroll
            for (int j = 0; j < 16; ++j) ss += sv[j] * sv[j];
            ss += dppx<0xB1>(ss); ss += dppx<0x4E>(ss); ss += dppx<0x141>(ss);
            const float rstd = rsqrtf(ss * (1.f / 128.f) + EPS);
            unsigned o[8];
#pragma unroll
            for (int j = 0; j < 8; ++j) {
                float y0, y1;
                const float g0 = gt[2 * j], g1 = gt[2 * j + 1];
                if (c0 < 512) { y0 = sigm(g0); y1 = sigm(g1); } else { y0 = silu(g0); y1 = silu(g1); }
                y0 *= sv[2 * j] * rstd * gnv[2 * j]; y1 *= sv[2 * j + 1] * rstd * gnv[2 * j + 1];
                o[j] = pack2(y0, y1);
            }
            if (row < TL) {
                u32x4* dst = (u32x4*)(p.hbuf + (size_t)row * D + c0);
                dst[0] = (u32x4){o[0], o[1], o[2], o[3]}; dst[1] = (u32x4){o[4], o[5], o[6], o[7]};
            }
        }
    }
}

__device__ void phase_norm2(const Params& p, int bid, int nblk) {
    const int tidx_ = opaque_tid();
    const int lane = tidx_ & 63, gw = bid * (NT / 64) + (tidx_ >> 6), nw = nblk * (NT / 64);
    for (int sp = gw; sp < TL / 32; sp += nw)
        norm_span<4, true>(p.x + (size_t)sp * 32 * D, p.ybuf + (size_t)sp * 32 * D, p.norm2_g, p.mod + (sp >> 6) * 6144, 4096, 3072, p.hbuf + (size_t)sp * 32 * D, 32, lane);
}

__device__ __forceinline__ unsigned fkey(float f) { const unsigned u = __float_as_uint(f); return (u & 0x80000000u) ? ~u : (u | 0x80000000u); }
__device__ __forceinline__ int mbcnt64(unsigned long long m) { return __builtin_amdgcn_mbcnt_hi((unsigned)(m >> 32), __builtin_amdgcn_mbcnt_lo((unsigned)m, 0)); }
#define LDS_FENCE() asm volatile("s_waitcnt lgkmcnt(0)" ::: "memory")

template <int NV>
__device__ __forceinline__ void wave_top16(const float (&val)[NV], const int (&tag)[NV], float* outv, int* outt) {
    unsigned u[NV];
#pragma unroll
    for (int v = 0; v < NV; ++v) u[v] = fkey(val[v]);
    unsigned T = 0;
    for (int bit = 31; bit >= 0; --bit) {
        const unsigned cand = T | (1u << bit);
        int cnt = 0;
#pragma unroll
        for (int v = 0; v < NV; ++v) cnt += __popcll(__ballot(u[v] >= cand));
        if (cnt >= 16) T = cand;
    }
    int base = 0;
#pragma unroll
    for (int v = 0; v < NV; ++v) {
        const bool gt = u[v] > T;
        const unsigned long long mk = __ballot(gt);
        const int pos = base + mbcnt64(mk);
        if (gt) { outv[pos] = val[v]; outt[pos] = tag[v]; }
        base += __popcll(mk);
    }
#pragma unroll
    for (int v = 0; v < NV; ++v) {
        const bool eq = u[v] == T;
        const unsigned long long mk = __ballot(eq);
        const int pos = base + mbcnt64(mk);
        if (eq && pos < 16) { outv[pos] = val[v]; outt[pos] = tag[v]; }
        base += __popcll(mk);
    }
}

template <int NV>
__device__ __forceinline__ void wave_top16_bisect(const float (&val)[NV], const int (&tag)[NV], float* outv, int* outt) {
    float mx = val[0], mn = val[0];
#pragma unroll
    for (int v = 1; v < NV; ++v) { mx = fmaxf(mx, val[v]); mn = fminf(mn, val[v]); }
    float hi = wave_max_fast(mx), lo = -wave_max_fast(-mn);
    float mid = 0.f; bool ok = false;
    for (int it = 0; it < 40; ++it) {
        mid = 0.5f * (lo + hi);
        int cnt = 0;
#pragma unroll
        for (int v = 0; v < NV; ++v) cnt += __popcll(__ballot(val[v] > mid));
        if (cnt == 16) { ok = true; break; }
        if (cnt > 16) lo = mid; else hi = mid;
    }
    if (!ok) { wave_top16<NV>(val, tag, outv, outt); return; }
    int base = 0;
#pragma unroll
    for (int v = 0; v < NV; ++v) {
        const bool gt = val[v] > mid;
        const unsigned long long mk = __ballot(gt);
        const int pos = base + mbcnt64(mk);
        if (gt) { outv[pos] = val[v]; outt[pos] = tag[v]; }
        base += __popcll(mk);
    }
}

template <int CTRL> __device__ __forceinline__ unsigned dppu(unsigned x) { return __builtin_amdgcn_update_dpp(0u, x, CTRL, 0xf, 0xf, false); }
__device__ __forceinline__ unsigned row_max16u(unsigned x) { x = max(x, dppu<0x128>(x)); x = max(x, dppu<0x124>(x)); x = max(x, dppu<0x4E>(x)); return max(x, dppu<0xB1>(x)); }
__device__ __forceinline__ float row_max16(float x) { x = fmaxf(x, dppx<0x128>(x)); x = fmaxf(x, dppx<0x124>(x)); x = fmaxf(x, dppx<0x4E>(x)); return fmaxf(x, dppx<0xB1>(x)); }
__device__ __forceinline__ float row_sum16(float x) { x += dppx<0x128>(x); x += dppx<0x124>(x); x += dppx<0x4E>(x); return x + dppx<0xB1>(x); }
__device__ __forceinline__ unsigned key_of(float v, unsigned tag) { const unsigned b = (__float_as_uint(v) & 0xffffff00u) | tag; return (b & 0x80000000u) ? ~b : (b | 0x80000000u); }
__device__ __forceinline__ unsigned bits_of_key(unsigned k) { return (k & 0x80000000u) ? (k & 0x7fffffffu) : ~k; }
#define CE_DESC(i, j) do { const unsigned hi_ = max(u[i], u[j]), lo_ = min(u[i], u[j]); u[i] = hi_; u[j] = lo_; } while (0)
template <int N>
__device__ __forceinline__ unsigned tournament16(unsigned (&u)[N], int lr) {
    unsigned res = 0u;
#pragma unroll
    for (int k = 0; k < 16; ++k) {
        const unsigned m = row_max16u(u[0]);
        const bool wn = (u[0] == m);
        res = (lr == k) ? m : res;
#pragma unroll
        for (int i = 0; i < N - 1; ++i) u[i] = wn ? u[i + 1] : u[i];
        u[N - 1] = wn ? 0u : u[N - 1];
    }
    return res;
}

template <int N>
__device__ __forceinline__ void tournament16x2(unsigned (&ua)[N], unsigned (&ub)[N], int lr, unsigned& ra, unsigned& rb) {
    ra = 0u; rb = 0u;
#pragma unroll
    for (int k = 0; k < 16; ++k) {
        const unsigned ma = row_max16u(ua[0]), mb = row_max16u(ub[0]);
        const bool wa = (ua[0] == ma), wb = (ub[0] == mb);
        ra = (lr == k) ? ma : ra; rb = (lr == k) ? mb : rb;
#pragma unroll
        for (int i = 0; i < N - 1; ++i) { ua[i] = wa ? ua[i + 1] : ua[i]; ub[i] = wb ? ub[i + 1] : ub[i]; }
        ua[N - 1] = wa ? 0u : ua[N - 1]; ub[N - 1] = wb ? 0u : ub[N - 1];
    }
}
#define SORT8_DESC() do { CE_DESC(0, 1); CE_DESC(2, 3); CE_DESC(4, 5); CE_DESC(6, 7); CE_DESC(0, 2); CE_DESC(1, 3); CE_DESC(4, 6); CE_DESC(5, 7); CE_DESC(1, 2); CE_DESC(5, 6); \
        CE_DESC(0, 4); CE_DESC(1, 5); CE_DESC(2, 6); CE_DESC(3, 7); CE_DESC(2, 4); CE_DESC(3, 5); CE_DESC(1, 2); CE_DESC(3, 4); CE_DESC(5, 6); } while (0)

__device__ void phase_topk(const Params& p, char* smem, int bid, int nblk) {
    const int tidx_ = opaque_tid();
    const int tid = tidx_, lane = tid & 63, w = __builtin_amdgcn_readfirstlane(tid >> 6), lr = lane & 15, lq = lane >> 4;
    constexpr int SS = 260;
    constexpr int WS = 16 * SS + 512;
    float* sc = (float*)smem + w * WS;
    float* tv = sc + 16 * SS + lq * 64;
    int* ti = (int*)(tv + 32);
    for (int item = bid; item < (TL / (NT / 4)) * 8; item += nblk) {
        const int ph = item & 7, t0 = (item >> 3) * (NT / 4) + w * 16;
#pragma unroll
        for (int hh = 0; hh < 2; ++hh) {
            bf16x8 af[4];
#pragma unroll
            for (int kk = 0; kk < 4; ++kk) af[kk] = *(const bf16x8*)(p.qbuf + (size_t)(t0 + lr) * 2048 + ph * 256 + hh * 128 + kk * 32 + lq * 8);
            const bf16_t* kb = p.keysb + (size_t)((ph * 2 + hh) * 128 + lr) * 128 + lq * 8;
            f32x4 acc[8];
            bf16x8 b0[4], b1[4];
#pragma unroll
            for (int kk = 0; kk < 4; ++kk) b0[kk] = *(const bf16x8*)(kb + kk * 32);
#pragma unroll
            for (int n = 0; n < 8; n += 2) {
#pragma unroll
                for (int kk = 0; kk < 4; ++kk) b1[kk] = *(const bf16x8*)(kb + (n + 1) * 16 * 128 + kk * 32);
                acc[n] = (f32x4){0.f, 0.f, 0.f, 0.f};
#pragma unroll
                for (int kk = 0; kk < 4; ++kk) acc[n] = MFMA16(af[kk], b0[kk], acc[n]);
                if (n + 2 < 8) {
#pragma unroll
                    for (int kk = 0; kk < 4; ++kk) b0[kk] = *(const bf16x8*)(kb + (n + 2) * 16 * 128 + kk * 32);
                }
                acc[n + 1] = (f32x4){0.f, 0.f, 0.f, 0.f};
#pragma unroll
                for (int kk = 0; kk < 4; ++kk) acc[n + 1] = MFMA16(af[kk], b1[kk], acc[n + 1]);
            }
#pragma unroll
            for (int n = 0; n < 8; ++n)
#pragma unroll
                for (int r = 0; r < 4; ++r) sc[(lq * 4 + r) * SS + hh * 128 + n * 16 + lr] = acc[n][r];
        }
        LDS_FENCE();
        for (int ps2 = 0; ps2 < 2; ++ps2) {
            float a0[2];
#pragma unroll
            for (int pp = 0; pp < 2; ++pp) {
                const int tt = (ps2 * 2 + pp) * 4 + lq;
                float* tvp = tv + pp * 256; int* tip = ti + pp * 256;
                unsigned ua[8], ub[8];
#pragma unroll
                for (int j = 0; j < 8; ++j) { ua[j] = key_of(sc[tt * SS + lr + 16 * j], 255u - (unsigned)(lr + 16 * j)); ub[j] = key_of(sc[tt * SS + 128 + lr + 16 * j], 255u - (unsigned)(lr + 16 * j)); }
                { unsigned (&u)[8] = ua; SORT8_DESC(); }
                { unsigned (&u)[8] = ub; SORT8_DESC(); }
                unsigned ra, rb;
                tournament16x2<8>(ua, ub, lr, ra, rb);
                const unsigned ba = bits_of_key(ra), bb = bits_of_key(rb);
                a0[pp] = __uint_as_float(ba);
                tvp[lr] = __uint_as_float(ba); tip[lr] = 255 - (int)(ba & 0xffu);
                tvp[16 + lr] = __uint_as_float(bb); tip[16 + lr] = 255 - (int)(bb & 0xffu);
            }
            LDS_FENCE();
            unsigned ca[16], cb2[16];
#pragma unroll
            for (int pp = 0; pp < 2; ++pp) {
                const float* tvp = tv + pp * 256;
                const f32x4 b0 = *(const f32x4*)(tvp + 16), b1 = *(const f32x4*)(tvp + 20), b2 = *(const f32x4*)(tvp + 24), b3 = *(const f32x4*)(tvp + 28);
                const float bj[16] = {b0[0], b0[1], b0[2], b0[3], b1[0], b1[1], b1[2], b1[3], b2[0], b2[1], b2[2], b2[3], b3[0], b3[1], b3[2], b3[3]};
#pragma unroll
                for (int j = 0; j < 16; ++j) { const unsigned kx = key_of(a0[pp] + bj[j], 255u - (unsigned)(lr * 16 + j)); if (pp == 0) ca[j] = kx; else cb2[j] = kx; }
            }
            unsigned rca, rcb;
            tournament16x2<16>(ca, cb2, lr, rca, rcb);
#pragma unroll
            for (int pp = 0; pp < 2; ++pp) {
                const int t = t0 + (ps2 * 2 + pp) * 4 + lq;
                const int* tip = ti + pp * 256;
                const unsigned cb = bits_of_key(pp == 0 ? rca : rcb);
                const float sv = __uint_as_float(cb);
                const int tag = 255 - (int)(cb & 0xffu);
                const int idx = tip[tag >> 4] * 128 + tip[16 + (tag & 15)];
                const float mx = row_max16(sv);
                const float ev = __expf(sv - mx);
                const float sm = row_sum16(ev);
                p.pidx[(size_t)t * 128 + ph * 16 + lr] = idx;
                p.pgw[(size_t)t * 128 + ph * 16 + lr] = ev / sm;
            }
            LDS_FENCE();
        }
    }
    __syncthreads();
}

typedef float f32x2 __attribute__((ext_vector_type(2)));
template <int CTRL> __device__ __forceinline__ float dppf(float x) {
    return __uint_as_float(__builtin_amdgcn_update_dpp(0u, __float_as_uint(x), CTRL, 0xf, 0xf, false));
}
__device__ __forceinline__ float red4(float a, float b, float c, float d) {
    auto r = __builtin_amdgcn_permlane32_swap(__float_as_uint(a), __float_as_uint(b), false, false);
    const float ab = __uint_as_float(r[0]) + __uint_as_float(r[1]);
    auto q = __builtin_amdgcn_permlane32_swap(__float_as_uint(c), __float_as_uint(d), false, false);
    const float cd = __uint_as_float(q[0]) + __uint_as_float(q[1]);
    auto s = __builtin_amdgcn_permlane16_swap(__float_as_uint(ab), __float_as_uint(cd), false, false);
    float x = __uint_as_float(s[0]) + __uint_as_float(s[1]);
    x += dppf<0x128>(x); x += dppf<0x124>(x); x += dppf<0x4E>(x); x += dppf<0xB1>(x);
    return x;
}
typedef unsigned u32x3 __attribute__((ext_vector_type(3)));
typedef unsigned u32x6 __attribute__((ext_vector_type(6)));
typedef float f32x32 __attribute__((ext_vector_type(32)));
#ifndef GP
#define GP 4
#endif
struct GB { unsigned a[GP], b[GP], c[GP]; };
__device__ __forceinline__ f32x32 dec32(unsigned a0, unsigned a1, unsigned a2, unsigned b0, unsigned b1, unsigned b2) {
    const u32x6 sv = (u32x6){a0, a1, a2, b0, b1, b2};
    return __builtin_amdgcn_cvt_scalef32_pk32_f32_fp6(sv, 1.0f);
}
__device__ __forceinline__ void gloadN(GB& buf, const __amdgpu_buffer_rsrc_t tab, int idxreg, int j0, int lane) {
#pragma unroll
    for (int jj = 0; jj < GP; ++jj) {
        const int e = __builtin_amdgcn_readlane(idxreg, j0 + jj);
        const u32x3 t3 = __builtin_amdgcn_raw_buffer_load_b96(tab, lane * 12, e * 768, 0);
        buf.a[jj] = t3[0]; buf.b[jj] = t3[1]; buf.c[jj] = t3[2];
    }
}
__device__ __forceinline__ float gdotsN(const GB& buf, const float (&hv)[16], float d, int j0, int lane) {
    int di = __float_as_int(d);
    f32x2 hv2[8];
#pragma unroll
    for (int k = 0; k < 8; ++k) hv2[k] = (f32x2){hv[2 * k], hv[2 * k + 1]};
    float chain0 = 0.f, chain1 = 0.f;
#pragma unroll
    for (int q = 0; q < GP / 4; ++q) {
        float pt[4];
#pragma unroll
        for (int h2 = 0; h2 < 2; ++h2) {
            const int jj = 4 * q + 2 * h2;
            unsigned w0 = buf.a[jj];
            asm volatile("" : "+v"(w0) : "v"(h2 ? chain1 : chain0));
            const f32x32 f = dec32(w0, buf.b[jj], buf.c[jj], buf.a[jj + 1], buf.b[jj + 1], buf.c[jj + 1]);
            f32x2 a0 = (f32x2){0.f, 0.f}, a1 = a0, c0 = a0, c1 = a0;
#pragma unroll
            for (int k = 0; k < 8; k += 2) {
                a0 += (f32x2){f[2 * k], f[2 * k + 1]} * hv2[k];           a1 += (f32x2){f[2 * k + 2], f[2 * k + 3]} * hv2[k + 1];
                c0 += (f32x2){f[16 + 2 * k], f[16 + 2 * k + 1]} * hv2[k]; c1 += (f32x2){f[16 + 2 * k + 2], f[16 + 2 * k + 3]} * hv2[k + 1];
            }
            const f32x2 as = a0 + a1, cs = c0 + c1;
            pt[2 * h2] = as[0] + as[1]; pt[2 * h2 + 1] = cs[0] + cs[1];
            if (h2) chain1 = pt[2 * h2 + 1]; else chain0 = pt[2 * h2 + 1];
        }
        const float x0 = red4(pt[0], pt[1], pt[2], pt[3]);
        di = (lane == j0 + 4 * q + 0) ? __builtin_amdgcn_readlane(__float_as_int(x0), 0) : di;
        di = (lane == j0 + 4 * q + 1) ? __builtin_amdgcn_readlane(__float_as_int(x0), 32) : di;
        di = (lane == j0 + 4 * q + 2) ? __builtin_amdgcn_readlane(__float_as_int(x0), 16) : di;
        di = (lane == j0 + 4 * q + 3) ? __builtin_amdgcn_readlane(__float_as_int(x0), 48) : di;
    }
    return __int_as_float(di);
}
__device__ __forceinline__ void gaxpyN(const GB& buf, float coef, f32x2 (&acc)[8], int j0) {
    float mk0 = 0.f, mk1 = 0.f;
#pragma unroll
    for (int jj = 0; jj < GP; jj += 2) {
        const float c0 = __int_as_float(__builtin_amdgcn_readlane(__float_as_int(coef), j0 + jj));
        const float c1 = __int_as_float(__builtin_amdgcn_readlane(__float_as_int(coef), j0 + jj + 1));
        unsigned w0 = buf.a[jj];
        asm volatile("" : "+v"(w0) : "v"((jj & 2) ? mk1 : mk0));
        const f32x32 f = dec32(w0, buf.b[jj], buf.c[jj], buf.a[jj + 1], buf.b[jj + 1], buf.c[jj + 1]);
        const f32x2 c02 = (f32x2){c0, c0}, c12 = (f32x2){c1, c1};
#pragma unroll
        for (int k = 0; k < 8; ++k) acc[k] += c02 * (f32x2){f[2 * k], f[2 * k + 1]} + c12 * (f32x2){f[16 + 2 * k], f[16 + 2 * k + 1]};
        if (jj & 2) mk1 = acc[7][1]; else mk0 = acc[7][1];
    }
}
__device__ __forceinline__ float gather_dots(const __amdgpu_buffer_rsrc_t tab, int idxreg, const float (&hv)[16], int lane) {
    float d = 0.f;
    GB bufA, bufB;
    constexpr int NG = 64 / GP;
    gloadN(bufA, tab, idxreg, 0, lane);
#pragma unroll 1
    for (int g = 0; g < NG; g += 2) {
        gloadN(bufB, tab, idxreg, (g + 1) * GP, lane);
        d = gdotsN(bufA, hv, d, g * GP, lane);
        gloadN(bufA, tab, idxreg, ((g + 2) & (NG - 1)) * GP, lane);
        d = gdotsN(bufB, hv, d, (g + 1) * GP, lane);
    }
    return d;
}
__device__ __forceinline__ void gather_axpy(const __amdgpu_buffer_rsrc_t tab, int idxreg, float coef, f32x2 (&acc)[8], int lane) {
    GB bufA, bufB;
    constexpr int NG = 64 / GP;
    gloadN(bufA, tab, idxreg, 0, lane);
#pragma unroll 1
    for (int g = 0; g < NG; g += 2) {
        gloadN(bufB, tab, idxreg, (g + 1) * GP, lane);
        gaxpyN(bufA, coef, acc, g * GP);
        gloadN(bufA, tab, idxreg, ((g + 2) & (NG - 1)) * GP, lane);
        gaxpyN(bufB, coef, acc, (g + 1) * GP);
    }
}
__device__ __forceinline__ float gelu_exact(float x) { return 0.5f * x * (1.f + erff(x * 0.7071067811865476f)); }

__device__ void phase_gather(const Params& p, int bid, int nblk) {
    const int tidx_ = opaque_tid();
    const int lane = tidx_ & 63;
    const int gw = bid * (NT / 64) + (tidx_ >> 6), nw = nblk * (NT / 64);
    const __amdgpu_buffer_rsrc_t ursrc = __builtin_amdgcn_make_buffer_rsrc((void*)p.u8, (short)0, 16384 * 768, 0x00020000);
    const __amdgpu_buffer_rsrc_t vrsrc = __builtin_amdgcn_make_buffer_rsrc((void*)p.v8, (short)0, 16384 * 768, 0x00020000);
    for (int t = gw; t < TL; t += nw) {
        float hv[16];
        {
            const u32x4 h0 = *(const u32x4*)(p.hbuf + (size_t)t * D + lane * 16), h1 = *(const u32x4*)(p.hbuf + (size_t)t * D + lane * 16 + 8);
#pragma unroll
            for (int q = 0; q < 4; ++q) { hv[2 * q] = lo2f(h0[q]); hv[2 * q + 1] = hi2f(h0[q]); hv[8 + 2 * q] = lo2f(h1[q]); hv[8 + 2 * q + 1] = hi2f(h1[q]); }
        }
        const int ia = p.pidx[(size_t)t * 128 + lane], ib = p.pidx[(size_t)t * 128 + 64 + lane];
        const float ga = p.pgw[(size_t)t * 128 + lane], gb = p.pgw[(size_t)t * 128 + 64 + lane];
        const float usA = p.usc[ia], usB = p.usc[ib], vsA = p.vsc[ia], vsB = p.vsc[ib];
        const float dA = gather_dots(ursrc, ia, hv, lane);
        const float dB = gather_dots(ursrc, ib, hv, lane);
        const float cA = gelu_exact(dA * usA) * ga * vsA, cB = gelu_exact(dB * usB) * gb * vsB;
        f32x2 acc2[8];
#pragma unroll
        for (int j = 0; j < 8; ++j) acc2[j] = (f32x2){0.f, 0.f};
        gather_axpy(vrsrc, ia, cA, acc2, lane);
        gather_axpy(vrsrc, ib, cB, acc2, lane);
        float acc[16];
#pragma unroll
        for (int j = 0; j < 8; ++j) { acc[2 * j] = acc2[j][0]; acc[2 * j + 1] = acc2[j][1]; }
        float* orow = p.out + (size_t)t * D + lane * 16;
        const float* xrow = p.x + (size_t)t * D + lane * 16;
        const float* g1 = p.mod + (t >> 11) * 6144 + 2048 + lane * 16;
        const float* g2 = g1 + 3072;
        float yo[16];
        {
            const u32x4 y0 = *(const u32x4*)(p.ybuf + (size_t)t * D + lane * 16), y1 = *(const u32x4*)(p.ybuf + (size_t)t * D + lane * 16 + 8);
#pragma unroll
            for (int q = 0; q < 4; ++q) { yo[2 * q] = lo2f(y0[q]); yo[2 * q + 1] = hi2f(y0[q]); yo[8 + 2 * q] = lo2f(y1[q]); yo[8 + 2 * q + 1] = hi2f(y1[q]); }
        }
        float y[16]; float ss = 0.f;
#pragma unroll
        for (int q = 0; q < 4; ++q) {
            const f32x4 xv = *(const f32x4*)(xrow + 4 * q), gv = *(const f32x4*)(g2 + 4 * q), g1v = *(const f32x4*)(g1 + 4 * q);
#pragma unroll
            for (int k = 0; k < 4; ++k) { y[4 * q + k] = xv[k] + g1v[k] * yo[4 * q + k] + gv[k] * acc[4 * q + k]; ss += y[4 * q + k] * y[4 * q + k]; }
        }
        ss = wave_sum(ss);
        const float rstd = rsqrtf(ss * (1.f / 1024.f) + EPS);
#pragma unroll
        for (int q = 0; q < 4; ++q) {
            const f32x4 gf = *(const f32x4*)(p.norm_f_g + lane * 16 + 4 * q);
            *(f32x4*)(orow + 4 * q) = (f32x4){y[4 * q] * rstd * gf[0], y[4 * q + 1] * rstd * gf[1], y[4 * q + 2] * rstd * gf[2], y[4 * q + 3] * rstd * gf[3]};
        }
    }
}

extern __shared__ __attribute__((aligned(16))) char dyn_smem[];

__device__ __forceinline__ void run_phase(const Params& p, int ph, char* smem, int bid, int nblk) {
#ifdef ONLY_PHASE
    if (ph != ONLY_PHASE) return;
#endif
    switch (ph) {
        case 0: phase_mod(p, smem, bid, nblk); phase_convert(p, smem, bid, nblk); break;
        case 1: phase_norm1(p, bid, nblk); break;
        case 2: { EpiZ e{p.z, p.zg, p.gate_b, p.conv_w}; gemm_run(p.hbuf, p.winT, TT, PTP, 1024, e, smem, bid, nblk); } break;
        case 3: phase_mlprep(p, bid, nblk); break;
        case 4: phase_mixers(p, smem, bid, nblk); break;
        case 5: phase_mixprep(p, bid, nblk); break;
        case 6: { EpiY e{p.ybuf}; gemm_run(p.hbuf, p.woutT, TL, 1024, 1024, e, smem, bid, nblk); } break;
        case 7: phase_norm2(p, bid, nblk); break;
        case 8: { EpiQb e{p.qbuf}; gemm_run(p.hbuf, p.wqT, TL, 2048, 1024, e, smem, bid, nblk); } break;
        case 9: phase_topk(p, smem, bid, nblk); break;
        case 10: phase_gather(p, bid, nblk); break;
    }
}
#ifndef PHASE_MASK
#define PHASE_MASK 0x7ff
#endif
constexpr int NPHASE = 11;

__device__ __forceinline__ void grid_barrier(unsigned* counter, unsigned target) {
    __syncthreads();
    if (threadIdx.x == 0) {
        __builtin_amdgcn_fence(__ATOMIC_RELEASE, "agent");
        asm volatile("s_waitcnt vmcnt(0)" ::: "memory");
        __hip_atomic_fetch_add(counter, 1u, __ATOMIC_RELAXED, __HIP_MEMORY_SCOPE_AGENT);
        while (__hip_atomic_load(counter, __ATOMIC_RELAXED, __HIP_MEMORY_SCOPE_AGENT) < target) __builtin_amdgcn_s_sleep(2);
        __builtin_amdgcn_fence(__ATOMIC_ACQUIRE, "agent");
        asm volatile("s_waitcnt vmcnt(0)" ::: "memory");
    }
    __syncthreads();
}
#if FUSED
#ifndef PROBE_REPEAT_PHASE
#define PROBE_REPEAT_PHASE (-1)
#endif
__global__ void __launch_bounds__(NT, 2) mega_kernel(Params p) {
    cg::grid_group grid = cg::this_grid();
    unsigned nbar = 0;
#define RUN_PHASE(PH) do { int nrep_ = (PROBE_REPEAT_PHASE == (PH)) ? 2 : 1; asm volatile("" : "+s"(nrep_)); \
        for (int r_ = 0; r_ < nrep_; ++r_) { run_phase(p, (PH), dyn_smem, blockIdx.x, gridDim.x); \
            if ((PH) == 0 && r_ == 0) grid.sync();   \
            else if ((PH) + 1 < NPHASE || r_ + 1 < nrep_) { ++nbar; grid_barrier(p.bar, nbar * gridDim.x); } } } while (0)
    RUN_PHASE(0); RUN_PHASE(1); RUN_PHASE(2); RUN_PHASE(3); RUN_PHASE(4); RUN_PHASE(5); RUN_PHASE(6); RUN_PHASE(7); RUN_PHASE(8); RUN_PHASE(9); RUN_PHASE(10);
#undef RUN_PHASE
}
#else
template <int PH>
__global__ void __launch_bounds__(NT, 2) phase_kernel(Params p) { run_phase(p, PH, dyn_smem, blockIdx.x, gridDim.x); }
#endif

static inline char* carve(char*& cur, size_t bytes) { char* r = cur; cur += (bytes + 255) & ~(size_t)255; return r; }

extern "C" void kernel_launch(void* const* d_in, const int* in_sizes, int n_in, void* d_out, int out_size, void* d_ws, size_t ws_size, hipStream_t stream) {
    Params p{};
    p.x = (const float*)d_in[0]; p.c = (const float*)d_in[1]; p.ctx = (const float*)d_in[2]; p.c_ctx = (const float*)d_in[3];
    p.w_mod = (const float*)d_in[4]; p.b_mod = (const float*)d_in[5]; p.norm1_g = (const float*)d_in[6]; p.w_in = (const float*)d_in[7];
    p.conv_w = (const float*)d_in[8]; p.gate_b = (const float*)d_in[9]; p.ml_norm_g = (const float*)d_in[10]; p.lr_w2 = (const float*)d_in[11];
    p.alpha_b = (const float*)d_in[12]; p.gla_norm_g = (const float*)d_in[13]; p.w_out = (const float*)d_in[14]; p.norm2_g = (const float*)d_in[15];
    p.wq = (const float*)d_in[16]; p.keys = (const float*)d_in[17]; p.pu = (const float*)d_in[18]; p.pv = (const float*)d_in[19]; p.norm_f_g = (const float*)d_in[20];
    p.out = (float*)d_out;
    char* cur = (char*)d_ws;
    p.mod = (float*)carve(cur, (size_t)33 * 6144 * 4);
    p.winT = (bf16_t*)carve(cur, (size_t)PTP * 1024 * 2);
    p.woutT = (bf16_t*)carve(cur, (size_t)1024 * 1024 * 2);
    p.wqT = (bf16_t*)carve(cur, (size_t)2048 * 1024 * 2);
    p.keysb = (bf16_t*)carve(cur, (size_t)8 * 2 * 128 * 128 * 2);
    p.u8 = (unsigned char*)carve(cur, (size_t)16384 * 768);
    p.v8 = (unsigned char*)carve(cur, (size_t)16384 * 768);
    p.usc = (float*)carve(cur, (size_t)16384 * 4);
    p.vsc = (float*)carve(cur, (size_t)16384 * 4);
    p.hbuf = (bf16_t*)carve(cur, (size_t)TT * 1024 * 2);
    p.z = (bf16_t*)carve(cur, (size_t)TT * ZS * 2);
    p.zg = (float*)carve(cur, (size_t)TT * 48 * 4);
    p.mixh = (bf16_t*)carve(cur, (size_t)2 * TL * 1024 * 2);
    p.bar = (unsigned*)carve(cur, 256);
    p.qbuf = p.z;
    p.pidx = (int*)p.mixh;
    p.pgw = (float*)((char*)p.mixh + (size_t)TL * 128 * 4);
    p.ybuf = p.mixh + (size_t)TL * 1024;
    if ((size_t)(cur - (char*)d_ws) > ws_size) { fprintf(stderr, "workspace too small: need %zu have %zu\n", (size_t)(cur - (char*)d_ws), ws_size); return; }
#if FUSED
    static int grid_blocks = 0;
    if (!grid_blocks) {
        int dev = 0, cus = 0, per_cu = 0;
        hipGetDevice(&dev);
        hipDeviceGetAttribute(&cus, hipDeviceAttributeMultiprocessorCount, dev);
        hipFuncSetAttribute((const void*)mega_kernel, hipFuncAttributeMaxDynamicSharedMemorySize, SMEM_BYTES);
        hipOccupancyMaxActiveBlocksPerMultiprocessor(&per_cu, mega_kernel, NT, SMEM_BYTES);
        if (per_cu > 1) per_cu = 1;
        grid_blocks = cus * per_cu;
    }
    hipMemsetAsync(p.bar, 0, 256, stream);
    void* args[] = {&p};
    hipError_t e = hipLaunchCooperativeKernel((void*)mega_kernel, dim3(grid_blocks), dim3(NT), args, SMEM_BYTES, stream);
    if (e != hipSuccess) fprintf(stderr, "cooperative launch failed: %s (grid %d)\n", hipGetErrorString(e), grid_blocks);
#else
    const int G = 512;
#define LAUNCH(PH) do { hipFuncSetAttribute((const void*)phase_kernel<PH>, hipFuncAttributeMaxDynamicSharedMemorySize, SMEM_BYTES); \
        hipLaunchKernelGGL(phase_kernel<PH>, dim3(G), dim3(NT), SMEM_BYTES, stream, p); } while (0)
    LAUNCH(0); LAUNCH(1); LAUNCH(2); LAUNCH(3); LAUNCH(4); LAUNCH(5); LAUNCH(6); LAUNCH(7); LAUNCH(8); LAUNCH(9);
#endif
}
```

```cpp
#include <hip/hip_runtime.h>
#include <hip/hip_cooperative_groups.h>
#include <cstdio>
#include <cstdint>
namespace cg = cooperative_groups;

#ifndef FUSED
#define FUSED 1
#endif
#ifndef MIX_SAMEKIND
#define MIX_SAMEKIND 0
#endif
#ifndef ML_CHUNKED
#define ML_CHUNKED 1
#endif
#ifndef GLA_CHUNKED
#define GLA_CHUNKED 1
#endif

typedef unsigned short bf16_t;
typedef short bf16x8 __attribute__((ext_vector_type(8)));
typedef float f32x4 __attribute__((ext_vector_type(4)));
typedef unsigned u32x4 __attribute__((ext_vector_type(4)));

constexpr int D = 1024, NB = 32, SEQ = 2048, CTX = 256;
constexpr int TL = NB * SEQ;
constexpr int TC = NB * CTX;
constexpr int TT = TL + TC;
constexpr int PT = 3632;
constexpr int PTP = 3840;
constexpr int ZS = 3632;
constexpr int C_MLQ = 0, C_MLK = 512, C_MLV = 1024, C_MLO = 1536, C_MLG = 2048, C_GQ = 2064, C_GK = 2320, C_GV = 2576, C_GR = 3088, C_LR = 3600;
constexpr int NT = 512;
constexpr int SMEM_BYTES = 160 * 1024;
constexpr float EPS = 1e-6f;

struct Params {
    const float *x, *c, *ctx, *c_ctx, *w_mod, *b_mod, *norm1_g, *w_in, *conv_w, *gate_b, *ml_norm_g, *lr_w2, *alpha_b, *gla_norm_g,
        *w_out, *norm2_g, *wq, *keys, *pu, *pv, *norm_f_g;
    float* out;
    float* mod;
    bf16_t* winT;
    bf16_t* woutT;
    bf16_t* wqT;
    bf16_t* keysb;
    unsigned char* u8;
    unsigned char* v8;
    float* usc;
    float* vsc;
    bf16_t* hbuf;
    bf16_t* z;
    float* zg;
    bf16_t* mixh;
    bf16_t* qbuf;
    int* pidx;
    float* pgw;
    bf16_t* ybuf;
    unsigned* bar;
};

__device__ __forceinline__ int opaque_tid() { int t = threadIdx.x; asm volatile("" : "+v"(t)); return t; }
__device__ __forceinline__ float bf2f(bf16_t v) { return __uint_as_float(((unsigned)v) << 16); }
__device__ __forceinline__ bf16_t f2bf(float f) { unsigned u = __float_as_uint(f); u += 0x7fffu + ((u >> 16) & 1u); return (bf16_t)(u >> 16); }
__device__ __forceinline__ unsigned pack2(float a, float b) { return (unsigned)f2bf(a) | ((unsigned)f2bf(b) << 16); }
__device__ __forceinline__ float lo2f(unsigned w) { return __uint_as_float(w << 16); }
__device__ __forceinline__ float hi2f(unsigned w) { return __uint_as_float(w & 0xffff0000u); }
__device__ __forceinline__ float wave_sum(float v) {
#pragma unroll
    for (int o = 32; o > 0; o >>= 1) v += __shfl_xor(v, o);
    return v;
}
__device__ __forceinline__ float wave_max(float v) {
#pragma unroll
    for (int o = 32; o > 0; o >>= 1) v = fmaxf(v, __shfl_xor(v, o));
    return v;
}
template <int CTRL> __device__ __forceinline__ float dppx(float x) {
    return __uint_as_float(__builtin_amdgcn_update_dpp(0u, __float_as_uint(x), CTRL, 0xf, 0xf, false));
}
__device__ __forceinline__ float wave_max_fast(float x) {
    x = fmaxf(x, dppx<0x128>(x)); x = fmaxf(x, dppx<0x124>(x)); x = fmaxf(x, dppx<0x4E>(x)); x = fmaxf(x, dppx<0xB1>(x));
    auto s = __builtin_amdgcn_permlane16_swap(__float_as_uint(x), __float_as_uint(x), false, false);
    x = fmaxf(__uint_as_float(s[0]), __uint_as_float(s[1]));
    auto t = __builtin_amdgcn_permlane32_swap(__float_as_uint(x), __float_as_uint(x), false, false);
    return fmaxf(__uint_as_float(t[0]), __uint_as_float(t[1]));
}
__device__ __forceinline__ float wave_sum_fast(float x) {
    x += dppx<0x128>(x); x += dppx<0x124>(x); x += dppx<0x4E>(x); x += dppx<0xB1>(x);
    auto s = __builtin_amdgcn_permlane16_swap(__float_as_uint(x), __float_as_uint(x), false, false);
    x = __uint_as_float(s[0]) + __uint_as_float(s[1]);
    auto t = __builtin_amdgcn_permlane32_swap(__float_as_uint(x), __float_as_uint(x), false, false);
    return __uint_as_float(t[0]) + __uint_as_float(t[1]);
}
__device__ __forceinline__ float logsig(float x) { return fminf(x, 0.f) - __logf(1.f + __expf(-fabsf(x))); }
__device__ __forceinline__ float silu(float x) { return x / (1.f + __expf(-x)); }
__device__ __forceinline__ float sigm(float x) { return 1.f / (1.f + __expf(-x)); }

namespace pg8 {
#define PG8_LAS __attribute__((address_space(3)))
typedef unsigned short bf16_t;
typedef short bf16x8 __attribute__((ext_vector_type(8)));
typedef float f32x4 __attribute__((ext_vector_type(4)));
typedef unsigned u32x4 __attribute__((ext_vector_type(4)));
constexpr int BM = 256, BK = 64, HALF = 128, HTB = HALF * BK * 2  , STAGE_BYTES = 8 * HTB, NXCD = 8, WGM = 8;

__host__ __device__ __forceinline__ int lds_byte(int r, int c) { const int st = (r >> 4) * 2 + (c >> 5), rr = r & 15, cc = c & 31, ob = rr * 64 + cc * 2; return st * 1024 + (ob ^ (((ob >> 9) & 1) << 5)); }
__host__ __device__ __forceinline__ void stage_rc(int b, int& R, int& C) { const int st = b / 1024, sb = b % 1024, swz = sb ^ (((sb >> 9) & 1) << 5); R = (st >> 1) * 16 + swz / 64; C = (st & 1) * 32 + (swz % 64) / 2; }
__host__ __device__ __forceinline__ int perm32(int rho) { const int n = rho >> 4, i = rho & 15; return 8 * (i >> 2) + 4 * n + (i & 3); }

struct Unit { int pm, pn; };
struct Gemm { const bf16_t* A; const bf16_t* Bt; int M, N, K; };

struct StaticOrder {
    int nM, nN, nwg, G, c;
    __host__ __device__ void init(int M, int N, int G_, int c_) { nM = M / BM; nN = N / BM; nwg = nM * nN; G = G_; c = c_; }
    __host__ __device__ bool next(int i, Unit& u) const {
        const long L = (long)i * G + c; if (L >= nwg) return false;
        int wgid = (int)L; { const int q = nwg / NXCD, r = nwg % NXCD, xcd = wgid % NXCD, off = wgid / NXCD; wgid = (xcd < r ? xcd * (q + 1) : r * (q + 1) + (xcd - r) * q) + off; }
        const int nig = WGM * nN, gid = wgid / nig, fm = gid * WGM, gsz = (nM - fm) < WGM ? (nM - fm) : WGM;
        u.pm = fm + ((wgid % nig) % gsz); u.pn = (wgid % nig) / gsz; return true;
    }
    __device__ __forceinline__ void a_ready(const Unit&) const {}
    __device__ __forceinline__ void done(const Unit&) const {}
};
__device__ __forceinline__ unsigned cvt_pk_bf16(float lo, float hi) { unsigned r; asm volatile("v_cvt_pk_bf16_f32 %0, %1, %2" : "=v"(r) : "v"(lo), "v"(hi)); return r; }

template <class Epi, class Sched, bool STAMP = false>
__device__ __forceinline__ void gemm_phase(PG8_LAS unsigned char* lds, const Gemm g, const Sched& S, const Epi& E, unsigned long long* stamps) {
    const int tid = opaque_tid(), wid = __builtin_amdgcn_readfirstlane(tid >> 6), lane = tid & 63, wr = wid >> 2, wc = wid & 3, fr = lane & 15, fq = lane >> 4;
    const int K = g.K, nt = K / BK;
    int ts_lo = 0, ts_hi = 0, nts = 0; const unsigned long long rt_entry = STAMP ? (unsigned long long)wall_clock64() : 0ull;
#define PG8_STAMP() do { if (STAMP && wid == 0 && nts < 64) { const unsigned long long _c = (unsigned long long)clock64(); \
        ts_lo = (lane == nts) ? (int)(unsigned)_c : ts_lo; ts_hi = (lane == nts) ? (int)(unsigned)(_c >> 32) : ts_hi; ++nts; } } while (0)
    PG8_STAMP();
    unsigned voffA[2], voffB[2];
#pragma unroll
    for (int i = 0; i < 2; ++i) { int R, C; stage_rc(tid * 16 + i * 8192, R, C); const int Rb = Epi::PERM ? ((R & ~31) + perm32(R & 31)) : R;
        voffA[i] = (unsigned)(R * K + C) * 2u; voffB[i] = (unsigned)(Rb * K + C) * 2u; }
    const size_t kstep = (size_t)(BK * 2);
    const size_t hstep = (size_t)HALF * K * 2;
    const size_t tstep = 2 * hstep;
    const unsigned ldsw = (unsigned)wid * 1024u;
    const int aoff = lds_byte(wr * 64 + fr, fq * 8), boff = lds_byte(wc * 32 + fr, fq * 8);
#define PG8_SA(b, h) (((b) * 2 + (h)) * HTB)
#define PG8_SB(b, h) ((4 + (b) * 2 + (h)) * HTB)
#define PG8_STAGE(bufoff, gbase, voff) do { _Pragma("unroll") for (int _i = 0; _i < 2; ++_i) \
        __builtin_amdgcn_global_load_lds((const unsigned*)((const char*)(gbase) + (voff)[_i]), (PG8_LAS unsigned*)(lds + (bufoff) + ldsw + _i * 8192), 16, 0, 0); } while (0)
#define PG8_LDA(dst, b, h) do { _Pragma("unroll") for (int m = 0; m < 4; ++m) _Pragma("unroll") for (int k = 0; k < 2; ++k) dst[m][k] = *(const PG8_LAS bf16x8*)(lds + PG8_SA(b, h) + aoff + m * 2048 + k * 1024); } while (0)
#define PG8_LDB(dst, b, h) do { _Pragma("unroll") for (int n = 0; n < 2; ++n) _Pragma("unroll") for (int k = 0; k < 2; ++k) dst[n][k] = *(const PG8_LAS bf16x8*)(lds + PG8_SB(b, h) + boff + n * 2048 + k * 1024); } while (0)
#define PG8_MMA(ai, bj, At, Bt) do { __builtin_amdgcn_s_setprio(1); _Pragma("unroll") for (int m = 0; m < 4; ++m) _Pragma("unroll") for (int n = 0; n < 2; ++n) _Pragma("unroll") for (int k = 0; k < 2; ++k) \
        acc[ai][bj][m][n] = __builtin_amdgcn_mfma_f32_16x16x32_bf16(Bt[n][k], At[m][k], acc[ai][bj][m][n], 0, 0, 0); __builtin_amdgcn_s_setprio(0); } while (0)
#define PG8_WAIT_V(n) asm volatile("s_waitcnt vmcnt(" #n ")" ::: "memory")
#define PG8_WAIT_L(n) asm volatile("s_waitcnt lgkmcnt(" #n ")" ::: "memory")
#define PG8_BAR __builtin_amdgcn_s_barrier()
#define PG8_SCHED __builtin_amdgcn_sched_barrier(0)
    Unit cur, nxt; int ui = 0;
    if (!S.next(0, cur)) return;
    f32x4 acc[2][2][4][2];
#pragma unroll
    for (int a = 0; a < 2; ++a)
#pragma unroll
        for (int b = 0; b < 2; ++b)
#pragma unroll
            for (int m = 0; m < 4; ++m)
#pragma unroll
                for (int n = 0; n < 2; ++n) acc[a][b][m][n] = (f32x4){0.f, 0.f, 0.f, 0.f};
    bf16x8 At[4][2], B0[2][2], B1[2][2];
    const char* cA = (const char*)g.A + (size_t)cur.pm * tstep; const char* cB = (const char*)g.Bt + (size_t)cur.pn * tstep;
    S.a_ready(cur);
    PG8_STAGE(PG8_SB(0, 0), cB, voffB); PG8_STAGE(PG8_SA(0, 0), cA, voffA); PG8_STAGE(PG8_SB(0, 1), cB + hstep, voffB); PG8_STAGE(PG8_SA(0, 1), cA + hstep, voffA);
    if (wr == 1) PG8_BAR;
    PG8_WAIT_V(4); PG8_BAR;
    PG8_STAGE(PG8_SB(1, 0), cB + kstep, voffB); PG8_STAGE(PG8_SA(1, 0), cA + kstep, voffA); PG8_STAGE(PG8_SB(1, 1), cB + hstep + kstep, voffB);
    PG8_WAIT_V(6); PG8_BAR;
    PG8_STAMP();
    for (;;) {
        const bool has_next = S.next(ui + 1, nxt);
        const char* nA = has_next ? (const char*)g.A + (size_t)nxt.pm * tstep : cA; const char* nB = has_next ? (const char*)g.Bt + (size_t)nxt.pn * tstep : cB;
        for (int t = 0; t < nt; t += 2) {
            const bool last = (t == nt - 2);
            const char* a1 = cA + (size_t)(t + 1) * kstep;
            const char* a2 = last ? nA : cA + (size_t)(t + 2) * kstep; const char* b2 = last ? nB : cB + (size_t)(t + 2) * kstep;
            const char* a3 = a2 + kstep; const char* b3 = b2 + kstep;
            if (last && has_next) S.a_ready(nxt);
            PG8_LDB(B0, 0, 0); PG8_SCHED; PG8_LDA(At, 0, 0); PG8_STAGE(PG8_SA(1, 1), a1 + hstep, voffA);
            PG8_WAIT_L(8); PG8_BAR; PG8_WAIT_L(0); PG8_MMA(0, 0, At, B0); PG8_BAR; PG8_SCHED;
            PG8_LDB(B1, 0, 1); PG8_STAGE(PG8_SB(0, 0), b2, voffB);
            PG8_BAR; PG8_WAIT_L(0); PG8_MMA(0, 1, At, B1); PG8_BAR;
            PG8_LDA(At, 0, 1); PG8_STAGE(PG8_SA(0, 0), a2, voffA);
            PG8_BAR; PG8_WAIT_L(0); PG8_MMA(1, 0, At, B0); PG8_BAR; PG8_SCHED;
            PG8_STAGE(PG8_SB(0, 1), b2 + hstep, voffB);
            PG8_WAIT_V(6); PG8_BAR; PG8_MMA(1, 1, At, B1); PG8_BAR;
            PG8_LDB(B0, 1, 0); PG8_SCHED; PG8_LDA(At, 1, 0); PG8_STAGE(PG8_SA(0, 1), a2 + hstep, voffA);
            PG8_WAIT_L(8); PG8_BAR; PG8_WAIT_L(0); PG8_MMA(0, 0, At, B0); PG8_BAR; PG8_SCHED;
            PG8_LDB(B1, 1, 1); PG8_STAGE(PG8_SB(1, 0), b3, voffB);
            PG8_BAR; PG8_WAIT_L(0); PG8_MMA(0, 1, At, B1); PG8_BAR;
            PG8_LDA(At, 1, 1); PG8_STAGE(PG8_SA(1, 0), a3, voffA);
            PG8_BAR; PG8_WAIT_L(0); PG8_MMA(1, 0, At, B0); PG8_BAR; PG8_SCHED;
            PG8_STAGE(PG8_SB(1, 1), b3 + hstep, voffB);
            PG8_WAIT_V(6); PG8_BAR; PG8_MMA(1, 1, At, B1); PG8_BAR;
        }
        PG8_STAMP();
        if constexpr (!Epi::AFTER_DRAIN) { E(acc, cur, wr, wc, fr, fq); S.done(cur); }
        PG8_STAMP();
        if (!has_next) break;
#pragma unroll
        for (int a = 0; a < 2; ++a)
#pragma unroll
            for (int b = 0; b < 2; ++b)
#pragma unroll
                for (int m = 0; m < 4; ++m)
#pragma unroll
                    for (int n = 0; n < 2; ++n) acc[a][b][m][n] = (f32x4){0.f, 0.f, 0.f, 0.f};
        cur = nxt; cA = nA; cB = nB; ++ui;
    }
    PG8_WAIT_V(0);
    if (wr == 0) PG8_BAR;
    PG8_BAR;
    if constexpr (Epi::AFTER_DRAIN) { E.fused(acc, cur, wr, wc, fr, fq, lds, wid, lane); S.done(cur); }
    PG8_STAMP();
    if (STAMP && wid == 0) { stamps[lane] = lane < nts ? (((unsigned long long)(unsigned)ts_hi << 32) | (unsigned)ts_lo) : 0ull;
        if (lane == 62) stamps[62] = rt_entry; if (lane == 63) stamps[63] = (unsigned long long)wall_clock64(); }
#undef PG8_STAMP
#undef PG8_SA
#undef PG8_SB
#undef PG8_STAGE
#undef PG8_LDA
#undef PG8_LDB
#undef PG8_MMA
#undef PG8_WAIT_V
#undef PG8_WAIT_L
#undef PG8_BAR
#undef PG8_SCHED
}
}

__device__ void phase_mod(const Params& p, char* smem, int bid, int nblk) {
    const int tidx_ = opaque_tid();
    float* condL = (float*)smem;
    const int tid = tidx_, cl = tid & 63, ks = tid >> 6;
    for (int item = bid; item < 96; item += nblk) {
        const int col0 = item * 64, col = col0 + cl;
        float acc[33];
#pragma unroll
        for (int b = 0; b < 33; ++b) acc[b] = 0.f;
        for (int kc = 0; kc < 4; ++kc) {
            __syncthreads();
            for (int e = tid; e < 8 * 32 * 33; e += NT) {
                const int sl = e / (32 * 33), kk = (e / 33) % 32, b = e % 33;
                const int k = sl * 128 + kc * 32 + kk;
                const float cv = b < 32 ? p.c[b * 1024 + k] : p.c_ctx[k];
                condL[e] = silu(cv);
            }
            __syncthreads();
            for (int kk = 0; kk < 32; ++kk) {
                const int k = ks * 128 + kc * 32 + kk;
                const float w = p.w_mod[(size_t)k * 6144 + col];
                const float* cp = condL + (ks * 32 + kk) * 33;
#pragma unroll
                for (int b = 0; b < 33; ++b) acc[b] += w * cp[b];
            }
        }
        __syncthreads();
#pragma unroll
        for (int b = 0; b < 33; ++b) condL[(ks * 33 + b) * 64 + cl] = acc[b];
        __syncthreads();
        for (int e = tid; e < 33 * 64; e += NT) {
            const int b = e >> 6, cc = e & 63;
            float v = 0.f;
#pragma unroll
            for (int q = 0; q < 8; ++q) v += condL[(q * 33 + b) * 64 + cc];
            p.mod[b * 6144 + col0 + cc] = v + p.b_mod[col0 + cc];
        }
        __syncthreads();
    }
}

__device__ void convT(const float* __restrict__ src, int K, int N, int Npad, bf16_t* __restrict__ dst, char* smem, int bid, int nblk) {
    const int tidx_ = opaque_tid();
    float* tile = (float*)smem;
    const int tid = tidx_;
    const int nk = K / 64, nn = Npad / 64;
    for (int t = bid; t < nk * nn; t += nblk) {
        const int k0 = (t % nk) * 64, n0 = (t / nk) * 64;
        __syncthreads();
#pragma unroll
        for (int r = 0; r < 64 / (NT / 64); ++r) {
            const int k = r * (NT / 64) + (tid >> 6), n = tid & 63;
            tile[k * 65 + n] = (n0 + n < N) ? src[(size_t)(k0 + k) * N + n0 + n] : 0.f;
        }
        __syncthreads();
#pragma unroll
        for (int r = 0; r < 64 / (NT / 64); ++r) {
            const int n = r * (NT / 64) + (tid >> 6), k = tid & 63;
            dst[(size_t)(n0 + n) * K + k0 + k] = f2bf(tile[k * 65 + n]);
        }
    }
    __syncthreads();
}
__device__ void conv_copy(const float* __restrict__ src, bf16_t* __restrict__ dst, size_t n, int gtid, int gthreads) {
    const size_t n4 = n / 4;
    for (size_t i = gtid; i < n4; i += gthreads) {
        const float4 v = ((const float4*)src)[i];
        uint2 o; o.x = pack2(v.x, v.y); o.y = pack2(v.z, v.w);
        ((uint2*)dst)[i] = o;
    }
}
__device__ void phase_convert(const Params& p, char* smem, int bid, int nblk) {
    const int tidx_ = opaque_tid();
    convT(p.w_in, 1024, PT, PTP, p.winT, smem, bid, nblk);
    convT(p.w_out, 1024, 1024, 1024, p.woutT, smem, bid, nblk);
    convT(p.wq, 1024, 2048, 2048, p.wqT, smem, bid, nblk);
    const int gtid = bid * NT + tidx_, gth = nblk * NT;
    conv_copy(p.keys, p.keysb, (size_t)8 * 2 * 128 * 128, gtid, gth);
    {
        const int lane = tidx_ & 63;
        const int gw = bid * (NT / 64) + (tidx_ >> 6), nw = nblk * (NT / 64);
        for (int row = gw; row < 2 * 16384; row += nw) {
            const bool isv = row >= 16384;
            const int r = isv ? row - 16384 : row;
            const float* src = (isv ? p.pv : p.pu) + (size_t)r * 1024 + lane * 16;
            f32x4 v[4];
            float mx = 0.f;
#pragma unroll
            for (int q = 0; q < 4; ++q) { v[q] = *(const f32x4*)(src + 4 * q); mx = fmaxf(mx, fmaxf(fmaxf(fabsf(v[q][0]), fabsf(v[q][1])), fmaxf(fabsf(v[q][2]), fabsf(v[q][3])))); }
            mx = wave_max(mx);
            mx = fmaxf(mx, 1e-30f);
            const float sc = 7.5f / mx;
            unsigned c[16];
#pragma unroll
            for (int i = 0; i < 16; ++i) {
                const float x = v[i >> 2][i & 3] * sc, a = fabsf(x);
                const float code = a < 2.f ? rintf(a * 8.f) : (a < 4.f ? 8.f + rintf(a * 4.f) : 16.f + rintf(a * 2.f));
                unsigned ci = (unsigned)fminf(code, 31.f);
                c[i] = ci | (x < 0.f ? 32u : 0u);
            }
            unsigned long long lo = 0ull; unsigned hi = 0u;
#pragma unroll
            for (int i = 0; i < 10; ++i) lo |= (unsigned long long)c[i] << (6 * i);
            lo |= (unsigned long long)(c[10] & 0xfu) << 60;
            hi = c[10] >> 4;
#pragma unroll
            for (int i = 11; i < 16; ++i) hi |= c[i] << (2 + 6 * (i - 11));
            unsigned* dst = (unsigned*)((isv ? p.v8 : p.u8) + (size_t)r * 768 + lane * 12);
            dst[0] = (unsigned)lo; dst[1] = (unsigned)(lo >> 32); dst[2] = hi;
            if (lane == 0) (isv ? p.vsc : p.usc)[r] = mx * (1.f / 7.5f);
        }
    }
}

template <int R>
__device__ __forceinline__ void norm_rows(const float* __restrict__ srcbase, const float* __restrict__ src2, int nrows1, int nrows, const float* __restrict__ gvec,
                                          const float* __restrict__ mod, int sc_off, int sh_off, bf16_t* __restrict__ dst, int gw, int nw, int lane) {
    for (int row0 = gw; row0 < nrows; row0 += R * nw) {
        f32x4 v[R][4]; float ss[R];
#pragma unroll
        for (int r = 0; r < R; ++r) {
            const int row = min(row0 + r * nw, nrows - 1);
            const float* src = row < nrows1 ? srcbase + (size_t)row * D : src2 + (size_t)(row - nrows1) * D;
#pragma unroll
            for (int j = 0; j < 4; ++j) v[r][j] = *(const f32x4*)(src + j * 256 + lane * 4);
        }
#pragma unroll
        for (int r = 0; r < R; ++r) {
            float a = 0.f;
#pragma unroll
            for (int j = 0; j < 4; ++j) a += v[r][j][0] * v[r][j][0] + v[r][j][1] * v[r][j][1] + v[r][j][2] * v[r][j][2] + v[r][j][3] * v[r][j][3];
            ss[r] = a;
        }
#pragma unroll
        for (int r = 0; r < R; ++r) ss[r] = wave_sum_fast(ss[r]);
#pragma unroll
        for (int r = 0; r < R; ++r) {
            const int row = row0 + r * nw;
            if (row >= nrows) continue;
            const float rstd = rsqrtf(ss[r] * (1.f / 1024.f) + EPS);
            const float* md = mod + (row < TL ? (row >> 11) : 32) * 6144;
#pragma unroll
            for (int j = 0; j < 4; ++j) {
                const int col = j * 256 + lane * 4;
                const f32x4 g = *(const f32x4*)(gvec + col), sc = *(const f32x4*)(md + sc_off + col), sh = *(const f32x4*)(md + sh_off + col);
                uint2 o;
                o.x = pack2(v[r][j][0] * rstd * g[0] * (1.f + sc[0]) + sh[0], v[r][j][1] * rstd * g[1] * (1.f + sc[1]) + sh[1]);
                o.y = pack2(v[r][j][2] * rstd * g[2] * (1.f + sc[2]) + sh[2], v[r][j][3] * rstd * g[3] * (1.f + sc[3]) + sh[3]);
                *(uint2*)(dst + (size_t)row * D + col) = o;
            }
        }
    }
}
template <int R, bool WITH_Y>
__device__ __forceinline__ void norm_span(const float* __restrict__ src, const bf16_t* __restrict__ ysrc, const float* __restrict__ gvec, const float* __restrict__ md,
                                          int sc_off, int sh_off, bf16_t* __restrict__ dst, int nr, int lane) {
    float A[16], B[16], G1[16];
#pragma unroll
    for (int q = 0; q < 2; ++q)
#pragma unroll
        for (int hq = 0; hq < 2; ++hq) {
            const int col = q * 512 + lane * 8 + hq * 4;
            const f32x4 g = *(const f32x4*)(gvec + col), sc = *(const f32x4*)(md + sc_off + col), sh = *(const f32x4*)(md + sh_off + col);
            f32x4 g1 = (f32x4){0.f, 0.f, 0.f, 0.f};
            if (WITH_Y) g1 = *(const f32x4*)(md + 2048 + col);
#pragma unroll
            for (int k = 0; k < 4; ++k) { A[q * 8 + hq * 4 + k] = g[k] * (1.f + sc[k]); B[q * 8 + hq * 4 + k] = sh[k]; G1[q * 8 + hq * 4 + k] = g1[k]; }
        }
    for (int i0 = 0; i0 < nr; i0 += R) {
        f32x4 v[R][4]; u32x4 yv[R][2];
#pragma unroll
        for (int r = 0; r < R; ++r) {
            const float* sp = src + (size_t)(i0 + r) * D + lane * 8;
            v[r][0] = *(const f32x4*)sp; v[r][1] = *(const f32x4*)(sp + 4); v[r][2] = *(const f32x4*)(sp + 512); v[r][3] = *(const f32x4*)(sp + 516);
            if (WITH_Y) { const bf16_t* yp = ysrc + (size_t)(i0 + r) * D + lane * 8; yv[r][0] = *(const u32x4*)yp; yv[r][1] = *(const u32x4*)(yp + 512); }
        }
        float ss[R];
#pragma unroll
        for (int r = 0; r < R; ++r) {
            if (WITH_Y) {
#pragma unroll
                for (int q = 0; q < 2; ++q)
#pragma unroll
                    for (int k = 0; k < 4; ++k) {
                        v[r][2 * q + (k >> 1)][(k & 1) * 2] += G1[q * 8 + 2 * k] * lo2f(yv[r][q][k]);
                        v[r][2 * q + (k >> 1)][(k & 1) * 2 + 1] += G1[q * 8 + 2 * k + 1] * hi2f(yv[r][q][k]);
                    }
            }
            float a = 0.f;
#pragma unroll
            for (int j = 0; j < 4; ++j) a += v[r][j][0] * v[r][j][0] + v[r][j][1] * v[r][j][1] + v[r][j][2] * v[r][j][2] + v[r][j][3] * v[r][j][3];
            ss[r] = a;
        }
#pragma unroll
        for (int r = 0; r < R; ++r) ss[r] = wave_sum_fast(ss[r]);
#pragma unroll
        for (int r = 0; r < R; ++r) {
            const float rstd = rsqrtf(ss[r] * (1.f / 1024.f) + EPS);
#pragma unroll
            for (int q = 0; q < 2; ++q) {
                float o[8];
#pragma unroll
                for (int k = 0; k < 8; ++k) o[k] = v[r][2 * q + (k >> 2)][k & 3] * rstd * A[q * 8 + k] + B[q * 8 + k];
                *(u32x4*)(dst + (size_t)(i0 + r) * D + q * 512 + lane * 8) = (u32x4){pack2(o[0], o[1]), pack2(o[2], o[3]), pack2(o[4], o[5]), pack2(o[6], o[7])};
            }
        }
    }
}
__device__ void phase_norm1(const Params& p, int bid, int nblk) {
    const int tidx_ = opaque_tid();
    const int lane = tidx_ & 63, gw = bid * (NT / 64) + (tidx_ >> 6), nw = nblk * (NT / 64);
    for (int sp = gw; sp < TL / 32; sp += nw)
        norm_span<4, false>(p.x + (size_t)sp * 32 * D, nullptr, p.norm1_g, p.mod + (sp >> 6) * 6144, 1024, 0, p.hbuf + (size_t)sp * 32 * D, 32, lane);
    for (int sp = gw; sp < TC / 4; sp += nw)
        norm_span<4, false>(p.ctx + (size_t)sp * 4 * D, nullptr, p.norm1_g, p.mod + 32 * 6144, 1024, 0, p.hbuf + (size_t)(TL + sp * 4) * D, 4, lane);
}

template <int CL, int CR> __device__ __forceinline__ float dpp_nb(float oldv, float cur) {
    return __uint_as_float(__builtin_amdgcn_update_dpp(__float_as_uint(oldv), __float_as_uint(cur), CL, 0xf, 0xf, false));
}
struct EpiZ {
    static constexpr bool PERM = true, AFTER_DRAIN = false;
    bf16_t* z; float* zg; const float* gate_b; const float* conv_w;
    __device__ __forceinline__ void operator()(const f32x4 (&acc)[2][2][4][2], const pg8::Unit& u, int wr, int wc, int fr, int fq) const {
        const int row0 = u.pm * 256 + wr * 64 + fr, colb = u.pn * 256 + wc * 32 + 8 * fq;
        if (u.pn < 4 && u.pm * 256 < TL) {
#pragma unroll
            for (int bj = 0; bj < 2; ++bj) {
                const int col = colb + bj * 128;
                const float scl = col >= 512 ? 0.08838834764831845f : 1.f;
                f32x4 w0[2], w1[2], w2[2];
#pragma unroll
                for (int n = 0; n < 2; ++n) { w0[n] = *(const f32x4*)(conv_w + col + 4 * n); w1[n] = *(const f32x4*)(conv_w + 1024 + col + 4 * n); w2[n] = *(const f32x4*)(conv_w + 2048 + col + 4 * n); }
#pragma unroll
                for (int ai = 0; ai < 2; ++ai) {
                    f32x4 o[4][2];
#pragma unroll
                    for (int n = 0; n < 2; ++n)
#pragma unroll
                        for (int m = 0; m < 4; ++m)
#pragma unroll
                            for (int c = 0; c < 4; ++c) {
                                const float cur = acc[ai][bj][m][n][c];
                                const float oL = m > 0 ? __uint_as_float(__builtin_amdgcn_update_dpp(0u, __float_as_uint(acc[ai][bj][m > 0 ? m - 1 : 0][n][c]), 0x121, 0xf, 0xf, false)) : 0.f;
                                const float oR = m < 3 ? __uint_as_float(__builtin_amdgcn_update_dpp(0u, __float_as_uint(acc[ai][bj][m < 3 ? m + 1 : 3][n][c]), 0x12F, 0xf, 0xf, false)) : 0.f;
                                const float L = __uint_as_float(__builtin_amdgcn_update_dpp(__float_as_uint(oL), __float_as_uint(cur), 0x111, 0xf, 0xf, false));
                                const float R = __uint_as_float(__builtin_amdgcn_update_dpp(__float_as_uint(oR), __float_as_uint(cur), 0x101, 0xf, 0xf, false));
                                o[m][n][c] = silu(w0[n][c] * L + w1[n][c] * cur + w2[n][c] * R) * scl;
                            }
#pragma unroll
                    for (int m = 0; m < 4; ++m) {
                        const size_t row = (size_t)(row0 + ai * 128 + m * 16);
                        const f32x4 v0 = o[m][0], v1 = o[m][1];
                        u32x4 w; w.x = pg8::cvt_pk_bf16(v0[0], v0[1]); w.y = pg8::cvt_pk_bf16(v0[2], v0[3]); w.z = pg8::cvt_pk_bf16(v1[0], v1[1]); w.w = pg8::cvt_pk_bf16(v1[2], v1[3]);
                        *(u32x4*)(z + row * ZS + col) = w;
                    }
                }
            }
            return;
        }
#pragma unroll
        for (int bj = 0; bj < 2; ++bj) {
            const int col = colb + bj * 128;
            if (col >= PT) continue;
            const bool isg = (col >= C_MLG && col < C_GQ), isl = (col >= C_LR);
#pragma unroll
            for (int ai = 0; ai < 2; ++ai)
#pragma unroll
                for (int m = 0; m < 4; ++m) {
                    const size_t row = (size_t)(row0 + ai * 128 + m * 16);
                    const f32x4 v0 = acc[ai][bj][m][0], v1 = acc[ai][bj][m][1];
                    if (isg) {
                        float* dst = zg + row * 48 + (col - C_MLG);
                        *(f32x4*)dst = v0 + *(const f32x4*)(gate_b + (col - C_MLG));
                        *(f32x4*)(dst + 4) = v1 + *(const f32x4*)(gate_b + (col - C_MLG) + 4);
                    } else if (isl) {
                        float* dst = zg + row * 48 + 16 + (col - C_LR);
                        *(f32x4*)dst = v0; *(f32x4*)(dst + 4) = v1;
                    } else {
                        u32x4 w; w.x = pg8::cvt_pk_bf16(v0[0], v0[1]); w.y = pg8::cvt_pk_bf16(v0[2], v0[3]); w.z = pg8::cvt_pk_bf16(v1[0], v1[1]); w.w = pg8::cvt_pk_bf16(v1[2], v1[3]);
                        *(u32x4*)(z + row * ZS + col) = w;
                    }
                }
        }
    }
};
struct EpiX1 {
    static constexpr bool PERM = false, AFTER_DRAIN = false;
    const float* x; const float* mod; float* out;
    __device__ __forceinline__ void operator()(const f32x4 (&acc)[2][2][4][2], const pg8::Unit& u, int wr, int wc, int fr, int fq) const {
        const int row0 = u.pm * 256 + wr * 64 + fr, col0 = u.pn * 256 + wc * 32 + 4 * fq;
#pragma unroll
        for (int ai = 0; ai < 2; ++ai)
#pragma unroll
            for (int m = 0; m < 4; ++m) {
                const int row = row0 + ai * 128 + m * 16;
                const float* g1 = mod + (row >> 11) * 6144 + 2048;
#pragma unroll
                for (int bj = 0; bj < 2; ++bj)
#pragma unroll
                    for (int n = 0; n < 2; ++n) {
                        const int col = col0 + bj * 128 + n * 16;
                        const size_t o = (size_t)row * D + col;
                        *(f32x4*)(out + o) = *(const f32x4*)(x + o) + *(const f32x4*)(g1 + col) * acc[ai][bj][m][n];
                    }
            }
    }
};
struct EpiY {
    static constexpr bool PERM = true, AFTER_DRAIN = false;
    bf16_t* y;
    __device__ __forceinline__ void operator()(const f32x4 (&acc)[2][2][4][2], const pg8::Unit& u, int wr, int wc, int fr, int fq) const {
        const int row0 = u.pm * 256 + wr * 64 + fr, colb = u.pn * 256 + wc * 32 + 8 * fq;
#pragma unroll
        for (int ai = 0; ai < 2; ++ai)
#pragma unroll
            for (int m = 0; m < 4; ++m) {
                bf16_t* rowp = y + (size_t)(row0 + ai * 128 + m * 16) * 1024 + colb;
#pragma unroll
                for (int bj = 0; bj < 2; ++bj) {
                    const f32x4 v0 = acc[ai][bj][m][0], v1 = acc[ai][bj][m][1];
                    u32x4 w; w.x = pg8::cvt_pk_bf16(v0[0], v0[1]); w.y = pg8::cvt_pk_bf16(v0[2], v0[3]); w.z = pg8::cvt_pk_bf16(v1[0], v1[1]); w.w = pg8::cvt_pk_bf16(v1[2], v1[3]);
                    *(u32x4*)(rowp + bj * 128) = w;
                }
            }
    }
};
struct EpiQb {
    static constexpr bool PERM = true, AFTER_DRAIN = false;
    bf16_t* q;
    __device__ __forceinline__ void operator()(const f32x4 (&acc)[2][2][4][2], const pg8::Unit& u, int wr, int wc, int fr, int fq) const {
        const int row0 = u.pm * 256 + wr * 64 + fr, colb = u.pn * 256 + wc * 32 + 8 * fq;
#pragma unroll
        for (int ai = 0; ai < 2; ++ai)
#pragma unroll
            for (int m = 0; m < 4; ++m) {
                bf16_t* rowp = q + (size_t)(row0 + ai * 128 + m * 16) * 2048 + colb;
#pragma unroll
                for (int bj = 0; bj < 2; ++bj) {
                    const f32x4 v0 = acc[ai][bj][m][0], v1 = acc[ai][bj][m][1];
                    u32x4 w; w.x = pg8::cvt_pk_bf16(v0[0], v0[1]); w.y = pg8::cvt_pk_bf16(v0[2], v0[3]); w.z = pg8::cvt_pk_bf16(v1[0], v1[1]); w.w = pg8::cvt_pk_bf16(v1[2], v1[3]);
                    *(u32x4*)(rowp + bj * 128) = w;
                }
            }
    }
};
template <class Epi>
__device__ __forceinline__ void gemm_run(const bf16_t* A, const bf16_t* Bt, int M, int N, int K, const Epi& e, char* smem, int bid, int nblk) {
    pg8::Gemm g{A, Bt, M, N, K};
    pg8::StaticOrder S; S.init(M, N, nblk, bid);
    pg8::gemm_phase<Epi, pg8::StaticOrder, false>((PG8_LAS unsigned char*)smem, g, S, e, nullptr);
}

#define MFMA16(a, b, c) __builtin_amdgcn_mfma_f32_16x16x32_bf16((a), (b), (c), 0, 0, 0)
__device__ __forceinline__ void conv8(const Params& p, const bf16_t* zc, int col, bool vl, bool vr, float scl, float* y) {
    const u32x4 cc = *(const u32x4*)zc;
    u32x4 ll = (u32x4){0u, 0u, 0u, 0u}, rr = (u32x4){0u, 0u, 0u, 0u};
    if (vl) ll = *(const u32x4*)(zc - ZS);
    if (vr) rr = *(const u32x4*)(zc + ZS);
    const f32x4 w0a = *(const f32x4*)(p.conv_w + col), w0b = *(const f32x4*)(p.conv_w + col + 4);
    const f32x4 w1a = *(const f32x4*)(p.conv_w + 1024 + col), w1b = *(const f32x4*)(p.conv_w + 1024 + col + 4);
    const f32x4 w2a = *(const f32x4*)(p.conv_w + 2048 + col), w2b = *(const f32x4*)(p.conv_w + 2048 + col + 4);
    const float w0[8] = {w0a[0], w0a[1], w0a[2], w0a[3], w0b[0], w0b[1], w0b[2], w0b[3]};
    const float w1[8] = {w1a[0], w1a[1], w1a[2], w1a[3], w1b[0], w1b[1], w1b[2], w1b[3]};
    const float w2[8] = {w2a[0], w2a[1], w2a[2], w2a[3], w2b[0], w2b[1], w2b[2], w2b[3]};
#pragma unroll
    for (int j = 0; j < 4; ++j) {
        const float y0 = w0[2 * j] * lo2f(ll[j]) + w1[2 * j] * lo2f(cc[j]) + w2[2 * j] * lo2f(rr[j]);
        const float y1 = w0[2 * j + 1] * hi2f(ll[j]) + w1[2 * j + 1] * hi2f(cc[j]) + w2[2 * j + 1] * hi2f(rr[j]);
        y[2 * j] = silu(y0) * scl; y[2 * j + 1] = silu(y1) * scl;
    }
}

template <int LBASE>
__device__ void mlstm_item_chunked(const Params& p, char* smem0, int tid, int b, int h, int dir) {
    char* smem = smem0 + LBASE;
    bf16_t* Qs = (bf16_t*)smem;
    bf16_t* Ks = Qs + 32 * 136;
    bf16_t* Ktw = Ks + 32 * 136;
    bf16_t* Vt = Ktw + 128 * 40;
    bf16_t* Ps = Vt + 144 * 40;
    bf16_t* Cb = Ps + 32 * 40;
    float* sg = (float*)(Cb + 144 * 136);
    float* sM = sg + 32; float* sinter = sg + 64; float* sfloor = sg + 96; float* sw = sg + 128; float* smisc = sg + 160;
    const int lane = tid & 63, w = __builtin_amdgcn_readfirstlane(tid >> 6), lr = lane & 15, lq = lane >> 4;
    for (int i = tid; i < 16 * 40; i += 256) Vt[128 * 40 + i] = 0x3f80;
    for (int i = tid; i < 144 * 136 / 2; i += 256) ((unsigned*)Cb)[i] = 0u;
    f32x4 CT[2][9];
#pragma unroll
    for (int i = 0; i < 2; ++i)
#pragma unroll
        for (int j = 0; j < 9; ++j) CT[i][j] = (f32x4){0.f, 0.f, 0.f, 0.f};
    float m_s = 0.f;
    u32x4 kr[2], qr[2], vr[2]; float g_ig = 0.f, g_f = 0.f;
#define ML_PREFETCH(BT) do { \
        const int bt_ = (BT); const bool lat_ = bt_ >= 8; const int pos0_ = lat_ ? (bt_ - 8) * 32 : bt_ * 32; \
        const int nlo_ = dir ? (lat_ ? SEQ : CTX) - 32 - pos0_ : pos0_; const int rowbase_ = lat_ ? b * SEQ : TL + b * CTX; \
        const int l_ = tid & 31, c8_ = tid >> 5; const size_t row_ = (size_t)(rowbase_ + (dir ? nlo_ + 31 - l_ : nlo_ + l_)); \
        _Pragma("unroll") for (int r_ = 0; r_ < 2; ++r_) { const int ec_ = c8_ + 8 * r_; \
            kr[r_] = lat_ ? *(const u32x4*)(p.z + row_ * ZS + C_MLK + h * 128 + ec_ * 8) : *(const u32x4*)(p.hbuf + row_ * 1024 + 512 + h * 128 + ec_ * 8); \
            if (lat_) qr[r_] = *(const u32x4*)(p.z + row_ * ZS + C_MLQ + h * 128 + ec_ * 8); \
            vr[r_] = *(const u32x4*)(p.z + row_ * ZS + C_MLV + h * 128 + ec_ * 8); } \
        if (w == 0) { const int lg_ = lane & 31; const float* gp_ = p.zg + (size_t)(rowbase_ + (dir ? nlo_ + 31 - lg_ : nlo_ + lg_)) * 48 + dir * 8 + h; g_ig = gp_[0]; g_f = gp_[4]; } \
    } while (0)
    qr[0] = (u32x4){0u, 0u, 0u, 0u}; qr[1] = qr[0];
    ML_PREFETCH(0);
    __syncthreads();
    for (int bt = 0; bt < 72; ++bt) {
        const bool lat = bt >= 8;
        const int pos0 = lat ? (bt - 8) * 32 : bt * 32;
        const int seg = lat ? SEQ : CTX;
        const int nlo = dir ? seg - 32 - pos0 : pos0;
        const int rowbase = lat ? b * SEQ : TL + b * CTX;
        if (w == 0) {
            const int l = lane & 31;
            const float ig = g_ig, lf = logsig(g_f);
            float bsum = lf;
            bsum += __uint_as_float(__builtin_amdgcn_update_dpp(0u, __float_as_uint(bsum), 0x111, 0xf, 0xf, false));
            bsum += __uint_as_float(__builtin_amdgcn_update_dpp(0u, __float_as_uint(bsum), 0x112, 0xf, 0xf, false));
            bsum += __uint_as_float(__builtin_amdgcn_update_dpp(0u, __float_as_uint(bsum), 0x114, 0xf, 0xf, false));
            bsum += __uint_as_float(__builtin_amdgcn_update_dpp(0u, __float_as_uint(bsum), 0x118, 0xf, 0xf, false));
            { const float r0 = __int_as_float(__builtin_amdgcn_readlane(__float_as_int(bsum), 15)); if (lane & 16) bsum += r0; }
            const float g = ig - bsum;
            float cm = g;
            const unsigned NEGINF = 0xff800000u;
            cm = fmaxf(cm, __uint_as_float(__builtin_amdgcn_update_dpp(NEGINF, __float_as_uint(cm), 0x111, 0xf, 0xf, false)));
            cm = fmaxf(cm, __uint_as_float(__builtin_amdgcn_update_dpp(NEGINF, __float_as_uint(cm), 0x112, 0xf, 0xf, false)));
            cm = fmaxf(cm, __uint_as_float(__builtin_amdgcn_update_dpp(NEGINF, __float_as_uint(cm), 0x114, 0xf, 0xf, false)));
            cm = fmaxf(cm, __uint_as_float(__builtin_amdgcn_update_dpp(NEGINF, __float_as_uint(cm), 0x118, 0xf, 0xf, false)));
            { const float r0 = __int_as_float(__builtin_amdgcn_readlane(__float_as_int(cm), 15)); if (lane & 16) cm = fmaxf(cm, r0); }
            const float M = fmaxf(m_s, cm);
            const float Ml = __int_as_float(__builtin_amdgcn_readlane(__float_as_int(M), 31)), bl = __int_as_float(__builtin_amdgcn_readlane(__float_as_int(bsum), 31));
            if (lane < 32) {
                sg[l] = g; sM[l] = M; sinter[l] = __expf(m_s - M); sfloor[l] = __expf(-(bsum + M)); sw[l] = __expf(g - Ml);
                if (lane == 0) { smisc[0] = __expf(m_s - Ml); smisc[1] = bl + Ml; }
            }
        }
        __syncthreads();
        {
            const int l = tid & 31, c8 = tid >> 5;
            const float wl = sw[l];
#pragma unroll
            for (int r = 0; r < 2; ++r) {
                const int ec = c8 + 8 * r;
                *(u32x4*)(Ks + l * 136 + ec * 8) = kr[r];
#pragma unroll
                for (int j = 0; j < 4; ++j) { Ktw[(ec * 8 + 2 * j) * 40 + l] = f2bf(lo2f(kr[r][j]) * wl); Ktw[(ec * 8 + 2 * j + 1) * 40 + l] = f2bf(hi2f(kr[r][j]) * wl); }
                if (lat) *(u32x4*)(Qs + l * 136 + ec * 8) = qr[r];
#pragma unroll
                for (int j = 0; j < 4; ++j) { Vt[(ec * 8 + 2 * j) * 40 + l] = (bf16_t)(vr[r][j] & 0xffffu); Vt[(ec * 8 + 2 * j + 1) * 40 + l] = (bf16_t)(vr[r][j] >> 16); }
            }
        }
        __syncthreads();
        if (bt + 1 < 72) ML_PREFETCH(bt + 1);
        if (lat) {
            const int mi = w >> 1, ni = w & 1;
            f32x4 sa = (f32x4){0.f, 0.f, 0.f, 0.f};
            if (!(mi == 0 && ni == 1)) {
#pragma unroll
                for (int kk = 0; kk < 4; ++kk) {
                    const bf16x8 af = *(const bf16x8*)(Qs + (mi * 16 + lr) * 136 + kk * 32 + lq * 8);
                    const bf16x8 bf = *(const bf16x8*)(Ks + (ni * 16 + lr) * 136 + kk * 32 + lq * 8);
                    sa = MFMA16(af, bf, sa);
                }
            }
            const int sidx = ni * 16 + lr;
            const float gs = sg[sidx];
#pragma unroll
            for (int r = 0; r < 4; ++r) {
                const int t = mi * 16 + lq * 4 + r;
                const float pv = (sidx <= t) ? sa[r] * __expf(gs - sM[t]) : 0.f;
                Ps[t * 40 + sidx] = f2bf(pv);
            }
        }
        __syncthreads();
        if (lat) {
            const int nts[3] = {2 * w, 2 * w + 1, 8};
            f32x4 acc[2][3];
#pragma unroll
            for (int i = 0; i < 2; ++i)
#pragma unroll
                for (int j = 0; j < 3; ++j) acc[i][j] = (f32x4){0.f, 0.f, 0.f, 0.f};
#pragma unroll 1
            for (int kk = 0; kk < 4; ++kk) {
                bf16x8 af[2], bf[3];
#pragma unroll
                for (int i = 0; i < 2; ++i) af[i] = *(const bf16x8*)(Qs + (i * 16 + lr) * 136 + kk * 32 + lq * 8);
#pragma unroll
                for (int j = 0; j < 3; ++j) bf[j] = *(const bf16x8*)(Cb + (nts[j] * 16 + lr) * 136 + kk * 32 + lq * 8);
#pragma unroll
                for (int i = 0; i < 2; ++i)
#pragma unroll
                    for (int j = 0; j < 3; ++j) acc[i][j] = MFMA16(af[i], bf[j], acc[i][j]);
            }
#pragma unroll
            for (int i = 0; i < 2; ++i)
#pragma unroll
                for (int r = 0; r < 4; ++r) {
                    const float it = sinter[i * 16 + lq * 4 + r];
#pragma unroll
                    for (int j = 0; j < 3; ++j) acc[i][j][r] *= it;
                }
            {
                bf16x8 af[2], bf[3];
#pragma unroll
                for (int i = 0; i < 2; ++i) af[i] = *(const bf16x8*)(Ps + (i * 16 + lr) * 40 + lq * 8);
#pragma unroll
                for (int j = 0; j < 3; ++j) bf[j] = *(const bf16x8*)(Vt + (nts[j] * 16 + lr) * 40 + lq * 8);
#pragma unroll
                for (int i = 0; i < 2; ++i)
#pragma unroll
                    for (int j = 0; j < 3; ++j) acc[i][j] = MFMA16(af[i], bf[j], acc[i][j]);
            }
#pragma unroll
            for (int i = 0; i < 2; ++i)
#pragma unroll
                for (int r = 0; r < 4; ++r) {
                    const int t = i * 16 + lq * 4 + r;
                    const float dn = fmaxf(fabsf(acc[i][2][r]), sfloor[t]);
                    const float inv = 1.f / dn;
                    const int n = dir ? nlo + 31 - t : nlo + t;
                    bf16_t* orow = p.mixh + ((size_t)dir * TL + rowbase + n) * 1024 + h * 128;
#pragma unroll
                    for (int j = 0; j < 2; ++j) orow[nts[j] * 16 + lr] = f2bf(acc[i][j][r] * inv);
                }
        }
        __syncthreads();
        {
            const float a = smisc[0];
            bf16x8 af[2];
#pragma unroll
            for (int i = 0; i < 2; ++i) af[i] = *(const bf16x8*)(Ktw + ((2 * w + i) * 16 + lr) * 40 + lq * 8);
#pragma unroll
            for (int j = 0; j < 9; ++j) {
                const bf16x8 bf = *(const bf16x8*)(Vt + (j * 16 + lr) * 40 + lq * 8);
#pragma unroll
                for (int i = 0; i < 2; ++i) {
                    CT[i][j] = CT[i][j] * a;
                    CT[i][j] = MFMA16(af[i], bf, CT[i][j]);
                    uint2 pk; pk.x = pack2(CT[i][j][0], CT[i][j][1]); pk.y = pack2(CT[i][j][2], CT[i][j][3]);
                    *(uint2*)(Cb + (j * 16 + lr) * 136 + (2 * w + i) * 16 + lq * 4) = pk;
                }
            }
            m_s = smisc[1];
        }
        __syncthreads();
        __syncthreads();
    }
}
#undef ML_PREFETCH

template <int LBASE>
__device__ void gla_item_chunked(const Params& p, char* smem0, int tid, int b, int h, int dir) {
    char* smem = smem0 + LBASE;
    bf16_t* Qd = (bf16_t*)smem;
    bf16_t* Qb = Qd + 32 * 72;
    bf16_t* Kd = Qb + 32 * 72;
    bf16_t* Kwt = Kd + 32 * 72;
    bf16_t* Vt = Kwt + 64 * 40;
    bf16_t* Ps = Vt + 128 * 40;
    bf16_t* Sb = Ps + 32 * 40;
    float* bc = (float*)(Sb + 128 * 72);
    float* w2s = bc + 32 * 64;
    const int lane = tid & 63, w = __builtin_amdgcn_readfirstlane(tid >> 6), lr = lane & 15, lq = lane >> 4;
    for (int i = tid; i < 128 * 72 / 2; i += 256) ((unsigned*)Sb)[i] = 0u;
    for (int i = tid; i < 16 * 64; i += 256) w2s[i] = p.lr_w2[(dir * 16 + (i >> 6)) * 256 + h * 64 + (i & 63)];
    if (tid < 64) w2s[16 * 64 + tid] = p.alpha_b[dir * 256 + h * 64 + tid];
    f32x4 S[8];
#pragma unroll
    for (int j = 0; j < 8; ++j) S[j] = (f32x4){0.f, 0.f, 0.f, 0.f};
    u32x4 kr, qr, vr[2]; f32x4 lrr[4];
#define GLA_PREFETCH(BT) do { \
        const int bt_ = (BT); const bool lat_ = bt_ >= 8; const int pos0_ = lat_ ? (bt_ - 8) * 32 : bt_ * 32; \
        const int nlo_ = dir ? (lat_ ? SEQ : CTX) - 32 - pos0_ : pos0_; const int rowbase_ = lat_ ? b * SEQ : TL + b * CTX; \
        { const int l_ = tid & 31, dc_ = tid >> 5; const size_t row_ = (size_t)(rowbase_ + (dir ? nlo_ + 31 - l_ : nlo_ + l_)); \
          kr = *(const u32x4*)(p.z + row_ * ZS + C_GK + h * 64 + dc_ * 8); \
          if (lat_) qr = *(const u32x4*)(p.z + row_ * ZS + C_GQ + h * 64 + dc_ * 8); \
          vr[0] = *(const u32x4*)(p.z + row_ * ZS + C_GV + h * 128 + dc_ * 8); vr[1] = *(const u32x4*)(p.z + row_ * ZS + C_GV + h * 128 + (dc_ + 8) * 8); } \
        { const int l_ = tid >> 3; const float* lp_ = p.zg + (size_t)(rowbase_ + (dir ? nlo_ + 31 - l_ : nlo_ + l_)) * 48 + 16 + dir * 16; \
          _Pragma("unroll") for (int q_ = 0; q_ < 4; ++q_) lrr[q_] = *(const f32x4*)(lp_ + 4 * q_); } \
    } while (0)
    qr = (u32x4){0u, 0u, 0u, 0u};
    GLA_PREFETCH(0);
    __syncthreads();
    for (int bt = 0; bt < 72; ++bt) {
        const bool lat = bt >= 8;
        const int pos0 = lat ? (bt - 8) * 32 : bt * 32;
        const int seg = lat ? SEQ : CTX;
        const int nlo = dir ? seg - 32 - pos0 : pos0;
        const int rowbase = lat ? b * SEQ : TL + b * CTX;
        {
            const int l = tid >> 3, d0 = (tid & 7) * 8;
            float al[8];
#pragma unroll
            for (int j = 0; j < 8; ++j) al[j] = w2s[16 * 64 + d0 + j];
#pragma unroll
            for (int q = 0; q < 16; ++q) {
                const float lv = lrr[q >> 2][q & 3];
                const f32x4 wa = *(const f32x4*)(w2s + q * 64 + d0), wb = *(const f32x4*)(w2s + q * 64 + d0 + 4);
                al[0] += lv * wa[0]; al[1] += lv * wa[1]; al[2] += lv * wa[2]; al[3] += lv * wa[3];
                al[4] += lv * wb[0]; al[5] += lv * wb[1]; al[6] += lv * wb[2]; al[7] += lv * wb[3];
            }
#pragma unroll
            for (int j = 0; j < 8; ++j) bc[l * 64 + d0 + j] = logsig(al[j]) * (1.f / 16.f);
        }
        __syncthreads();
        if (tid < 64) {
            float cv[32];
#pragma unroll
            for (int l = 0; l < 32; ++l) cv[l] = bc[l * 64 + tid];
#pragma unroll
            for (int l = 1; l < 32; ++l) cv[l] += cv[l - 1];
#pragma unroll
            for (int l = 0; l < 32; ++l) bc[l * 64 + tid] = cv[l];
        }
        __syncthreads();
        {
            const int l = tid & 31, dc = tid >> 5;
            float bl[8], rf[8], be[8];
#pragma unroll
            for (int j = 0; j < 8; ++j) { bl[j] = bc[l * 64 + dc * 8 + j]; rf[j] = bc[16 * 64 + dc * 8 + j]; be[j] = bc[31 * 64 + dc * 8 + j]; }
            {
                float kf[8];
#pragma unroll
                for (int j = 0; j < 4; ++j) { kf[2 * j] = lo2f(kr[j]); kf[2 * j + 1] = hi2f(kr[j]); }
                float kd[8];
#pragma unroll
                for (int j = 0; j < 8; ++j) { kd[j] = kf[j] * __expf(rf[j] - bl[j]); Kwt[(dc * 8 + j) * 40 + l] = f2bf(kf[j] * __expf(be[j] - bl[j])); }
                *(u32x4*)(Kd + l * 72 + dc * 8) = (u32x4){pack2(kd[0], kd[1]), pack2(kd[2], kd[3]), pack2(kd[4], kd[5]), pack2(kd[6], kd[7])};
            }
            if (lat) {
                float qf[8];
#pragma unroll
                for (int j = 0; j < 4; ++j) { qf[2 * j] = lo2f(qr[j]) * 0.125f; qf[2 * j + 1] = hi2f(qr[j]) * 0.125f; }
                float qd[8], qb[8];
#pragma unroll
                for (int j = 0; j < 8; ++j) { qd[j] = qf[j] * __expf(bl[j] - rf[j]); qb[j] = qf[j] * __expf(bl[j]); }
                *(u32x4*)(Qd + l * 72 + dc * 8) = (u32x4){pack2(qd[0], qd[1]), pack2(qd[2], qd[3]), pack2(qd[4], qd[5]), pack2(qd[6], qd[7])};
                *(u32x4*)(Qb + l * 72 + dc * 8) = (u32x4){pack2(qb[0], qb[1]), pack2(qb[2], qb[3]), pack2(qb[4], qb[5]), pack2(qb[6], qb[7])};
            }
#pragma unroll
            for (int r = 0; r < 2; ++r) {
                const int ec = dc + 8 * r;
#pragma unroll
                for (int j = 0; j < 4; ++j) { Vt[(ec * 8 + 2 * j) * 40 + l] = (bf16_t)(vr[r][j] & 0xffffu); Vt[(ec * 8 + 2 * j + 1) * 40 + l] = (bf16_t)(vr[r][j] >> 16); }
            }
        }
        __syncthreads();
        if (bt + 1 < 72) GLA_PREFETCH(bt + 1);
        if (lat) {
            const int mi = w >> 1, ni = w & 1;
            f32x4 sa = (f32x4){0.f, 0.f, 0.f, 0.f};
            if (!(mi == 0 && ni == 1)) {
#pragma unroll
                for (int kk = 0; kk < 2; ++kk) {
                    const bf16x8 af = *(const bf16x8*)(Qd + (mi * 16 + lr) * 72 + kk * 32 + lq * 8);
                    const bf16x8 bf = *(const bf16x8*)(Kd + (ni * 16 + lr) * 72 + kk * 32 + lq * 8);
                    sa = MFMA16(af, bf, sa);
                }
            }
            const int sidx = ni * 16 + lr;
#pragma unroll
            for (int r = 0; r < 4; ++r) {
                const int t = mi * 16 + lq * 4 + r;
                Ps[t * 40 + sidx] = f2bf((sidx <= t) ? sa[r] : 0.f);
            }
        }
        __syncthreads();
        if (lat) {
            f32x4 acc[2][2];
#pragma unroll
            for (int i = 0; i < 2; ++i)
#pragma unroll
                for (int j = 0; j < 2; ++j) acc[i][j] = (f32x4){0.f, 0.f, 0.f, 0.f};
#pragma unroll
            for (int kk = 0; kk < 2; ++kk) {
                bf16x8 af[2], bf[2];
#pragma unroll
                for (int i = 0; i < 2; ++i) af[i] = *(const bf16x8*)(Qb + (i * 16 + lr) * 72 + kk * 32 + lq * 8);
#pragma unroll
                for (int j = 0; j < 2; ++j) bf[j] = *(const bf16x8*)(Sb + ((2 * w + j) * 16 + lr) * 72 + kk * 32 + lq * 8);
#pragma unroll
                for (int i = 0; i < 2; ++i)
#pragma unroll
                    for (int j = 0; j < 2; ++j) acc[i][j] = MFMA16(af[i], bf[j], acc[i][j]);
            }
            {
                bf16x8 af[2], bf[2];
#pragma unroll
                for (int i = 0; i < 2; ++i) af[i] = *(const bf16x8*)(Ps + (i * 16 + lr) * 40 + lq * 8);
#pragma unroll
                for (int j = 0; j < 2; ++j) bf[j] = *(const bf16x8*)(Vt + ((2 * w + j) * 16 + lr) * 40 + lq * 8);
#pragma unroll
                for (int i = 0; i < 2; ++i)
#pragma unroll
                    for (int j = 0; j < 2; ++j) acc[i][j] = MFMA16(af[i], bf[j], acc[i][j]);
            }
#pragma unroll
            for (int i = 0; i < 2; ++i)
#pragma unroll
                for (int r = 0; r < 4; ++r) {
                    const int t = i * 16 + lq * 4 + r;
                    const int n = dir ? nlo + 31 - t : nlo + t;
                    bf16_t* orow = p.mixh + ((size_t)dir * TL + rowbase + n) * 1024 + 512 + h * 128;
#pragma unroll
                    for (int j = 0; j < 2; ++j) orow[(2 * w + j) * 16 + lr] = f2bf(acc[i][j][r]);
                }
        }
        __syncthreads();
        {
            float rs[4];
#pragma unroll
            for (int r = 0; r < 4; ++r) rs[r] = __expf(bc[31 * 64 + w * 16 + lq * 4 + r]);
            const bf16x8 af = *(const bf16x8*)(Kwt + (w * 16 + lr) * 40 + lq * 8);
#pragma unroll
            for (int j = 0; j < 8; ++j) {
                const bf16x8 bf = *(const bf16x8*)(Vt + (j * 16 + lr) * 40 + lq * 8);
#pragma unroll
                for (int r = 0; r < 4; ++r) S[j][r] *= rs[r];
                S[j] = MFMA16(af, bf, S[j]);
                uint2 pk; pk.x = pack2(S[j][0], S[j][1]); pk.y = pack2(S[j][2], S[j][3]);
                *(uint2*)(Sb + (j * 16 + lr) * 72 + w * 16 + lq * 4) = pk;
            }
        }
        __syncthreads();
    }
}
#undef GLA_PREFETCH

__device__ void phase_mlprep(const Params& p, int bid, int nblk) {
    const int tidx_ = opaque_tid();
    const int lane = tidx_ & 63;
    const int gw = bid * (NT / 64) + (tidx_ >> 6), nw = nblk * (NT / 64);
    const int c0 = lane * 16;
    float w0[16], w1[16], w2[16];
#pragma unroll
    for (int j = 0; j < 16; ++j) { w0[j] = p.conv_w[c0 + j]; w1[j] = p.conv_w[1024 + c0 + j]; w2[j] = p.conv_w[2048 + c0 + j]; }
    const float scl = c0 >= 512 ? 0.08838834764831845f : 1.f;
    constexpr int R = 2;
    for (int row0 = TL + gw; row0 < TT; row0 += R * nw) {
        u32x4 cc[R][2], ll[R][2], rr[R][2];
#pragma unroll
        for (int r = 0; r < R; ++r) {
            const int row = min(row0 + r * nw, TT - 1);
            const bool lat = row < TL;
            const int n = lat ? (row & (SEQ - 1)) : ((row - TL) & (CTX - 1));
            const bool vl = lat ? ((n & 63) != 0) : (n != 0);
            const bool vr = lat ? ((n & 63) != 63) : (n != CTX - 1);
            const bf16_t* zc = p.z + (size_t)row * ZS + c0;
#pragma unroll
            for (int q = 0; q < 2; ++q) {
                cc[r][q] = *(const u32x4*)(zc + 8 * q);
                ll[r][q] = vl ? *(const u32x4*)(zc - ZS + 8 * q) : (u32x4){0u, 0u, 0u, 0u};
                rr[r][q] = vr ? *(const u32x4*)(zc + ZS + 8 * q) : (u32x4){0u, 0u, 0u, 0u};
            }
        }
#pragma unroll
        for (int r = 0; r < R; ++r) {
            const int row = row0 + r * nw;
            unsigned o[8];
#pragma unroll
            for (int q = 0; q < 2; ++q)
#pragma unroll
                for (int j = 0; j < 4; ++j) {
                    const int e = q * 8 + 2 * j;
                    const float y0 = w0[e] * lo2f(ll[r][q][j]) + w1[e] * lo2f(cc[r][q][j]) + w2[e] * lo2f(rr[r][q][j]);
                    const float y1 = w0[e + 1] * hi2f(ll[r][q][j]) + w1[e + 1] * hi2f(cc[r][q][j]) + w2[e + 1] * hi2f(rr[r][q][j]);
                    o[q * 4 + j] = pack2(silu(y0) * scl, silu(y1) * scl);
                }
            if (row < TT) {
                u32x4* dst = (u32x4*)(p.hbuf + (size_t)row * 1024 + c0);
                dst[0] = (u32x4){o[0], o[1], o[2], o[3]}; dst[1] = (u32x4){o[4], o[5], o[6], o[7]};
            }
        }
    }
}

__device__ void phase_mixers(const Params& p, char* smem, int bid, int nblk) {
    const int tidx_ = opaque_tid();
    const int sub = __builtin_amdgcn_readfirstlane(tidx_ >> 8), stid = tidx_ & 255;
#if MIX_SAMEKIND
    for (int pr = bid; pr < 256; pr += nblk) {
        const bool isml = pr < 128;
        const int it = ((pr & 127) << 1) + sub;
        const int b = it >> 3, h = (it >> 1) & 3, dir = it & 1;
        if (isml) { if (sub == 0) mlstm_item_chunked<0>(p, smem, stid, b, h, dir); else mlstm_item_chunked<81920>(p, smem, stid, b, h, dir); }
        else { if (sub == 0) gla_item_chunked<0>(p, smem, stid, b, h, dir); else gla_item_chunked<81920>(p, smem, stid, b, h, dir); }
        __syncthreads();
    }
#else
    for (int it = bid; it < 256; it += nblk) {
        const int b = it >> 3, h = (it >> 1) & 3, dir = it & 1;
        if (sub == 0) mlstm_item_chunked<0>(p, smem, stid, b, h, dir);
        else gla_item_chunked<81920>(p, smem, stid, b, h, dir);
        __syncthreads();
    }
#endif
}

__device__ void phase_mixprep(const Params& p, int bid, int nblk) {
    const int tidx_ = opaque_tid();
    const int lane = tidx_ & 63;
    const int gw = bid * (NT / 64) + (tidx_ >> 6), nw = nblk * (NT / 64);
    const int c0 = lane * 16;
    const float* gn = c0 < 512 ? p.ml_norm_g + c0 : p.gla_norm_g + (c0 - 512);
    float gnv[16];
#pragma unroll
    for (int j = 0; j < 16; ++j) gnv[j] = gn[j];
    constexpr int R = 4;
    for (int row0 = gw; row0 < TL; row0 += R * nw) {
        u32x4 u0[R][2], u1[R][2], ug[R][2];
#pragma unroll
        for (int r = 0; r < R; ++r) {
            const int row = min(row0 + r * nw, TL - 1);
            const u32x4* a0 = (const u32x4*)(p.mixh + (size_t)row * 1024 + c0);
            const u32x4* a1 = (const u32x4*)(p.mixh + ((size_t)TL + row) * 1024 + c0);
            const u32x4* gp = (const u32x4*)(p.z + (size_t)row * ZS + (c0 < 512 ? C_MLO + c0 : C_GR + (c0 - 512)));
#pragma unroll
            for (int q = 0; q < 2; ++q) { u0[r][q] = a0[q]; u1[r][q] = a1[q]; ug[r][q] = gp[q]; }
        }
#pragma unroll
        for (int r = 0; r < R; ++r) {
            const int row = row0 + r * nw;
            float sv[16], gt[16];
#pragma unroll
            for (int q = 0; q < 2; ++q)
#pragma unroll
                for (int j = 0; j < 4; ++j) {
                    sv[q * 8 + 2 * j] = lo2f(u0[r][q][j]) + lo2f(u1[r][q][j]); sv[q * 8 + 2 * j + 1] = hi2f(u0[r][q][j]) + hi2f(u1[r][q][j]);
                    gt[q * 8 + 2 * j] = lo2f(ug[r][q][j]); gt[q * 8 + 2 * j + 1] = hi2f(ug[r][q][j]);
                }
            float ss = 0.f;
#pragma unroll
            for (int j = 0; j < 16; ++j) ss += sv[j] * sv[j];
            ss += dppx<0xB1>(ss); ss += dppx<0x4E>(ss); ss += dppx<0x141>(ss);
            const float rstd = rsqrtf(ss * (1.f / 128.f) + EPS);
            unsigned o[8];
#pragma unroll
            for (int j = 0; j < 8; ++j) {
                float y0, y1;
                const float g0 = gt[2 * j], g1 = gt[2 * j + 1];
                if (c0 < 512) { y0 = sigm(g0); y1 = sigm(g1); } else { y0 = silu(g0); y1 = silu(g1); }
                y0 *= sv[2 * j] * rstd * gnv[2 * j]; y1 *= sv[2 * j + 1] * rstd * gnv[2 * j + 1];
                o[j] = pack2(y0, y1);
            }
            if (row < TL) {
                u32x4* dst = (u32x4*)(p.hbuf + (size_t)row * D + c0);
                dst[0] = (u32x4){o[0], o[1], o[2], o[3]}; dst[1] = (u32x4){o[4], o[5], o[6], o[7]};
            }
        }
    }
}

__device__ void phase_norm2(const Params& p, int bid, int nblk) {
    const int tidx_ = opaque_tid();
    const int lane = tidx_ & 63, gw = bid * (NT / 64) + (tidx_ >> 6), nw = nblk * (NT / 64);
    for (int sp = gw; sp < TL / 32; sp += nw)
        norm_span<4, true>(p.x + (size_t)sp * 32 * D, p.ybuf + (size_t)sp * 32 * D, p.norm2_g, p.mod + (sp >> 6) * 6144, 4096, 3072, p.hbuf + (size_t)sp * 32 * D, 32, lane);
}

__device__ __forceinline__ unsigned fkey(float f) { const unsigned u = __float_as_uint(f); return (u & 0x80000000u) ? ~u : (u | 0x80000000u); }
__device__ __forceinline__ int mbcnt64(unsigned long long m) { return __builtin_amdgcn_mbcnt_hi((unsigned)(m >> 32), __builtin_amdgcn_mbcnt_lo((unsigned)m, 0)); }
#define LDS_FENCE() asm volatile("s_waitcnt lgkmcnt(0)" ::: "memory")

template <int NV>
__device__ __forceinline__ void wave_top16(const float (&val)[NV], const int (&tag)[NV], float* outv, int* outt) {
    unsigned u[NV];
#pragma unroll
    for (int v = 0; v < NV; ++v) u[v] = fkey(val[v]);
    unsigned T = 0;
    for (int bit = 31; bit >= 0; --bit) {
        const unsigned cand = T | (1u << bit);
        int cnt = 0;
#pragma unroll
        for (int v = 0; v < NV; ++v) cnt += __popcll(__ballot(u[v] >= cand));
        if (cnt >= 16) T = cand;
    }
    int base = 0;
#pragma unroll
    for (int v = 0; v < NV; ++v) {
        const bool gt = u[v] > T;
        const unsigned long long mk = __ballot(gt);
        const int pos = base + mbcnt64(mk);
        if (gt) { outv[pos] = val[v]; outt[pos] = tag[v]; }
        base += __popcll(mk);
    }
#pragma unroll
    for (int v = 0; v < NV; ++v) {
        const bool eq = u[v] == T;
        const unsigned long long mk = __ballot(eq);
        const int pos = base + mbcnt64(mk);
        if (eq && pos < 16) { outv[pos] = val[v]; outt[pos] = tag[v]; }
        base += __popcll(mk);
    }
}

template <int NV>
__device__ __forceinline__ void wave_top16_bisect(const float (&val)[NV], const int (&tag)[NV], float* outv, int* outt) {
    float mx = val[0], mn = val[0];
#pragma unroll
    for (int v = 1; v < NV; ++v) { mx = fmaxf(mx, val[v]); mn = fminf(mn, val[v]); }
    float hi = wave_max_fast(mx), lo = -wave_max_fast(-mn);
    float mid = 0.f; bool ok = false;
    for (int it = 0; it < 40; ++it) {
        mid = 0.5f * (lo + hi);
        int cnt = 0;
#pragma unroll
        for (int v = 0; v < NV; ++v) cnt += __popcll(__ballot(val[v] > mid));
        if (cnt == 16) { ok = true; break; }
        if (cnt > 16) lo = mid; else hi = mid;
    }
    if (!ok) { wave_top16<NV>(val, tag, outv, outt); return; }
    int base = 0;
#pragma unroll
    for (int v = 0; v < NV; ++v) {
        const bool gt = val[v] > mid;
        const unsigned long long mk = __ballot(gt);
        const int pos = base + mbcnt64(mk);
        if (gt) { outv[pos] = val[v]; outt[pos] = tag[v]; }
        base += __popcll(mk);
    }
}

template <int CTRL> __device__ __forceinline__ unsigned dppu(unsigned x) { return __builtin_amdgcn_update_dpp(0u, x, CTRL, 0xf, 0xf, false); }
__device__ __forceinline__ unsigned row_max16u(unsigned x) { x = max(x, dppu<0x128>(x)); x = max(x, dppu<0x124>(x)); x = max(x, dppu<0x4E>(x)); return max(x, dppu<0xB1>(x)); }
__device__ __forceinline__ float row_max16(float x) { x = fmaxf(x, dppx<0x128>(x)); x = fmaxf(x, dppx<0x124>(x)); x = fmaxf(x, dppx<0x4E>(x)); return fmaxf(x, dppx<0xB1>(x)); }
__device__ __forceinline__ float row_sum16(float x) { x += dppx<0x128>(x); x += dppx<0x124>(x); x += dppx<0x4E>(x); return x + dppx<0xB1>(x); }
__device__ __forceinline__ unsigned key_of(float v, unsigned tag) { const unsigned b = (__float_as_uint(v) & 0xffffff00u) | tag; return (b & 0x80000000u) ? ~b : (b | 0x80000000u); }
__device__ __forceinline__ unsigned bits_of_key(unsigned k) { return (k & 0x80000000u) ? (k & 0x7fffffffu) : ~k; }
#define CE_DESC(i, j) do { const unsigned hi_ = max(u[i], u[j]), lo_ = min(u[i], u[j]); u[i] = hi_; u[j] = lo_; } while (0)
template <int N>
__device__ __forceinline__ unsigned tournament16(unsigned (&u)[N], int lr) {
    unsigned res = 0u;
#pragma unroll
    for (int k = 0; k < 16; ++k) {
        const unsigned m = row_max16u(u[0]);
        const bool wn = (u[0] == m);
        res = (lr == k) ? m : res;
#pragma unroll
        for (int i = 0; i < N - 1; ++i) u[i] = wn ? u[i + 1] : u[i];
        u[N - 1] = wn ? 0u : u[N - 1];
    }
    return res;
}

template <int N>
__device__ __forceinline__ void tournament16x2(unsigned (&ua)[N], unsigned (&ub)[N], int lr, unsigned& ra, unsigned& rb) {
    ra = 0u; rb = 0u;
#pragma unroll
    for (int k = 0; k < 16; ++k) {
        const unsigned ma = row_max16u(ua[0]), mb = row_max16u(ub[0]);
        const bool wa = (ua[0] == ma), wb = (ub[0] == mb);
        ra = (lr == k) ? ma : ra; rb = (lr == k) ? mb : rb;
#pragma unroll
        for (int i = 0; i < N - 1; ++i) { ua[i] = wa ? ua[i + 1] : ua[i]; ub[i] = wb ? ub[i + 1] : ub[i]; }
        ua[N - 1] = wa ? 0u : ua[N - 1]; ub[N - 1] = wb ? 0u : ub[N - 1];
    }
}
#define SORT8_DESC() do { CE_DESC(0, 1); CE_DESC(2, 3); CE_DESC(4, 5); CE_DESC(6, 7); CE_DESC(0, 2); CE_DESC(1, 3); CE_DESC(4, 6); CE_DESC(5, 7); CE_DESC(1, 2); CE_DESC(5, 6); \
        CE_DESC(0, 4); CE_DESC(1, 5); CE_DESC(2, 6); CE_DESC(3, 7); CE_DESC(2, 4); CE_DESC(3, 5); CE_DESC(1, 2); CE_DESC(3, 4); CE_DESC(5, 6); } while (0)

__device__ void phase_topk(const Params& p, char* smem, int bid, int nblk) {
    const int tidx_ = opaque_tid();
    const int tid = tidx_, lane = tid & 63, w = __builtin_amdgcn_readfirstlane(tid >> 6), lr = lane & 15, lq = lane >> 4;
    constexpr int SS = 260;
    constexpr int WS = 16 * SS + 512;
    float* sc = (float*)smem + w * WS;
    float* tv = sc + 16 * SS + lq * 64;
    int* ti = (int*)(tv + 32);
    for (int item = bid; item < (TL / (NT / 4)) * 8; item += nblk) {
        const int ph = item & 7, t0 = (item >> 3) * (NT / 4) + w * 16;
#pragma unroll
        for (int hh = 0; hh < 2; ++hh) {
            bf16x8 af[4];
#pragma unroll
            for (int kk = 0; kk < 4; ++kk) af[kk] = *(const bf16x8*)(p.qbuf + (size_t)(t0 + lr) * 2048 + ph * 256 + hh * 128 + kk * 32 + lq * 8);
            const bf16_t* kb = p.keysb + (size_t)((ph * 2 + hh) * 128 + lr) * 128 + lq * 8;
            f32x4 acc[8];
            bf16x8 b0[4], b1[4];
#pragma unroll
            for (int kk = 0; kk < 4; ++kk) b0[kk] = *(const bf16x8*)(kb + kk * 32);
#pragma unroll
            for (int n = 0; n < 8; n += 2) {
#pragma unroll
                for (int kk = 0; kk < 4; ++kk) b1[kk] = *(const bf16x8*)(kb + (n + 1) * 16 * 128 + kk * 32);
                acc[n] = (f32x4){0.f, 0.f, 0.f, 0.f};
#pragma unroll
                for (int kk = 0; kk < 4; ++kk) acc[n] = MFMA16(af[kk], b0[kk], acc[n]);
                if (n + 2 < 8) {
#pragma unroll
                    for (int kk = 0; kk < 4; ++kk) b0[kk] = *(const bf16x8*)(kb + (n + 2) * 16 * 128 + kk * 32);
                }
                acc[n + 1] = (f32x4){0.f, 0.f, 0.f, 0.f};
#pragma unroll
                for (int kk = 0; kk < 4; ++kk) acc[n + 1] = MFMA16(af[kk], b1[kk], acc[n + 1]);
            }
#pragma unroll
            for (int n = 0; n < 8; ++n)
#pragma unroll
                for (int r = 0; r < 4; ++r) sc[(lq * 4 + r) * SS + hh * 128 + n * 16 + lr] = acc[n][r];
        }
        LDS_FENCE();
        for (int ps2 = 0; ps2 < 2; ++ps2) {
            float a0[2];
#pragma unroll
            for (int pp = 0; pp < 2; ++pp) {
                const int tt = (ps2 * 2 + pp) * 4 + lq;
                float* tvp = tv + pp * 256; int* tip = ti + pp * 256;
                unsigned ua[8], ub[8];
#pragma unroll
                for (int j = 0; j < 8; ++j) { ua[j] = key_of(sc[tt * SS + lr + 16 * j], 255u - (unsigned)(lr + 16 * j)); ub[j] = key_of(sc[tt * SS + 128 + lr + 16 * j], 255u - (unsigned)(lr + 16 * j)); }
                { unsigned (&u)[8] = ua; SORT8_DESC(); }
                { unsigned (&u)[8] = ub; SORT8_DESC(); }
                unsigned ra, rb;
                tournament16x2<8>(ua, ub, lr, ra, rb);
                const unsigned ba = bits_of_key(ra), bb = bits_of_key(rb);
                a0[pp] = __uint_as_float(ba);
                tvp[lr] = __uint_as_float(ba); tip[lr] = 255 - (int)(ba & 0xffu);
                tvp[16 + lr] = __uint_as_float(bb); tip[16 + lr] = 255 - (int)(bb & 0xffu);
            }
            LDS_FENCE();
            unsigned ca[16], cb2[16];
#pragma unroll
            for (int pp = 0; pp < 2; ++pp) {
                const float* tvp = tv + pp * 256;
                const f32x4 b0 = *(const f32x4*)(tvp + 16), b1 = *(const f32x4*)(tvp + 20), b2 = *(const f32x4*)(tvp + 24), b3 = *(const f32x4*)(tvp + 28);
                const float bj[16] = {b0[0], b0[1], b0[2], b0[3], b1[0], b1[1], b1[2], b1[3], b2[0], b2[1], b2[2], b2[3], b3[0], b3[1], b3[2], b3[3]};
#pragma unroll
                for (int j = 0; j < 16; ++j) { const unsigned kx = key_of(a0[pp] + bj[j], 255u - (unsigned)(lr * 16 + j)); if (pp == 0) ca[j] = kx; else cb2[j] = kx; }
            }
            unsigned rca, rcb;
            tournament16x2<16>(ca, cb2, lr, rca, rcb);
#pragma unroll
            for (int pp = 0; pp < 2; ++pp) {
                const int t = t0 + (ps2 * 2 + pp) * 4 + lq;
                const int* tip = ti + pp * 256;
                const unsigned cb = bits_of_key(pp == 0 ? rca : rcb);
                const float sv = __uint_as_float(cb);
                const int tag = 255 - (int)(cb & 0xffu);
                const int idx = tip[tag >> 4] * 128 + tip[16 + (tag & 15)];
                const float mx = row_max16(sv);
                const float ev = __expf(sv - mx);
                const float sm = row_sum16(ev);
                p.pidx[(size_t)t * 128 + ph * 16 + lr] = idx;
                p.pgw[(size_t)t * 128 + ph * 16 + lr] = ev / sm;
            }
            LDS_FENCE();
        }
    }
    __syncthreads();
}

typedef float f32x2 __attribute__((ext_vector_type(2)));
template <int CTRL> __device__ __forceinline__ float dppf(float x) {
    return __uint_as_float(__builtin_amdgcn_update_dpp(0u, __float_as_uint(x), CTRL, 0xf, 0xf, false));
}
__device__ __forceinline__ float red4(float a, float b, float c, float d) {
    auto r = __builtin_amdgcn_permlane32_swap(__float_as_uint(a), __float_as_uint(b), false, false);
    const float ab = __uint_as_float(r[0]) + __uint_as_float(r[1]);
    auto q = __builtin_amdgcn_permlane32_swap(__float_as_uint(c), __float_as_uint(d), false, false);
    const float cd = __uint_as_float(q[0]) + __uint_as_float(q[1]);
    auto s = __builtin_amdgcn_permlane16_swap(__float_as_uint(ab), __float_as_uint(cd), false, false);
    float x = __uint_as_float(s[0]) + __uint_as_float(s[1]);
    x += dppf<0x128>(x); x += dppf<0x124>(x); x += dppf<0x4E>(x); x += dppf<0xB1>(x);
    return x;
}
typedef unsigned u32x3 __attribute__((ext_vector_type(3)));
typedef unsigned u32x6 __attribute__((ext_vector_type(6)));
typedef float f32x32 __attribute__((ext_vector_type(32)));
#ifndef GP
#define GP 4
#endif
struct GB { unsigned a[GP], b[GP], c[GP]; };
__device__ __forceinline__ f32x32 dec32(unsigned a0, unsigned a1, unsigned a2, unsigned b0, unsigned b1, unsigned b2) {
    const u32x6 sv = (u32x6){a0, a1, a2, b0, b1, b2};
    return __builtin_amdgcn_cvt_scalef32_pk32_f32_fp6(sv, 1.0f);
}
__device__ __forceinline__ void gloadN(GB& buf, const __amdgpu_buffer_rsrc_t tab, int idxreg, int j0, int lane) {
#pragma unroll
    for (int jj = 0; jj < GP; ++jj) {
        const int e = __builtin_amdgcn_readlane(idxreg, j0 + jj);
        const u32x3 t3 = __builtin_amdgcn_raw_buffer_load_b96(tab, lane * 12, e * 768, 0);
        buf.a[jj] = t3[0]; buf.b[jj] = t3[1]; buf.c[jj] = t3[2];
    }
}
__device__ __forceinline__ float gdotsN(const GB& buf, const float (&hv)[16], float d, int j0, int lane) {
    int di = __float_as_int(d);
    f32x2 hv2[8];
#pragma unroll
    for (int k = 0; k < 8; ++k) hv2[k] = (f32x2){hv[2 * k], hv[2 * k + 1]};
    float chain0 = 0.f, chain1 = 0.f;
#pragma unroll
    for (int q = 0; q < GP / 4; ++q) {
        float pt[4];
#pragma unroll
        for (int h2 = 0; h2 < 2; ++h2) {
            const int jj = 4 * q + 2 * h2;
            unsigned w0 = buf.a[jj];
            asm volatile("" : "+v"(w0) : "v"(h2 ? chain1 : chain0));
            const f32x32 f = dec32(w0, buf.b[jj], buf.c[jj], buf.a[jj + 1], buf.b[jj + 1], buf.c[jj + 1]);
            f32x2 a0 = (f32x2){0.f, 0.f}, a1 = a0, c0 = a0, c1 = a0;
#pragma unroll
            for (int k = 0; k < 8; k += 2) {
                a0 += (f32x2){f[2 * k], f[2 * k + 1]} * hv2[k];           a1 += (f32x2){f[2 * k + 2], f[2 * k + 3]} * hv2[k + 1];
                c0 += (f32x2){f[16 + 2 * k], f[16 + 2 * k + 1]} * hv2[k]; c1 += (f32x2){f[16 + 2 * k + 2], f[16 + 2 * k + 3]} * hv2[k + 1];
            }
            const f32x2 as = a0 + a1, cs = c0 + c1;
            pt[2 * h2] = as[0] + as[1]; pt[2 * h2 + 1] = cs[0] + cs[1];
            if (h2) chain1 = pt[2 * h2 + 1]; else chain0 = pt[2 * h2 + 1];
        }
        const float x0 = red4(pt[0], pt[1], pt[2], pt[3]);
        {
            const int r0 = __builtin_amdgcn_readlane(__float_as_int(x0), 0), r1 = __builtin_amdgcn_readlane(__float_as_int(x0), 32);
            const int r2 = __builtin_amdgcn_readlane(__float_as_int(x0), 16), r3 = __builtin_amdgcn_readlane(__float_as_int(x0), 48);
            const int rel = lane - (j0 + 4 * q);
            int v = (rel == 0) ? r0 : di; v = (rel == 1) ? r1 : v; v = (rel == 2) ? r2 : v; di = (rel == 3) ? r3 : v;
        }
    }
    return __int_as_float(di);
}
__device__ __forceinline__ void gaxpyN(const GB& buf, float coef, f32x2 (&acc)[8], int j0) {
    float mk0 = 0.f, mk1 = 0.f;
#pragma unroll
    for (int jj = 0; jj < GP; jj += 2) {
        const float c0 = __int_as_float(__builtin_amdgcn_readlane(__float_as_int(coef), j0 + jj));
        const float c1 = __int_as_float(__builtin_amdgcn_readlane(__float_as_int(coef), j0 + jj + 1));
        unsigned w0 = buf.a[jj];
        asm volatile("" : "+v"(w0) : "v"((jj & 2) ? mk1 : mk0));
        const f32x32 f = dec32(w0, buf.b[jj], buf.c[jj], buf.a[jj + 1], buf.b[jj + 1], buf.c[jj + 1]);
        const f32x2 c02 = (f32x2){c0, c0}, c12 = (f32x2){c1, c1};
#pragma unroll
        for (int k = 0; k < 8; ++k) acc[k] += c02 * (f32x2){f[2 * k], f[2 * k + 1]} + c12 * (f32x2){f[16 + 2 * k], f[16 + 2 * k + 1]};
        if (jj & 2) mk1 = acc[7][1]; else mk0 = acc[7][1];
    }
}
__device__ __forceinline__ float gather_dots(const __amdgpu_buffer_rsrc_t tab, int idxreg, const float (&hv)[16], int lane) {
    float d = 0.f;
    GB bufA, bufB;
    constexpr int NG = 64 / GP;
    gloadN(bufA, tab, idxreg, 0, lane);
#pragma unroll 1
    for (int g = 0; g < NG; g += 2) {
        gloadN(bufB, tab, idxreg, (g + 1) * GP, lane);
        d = gdotsN(bufA, hv, d, g * GP, lane);
        gloadN(bufA, tab, idxreg, ((g + 2) & (NG - 1)) * GP, lane);
        d = gdotsN(bufB, hv, d, (g + 1) * GP, lane);
    }
    return d;
}
__device__ __forceinline__ void gather_axpy(const __amdgpu_buffer_rsrc_t tab, int idxreg, float coef, f32x2 (&acc)[8], int lane) {
    GB bufA, bufB;
    constexpr int NG = 64 / GP;
    gloadN(bufA, tab, idxreg, 0, lane);
#pragma unroll 1
    for (int g = 0; g < NG; g += 2) {
        gloadN(bufB, tab, idxreg, (g + 1) * GP, lane);
        gaxpyN(bufA, coef, acc, g * GP);
        gloadN(bufA, tab, idxreg, ((g + 2) & (NG - 1)) * GP, lane);
        gaxpyN(bufB, coef, acc, (g + 1) * GP);
    }
}
__device__ __forceinline__ float gelu_exact(float x) { return 0.5f * x * (1.f + erff(x * 0.7071067811865476f)); }

__device__ void phase_gather(const Params& p, int bid, int nblk) {
    const int tidx_ = opaque_tid();
    const int lane = tidx_ & 63;
    const int gw = bid * (NT / 64) + (tidx_ >> 6), nw = nblk * (NT / 64);
    const __amdgpu_buffer_rsrc_t ursrc = __builtin_amdgcn_make_buffer_rsrc((void*)p.u8, (short)0, 16384 * 768, 0x00020000);
    const __amdgpu_buffer_rsrc_t vrsrc = __builtin_amdgcn_make_buffer_rsrc((void*)p.v8, (short)0, 16384 * 768, 0x00020000);
    for (int t = gw; t < TL; t += nw) {
        float hv[16];
        {
            const u32x4 h0 = *(const u32x4*)(p.hbuf + (size_t)t * D + lane * 16), h1 = *(const u32x4*)(p.hbuf + (size_t)t * D + lane * 16 + 8);
#pragma unroll
            for (int q = 0; q < 4; ++q) { hv[2 * q] = lo2f(h0[q]); hv[2 * q + 1] = hi2f(h0[q]); hv[8 + 2 * q] = lo2f(h1[q]); hv[8 + 2 * q + 1] = hi2f(h1[q]); }
        }
        const int ia = p.pidx[(size_t)t * 128 + lane], ib = p.pidx[(size_t)t * 128 + 64 + lane];
        const float ga = p.pgw[(size_t)t * 128 + lane], gb = p.pgw[(size_t)t * 128 + 64 + lane];
        const float usA = p.usc[ia], usB = p.usc[ib], vsA = p.vsc[ia], vsB = p.vsc[ib];
        const float dA = gather_dots(ursrc, ia, hv, lane);
        const float dB = gather_dots(ursrc, ib, hv, lane);
        const float cA = gelu_exact(dA * usA) * ga * vsA, cB = gelu_exact(dB * usB) * gb * vsB;
        f32x2 acc2[8];
#pragma unroll
        for (int j = 0; j < 8; ++j) acc2[j] = (f32x2){0.f, 0.f};
        gather_axpy(vrsrc, ia, cA, acc2, lane);
        gather_axpy(vrsrc, ib, cB, acc2, lane);
        float acc[16];
#pragma unroll
        for (int j = 0; j < 8; ++j) { acc[2 * j] = acc2[j][0]; acc[2 * j + 1] = acc2[j][1]; }
        float* orow = p.out + (size_t)t * D + lane * 16;
        const float* xrow = p.x + (size_t)t * D + lane * 16;
        const float* g1 = p.mod + (t >> 11) * 6144 + 2048 + lane * 16;
        const float* g2 = g1 + 3072;
        float yo[16];
        {
            const u32x4 y0 = *(const u32x4*)(p.ybuf + (size_t)t * D + lane * 16), y1 = *(const u32x4*)(p.ybuf + (size_t)t * D + lane * 16 + 8);
#pragma unroll
            for (int q = 0; q < 4; ++q) { yo[2 * q] = lo2f(y0[q]); yo[2 * q + 1] = hi2f(y0[q]); yo[8 + 2 * q] = lo2f(y1[q]); yo[8 + 2 * q + 1] = hi2f(y1[q]); }
        }
        float y[16]; float ss = 0.f;
#pragma unroll
        for (int q = 0; q < 4; ++q) {
            const f32x4 xv = *(const f32x4*)(xrow + 4 * q), gv = *(const f32x4*)(g2 + 4 * q), g1v = *(const f32x4*)(g1 + 4 * q);
#pragma unroll
            for (int k = 0; k < 4; ++k) { y[4 * q + k] = xv[k] + g1v[k] * yo[4 * q + k] + gv[k] * acc[4 * q + k]; ss += y[4 * q + k] * y[4 * q + k]; }
        }
        ss = wave_sum(ss);
        const float rstd = rsqrtf(ss * (1.f / 1024.f) + EPS);
#pragma unroll
        for (int q = 0; q < 4; ++q) {
            const f32x4 gf = *(const f32x4*)(p.norm_f_g + lane * 16 + 4 * q);
            *(f32x4*)(orow + 4 * q) = (f32x4){y[4 * q] * rstd * gf[0], y[4 * q + 1] * rstd * gf[1], y[4 * q + 2] * rstd * gf[2], y[4 * q + 3] * rstd * gf[3]};
        }
    }
}

extern __shared__ __attribute__((aligned(16))) char dyn_smem[];

__device__ __forceinline__ void run_phase(const Params& p, int ph, char* smem, int bid, int nblk) {
#ifdef ONLY_PHASE
    if (ph != ONLY_PHASE) return;
#endif
    switch (ph) {
        case 0: phase_mod(p, smem, bid, nblk); phase_convert(p, smem, bid, nblk); break;
        case 1: phase_norm1(p, bid, nblk); break;
        case 2: { EpiZ e{p.z, p.zg, p.gate_b, p.conv_w}; gemm_run(p.hbuf, p.winT, TT, PTP, 1024, e, smem, bid, nblk); } break;
        case 3: phase_mlprep(p, bid, nblk); break;
        case 4: phase_mixers(p, smem, bid, nblk); break;
        case 5: phase_mixprep(p, bid, nblk); break;
        case 6: { EpiY e{p.ybuf}; gemm_run(p.hbuf, p.woutT, TL, 1024, 1024, e, smem, bid, nblk); } break;
        case 7: phase_norm2(p, bid, nblk); break;
        case 8: { EpiQb e{p.qbuf}; gemm_run(p.hbuf, p.wqT, TL, 2048, 1024, e, smem, bid, nblk); } break;
        case 9: phase_topk(p, smem, bid, nblk); break;
        case 10: phase_gather(p, bid, nblk); break;
    }
}
#ifndef PHASE_MASK
#define PHASE_MASK 0x7ff
#endif
constexpr int NPHASE = 11;

__device__ __forceinline__ void grid_barrier(unsigned* counter, unsigned target) {
    __syncthreads();
    if (threadIdx.x == 0) {
        __builtin_amdgcn_fence(__ATOMIC_RELEASE, "agent");
        asm volatile("s_waitcnt vmcnt(0)" ::: "memory");
        __hip_atomic_fetch_add(counter, 1u, __ATOMIC_RELAXED, __HIP_MEMORY_SCOPE_AGENT);
        while (__hip_atomic_load(counter, __ATOMIC_RELAXED, __HIP_MEMORY_SCOPE_AGENT) < target) __builtin_amdgcn_s_sleep(2);
        __builtin_amdgcn_fence(__ATOMIC_ACQUIRE, "agent");
        asm volatile("s_waitcnt vmcnt(0)" ::: "memory");
    }
    __syncthreads();
}
#if FUSED
#ifndef PROBE_REPEAT_PHASE
#define PROBE_REPEAT_PHASE (-1)
#endif
__global__ void __launch_bounds__(NT, 2) mega_kernel(Params p) {
    cg::grid_group grid = cg::this_grid();
    unsigned nbar = 0;
#define RUN_PHASE(PH) do { int nrep_ = (PROBE_REPEAT_PHASE == (PH)) ? 2 : 1; asm volatile("" : "+s"(nrep_)); \
        for (int r_ = 0; r_ < nrep_; ++r_) { run_phase(p, (PH), dyn_smem, blockIdx.x, gridDim.x); \
            if ((PH) == 0 && r_ == 0) grid.sync();   \
            else if ((PH) + 1 < NPHASE || r_ + 1 < nrep_) { ++nbar; grid_barrier(p.bar, nbar * gridDim.x); } } } while (0)
    RUN_PHASE(0); RUN_PHASE(1); RUN_PHASE(2); RUN_PHASE(3); RUN_PHASE(4); RUN_PHASE(5); RUN_PHASE(6); RUN_PHASE(7); RUN_PHASE(8); RUN_PHASE(9); RUN_PHASE(10);
#undef RUN_PHASE
}
#else
template <int PH>
__global__ void __launch_bounds__(NT, 2) phase_kernel(Params p) { run_phase(p, PH, dyn_smem, blockIdx.x, gridDim.x); }
#endif

static inline char* carve(char*& cur, size_t bytes) { char* r = cur; cur += (bytes + 255) & ~(size_t)255; return r; }

extern "C" void kernel_launch(void* const* d_in, const int* in_sizes, int n_in, void* d_out, int out_size, void* d_ws, size_t ws_size, hipStream_t stream) {
    Params p{};
    p.x = (const float*)d_in[0]; p.c = (const float*)d_in[1]; p.ctx = (const float*)d_in[2]; p.c_ctx = (const float*)d_in[3];
    p.w_mod = (const float*)d_in[4]; p.b_mod = (const float*)d_in[5]; p.norm1_g = (const float*)d_in[6]; p.w_in = (const float*)d_in[7];
    p.conv_w = (const float*)d_in[8]; p.gate_b = (const float*)d_in[9]; p.ml_norm_g = (const float*)d_in[10]; p.lr_w2 = (const float*)d_in[11];
    p.alpha_b = (const float*)d_in[12]; p.gla_norm_g = (const float*)d_in[13]; p.w_out = (const float*)d_in[14]; p.norm2_g = (const float*)d_in[15];
    p.wq = (const float*)d_in[16]; p.keys = (const float*)d_in[17]; p.pu = (const float*)d_in[18]; p.pv = (const float*)d_in[19]; p.norm_f_g = (const float*)d_in[20];
    p.out = (float*)d_out;
    char* cur = (char*)d_ws;
    p.mod = (float*)carve(cur, (size_t)33 * 6144 * 4);
    p.winT = (bf16_t*)carve(cur, (size_t)PTP * 1024 * 2);
    p.woutT = (bf16_t*)carve(cur, (size_t)1024 * 1024 * 2);
    p.wqT = (bf16_t*)carve(cur, (size_t)2048 * 1024 * 2);
    p.keysb = (bf16_t*)carve(cur, (size_t)8 * 2 * 128 * 128 * 2);
    p.u8 = (unsigned char*)carve(cur, (size_t)16384 * 768);
    p.v8 = (unsigned char*)carve(cur, (size_t)16384 * 768);
    p.usc = (float*)carve(cur, (size_t)16384 * 4);
    p.vsc = (float*)carve(cur, (size_t)16384 * 4);
    p.hbuf = (bf16_t*)carve(cur, (size_t)TT * 1024 * 2);
    p.z = (bf16_t*)carve(cur, (size_t)TT * ZS * 2);
    p.zg = (float*)carve(cur, (size_t)TT * 48 * 4);
    p.mixh = (bf16_t*)carve(cur, (size_t)2 * TL * 1024 * 2);
    p.bar = (unsigned*)carve(cur, 256);
    p.qbuf = p.z;
    p.pidx = (int*)p.mixh;
    p.pgw = (float*)((char*)p.mixh + (size_t)TL * 128 * 4);
    p.ybuf = p.mixh + (size_t)TL * 1024;
    if ((size_t)(cur - (char*)d_ws) > ws_size) { fprintf(stderr, "workspace too small: need %zu have %zu\n", (size_t)(cur - (char*)d_ws), ws_size); return; }
#if FUSED
    static int grid_blocks = 0;
    if (!grid_blocks) {
        int dev = 0, cus = 0, per_cu = 0;
        hipGetDevice(&dev);
        hipDeviceGetAttribute(&cus, hipDeviceAttributeMultiprocessorCount, dev);
        hipFuncSetAttribute((const void*)mega_kernel, hipFuncAttributeMaxDynamicSharedMemorySize, SMEM_BYTES);
        hipOccupancyMaxActiveBlocksPerMultiprocessor(&per_cu, mega_kernel, NT, SMEM_BYTES);
        if (per_cu > 1) per_cu = 1;
        grid_blocks = cus * per_cu;
    }
    hipMemsetAsync(p.bar, 0, 256, stream);
    void* args[] = {&p};
    hipError_t e = hipLaunchCooperativeKernel((void*)mega_kernel, dim3(grid_blocks), dim3(NT), args, SMEM_BYTES, stream);
    if (e != hipSuccess) fprintf(stderr, "cooperative launch failed: %s (grid %d)\n", hipGetErrorString(e), grid_blocks);
#else
    const int G = 512;
#define LAUNCH(PH) do { hipFuncSetAttribute((const void*)phase_kernel<PH>, hipFuncAttributeMaxDynamicSharedMemorySize, SMEM_BYTES); \
        hipLaunchKernelGGL(phase_kernel<PH>, dim3(G), dim3(NT), SMEM_BYTES, stream, p); } while (0)
    LAUNCH(0); LAUNCH(1); LAUNCH(2); LAUNCH(3); LAUNCH(4); LAUNCH(5); LAUNCH(6); LAUNCH(7); LAUNCH(8); LAUNCH(9);
#endif
}
```

```cpp
#include <hip/hip_runtime.h>
#include <hip/hip_cooperative_groups.h>
#include <cstdio>
#include <cstdint>
namespace cg = cooperative_groups;

#ifndef FUSED
#define FUSED 1
#endif
#ifndef GEMM_SP2
#define GEMM_SP2 1
#endif
#ifndef MIX_SAMEKIND
#define MIX_SAMEKIND 0
#endif
#ifndef ML_CHUNKED
#define ML_CHUNKED 1
#endif
#ifndef GLA_CHUNKED
#define GLA_CHUNKED 1
#endif

typedef unsigned short bf16_t;
typedef short bf16x8 __attribute__((ext_vector_type(8)));
typedef float f32x4 __attribute__((ext_vector_type(4)));
typedef unsigned u32x4 __attribute__((ext_vector_type(4)));

constexpr int D = 1024, NB = 32, SEQ = 2048, CTX = 256;
constexpr int TL = NB * SEQ;
constexpr int TC = NB * CTX;
constexpr int TT = TL + TC;
constexpr int PT = 3632;
constexpr int PTP = 3840;
constexpr int ZS = 3632;
constexpr int C_MLQ = 0, C_MLK = 512, C_MLV = 1024, C_MLO = 1536, C_MLG = 2048, C_GQ = 2064, C_GK = 2320, C_GV = 2576, C_GR = 3088, C_LR = 3600;
constexpr int NT = 512;
constexpr int SMEM_BYTES = 160 * 1024;
constexpr float EPS = 1e-6f;

struct Params {
    const float *x, *c, *ctx, *c_ctx, *w_mod, *b_mod, *norm1_g, *w_in, *conv_w, *gate_b, *ml_norm_g, *lr_w2, *alpha_b, *gla_norm_g,
        *w_out, *norm2_g, *wq, *keys, *pu, *pv, *norm_f_g;
    float* out;
    float* mod;
    bf16_t* winT;
    bf16_t* woutT;
    bf16_t* wqT;
    bf16_t* keysb;
    unsigned char* u8;
    unsigned char* v8;
    float* usc;
    float* vsc;
    bf16_t* hbuf;
    bf16_t* z;
    float* zg;
    bf16_t* mixh;
    bf16_t* qbuf;
    int* pidx;
    float* pgw;
    bf16_t* ybuf;
    unsigned* bar;
};

__device__ __forceinline__ int opaque_tid() { int t = threadIdx.x; asm volatile("" : "+v"(t)); return t; }
__device__ __forceinline__ float bf2f(bf16_t v) { return __uint_as_float(((unsigned)v) << 16); }
__device__ __forceinline__ bf16_t f2bf(float f) { unsigned u = __float_as_uint(f); u += 0x7fffu + ((u >> 16) & 1u); return (bf16_t)(u >> 16); }
__device__ __forceinline__ unsigned pack2(float a, float b) { return (unsigned)f2bf(a) | ((unsigned)f2bf(b) << 16); }
__device__ __forceinline__ float lo2f(unsigned w) { return __uint_as_float(w << 16); }
__device__ __forceinline__ float hi2f(unsigned w) { return __uint_as_float(w & 0xffff0000u); }
__device__ __forceinline__ float wave_sum(float v) {
#pragma unroll
    for (int o = 32; o > 0; o >>= 1) v += __shfl_xor(v, o);
    return v;
}
__device__ __forceinline__ float wave_max(float v) {
#pragma unroll
    for (int o = 32; o > 0; o >>= 1) v = fmaxf(v, __shfl_xor(v, o));
    return v;
}
template <int CTRL> __device__ __forceinline__ float dppx(float x) {
    return __uint_as_float(__builtin_amdgcn_update_dpp(0u, __float_as_uint(x), CTRL, 0xf, 0xf, false));
}
__device__ __forceinline__ float wave_max_fast(float x) {
    x = fmaxf(x, dppx<0x128>(x)); x = fmaxf(x, dppx<0x124>(x)); x = fmaxf(x, dppx<0x4E>(x)); x = fmaxf(x, dppx<0xB1>(x));
    auto s = __builtin_amdgcn_permlane16_swap(__float_as_uint(x), __float_as_uint(x), false, false);
    x = fmaxf(__uint_as_float(s[0]), __uint_as_float(s[1]));
    auto t = __builtin_amdgcn_permlane32_swap(__float_as_uint(x), __float_as_uint(x), false, false);
    return fmaxf(__uint_as_float(t[0]), __uint_as_float(t[1]));
}
__device__ __forceinline__ float wave_sum_fast(float x) {
    x += dppx<0x128>(x); x += dppx<0x124>(x); x += dppx<0x4E>(x); x += dppx<0xB1>(x);
    auto s = __builtin_amdgcn_permlane16_swap(__float_as_uint(x), __float_as_uint(x), false, false);
    x = __uint_as_float(s[0]) + __uint_as_float(s[1]);
    auto t = __builtin_amdgcn_permlane32_swap(__float_as_uint(x), __float_as_uint(x), false, false);
    return __uint_as_float(t[0]) + __uint_as_float(t[1]);
}
__device__ __forceinline__ float logsig(float x) { return fminf(x, 0.f) - __logf(1.f + __expf(-fabsf(x))); }
__device__ __forceinline__ float silu(float x) { return x / (1.f + __expf(-x)); }
__device__ __forceinline__ float sigm(float x) { return 1.f / (1.f + __expf(-x)); }

namespace pg8 {
#define PG8_LAS __attribute__((address_space(3)))
typedef unsigned short bf16_t;
typedef short bf16x8 __attribute__((ext_vector_type(8)));
typedef float f32x4 __attribute__((ext_vector_type(4)));
typedef unsigned u32x4 __attribute__((ext_vector_type(4)));
constexpr int BM = 256, BK = 64, HALF = 128, HTB = HALF * BK * 2  , STAGE_BYTES = 8 * HTB, NXCD = 8, WGM = 8;

__host__ __device__ __forceinline__ int lds_byte(int r, int c) { const int st = (r >> 4) * 2 + (c >> 5), rr = r & 15, cc = c & 31, ob = rr * 64 + cc * 2; return st * 1024 + (ob ^ (((ob >> 9) & 1) << 5)); }
__host__ __device__ __forceinline__ void stage_rc(int b, int& R, int& C) { const int st = b / 1024, sb = b % 1024, swz = sb ^ (((sb >> 9) & 1) << 5); R = (st >> 1) * 16 + swz / 64; C = (st & 1) * 32 + (swz % 64) / 2; }
__host__ __device__ __forceinline__ int perm32(int rho) { const int n = rho >> 4, i = rho & 15; return 8 * (i >> 2) + 4 * n + (i & 3); }

struct Unit { int pm, pn; };
struct Gemm { const bf16_t* A; const bf16_t* Bt; int M, N, K; };

struct StaticOrder {
    int nM, nN, nwg, G, c;
    __host__ __device__ void init(int M, int N, int G_, int c_) { nM = M / BM; nN = N / BM; nwg = nM * nN; G = G_; c = c_; }
    __host__ __device__ bool next(int i, Unit& u) const {
        const long L = (long)i * G + c; if (L >= nwg) return false;
        int wgid = (int)L; { const int q = nwg / NXCD, r = nwg % NXCD, xcd = wgid % NXCD, off = wgid / NXCD; wgid = (xcd < r ? xcd * (q + 1) : r * (q + 1) + (xcd - r) * q) + off; }
        const int nig = WGM * nN, gid = wgid / nig, fm = gid * WGM, gsz = (nM - fm) < WGM ? (nM - fm) : WGM;
        u.pm = fm + ((wgid % nig) % gsz); u.pn = (wgid % nig) / gsz; return true;
    }
    __device__ __forceinline__ void a_ready(const Unit&) const {}
    __device__ __forceinline__ void done(const Unit&) const {}
};
__device__ __forceinline__ unsigned cvt_pk_bf16(float lo, float hi) { unsigned r; asm volatile("v_cvt_pk_bf16_f32 %0, %1, %2" : "=v"(r) : "v"(lo), "v"(hi)); return r; }

template <class Epi, class Sched, bool STAMP = false>
__device__ __forceinline__ void gemm_phase(PG8_LAS unsigned char* lds, const Gemm g, const Sched& S, const Epi& E, unsigned long long* stamps) {
    const int tid = opaque_tid(), wid = __builtin_amdgcn_readfirstlane(tid >> 6), lane = tid & 63, wr = wid >> 2, wc = wid & 3, fr = lane & 15, fq = lane >> 4;
    const int K = g.K, nt = K / BK;
    int ts_lo = 0, ts_hi = 0, nts = 0; const unsigned long long rt_entry = STAMP ? (unsigned long long)wall_clock64() : 0ull;
#define PG8_STAMP() do { if (STAMP && wid == 0 && nts < 64) { const unsigned long long _c = (unsigned long long)clock64(); \
        ts_lo = (lane == nts) ? (int)(unsigned)_c : ts_lo; ts_hi = (lane == nts) ? (int)(unsigned)(_c >> 32) : ts_hi; ++nts; } } while (0)
    PG8_STAMP();
    unsigned voffA[2], voffB[2];
#pragma unroll
    for (int i = 0; i < 2; ++i) { int R, C; stage_rc(tid * 16 + i * 8192, R, C); const int Rb = Epi::PERM ? ((R & ~31) + perm32(R & 31)) : R;
        voffA[i] = (unsigned)(R * K + C) * 2u; voffB[i] = (unsigned)(Rb * K + C) * 2u; }
    const size_t kstep = (size_t)(BK * 2);
    const size_t hstep = (size_t)HALF * K * 2;
    const size_t tstep = 2 * hstep;
    const unsigned ldsw = (unsigned)wid * 1024u;
    const int aoff = lds_byte(wr * 64 + fr, fq * 8), boff = lds_byte(wc * 32 + fr, fq * 8);
#define PG8_SA(b, h) (((b) * 2 + (h)) * HTB)
#define PG8_SB(b, h) ((4 + (b) * 2 + (h)) * HTB)
#define PG8_STAGE(bufoff, gbase, voff) do { _Pragma("unroll") for (int _i = 0; _i < 2; ++_i) \
        __builtin_amdgcn_global_load_lds((const unsigned*)((const char*)(gbase) + (voff)[_i]), (PG8_LAS unsigned*)(lds + (bufoff) + ldsw + _i * 8192), 16, 0, 0); } while (0)
#define PG8_LDA(dst, b, h) do { _Pragma("unroll") for (int m = 0; m < 4; ++m) _Pragma("unroll") for (int k = 0; k < 2; ++k) dst[m][k] = *(const PG8_LAS bf16x8*)(lds + PG8_SA(b, h) + aoff + m * 2048 + k * 1024); } while (0)
#define PG8_LDB(dst, b, h) do { _Pragma("unroll") for (int n = 0; n < 2; ++n) _Pragma("unroll") for (int k = 0; k < 2; ++k) dst[n][k] = *(const PG8_LAS bf16x8*)(lds + PG8_SB(b, h) + boff + n * 2048 + k * 1024); } while (0)
#define PG8_MMA(ai, bj, At, Bt) do { __builtin_amdgcn_s_setprio(1); _Pragma("unroll") for (int m = 0; m < 4; ++m) _Pragma("unroll") for (int n = 0; n < 2; ++n) _Pragma("unroll") for (int k = 0; k < 2; ++k) \
        acc[ai][bj][m][n] = __builtin_amdgcn_mfma_f32_16x16x32_bf16(Bt[n][k], At[m][k], acc[ai][bj][m][n], 0, 0, 0); __builtin_amdgcn_s_setprio(0); } while (0)
#define PG8_WAIT_V(n) asm volatile("s_waitcnt vmcnt(" #n ")" ::: "memory")
#define PG8_WAIT_L(n) asm volatile("s_waitcnt lgkmcnt(" #n ")" ::: "memory")
#define PG8_BAR __builtin_amdgcn_s_barrier()
#define PG8_SCHED __builtin_amdgcn_sched_barrier(0)
    Unit cur, nxt; int ui = 0;
    if (!S.next(0, cur)) return;
    f32x4 acc[2][2][4][2];
#pragma unroll
    for (int a = 0; a < 2; ++a)
#pragma unroll
        for (int b = 0; b < 2; ++b)
#pragma unroll
            for (int m = 0; m < 4; ++m)
#pragma unroll
                for (int n = 0; n < 2; ++n) acc[a][b][m][n] = (f32x4){0.f, 0.f, 0.f, 0.f};
    bf16x8 At[4][2], B0[2][2], B1[2][2];
    const char* cA = (const char*)g.A + (size_t)cur.pm * tstep; const char* cB = (const char*)g.Bt + (size_t)cur.pn * tstep;
    S.a_ready(cur);
    PG8_STAGE(PG8_SB(0, 0), cB, voffB); PG8_STAGE(PG8_SA(0, 0), cA, voffA); PG8_STAGE(PG8_SB(0, 1), cB + hstep, voffB); PG8_STAGE(PG8_SA(0, 1), cA + hstep, voffA);
    if (wr == 1) PG8_BAR;
    PG8_WAIT_V(4); PG8_BAR;
    PG8_STAGE(PG8_SB(1, 0), cB + kstep, voffB); PG8_STAGE(PG8_SA(1, 0), cA + kstep, voffA); PG8_STAGE(PG8_SB(1, 1), cB + hstep + kstep, voffB);
    PG8_WAIT_V(6); PG8_BAR;
    PG8_STAMP();
    for (;;) {
        const bool has_next = S.next(ui + 1, nxt);
        const char* nA = has_next ? (const char*)g.A + (size_t)nxt.pm * tstep : cA; const char* nB = has_next ? (const char*)g.Bt + (size_t)nxt.pn * tstep : cB;
        for (int t = 0; t < nt; t += 2) {
            const bool last = (t == nt - 2);
            const char* a1 = cA + (size_t)(t + 1) * kstep;
            const char* a2 = last ? nA : cA + (size_t)(t + 2) * kstep; const char* b2 = last ? nB : cB + (size_t)(t + 2) * kstep;
            const char* a3 = a2 + kstep; const char* b3 = b2 + kstep;
            if (last && has_next) S.a_ready(nxt);
            PG8_LDB(B0, 0, 0); PG8_SCHED; PG8_LDA(At, 0, 0); PG8_STAGE(PG8_SA(1, 1), a1 + hstep, voffA);
            PG8_WAIT_L(8); PG8_BAR; PG8_WAIT_L(0); PG8_MMA(0, 0, At, B0); PG8_BAR; PG8_SCHED;
            PG8_LDB(B1, 0, 1); PG8_STAGE(PG8_SB(0, 0), b2, voffB);
            PG8_BAR; PG8_WAIT_L(0); PG8_MMA(0, 1, At, B1); PG8_BAR;
            PG8_LDA(At, 0, 1); PG8_STAGE(PG8_SA(0, 0), a2, voffA);
            PG8_BAR; PG8_WAIT_L(0); PG8_MMA(1, 0, At, B0); PG8_BAR; PG8_SCHED;
            PG8_STAGE(PG8_SB(0, 1), b2 + hstep, voffB);
            PG8_WAIT_V(6); PG8_BAR; PG8_MMA(1, 1, At, B1); PG8_BAR;
            PG8_LDB(B0, 1, 0); PG8_SCHED; PG8_LDA(At, 1, 0); PG8_STAGE(PG8_SA(0, 1), a2 + hstep, voffA);
            PG8_WAIT_L(8); PG8_BAR; PG8_WAIT_L(0); PG8_MMA(0, 0, At, B0); PG8_BAR; PG8_SCHED;
            PG8_LDB(B1, 1, 1); PG8_STAGE(PG8_SB(1, 0), b3, voffB);
            PG8_BAR; PG8_WAIT_L(0); PG8_MMA(0, 1, At, B1); PG8_BAR;
            PG8_LDA(At, 1, 1); PG8_STAGE(PG8_SA(1, 0), a3, voffA);
            PG8_BAR; PG8_WAIT_L(0); PG8_MMA(1, 0, At, B0); PG8_BAR; PG8_SCHED;
            PG8_STAGE(PG8_SB(1, 1), b3 + hstep, voffB);
            PG8_WAIT_V(6); PG8_BAR; PG8_MMA(1, 1, At, B1); PG8_BAR;
        }
        PG8_STAMP();
        if constexpr (!Epi::AFTER_DRAIN) { E(acc, cur, wr, wc, fr, fq); S.done(cur); }
        PG8_STAMP();
        if (!has_next) break;
#pragma unroll
        for (int a = 0; a < 2; ++a)
#pragma unroll
            for (int b = 0; b < 2; ++b)
#pragma unroll
                for (int m = 0; m < 4; ++m)
#pragma unroll
                    for (int n = 0; n < 2; ++n) acc[a][b][m][n] = (f32x4){0.f, 0.f, 0.f, 0.f};
        cur = nxt; cA = nA; cB = nB; ++ui;
    }
    PG8_WAIT_V(0);
    if (wr == 0) PG8_BAR;
    PG8_BAR;
    if constexpr (Epi::AFTER_DRAIN) { E.fused(acc, cur, wr, wc, fr, fq, lds, wid, lane); S.done(cur); }
    PG8_STAMP();
    if (STAMP && wid == 0) { stamps[lane] = lane < nts ? (((unsigned long long)(unsigned)ts_hi << 32) | (unsigned)ts_lo) : 0ull;
        if (lane == 62) stamps[62] = rt_entry; if (lane == 63) stamps[63] = (unsigned long long)wall_clock64(); }
#undef PG8_STAMP
#undef PG8_SA
#undef PG8_SB
#undef PG8_STAGE
#undef PG8_LDA
#undef PG8_LDB
#undef PG8_MMA
#undef PG8_WAIT_V
#undef PG8_WAIT_L
#undef PG8_BAR
#undef PG8_SCHED
}
template <class Epi, class Sched, bool ALIGN_EPI = false, bool SP2 = false>
__device__ __forceinline__ void gemm_phase_sp2(PG8_LAS unsigned char* lds, const Gemm g, const Sched& S, const Epi& E) {
    const int tid = opaque_tid(), wid = __builtin_amdgcn_readfirstlane(tid >> 6), lane = tid & 63, wr = wid >> 2, wc = wid & 3, fr = lane & 15, fq = lane >> 4;
    const int K = g.K, nt = K / BK;
    unsigned voffA[2], voffB[2];
#pragma unroll
    for (int i = 0; i < 2; ++i) { int R, C; stage_rc(tid * 16 + i * 8192, R, C); const int Rb = Epi::PERM ? ((R & ~31) + perm32(R & 31)) : R;
        voffA[i] = (unsigned)(R * K + C) * 2u; voffB[i] = (unsigned)(Rb * K + C) * 2u; }
    const size_t kstep = (size_t)(BK * 2);
    const size_t hstep = (size_t)HALF * K * 2;
    const size_t tstep = 2 * hstep;
    const unsigned ldsw = (unsigned)wid * 1024u;
    const int aoff = lds_byte(wr * 64 + fr, fq * 8), boff = lds_byte(wc * 32 + fr, fq * 8);
#define PG8_SA(b, h) (((b) * 2 + (h)) * HTB)
#define PG8_SB(b, h) ((4 + (b) * 2 + (h)) * HTB)
#define PG8_STAGE(bufoff, gbase, voff) do { _Pragma("unroll") for (int _i = 0; _i < 2; ++_i) \
        __builtin_amdgcn_global_load_lds((const unsigned*)((const char*)(gbase) + (voff)[_i]), (PG8_LAS unsigned*)(lds + (bufoff) + ldsw + _i * 8192), 16, 0, 0); } while (0)
#define PG8_LDA(dst, b, h) do { _Pragma("unroll") for (int m = 0; m < 4; ++m) _Pragma("unroll") for (int k = 0; k < 2; ++k) dst[m][k] = *(const PG8_LAS bf16x8*)(lds + PG8_SA(b, h) + aoff + m * 2048 + k * 1024); } while (0)
#define PG8_LDB(dst, b, h) do { _Pragma("unroll") for (int n = 0; n < 2; ++n) _Pragma("unroll") for (int k = 0; k < 2; ++k) dst[n][k] = *(const PG8_LAS bf16x8*)(lds + PG8_SB(b, h) + boff + n * 2048 + k * 1024); } while (0)
#define PG8_MMA(ai, bj, At, Bt) do { __builtin_amdgcn_s_setprio(1); _Pragma("unroll") for (int m = 0; m < 4; ++m) _Pragma("unroll") for (int n = 0; n < 2; ++n) _Pragma("unroll") for (int k = 0; k < 2; ++k) \
        acc[ai][bj][m][n] = __builtin_amdgcn_mfma_f32_16x16x32_bf16(Bt[n][k], At[m][k], acc[ai][bj][m][n], 0, 0, 0); __builtin_amdgcn_s_setprio(0); } while (0)
#define PG8_WAIT_V(n) asm volatile("s_waitcnt vmcnt(" #n ")" ::: "memory")
#define PG8_WAIT_L(n) asm volatile("s_waitcnt lgkmcnt(" #n ")" ::: "memory")
#define PG8_BAR __builtin_amdgcn_s_barrier()
#define PG8_SCHED __builtin_amdgcn_sched_barrier(0)
    Unit cur, nxt; int ui = 0;
    if (!S.next(0, cur)) return;
    f32x4 acc[2][2][4][2];
#pragma unroll
    for (int a = 0; a < 2; ++a)
#pragma unroll
        for (int b = 0; b < 2; ++b)
#pragma unroll
            for (int m = 0; m < 4; ++m)
#pragma unroll
                for (int n = 0; n < 2; ++n) acc[a][b][m][n] = (f32x4){0.f, 0.f, 0.f, 0.f};
    bf16x8 At[4][2], B0[2][2], B1[2][2];
    const char* cA = (const char*)g.A + (size_t)cur.pm * tstep; const char* cB = (const char*)g.Bt + (size_t)cur.pn * tstep;
    S.a_ready(cur);
    if constexpr (SP2) {
        PG8_STAGE(PG8_SB(0, 0), cB, voffB); PG8_STAGE(PG8_SB(0, 1), cB + hstep, voffB); PG8_STAGE(PG8_SA(0, 0), cA, voffA); PG8_STAGE(PG8_SA(0, 1), cA + hstep, voffA);
        if (wr == 1) PG8_BAR;
        PG8_WAIT_V(2); PG8_BAR;
        PG8_STAGE(PG8_SB(1, 0), cB + kstep, voffB); PG8_STAGE(PG8_SA(1, 0), cA + kstep, voffA); PG8_STAGE(PG8_SB(1, 1), cB + hstep + kstep, voffB);
        PG8_WAIT_V(6); PG8_BAR;
    } else {
        PG8_STAGE(PG8_SB(0, 0), cB, voffB); PG8_STAGE(PG8_SA(0, 0), cA, voffA); PG8_STAGE(PG8_SB(0, 1), cB + hstep, voffB); PG8_STAGE(PG8_SA(0, 1), cA + hstep, voffA);
        if (wr == 1) PG8_BAR;
        PG8_WAIT_V(4); PG8_BAR;
        PG8_STAGE(PG8_SB(1, 0), cB + kstep, voffB); PG8_STAGE(PG8_SA(1, 0), cA + kstep, voffA); PG8_STAGE(PG8_SB(1, 1), cB + hstep + kstep, voffB);
        PG8_WAIT_V(6); PG8_BAR;
    }
    for (;;) {
        const bool has_next = S.next(ui + 1, nxt);
        const char* nA = has_next ? (const char*)g.A + (size_t)nxt.pm * tstep : cA; const char* nB = has_next ? (const char*)g.Bt + (size_t)nxt.pn * tstep : cB;
        for (int t = 0; t < nt; t += 2) {
            const bool last = (t == nt - 2);
            const char* a1 = cA + (size_t)(t + 1) * kstep;
            const char* a2 = last ? nA : cA + (size_t)(t + 2) * kstep; const char* b2 = last ? nB : cB + (size_t)(t + 2) * kstep;
            const char* a3 = a2 + kstep; const char* b3 = b2 + kstep;
            if (last && has_next) S.a_ready(nxt);
            if constexpr (SP2) {
            PG8_LDB(B0, 0, 0); PG8_LDB(B1, 0, 1); PG8_SCHED; PG8_LDA(At, 0, 0); PG8_STAGE(PG8_SA(1, 1), a1 + hstep, voffA);
            PG8_WAIT_V(8); PG8_WAIT_L(0); PG8_BAR; PG8_MMA(0, 0, At, B0); PG8_MMA(0, 1, At, B1); PG8_BAR; PG8_SCHED;
            PG8_LDA(At, 0, 1); PG8_STAGE(PG8_SB(0, 0), b2, voffB); PG8_STAGE(PG8_SB(0, 1), b2 + hstep, voffB); PG8_STAGE(PG8_SA(0, 0), a2, voffA);
            PG8_WAIT_V(8); PG8_WAIT_L(0); PG8_BAR; PG8_MMA(1, 0, At, B0); PG8_MMA(1, 1, At, B1); PG8_BAR; PG8_SCHED;
            PG8_LDB(B0, 1, 0); PG8_LDB(B1, 1, 1); PG8_SCHED; PG8_LDA(At, 1, 0); PG8_STAGE(PG8_SA(0, 1), a2 + hstep, voffA);
            PG8_WAIT_V(8); PG8_WAIT_L(0); PG8_BAR; PG8_MMA(0, 0, At, B0); PG8_MMA(0, 1, At, B1); PG8_BAR; PG8_SCHED;
            PG8_LDA(At, 1, 1); PG8_STAGE(PG8_SB(1, 0), b3, voffB); PG8_STAGE(PG8_SB(1, 1), b3 + hstep, voffB); PG8_STAGE(PG8_SA(1, 0), a3, voffA);
            PG8_WAIT_V(8); PG8_WAIT_L(0); PG8_BAR; PG8_MMA(1, 0, At, B0); PG8_MMA(1, 1, At, B1); PG8_BAR; PG8_SCHED;
            } else {
            PG8_LDB(B0, 0, 0); PG8_SCHED; PG8_LDA(At, 0, 0); PG8_STAGE(PG8_SA(1, 1), a1 + hstep, voffA);
            PG8_WAIT_L(8); PG8_BAR; PG8_WAIT_L(0); PG8_MMA(0, 0, At, B0); PG8_BAR; PG8_SCHED;
            PG8_LDB(B1, 0, 1); PG8_STAGE(PG8_SB(0, 0), b2, voffB);
            PG8_BAR; PG8_WAIT_L(0); PG8_MMA(0, 1, At, B1); PG8_BAR;
            PG8_LDA(At, 0, 1); PG8_STAGE(PG8_SA(0, 0), a2, voffA);
            PG8_BAR; PG8_WAIT_L(0); PG8_MMA(1, 0, At, B0); PG8_BAR; PG8_SCHED;
            PG8_STAGE(PG8_SB(0, 1), b2 + hstep, voffB);
            PG8_WAIT_V(6); PG8_BAR; PG8_MMA(1, 1, At, B1); PG8_BAR;
            PG8_LDB(B0, 1, 0); PG8_SCHED; PG8_LDA(At, 1, 0); PG8_STAGE(PG8_SA(0, 1), a2 + hstep, voffA);
            PG8_WAIT_L(8); PG8_BAR; PG8_WAIT_L(0); PG8_MMA(0, 0, At, B0); PG8_BAR; PG8_SCHED;
            PG8_LDB(B1, 1, 1); PG8_STAGE(PG8_SB(1, 0), b3, voffB);
            PG8_BAR; PG8_WAIT_L(0); PG8_MMA(0, 1, At, B1); PG8_BAR;
            PG8_LDA(At, 1, 1); PG8_STAGE(PG8_SA(1, 0), a3, voffA);
            PG8_BAR; PG8_WAIT_L(0); PG8_MMA(1, 0, At, B0); PG8_BAR; PG8_SCHED;
            PG8_STAGE(PG8_SB(1, 1), b3 + hstep, voffB);
            PG8_WAIT_V(6); PG8_BAR; PG8_MMA(1, 1, At, B1); PG8_BAR;
            }
        }
        if constexpr (ALIGN_EPI) { if (wr == 0) PG8_BAR; }
        if constexpr (!Epi::AFTER_DRAIN) { E(acc, cur, wr, wc, fr, fq); S.done(cur); }
        if (!has_next) break;
#pragma unroll
        for (int a = 0; a < 2; ++a)
#pragma unroll
            for (int b = 0; b < 2; ++b)
#pragma unroll
                for (int m = 0; m < 4; ++m)
#pragma unroll
                    for (int n = 0; n < 2; ++n) acc[a][b][m][n] = (f32x4){0.f, 0.f, 0.f, 0.f};
        cur = nxt; cA = nA; cB = nB; ++ui;
        if constexpr (ALIGN_EPI) { if (wr == 1) PG8_BAR; }
    }
    PG8_WAIT_V(0);
    if constexpr (!ALIGN_EPI) { if (wr == 0) PG8_BAR; }
    PG8_BAR;
    if constexpr (Epi::AFTER_DRAIN) { E.fused(acc, cur, wr, wc, fr, fq, lds, wid, lane); S.done(cur); }
#undef PG8_SA
#undef PG8_SB
#undef PG8_STAGE
#undef PG8_LDA
#undef PG8_LDB
#undef PG8_MMA
#undef PG8_WAIT_V
#undef PG8_WAIT_L
#undef PG8_BAR
#undef PG8_SCHED
}
}

__device__ void phase_mod(const Params& p, char* smem, int bid, int nblk) {
    const int tidx_ = opaque_tid();
    float* condL = (float*)smem;
    const int tid = tidx_, cl = tid & 63, ks = tid >> 6;
    for (int item = bid; item < 96; item += nblk) {
        const int col0 = item * 64, col = col0 + cl;
        float acc[33];
#pragma unroll
        for (int b = 0; b < 33; ++b) acc[b] = 0.f;
        for (int kc = 0; kc < 4; ++kc) {
            __syncthreads();
            for (int e = tid; e < 8 * 32 * 33; e += NT) {
                const int sl = e / (32 * 33), kk = (e / 33) % 32, b = e % 33;
                const int k = sl * 128 + kc * 32 + kk;
                const float cv = b < 32 ? p.c[b * 1024 + k] : p.c_ctx[k];
                condL[e] = silu(cv);
            }
            __syncthreads();
            for (int kk = 0; kk < 32; ++kk) {
                const int k = ks * 128 + kc * 32 + kk;
                const float w = p.w_mod[(size_t)k * 6144 + col];
                const float* cp = condL + (ks * 32 + kk) * 33;
#pragma unroll
                for (int b = 0; b < 33; ++b) acc[b] += w * cp[b];
            }
        }
        __syncthreads();
#pragma unroll
        for (int b = 0; b < 33; ++b) condL[(ks * 33 + b) * 64 + cl] = acc[b];
        __syncthreads();
        for (int e = tid; e < 33 * 64; e += NT) {
            const int b = e >> 6, cc = e & 63;
            float v = 0.f;
#pragma unroll
            for (int q = 0; q < 8; ++q) v += condL[(q * 33 + b) * 64 + cc];
            p.mod[b * 6144 + col0 + cc] = v + p.b_mod[col0 + cc];
        }
        __syncthreads();
    }
}

__device__ void convT(const float* __restrict__ src, int K, int N, int Npad, bf16_t* __restrict__ dst, char* smem, int bid, int nblk) {
    const int tidx_ = opaque_tid();
    float* tile = (float*)smem;
    const int tid = tidx_;
    const int nk = K / 64, nn = Npad / 64;
    for (int t = bid; t < nk * nn; t += nblk) {
        const int k0 = (t % nk) * 64, n0 = (t / nk) * 64;
        __syncthreads();
#pragma unroll
        for (int r = 0; r < 64 / (NT / 64); ++r) {
            const int k = r * (NT / 64) + (tid >> 6), n = tid & 63;
            tile[k * 65 + n] = (n0 + n < N) ? src[(size_t)(k0 + k) * N + n0 + n] : 0.f;
        }
        __syncthreads();
#pragma unroll
        for (int r = 0; r < 64 / (NT / 64); ++r) {
            const int n = r * (NT / 64) + (tid >> 6), k = tid & 63;
            dst[(size_t)(n0 + n) * K + k0 + k] = f2bf(tile[k * 65 + n]);
        }
    }
    __syncthreads();
}
__device__ void conv_copy(const float* __restrict__ src, bf16_t* __restrict__ dst, size_t n, int gtid, int gthreads) {
    const size_t n4 = n / 4;
    for (size_t i = gtid; i < n4; i += gthreads) {
        const float4 v = ((const float4*)src)[i];
        uint2 o; o.x = pack2(v.x, v.y); o.y = pack2(v.z, v.w);
        ((uint2*)dst)[i] = o;
    }
}
__device__ void phase_convert(const Params& p, char* smem, int bid, int nblk) {
    const int tidx_ = opaque_tid();
    convT(p.w_in, 1024, PT, PTP, p.winT, smem, bid, nblk);
    convT(p.w_out, 1024, 1024, 1024, p.woutT, smem, bid, nblk);
    convT(p.wq, 1024, 2048, 2048, p.wqT, smem, bid, nblk);
    const int gtid = bid * NT + tidx_, gth = nblk * NT;
    conv_copy(p.keys, p.keysb, (size_t)8 * 2 * 128 * 128, gtid, gth);
    {
        const int lane = tidx_ & 63;
        const int gw = bid * (NT / 64) + (tidx_ >> 6), nw = nblk * (NT / 64);
        for (int row = gw; row < 2 * 16384; row += nw) {
            const bool isv = row >= 16384;
            const int r = isv ? row - 16384 : row;
            const float* src = (isv ? p.pv : p.pu) + (size_t)r * 1024 + lane * 16;
            f32x4 v[4];
            float mx = 0.f;
#pragma unroll
            for (int q = 0; q < 4; ++q) { v[q] = *(const f32x4*)(src + 4 * q); mx = fmaxf(mx, fmaxf(fmaxf(fabsf(v[q][0]), fabsf(v[q][1])), fmaxf(fabsf(v[q][2]), fabsf(v[q][3])))); }
            mx = wave_max(mx);
            mx = fmaxf(mx, 1e-30f);
            const float sc = 7.5f / mx;
            unsigned c[16];
#pragma unroll
            for (int i = 0; i < 16; ++i) {
                const float x = v[i >> 2][i & 3] * sc, a = fabsf(x);
                const float code = a < 2.f ? rintf(a * 8.f) : (a < 4.f ? 8.f + rintf(a * 4.f) : 16.f + rintf(a * 2.f));
                unsigned ci = (unsigned)fminf(code, 31.f);
                c[i] = ci | (x < 0.f ? 32u : 0u);
            }
            unsigned long long lo = 0ull; unsigned hi = 0u;
#pragma unroll
            for (int i = 0; i < 10; ++i) lo |= (unsigned long long)c[i] << (6 * i);
            lo |= (unsigned long long)(c[10] & 0xfu) << 60;
            hi = c[10] >> 4;
#pragma unroll
            for (int i = 11; i < 16; ++i) hi |= c[i] << (2 + 6 * (i - 11));
            unsigned* dst = (unsigned*)((isv ? p.v8 : p.u8) + (size_t)r * 768 + lane * 12);
            dst[0] = (unsigned)lo; dst[1] = (unsigned)(lo >> 32); dst[2] = hi;
            if (lane == 0) (isv ? p.vsc : p.usc)[r] = mx * (1.f / 7.5f);
        }
    }
}

template <int R>
__device__ __forceinline__ void norm_rows(const float* __restrict__ srcbase, const float* __restrict__ src2, int nrows1, int nrows, const float* __restrict__ gvec,
                                          const float* __restrict__ mod, int sc_off, int sh_off, bf16_t* __restrict__ dst, int gw, int nw, int lane) {
    for (int row0 = gw; row0 < nrows; row0 += R * nw) {
        f32x4 v[R][4]; float ss[R];
#pragma unroll
        for (int r = 0; r < R; ++r) {
            const int row = min(row0 + r * nw, nrows - 1);
            const float* src = row < nrows1 ? srcbase + (size_t)row * D : src2 + (size_t)(row - nrows1) * D;
#pragma unroll
            for (int j = 0; j < 4; ++j) v[r][j] = *(const f32x4*)(src + j * 256 + lane * 4);
        }
#pragma unroll
        for (int r = 0; r < R; ++r) {
            float a = 0.f;
#pragma unroll
            for (int j = 0; j < 4; ++j) a += v[r][j][0] * v[r][j][0] + v[r][j][1] * v[r][j][1] + v[r][j][2] * v[r][j][2] + v[r][j][3] * v[r][j][3];
            ss[r] = a;
        }
#pragma unroll
        for (int r = 0; r < R; ++r) ss[r] = wave_sum_fast(ss[r]);
#pragma unroll
        for (int r = 0; r < R; ++r) {
            const int row = row0 + r * nw;
            if (row >= nrows) continue;
            const float rstd = rsqrtf(ss[r] * (1.f / 1024.f) + EPS);
            const float* md = mod + (row < TL ? (row >> 11) : 32) * 6144;
#pragma unroll
            for (int j = 0; j < 4; ++j) {
                const int col = j * 256 + lane * 4;
                const f32x4 g = *(const f32x4*)(gvec + col), sc = *(const f32x4*)(md + sc_off + col), sh = *(const f32x4*)(md + sh_off + col);
                uint2 o;
                o.x = pack2(v[r][j][0] * rstd * g[0] * (1.f + sc[0]) + sh[0], v[r][j][1] * rstd * g[1] * (1.f + sc[1]) + sh[1]);
                o.y = pack2(v[r][j][2] * rstd * g[2] * (1.f + sc[2]) + sh[2], v[r][j][3] * rstd * g[3] * (1.f + sc[3]) + sh[3]);
                *(uint2*)(dst + (size_t)row * D + col) = o;
            }
        }
    }
}
template <int R, bool WITH_Y>
__device__ __forceinline__ void norm_span(const float* __restrict__ src, const bf16_t* __restrict__ ysrc, const float* __restrict__ gvec, const float* __restrict__ md,
                                          int sc_off, int sh_off, bf16_t* __restrict__ dst, int nr, int lane) {
    float A[16], B[16], G1[16];
#pragma unroll
    for (int q = 0; q < 2; ++q)
#pragma unroll
        for (int hq = 0; hq < 2; ++hq) {
            const int col = q * 512 + lane * 8 + hq * 4;
            const f32x4 g = *(const f32x4*)(gvec + col), sc = *(const f32x4*)(md + sc_off + col), sh = *(const f32x4*)(md + sh_off + col);
            f32x4 g1 = (f32x4){0.f, 0.f, 0.f, 0.f};
            if (WITH_Y) g1 = *(const f32x4*)(md + 2048 + col);
#pragma unroll
            for (int k = 0; k < 4; ++k) { A[q * 8 + hq * 4 + k] = g[k] * (1.f + sc[k]); B[q * 8 + hq * 4 + k] = sh[k]; G1[q * 8 + hq * 4 + k] = g1[k]; }
        }
    for (int i0 = 0; i0 < nr; i0 += R) {
        f32x4 v[R][4]; u32x4 yv[R][2];
#pragma unroll
        for (int r = 0; r < R; ++r) {
            const float* sp = src + (size_t)(i0 + r) * D + lane * 8;
            v[r][0] = *(const f32x4*)sp; v[r][1] = *(const f32x4*)(sp + 4); v[r][2] = *(const f32x4*)(sp + 512); v[r][3] = *(const f32x4*)(sp + 516);
            if (WITH_Y) { const bf16_t* yp = ysrc + (size_t)(i0 + r) * D + lane * 8; yv[r][0] = *(const u32x4*)yp; yv[r][1] = *(const u32x4*)(yp + 512); }
        }
        float ss[R];
#pragma unroll
        for (int r = 0; r < R; ++r) {
            if (WITH_Y) {
#pragma unroll
                for (int q = 0; q < 2; ++q)
#pragma unroll
                    for (int k = 0; k < 4; ++k) {
                        v[r][2 * q + (k >> 1)][(k & 1) * 2] += G1[q * 8 + 2 * k] * lo2f(yv[r][q][k]);
                        v[r][2 * q + (k >> 1)][(k & 1) * 2 + 1] += G1[q * 8 + 2 * k + 1] * hi2f(yv[r][q][k]);
                    }
            }
            float a = 0.f;
#pragma unroll
            for (int j = 0; j < 4; ++j) a += v[r][j][0] * v[r][j][0] + v[r][j][1] * v[r][j][1] + v[r][j][2] * v[r][j][2] + v[r][j][3] * v[r][j][3];
            ss[r] = a;
        }
#pragma unroll
        for (int r = 0; r < R; ++r) ss[r] = wave_sum_fast(ss[r]);
#pragma unroll
        for (int r = 0; r < R; ++r) {
            const float rstd = rsqrtf(ss[r] * (1.f / 1024.f) + EPS);
#pragma unroll
            for (int q = 0; q < 2; ++q) {
                float o[8];
#pragma unroll
                for (int k = 0; k < 8; ++k) o[k] = v[r][2 * q + (k >> 2)][k & 3] * rstd * A[q * 8 + k] + B[q * 8 + k];
                *(u32x4*)(dst + (size_t)(i0 + r) * D + q * 512 + lane * 8) = (u32x4){pack2(o[0], o[1]), pack2(o[2], o[3]), pack2(o[4], o[5]), pack2(o[6], o[7])};
            }
        }
    }
}
__device__ void phase_norm1(const Params& p, int bid, int nblk) {
    const int tidx_ = opaque_tid();
    const int lane = tidx_ & 63, gw = bid * (NT / 64) + (tidx_ >> 6), nw = nblk * (NT / 64);
    for (int sp = gw; sp < TL / 32; sp += nw)
        norm_span<4, false>(p.x + (size_t)sp * 32 * D, nullptr, p.norm1_g, p.mod + (sp >> 6) * 6144, 1024, 0, p.hbuf + (size_t)sp * 32 * D, 32, lane);
    for (int sp = gw; sp < TC / 4; sp += nw)
        norm_span<4, false>(p.ctx + (size_t)sp * 4 * D, nullptr, p.norm1_g, p.mod + 32 * 6144, 1024, 0, p.hbuf + (size_t)(TL + sp * 4) * D, 4, lane);
}

template <int CL, int CR> __device__ __forceinline__ float dpp_nb(float oldv, float cur) {
    return __uint_as_float(__builtin_amdgcn_update_dpp(__float_as_uint(oldv), __float_as_uint(cur), CL, 0xf, 0xf, false));
}
struct EpiZ {
    static constexpr bool PERM = true, AFTER_DRAIN = false;
    bf16_t* z; float* zg; const float* gate_b; const float* conv_w;
    __device__ __forceinline__ void operator()(const f32x4 (&acc)[2][2][4][2], const pg8::Unit& u, int wr, int wc, int fr, int fq) const {
        const int row0 = u.pm * 256 + wr * 64 + fr, colb = u.pn * 256 + wc * 32 + 8 * fq;
        if (u.pn < 4 && u.pm * 256 < TL) {
#pragma unroll
            for (int bj = 0; bj < 2; ++bj) {
                const int col = colb + bj * 128;
                const float scl = col >= 512 ? 0.08838834764831845f : 1.f;
                f32x4 w0[2], w1[2], w2[2];
#pragma unroll
                for (int n = 0; n < 2; ++n) { w0[n] = *(const f32x4*)(conv_w + col + 4 * n); w1[n] = *(const f32x4*)(conv_w + 1024 + col + 4 * n); w2[n] = *(const f32x4*)(conv_w + 2048 + col + 4 * n); }
#pragma unroll
                for (int ai = 0; ai < 2; ++ai) {
                    f32x4 o[4][2];
#pragma unroll
                    for (int n = 0; n < 2; ++n)
#pragma unroll
                        for (int m = 0; m < 4; ++m)
#pragma unroll
                            for (int c = 0; c < 4; ++c) {
                                const float cur = acc[ai][bj][m][n][c];
                                const float oL = m > 0 ? __uint_as_float(__builtin_amdgcn_update_dpp(0u, __float_as_uint(acc[ai][bj][m > 0 ? m - 1 : 0][n][c]), 0x121, 0xf, 0xf, false)) : 0.f;
                                const float oR = m < 3 ? __uint_as_float(__builtin_amdgcn_update_dpp(0u, __float_as_uint(acc[ai][bj][m < 3 ? m + 1 : 3][n][c]), 0x12F, 0xf, 0xf, false)) : 0.f;
                                const float L = __uint_as_float(__builtin_amdgcn_update_dpp(__float_as_uint(oL), __float_as_uint(cur), 0x111, 0xf, 0xf, false));
                                const float R = __uint_as_float(__builtin_amdgcn_update_dpp(__float_as_uint(oR), __float_as_uint(cur), 0x101, 0xf, 0xf, false));
                                o[m][n][c] = silu(w0[n][c] * L + w1[n][c] * cur + w2[n][c] * R) * scl;
                            }
#pragma unroll
                    for (int m = 0; m < 4; ++m) {
                        const size_t row = (size_t)(row0 + ai * 128 + m * 16);
                        const f32x4 v0 = o[m][0], v1 = o[m][1];
                        u32x4 w; w.x = pg8::cvt_pk_bf16(v0[0], v0[1]); w.y = pg8::cvt_pk_bf16(v0[2], v0[3]); w.z = pg8::cvt_pk_bf16(v1[0], v1[1]); w.w = pg8::cvt_pk_bf16(v1[2], v1[3]);
                        *(u32x4*)(z + row * ZS + col) = w;
                    }
                }
            }
            return;
        }
#pragma unroll
        for (int bj = 0; bj < 2; ++bj) {
            const int col = colb + bj * 128;
            if (col >= PT) continue;
            const bool isg = (col >= C_MLG && col < C_GQ), isl = (col >= C_LR);
#pragma unroll
            for (int ai = 0; ai < 2; ++ai)
#pragma unroll
                for (int m = 0; m < 4; ++m) {
                    const size_t row = (size_t)(row0 + ai * 128 + m * 16);
                    const f32x4 v0 = acc[ai][bj][m][0], v1 = acc[ai][bj][m][1];
                    if (isg) {
                        float* dst = zg + row * 48 + (col - C_MLG);
                        *(f32x4*)dst = v0 + *(const f32x4*)(gate_b + (col - C_MLG));
                        *(f32x4*)(dst + 4) = v1 + *(const f32x4*)(gate_b + (col - C_MLG) + 4);
                    } else if (isl) {
                        float* dst = zg + row * 48 + 16 + (col - C_LR);
                        *(f32x4*)dst = v0; *(f32x4*)(dst + 4) = v1;
                    } else {
                        u32x4 w; w.x = pg8::cvt_pk_bf16(v0[0], v0[1]); w.y = pg8::cvt_pk_bf16(v0[2], v0[3]); w.z = pg8::cvt_pk_bf16(v1[0], v1[1]); w.w = pg8::cvt_pk_bf16(v1[2], v1[3]);
                        *(u32x4*)(z + row * ZS + col) = w;
                    }
                }
        }
    }
};
struct EpiX1 {
    static constexpr bool PERM = false, AFTER_DRAIN = false;
    const float* x; const float* mod; float* out;
    __device__ __forceinline__ void operator()(const f32x4 (&acc)[2][2][4][2], const pg8::Unit& u, int wr, int wc, int fr, int fq) const {
        const int row0 = u.pm * 256 + wr * 64 + fr, col0 = u.pn * 256 + wc * 32 + 4 * fq;
#pragma unroll
        for (int ai = 0; ai < 2; ++ai)
#pragma unroll
            for (int m = 0; m < 4; ++m) {
                const int row = row0 + ai * 128 + m * 16;
                const float* g1 = mod + (row >> 11) * 6144 + 2048;
#pragma unroll
                for (int bj = 0; bj < 2; ++bj)
#pragma unroll
                    for (int n = 0; n < 2; ++n) {
                        const int col = col0 + bj * 128 + n * 16;
                        const size_t o = (size_t)row * D + col;
                        *(f32x4*)(out + o) = *(const f32x4*)(x + o) + *(const f32x4*)(g1 + col) * acc[ai][bj][m][n];
                    }
            }
    }
};
struct EpiY {
    static constexpr bool PERM = true, AFTER_DRAIN = false;
    bf16_t* y;
    __device__ __forceinline__ void operator()(const f32x4 (&acc)[2][2][4][2], const pg8::Unit& u, int wr, int wc, int fr, int fq) const {
        const int row0 = u.pm * 256 + wr * 64 + fr, colb = u.pn * 256 + wc * 32 + 8 * fq;
#pragma unroll
        for (int ai = 0; ai < 2; ++ai)
#pragma unroll
            for (int m = 0; m < 4; ++m) {
                bf16_t* rowp = y + (size_t)(row0 + ai * 128 + m * 16) * 1024 + colb;
#pragma unroll
                for (int bj = 0; bj < 2; ++bj) {
                    const f32x4 v0 = acc[ai][bj][m][0], v1 = acc[ai][bj][m][1];
                    u32x4 w; w.x = pg8::cvt_pk_bf16(v0[0], v0[1]); w.y = pg8::cvt_pk_bf16(v0[2], v0[3]); w.z = pg8::cvt_pk_bf16(v1[0], v1[1]); w.w = pg8::cvt_pk_bf16(v1[2], v1[3]);
                    *(u32x4*)(rowp + bj * 128) = w;
                }
            }
    }
};
struct EpiQb {
    static constexpr bool PERM = true, AFTER_DRAIN = false;
    bf16_t* q;
    __device__ __forceinline__ void operator()(const f32x4 (&acc)[2][2][4][2], const pg8::Unit& u, int wr, int wc, int fr, int fq) const {
        const int row0 = u.pm * 256 + wr * 64 + fr, colb = u.pn * 256 + wc * 32 + 8 * fq;
#pragma unroll
        for (int ai = 0; ai < 2; ++ai)
#pragma unroll
            for (int m = 0; m < 4; ++m) {
                bf16_t* rowp = q + (size_t)(row0 + ai * 128 + m * 16) * 2048 + colb;
#pragma unroll
                for (int bj = 0; bj < 2; ++bj) {
                    const f32x4 v0 = acc[ai][bj][m][0], v1 = acc[ai][bj][m][1];
                    u32x4 w; w.x = pg8::cvt_pk_bf16(v0[0], v0[1]); w.y = pg8::cvt_pk_bf16(v0[2], v0[3]); w.z = pg8::cvt_pk_bf16(v1[0], v1[1]); w.w = pg8::cvt_pk_bf16(v1[2], v1[3]);
                    *(u32x4*)(rowp + bj * 128) = w;
                }
            }
    }
};
template <class Epi>
__device__ __forceinline__ void gemm_run(const bf16_t* A, const bf16_t* Bt, int M, int N, int K, const Epi& e, char* smem, int bid, int nblk) {
    pg8::Gemm g{A, Bt, M, N, K};
    pg8::StaticOrder S; S.init(M, N, nblk, bid);
#if GEMM_SP2
    pg8::gemm_phase_sp2<Epi, pg8::StaticOrder, true, true>((PG8_LAS unsigned char*)smem, g, S, e);
#else
    pg8::gemm_phase<Epi, pg8::StaticOrder, false>((PG8_LAS unsigned char*)smem, g, S, e, nullptr);
#endif
}

#define MFMA16(a, b, c) __builtin_amdgcn_mfma_f32_16x16x32_bf16((a), (b), (c), 0, 0, 0)
__device__ __forceinline__ void conv8(const Params& p, const bf16_t* zc, int col, bool vl, bool vr, float scl, float* y) {
    const u32x4 cc = *(const u32x4*)zc;
    u32x4 ll = (u32x4){0u, 0u, 0u, 0u}, rr = (u32x4){0u, 0u, 0u, 0u};
    if (vl) ll = *(const u32x4*)(zc - ZS);
    if (vr) rr = *(const u32x4*)(zc + ZS);
    const f32x4 w0a = *(const f32x4*)(p.conv_w + col), w0b = *(const f32x4*)(p.conv_w + col + 4);
    const f32x4 w1a = *(const f32x4*)(p.conv_w + 1024 + col), w1b = *(const f32x4*)(p.conv_w + 1024 + col + 4);
    const f32x4 w2a = *(const f32x4*)(p.conv_w + 2048 + col), w2b = *(const f32x4*)(p.conv_w + 2048 + col + 4);
    const float w0[8] = {w0a[0], w0a[1], w0a[2], w0a[3], w0b[0], w0b[1], w0b[2], w0b[3]};
    const float w1[8] = {w1a[0], w1a[1], w1a[2], w1a[3], w1b[0], w1b[1], w1b[2], w1b[3]};
    const float w2[8] = {w2a[0], w2a[1], w2a[2], w2a[3], w2b[0], w2b[1], w2b[2], w2b[3]};
#pragma unroll
    for (int j = 0; j < 4; ++j) {
        const float y0 = w0[2 * j] * lo2f(ll[j]) + w1[2 * j] * lo2f(cc[j]) + w2[2 * j] * lo2f(rr[j]);
        const float y1 = w0[2 * j + 1] * hi2f(ll[j]) + w1[2 * j + 1] * hi2f(cc[j]) + w2[2 * j + 1] * hi2f(rr[j]);
        y[2 * j] = silu(y0) * scl; y[2 * j + 1] = silu(y1) * scl;
    }
}

template <int LBASE>
__device__ void mlstm_item_chunked(const Params& p, char* smem0, int tid, int b, int h, int dir) {
    char* smem = smem0 + LBASE;
    bf16_t* Qs = (bf16_t*)smem;
    bf16_t* Ks = Qs + 32 * 136;
    bf16_t* Ktw = Ks + 32 * 136;
    bf16_t* Vt = Ktw + 128 * 40;
    bf16_t* Ps = Vt + 144 * 40;
    bf16_t* Cb = Ps + 32 * 40;
    float* sg = (float*)(Cb + 144 * 136);
    float* sM = sg + 32; float* sinter = sg + 64; float* sfloor = sg + 96; float* sw = sg + 128; float* smisc = sg + 160;
    const int lane = tid & 63, w = __builtin_amdgcn_readfirstlane(tid >> 6), lr = lane & 15, lq = lane >> 4;
    for (int i = tid; i < 16 * 40; i += 256) Vt[128 * 40 + i] = 0x3f80;
    for (int i = tid; i < 144 * 136 / 2; i += 256) ((unsigned*)Cb)[i] = 0u;
    f32x4 CT[2][9];
#pragma unroll
    for (int i = 0; i < 2; ++i)
#pragma unroll
        for (int j = 0; j < 9; ++j) CT[i][j] = (f32x4){0.f, 0.f, 0.f, 0.f};
    float m_s = 0.f;
    u32x4 kr[2], qr[2], vr[2]; float g_ig = 0.f, g_f = 0.f;
#define ML_PREFETCH(BT) do { \
        const int bt_ = (BT); const bool lat_ = bt_ >= 8; const int pos0_ = lat_ ? (bt_ - 8) * 32 : bt_ * 32; \
        const int nlo_ = dir ? (lat_ ? SEQ : CTX) - 32 - pos0_ : pos0_; const int rowbase_ = lat_ ? b * SEQ : TL + b * CTX; \
        const int l_ = tid & 31, c8_ = tid >> 5; const size_t row_ = (size_t)(rowbase_ + (dir ? nlo_ + 31 - l_ : nlo_ + l_)); \
        _Pragma("unroll") for (int r_ = 0; r_ < 2; ++r_) { const int ec_ = c8_ + 8 * r_; \
            kr[r_] = lat_ ? *(const u32x4*)(p.z + row_ * ZS + C_MLK + h * 128 + ec_ * 8) : *(const u32x4*)(p.hbuf + row_ * 1024 + 512 + h * 128 + ec_ * 8); \
            if (lat_) qr[r_] = *(const u32x4*)(p.z + row_ * ZS + C_MLQ + h * 128 + ec_ * 8); \
            vr[r_] = *(const u32x4*)(p.z + row_ * ZS + C_MLV + h * 128 + ec_ * 8); } \
        if (w == 0) { const int lg_ = lane & 31; const float* gp_ = p.zg + (size_t)(rowbase_ + (dir ? nlo_ + 31 - lg_ : nlo_ + lg_)) * 48 + dir * 8 + h; g_ig = gp_[0]; g_f = gp_[4]; } \
    } while (0)
    qr[0] = (u32x4){0u, 0u, 0u, 0u}; qr[1] = qr[0];
    ML_PREFETCH(0);
    __syncthreads();
    for (int bt = 0; bt < 72; ++bt) {
        const bool lat = bt >= 8;
        const int pos0 = lat ? (bt - 8) * 32 : bt * 32;
        const int seg = lat ? SEQ : CTX;
        const int nlo = dir ? seg - 32 - pos0 : pos0;
        const int rowbase = lat ? b * SEQ : TL + b * CTX;
        if (w == 0) {
            const int l = lane & 31;
            const float ig = g_ig, lf = logsig(g_f);
            float bsum = lf;
            bsum += __uint_as_float(__builtin_amdgcn_update_dpp(0u, __float_as_uint(bsum), 0x111, 0xf, 0xf, false));
            bsum += __uint_as_float(__builtin_amdgcn_update_dpp(0u, __float_as_uint(bsum), 0x112, 0xf, 0xf, false));
            bsum += __uint_as_float(__builtin_amdgcn_update_dpp(0u, __float_as_uint(bsum), 0x114, 0xf, 0xf, false));
            bsum += __uint_as_float(__builtin_amdgcn_update_dpp(0u, __float_as_uint(bsum), 0x118, 0xf, 0xf, false));
            { const float r0 = __int_as_float(__builtin_amdgcn_readlane(__float_as_int(bsum), 15)); if (lane & 16) bsum += r0; }
            const float g = ig - bsum;
            float cm = g;
            const unsigned NEGINF = 0xff800000u;
            cm = fmaxf(cm, __uint_as_float(__builtin_amdgcn_update_dpp(NEGINF, __float_as_uint(cm), 0x111, 0xf, 0xf, false)));
            cm = fmaxf(cm, __uint_as_float(__builtin_amdgcn_update_dpp(NEGINF, __float_as_uint(cm), 0x112, 0xf, 0xf, false)));
            cm = fmaxf(cm, __uint_as_float(__builtin_amdgcn_update_dpp(NEGINF, __float_as_uint(cm), 0x114, 0xf, 0xf, false)));
            cm = fmaxf(cm, __uint_as_float(__builtin_amdgcn_update_dpp(NEGINF, __float_as_uint(cm), 0x118, 0xf, 0xf, false)));
            { const float r0 = __int_as_float(__builtin_amdgcn_readlane(__float_as_int(cm), 15)); if (lane & 16) cm = fmaxf(cm, r0); }
            const float M = fmaxf(m_s, cm);
            const float Ml = __int_as_float(__builtin_amdgcn_readlane(__float_as_int(M), 31)), bl = __int_as_float(__builtin_amdgcn_readlane(__float_as_int(bsum), 31));
            if (lane < 32) {
                sg[l] = g; sM[l] = M; sinter[l] = __expf(m_s - M); sfloor[l] = __expf(-(bsum + M)); sw[l] = __expf(g - Ml);
                if (lane == 0) { smisc[0] = __expf(m_s - Ml); smisc[1] = bl + Ml; }
            }
        }
        __syncthreads();
        {
            const int l = tid & 31, c8 = tid >> 5;
            const float wl = sw[l];
#pragma unroll
            for (int r = 0; r < 2; ++r) {
                const int ec = c8 + 8 * r;
                *(u32x4*)(Ks + l * 136 + ec * 8) = kr[r];
#pragma unroll
                for (int j = 0; j < 4; ++j) { Ktw[(ec * 8 + 2 * j) * 40 + l] = f2bf(lo2f(kr[r][j]) * wl); Ktw[(ec * 8 + 2 * j + 1) * 40 + l] = f2bf(hi2f(kr[r][j]) * wl); }
                if (lat) *(u32x4*)(Qs + l * 136 + ec * 8) = qr[r];
#pragma unroll
                for (int j = 0; j < 4; ++j) { Vt[(ec * 8 + 2 * j) * 40 + l] = (bf16_t)(vr[r][j] & 0xffffu); Vt[(ec * 8 + 2 * j + 1) * 40 + l] = (bf16_t)(vr[r][j] >> 16); }
            }
        }
        __syncthreads();
        if (bt + 1 < 72) ML_PREFETCH(bt + 1);
        if (lat) {
            const int mi = w >> 1, ni = w & 1;
            f32x4 sa = (f32x4){0.f, 0.f, 0.f, 0.f};
            if (!(mi == 0 && ni == 1)) {
#pragma unroll
                for (int kk = 0; kk < 4; ++kk) {
                    const bf16x8 af = *(const bf16x8*)(Qs + (mi * 16 + lr) * 136 + kk * 32 + lq * 8);
                    const bf16x8 bf = *(const bf16x8*)(Ks + (ni * 16 + lr) * 136 + kk * 32 + lq * 8);
                    sa = MFMA16(af, bf, sa);
                }
            }
            const int sidx = ni * 16 + lr;
            const float gs = sg[sidx];
#pragma unroll
            for (int r = 0; r < 4; ++r) {
                const int t = mi * 16 + lq * 4 + r;
                const float pv = (sidx <= t) ? sa[r] * __expf(gs - sM[t]) : 0.f;
                Ps[t * 40 + sidx] = f2bf(pv);
            }
        }
        __syncthreads();
        if (lat) {
            const int nts[3] = {2 * w, 2 * w + 1, 8};
            f32x4 acc[2][3];
#pragma unroll
            for (int i = 0; i < 2; ++i)
#pragma unroll
                for (int j = 0; j < 3; ++j) acc[i][j] = (f32x4){0.f, 0.f, 0.f, 0.f};
#pragma unroll 1
            for (int kk = 0; kk < 4; ++kk) {
                bf16x8 af[2], bf[3];
#pragma unroll
                for (int i = 0; i < 2; ++i) af[i] = *(const bf16x8*)(Qs + (i * 16 + lr) * 136 + kk * 32 + lq * 8);
#pragma unroll
                for (int j = 0; j < 3; ++j) bf[j] = *(const bf16x8*)(Cb + (nts[j] * 16 + lr) * 136 + kk * 32 + lq * 8);
#pragma unroll
                for (int i = 0; i < 2; ++i)
#pragma unroll
                    for (int j = 0; j < 3; ++j) acc[i][j] = MFMA16(af[i], bf[j], acc[i][j]);
            }
#pragma unroll
            for (int i = 0; i < 2; ++i)
#pragma unroll
                for (int r = 0; r < 4; ++r) {
                    const float it = sinter[i * 16 + lq * 4 + r];
#pragma unroll
                    for (int j = 0; j < 3; ++j) acc[i][j][r] *= it;
                }
            {
                bf16x8 af[2], bf[3];
#pragma unroll
                for (int i = 0; i < 2; ++i) af[i] = *(const bf16x8*)(Ps + (i * 16 + lr) * 40 + lq * 8);
#pragma unroll
                for (int j = 0; j < 3; ++j) bf[j] = *(const bf16x8*)(Vt + (nts[j] * 16 + lr) * 40 + lq * 8);
#pragma unroll
                for (int i = 0; i < 2; ++i)
#pragma unroll
                    for (int j = 0; j < 3; ++j) acc[i][j] = MFMA16(af[i], bf[j], acc[i][j]);
            }
#pragma unroll
            for (int i = 0; i < 2; ++i)
#pragma unroll
                for (int r = 0; r < 4; ++r) {
                    const int t = i * 16 + lq * 4 + r;
                    const float dn = fmaxf(fabsf(acc[i][2][r]), sfloor[t]);
                    const float inv = 1.f / dn;
                    const int n = dir ? nlo + 31 - t : nlo + t;
                    bf16_t* orow = p.mixh + ((size_t)dir * TL + rowbase + n) * 1024 + h * 128;
#pragma unroll
                    for (int j = 0; j < 2; ++j) orow[nts[j] * 16 + lr] = f2bf(acc[i][j][r] * inv);
                }
        }
        __syncthreads();
        {
            const float a = smisc[0];
            bf16x8 af[2];
#pragma unroll
            for (int i = 0; i < 2; ++i) af[i] = *(const bf16x8*)(Ktw + ((2 * w + i) * 16 + lr) * 40 + lq * 8);
#pragma unroll
            for (int j = 0; j < 9; ++j) {
                const bf16x8 bf = *(const bf16x8*)(Vt + (j * 16 + lr) * 40 + lq * 8);
#pragma unroll
                for (int i = 0; i < 2; ++i) {
                    CT[i][j] = CT[i][j] * a;
                    CT[i][j] = MFMA16(af[i], bf, CT[i][j]);
                    uint2 pk; pk.x = pack2(CT[i][j][0], CT[i][j][1]); pk.y = pack2(CT[i][j][2], CT[i][j][3]);
                    *(uint2*)(Cb + (j * 16 + lr) * 136 + (2 * w + i) * 16 + lq * 4) = pk;
                }
            }
            m_s = smisc[1];
        }
        __syncthreads();
        __syncthreads();
    }
}
#undef ML_PREFETCH

template <int LBASE>
__device__ void gla_item_chunked(const Params& p, char* smem0, int tid, int b, int h, int dir) {
    char* smem = smem0 + LBASE;
    bf16_t* Qd = (bf16_t*)smem;
    bf16_t* Qb = Qd + 32 * 72;
    bf16_t* Kd = Qb + 32 * 72;
    bf16_t* Kwt = Kd + 32 * 72;
    bf16_t* Vt = Kwt + 64 * 40;
    bf16_t* Ps = Vt + 128 * 40;
    bf16_t* Sb = Ps + 32 * 40;
    float* bc = (float*)(Sb + 128 * 72);
    float* w2s = bc + 32 * 64;
    const int lane = tid & 63, w = __builtin_amdgcn_readfirstlane(tid >> 6), lr = lane & 15, lq = lane >> 4;
    for (int i = tid; i < 128 * 72 / 2; i += 256) ((unsigned*)Sb)[i] = 0u;
    for (int i = tid; i < 16 * 64; i += 256) w2s[i] = p.lr_w2[(dir * 16 + (i >> 6)) * 256 + h * 64 + (i & 63)];
    if (tid < 64) w2s[16 * 64 + tid] = p.alpha_b[dir * 256 + h * 64 + tid];
    f32x4 S[8];
#pragma unroll
    for (int j = 0; j < 8; ++j) S[j] = (f32x4){0.f, 0.f, 0.f, 0.f};
    u32x4 kr, qr, vr[2]; f32x4 lrr[4];
#define GLA_PREFETCH(BT) do { \
        const int bt_ = (BT); const bool lat_ = bt_ >= 8; const int pos0_ = lat_ ? (bt_ - 8) * 32 : bt_ * 32; \
        const int nlo_ = dir ? (lat_ ? SEQ : CTX) - 32 - pos0_ : pos0_; const int rowbase_ = lat_ ? b * SEQ : TL + b * CTX; \
        { const int l_ = tid & 31, dc_ = tid >> 5; const size_t row_ = (size_t)(rowbase_ + (dir ? nlo_ + 31 - l_ : nlo_ + l_)); \
          kr = *(const u32x4*)(p.z + row_ * ZS + C_GK + h * 64 + dc_ * 8); \
          if (lat_) qr = *(const u32x4*)(p.z + row_ * ZS + C_GQ + h * 64 + dc_ * 8); \
          vr[0] = *(const u32x4*)(p.z + row_ * ZS + C_GV + h * 128 + dc_ * 8); vr[1] = *(const u32x4*)(p.z + row_ * ZS + C_GV + h * 128 + (dc_ + 8) * 8); } \
        { const int l_ = tid >> 3; const float* lp_ = p.zg + (size_t)(rowbase_ + (dir ? nlo_ + 31 - l_ : nlo_ + l_)) * 48 + 16 + dir * 16; \
          _Pragma("unroll") for (int q_ = 0; q_ < 4; ++q_) lrr[q_] = *(const f32x4*)(lp_ + 4 * q_); } \
    } while (0)
    qr = (u32x4){0u, 0u, 0u, 0u};
    GLA_PREFETCH(0);
    __syncthreads();
    for (int bt = 0; bt < 72; ++bt) {
        const bool lat = bt >= 8;
        const int pos0 = lat ? (bt - 8) * 32 : bt * 32;
        const int seg = lat ? SEQ : CTX;
        const int nlo = dir ? seg - 32 - pos0 : pos0;
        const int rowbase = lat ? b * SEQ : TL + b * CTX;
        {
            const int l = tid >> 3, d0 = (tid & 7) * 8;
            float al[8];
#pragma unroll
            for (int j = 0; j < 8; ++j) al[j] = w2s[16 * 64 + d0 + j];
#pragma unroll
            for (int q = 0; q < 16; ++q) {
                const float lv = lrr[q >> 2][q & 3];
                const f32x4 wa = *(const f32x4*)(w2s + q * 64 + d0), wb = *(const f32x4*)(w2s + q * 64 + d0 + 4);
                al[0] += lv * wa[0]; al[1] += lv * wa[1]; al[2] += lv * wa[2]; al[3] += lv * wa[3];
                al[4] += lv * wb[0]; al[5] += lv * wb[1]; al[6] += lv * wb[2]; al[7] += lv * wb[3];
            }
#pragma unroll
            for (int j = 0; j < 8; ++j) bc[l * 64 + d0 + j] = logsig(al[j]) * (1.f / 16.f);
        }
        __syncthreads();
        if (tid < 64) {
            float cv[32];
#pragma unroll
            for (int l = 0; l < 32; ++l) cv[l] = bc[l * 64 + tid];
#pragma unroll
            for (int l = 1; l < 32; ++l) cv[l] += cv[l - 1];
#pragma unroll
            for (int l = 0; l < 32; ++l) bc[l * 64 + tid] = cv[l];
        }
        __syncthreads();
        {
            const int l = tid & 31, dc = tid >> 5;
            float bl[8], rf[8], be[8];
#pragma unroll
            for (int j = 0; j < 8; ++j) { bl[j] = bc[l * 64 + dc * 8 + j]; rf[j] = bc[16 * 64 + dc * 8 + j]; be[j] = bc[31 * 64 + dc * 8 + j]; }
            {
                float kf[8];
#pragma unroll
                for (int j = 0; j < 4; ++j) { kf[2 * j] = lo2f(kr[j]); kf[2 * j + 1] = hi2f(kr[j]); }
                float kd[8];
#pragma unroll
                for (int j = 0; j < 8; ++j) { kd[j] = kf[j] * __expf(rf[j] - bl[j]); Kwt[(dc * 8 + j) * 40 + l] = f2bf(kf[j] * __expf(be[j] - bl[j])); }
                *(u32x4*)(Kd + l * 72 + dc * 8) = (u32x4){pack2(kd[0], kd[1]), pack2(kd[2], kd[3]), pack2(kd[4], kd[5]), pack2(kd[6], kd[7])};
            }
            if (lat) {
                float qf[8];
#pragma unroll
                for (int j = 0; j < 4; ++j) { qf[2 * j] = lo2f(qr[j]) * 0.125f; qf[2 * j + 1] = hi2f(qr[j]) * 0.125f; }
                float qd[8], qb[8];
#pragma unroll
                for (int j = 0; j < 8; ++j) { qd[j] = qf[j] * __expf(bl[j] - rf[j]); qb[j] = qf[j] * __expf(bl[j]); }
                *(u32x4*)(Qd + l * 72 + dc * 8) = (u32x4){pack2(qd[0], qd[1]), pack2(qd[2], qd[3]), pack2(qd[4], qd[5]), pack2(qd[6], qd[7])};
                *(u32x4*)(Qb + l * 72 + dc * 8) = (u32x4){pack2(qb[0], qb[1]), pack2(qb[2], qb[3]), pack2(qb[4], qb[5]), pack2(qb[6], qb[7])};
            }
#pragma unroll
            for (int r = 0; r < 2; ++r) {
                const int ec = dc + 8 * r;
#pragma unroll
                for (int j = 0; j < 4; ++j) { Vt[(ec * 8 + 2 * j) * 40 + l] = (bf16_t)(vr[r][j] & 0xffffu); Vt[(ec * 8 + 2 * j + 1) * 40 + l] = (bf16_t)(vr[r][j] >> 16); }
            }
        }
        __syncthreads();
        if (bt + 1 < 72) GLA_PREFETCH(bt + 1);
        if (lat) {
            const int mi = w >> 1, ni = w & 1;
            f32x4 sa = (f32x4){0.f, 0.f, 0.f, 0.f};
            if (!(mi == 0 && ni == 1)) {
#pragma unroll
                for (int kk = 0; kk < 2; ++kk) {
                    const bf16x8 af = *(const bf16x8*)(Qd + (mi * 16 + lr) * 72 + kk * 32 + lq * 8);
                    const bf16x8 bf = *(const bf16x8*)(Kd + (ni * 16 + lr) * 72 + kk * 32 + lq * 8);
                    sa = MFMA16(af, bf, sa);
                }
            }
            const int sidx = ni * 16 + lr;
#pragma unroll
            for (int r = 0; r < 4; ++r) {
                const int t = mi * 16 + lq * 4 + r;
                Ps[t * 40 + sidx] = f2bf((sidx <= t) ? sa[r] : 0.f);
            }
        }
        __syncthreads();
        if (lat) {
            f32x4 acc[2][2];
#pragma unroll
            for (int i = 0; i < 2; ++i)
#pragma unroll
                for (int j = 0; j < 2; ++j) acc[i][j] = (f32x4){0.f, 0.f, 0.f, 0.f};
#pragma unroll
            for (int kk = 0; kk < 2; ++kk) {
                bf16x8 af[2], bf[2];
#pragma unroll
                for (int i = 0; i < 2; ++i) af[i] = *(const bf16x8*)(Qb + (i * 16 + lr) * 72 + kk * 32 + lq * 8);
#pragma unroll
                for (int j = 0; j < 2; ++j) bf[j] = *(const bf16x8*)(Sb + ((2 * w + j) * 16 + lr) * 72 + kk * 32 + lq * 8);
#pragma unroll
                for (int i = 0; i < 2; ++i)
#pragma unroll
                    for (int j = 0; j < 2; ++j) acc[i][j] = MFMA16(af[i], bf[j], acc[i][j]);
            }
            {
                bf16x8 af[2], bf[2];
#pragma unroll
                for (int i = 0; i < 2; ++i) af[i] = *(const bf16x8*)(Ps + (i * 16 + lr) * 40 + lq * 8);
#pragma unroll
                for (int j = 0; j < 2; ++j) bf[j] = *(const bf16x8*)(Vt + ((2 * w + j) * 16 + lr) * 40 + lq * 8);
#pragma unroll
                for (int i = 0; i < 2; ++i)
#pragma unroll
                    for (int j = 0; j < 2; ++j) acc[i][j] = MFMA16(af[i], bf[j], acc[i][j]);
            }
#pragma unroll
            for (int i = 0; i < 2; ++i)
#pragma unroll
                for (int r = 0; r < 4; ++r) {
                    const int t = i * 16 + lq * 4 + r;
                    const int n = dir ? nlo + 31 - t : nlo + t;
                    bf16_t* orow = p.mixh + ((size_t)dir * TL + rowbase + n) * 1024 + 512 + h * 128;
#pragma unroll
                    for (int j = 0; j < 2; ++j) orow[(2 * w + j) * 16 + lr] = f2bf(acc[i][j][r]);
                }
        }
        __syncthreads();
        {
            float rs[4];
#pragma unroll
            for (int r = 0; r < 4; ++r) rs[r] = __expf(bc[31 * 64 + w * 16 + lq * 4 + r]);
            const bf16x8 af = *(const bf16x8*)(Kwt + (w * 16 + lr) * 40 + lq * 8);
#pragma unroll
            for (int j = 0; j < 8; ++j) {
                const bf16x8 bf = *(const bf16x8*)(Vt + (j * 16 + lr) * 40 + lq * 8);
#pragma unroll
                for (int r = 0; r < 4; ++r) S[j][r] *= rs[r];
                S[j] = MFMA16(af, bf, S[j]);
                uint2 pk; pk.x = pack2(S[j][0], S[j][1]); pk.y = pack2(S[j][2], S[j][3]);
                *(uint2*)(Sb + (j * 16 + lr) * 72 + w * 16 + lq * 4) = pk;
            }
        }
        __syncthreads();
    }
}
#undef GLA_PREFETCH

__device__ void phase_mlprep(const Params& p, int bid, int nblk) {
    const int tidx_ = opaque_tid();
    const int lane = tidx_ & 63;
    const int gw = bid * (NT / 64) + (tidx_ >> 6), nw = nblk * (NT / 64);
    const int c0 = lane * 16;
    float w0[16], w1[16], w2[16];
#pragma unroll
    for (int j = 0; j < 16; ++j) { w0[j] = p.conv_w[c0 + j]; w1[j] = p.conv_w[1024 + c0 + j]; w2[j] = p.conv_w[2048 + c0 + j]; }
    const float scl = c0 >= 512 ? 0.08838834764831845f : 1.f;
    constexpr int R = 2;
    for (int row0 = TL + gw; row0 < TT; row0 += R * nw) {
        u32x4 cc[R][2], ll[R][2], rr[R][2];
#pragma unroll
        for (int r = 0; r < R; ++r) {
            const int row = min(row0 + r * nw, TT - 1);
            const bool lat = row < TL;
            const int n = lat ? (row & (SEQ - 1)) : ((row - TL) & (CTX - 1));
            const bool vl = lat ? ((n & 63) != 0) : (n != 0);
            const bool vr = lat ? ((n & 63) != 63) : (n != CTX - 1);
            const bf16_t* zc = p.z + (size_t)row * ZS + c0;
#pragma unroll
            for (int q = 0; q < 2; ++q) {
                cc[r][q] = *(const u32x4*)(zc + 8 * q);
                ll[r][q] = vl ? *(const u32x4*)(zc - ZS + 8 * q) : (u32x4){0u, 0u, 0u, 0u};
                rr[r][q] = vr ? *(const u32x4*)(zc + ZS + 8 * q) : (u32x4){0u, 0u, 0u, 0u};
            }
        }
#pragma unroll
        for (int r = 0; r < R; ++r) {
            const int row = row0 + r * nw;
            unsigned o[8];
#pragma unroll
            for (int q = 0; q < 2; ++q)
#pragma unroll
                for (int j = 0; j < 4; ++j) {
                    const int e = q * 8 + 2 * j;
                    const float y0 = w0[e] * lo2f(ll[r][q][j]) + w1[e] * lo2f(cc[r][q][j]) + w2[e] * lo2f(rr[r][q][j]);
                    const float y1 = w0[e + 1] * hi2f(ll[r][q][j]) + w1[e + 1] * hi2f(cc[r][q][j]) + w2[e + 1] * hi2f(rr[r][q][j]);
                    o[q * 4 + j] = pack2(silu(y0) * scl, silu(y1) * scl);
                }
            if (row < TT) {
                u32x4* dst = (u32x4*)(p.hbuf + (size_t)row * 1024 + c0);
                dst[0] = (u32x4){o[0], o[1], o[2], o[3]}; dst[1] = (u32x4){o[4], o[5], o[6], o[7]};
            }
        }
    }
}

__device__ void phase_mixers(const Params& p, char* smem, int bid, int nblk) {
    const int tidx_ = opaque_tid();
    const int sub = __builtin_amdgcn_readfirstlane(tidx_ >> 8), stid = tidx_ & 255;
#if MIX_SAMEKIND
    for (int pr = bid; pr < 256; pr += nblk) {
        const bool isml = pr < 128;
        const int it = ((pr & 127) << 1) + sub;
        const int b = it >> 3, h = (it >> 1) & 3, dir = it & 1;
        if (isml) { if (sub == 0) mlstm_item_chunked<0>(p, smem, stid, b, h, dir); else mlstm_item_chunked<81920>(p, smem, stid, b, h, dir); }
        else { if (sub == 0) gla_item_chunked<0>(p, smem, stid, b, h, dir); else gla_item_chunked<81920>(p, smem, stid, b, h, dir); }
        __syncthreads();
    }
#else
    for (int it = bid; it < 256; it += nblk) {
        const int b = it >> 3, h = (it >> 1) & 3, dir = it & 1;
        if (sub == 0) mlstm_item_chunked<0>(p, smem, stid, b, h, dir);
        else gla_item_chunked<81920>(p, smem, stid, b, h, dir);
        __syncthreads();
    }
#endif
}

__device__ void phase_mixprep(const Params& p, int bid, int nblk) {
    const int tidx_ = opaque_tid();
    const int lane = tidx_ & 63;
    const int gw = bid * (NT / 64) + (tidx_ >> 6), nw = nblk * (NT / 64);
    const int c0 = lane * 16;
    const float* gn = c0 < 512 ? p.ml_norm_g + c0 : p.gla_norm_g + (c0 - 512);
    float gnv[16];
#pragma unroll
    for (int j = 0; j < 16; ++j) gnv[j] = gn[j];
    constexpr int R = 4;
    for (int row0 = gw; row0 < TL; row0 += R * nw) {
        u32x4 u0[R][2], u1[R][2], ug[R][2];
#pragma unroll
        for (int r = 0; r < R; ++r) {
            const int row = min(row0 + r * nw, TL - 1);
            const u32x4* a0 = (const u32x4*)(p.mixh + (size_t)row * 1024 + c0);
            const u32x4* a1 = (const u32x4*)(p.mixh + ((size_t)TL + row) * 1024 + c0);
            const u32x4* gp = (const u32x4*)(p.z + (size_t)row * ZS + (c0 < 512 ? C_MLO + c0 : C_GR + (c0 - 512)));
#pragma unroll
            for (int q = 0; q < 2; ++q) { u0[r][q] = a0[q]; u1[r][q] = a1[q]; ug[r][q] = gp[q]; }
        }
#pragma unroll
        for (int r = 0; r < R; ++r) {
            const int row = row0 + r * nw;
            float sv[16], gt[16];
#pragma unroll
            for (int q = 0; q < 2; ++q)
#pragma unroll
                for (int j = 0; j < 4; ++j) {
                    sv[q * 8 + 2 * j] = lo2f(u0[r][q][j]) + lo2f(u1[r][q][j]); sv[q * 8 + 2 * j + 1] = hi2f(u0[r][q][j]) + hi2f(u1[r][q][j]);
                    gt[q * 8 + 2 * j] = lo2f(ug[r][q][j]); gt[q * 8 + 2 * j + 1] = hi2f(ug[r][q][j]);
                }
            float ss = 0.f;
#pragma unroll
            for (int j = 0; j < 16; ++j) ss += sv[j] * sv[j];
            ss += dppx<0xB1>(ss); ss += dppx<0x4E>(ss); ss += dppx<0x141>(ss);
            const float rstd = rsqrtf(ss * (1.f / 128.f) + EPS);
            unsigned o[8];
#pragma unroll
            for (int j = 0; j < 8; ++j) {
                float y0, y1;
                const float g0 = gt[2 * j], g1 = gt[2 * j + 1];
                if (c0 < 512) { y0 = sigm(g0); y1 = sigm(g1); } else { y0 = silu(g0); y1 = silu(g1); }
                y0 *= sv[2 * j] * rstd * gnv[2 * j]; y1 *= sv[2 * j + 1] * rstd * gnv[2 * j + 1];
                o[j] = pack2(y0, y1);
            }
            if (row < TL) {
                u32x4* dst = (u32x4*)(p.hbuf + (size_t)row * D + c0);
                dst[0] = (u32x4){o[0], o[1], o[2], o[3]}; dst[1] = (u32x4){o[4], o[5], o[6], o[7]};
            }
        }
    }
}

__device__ void phase_norm2(const Params& p, int bid, int nblk) {
    const int tidx_ = opaque_tid();
    const int lane = tidx_ & 63, gw = bid * (NT / 64) + (tidx_ >> 6), nw = nblk * (NT / 64);
    for (int sp = gw; sp < TL / 32; sp += nw)
        norm_span<4, true>(p.x + (size_t)sp * 32 * D, p.ybuf + (size_t)sp * 32 * D, p.norm2_g, p.mod + (sp >> 6) * 6144, 4096, 3072, p.hbuf + (size_t)sp * 32 * D, 32, lane);
}

__device__ __forceinline__ unsigned fkey(float f) { const unsigned u = __float_as_uint(f); return (u & 0x80000000u) ? ~u : (u | 0x80000000u); }
__device__ __forceinline__ int mbcnt64(unsigned long long m) { return __builtin_amdgcn_mbcnt_hi((unsigned)(m >> 32), __builtin_amdgcn_mbcnt_lo((unsigned)m, 0)); }
#define LDS_FENCE() asm volatile("s_waitcnt lgkmcnt(0)" ::: "memory")

template <int NV>
__device__ __forceinline__ void wave_top16(const float (&val)[NV], const int (&tag)[NV], float* outv, int* outt) {
    unsigned u[NV];
#pragma unroll
    for (int v = 0; v < NV; ++v) u[v] = fkey(val[v]);
    unsigned T = 0;
    for (int bit = 31; bit >= 0; --bit) {
        const unsigned cand = T | (1u << bit);
        int cnt = 0;
#pragma unroll
        for (int v = 0; v < NV; ++v) cnt += __popcll(__ballot(u[v] >= cand));
        if (cnt >= 16) T = cand;
    }
    int base = 0;
#pragma unroll
    for (int v = 0; v < NV; ++v) {
        const bool gt = u[v] > T;
        const unsigned long long mk = __ballot(gt);
        const int pos = base + mbcnt64(mk);
        if (gt) { outv[pos] = val[v]; outt[pos] = tag[v]; }
        base += __popcll(mk);
    }
#pragma unroll
    for (int v = 0; v < NV; ++v) {
        const bool eq = u[v] == T;
        const unsigned long long mk = __ballot(eq);
        const int pos = base + mbcnt64(mk);
        if (eq && pos < 16) { outv[pos] = val[v]; outt[pos] = tag[v]; }
        base += __popcll(mk);
    }
}

template <int NV>
__device__ __forceinline__ void wave_top16_bisect(const float (&val)[NV], const int (&tag)[NV], float* outv, int* outt) {
    float mx = val[0], mn = val[0];
#pragma unroll
    for (int v = 1; v < NV; ++v) { mx = fmaxf(mx, val[v]); mn = fminf(mn, val[v]); }
    float hi = wave_max_fast(mx), lo = -wave_max_fast(-mn);
    float mid = 0.f; bool ok = false;
    for (int it = 0; it < 40; ++it) {
        mid = 0.5f * (lo + hi);
        int cnt = 0;
#pragma unroll
        for (int v = 0; v < NV; ++v) cnt += __popcll(__ballot(val[v] > mid));
        if (cnt == 16) { ok = true; break; }
        if (cnt > 16) lo = mid; else hi = mid;
    }
    if (!ok) { wave_top16<NV>(val, tag, outv, outt); return; }
    int base = 0;
#pragma unroll
    for (int v = 0; v < NV; ++v) {
        const bool gt = val[v] > mid;
        const unsigned long long mk = __ballot(gt);
        const int pos = base + mbcnt64(mk);
        if (gt) { outv[pos] = val[v]; outt[pos] = tag[v]; }
        base += __popcll(mk);
    }
}

template <int CTRL> __device__ __forceinline__ unsigned dppu(unsigned x) { return __builtin_amdgcn_update_dpp(0u, x, CTRL, 0xf, 0xf, false); }
__device__ __forceinline__ unsigned row_max16u(unsigned x) { x = max(x, dppu<0x128>(x)); x = max(x, dppu<0x124>(x)); x = max(x, dppu<0x4E>(x)); return max(x, dppu<0xB1>(x)); }
__device__ __forceinline__ float row_max16(float x) { x = fmaxf(x, dppx<0x128>(x)); x = fmaxf(x, dppx<0x124>(x)); x = fmaxf(x, dppx<0x4E>(x)); return fmaxf(x, dppx<0xB1>(x)); }
__device__ __forceinline__ float row_sum16(float x) { x += dppx<0x128>(x); x += dppx<0x124>(x); x += dppx<0x4E>(x); return x + dppx<0xB1>(x); }
__device__ __forceinline__ unsigned key_of(float v, unsigned tag) { const unsigned b = (__float_as_uint(v) & 0xffffff00u) | tag; return (b & 0x80000000u) ? ~b : (b | 0x80000000u); }
__device__ __forceinline__ unsigned bits_of_key(unsigned k) { return (k & 0x80000000u) ? (k & 0x7fffffffu) : ~k; }
#define CE_DESC(i, j) do { const unsigned hi_ = max(u[i], u[j]), lo_ = min(u[i], u[j]); u[i] = hi_; u[j] = lo_; } while (0)
template <int N>
__device__ __forceinline__ unsigned tournament16(unsigned (&u)[N], int lr) {
    unsigned res = 0u;
#pragma unroll
    for (int k = 0; k < 16; ++k) {
        const unsigned m = row_max16u(u[0]);
        const bool wn = (u[0] == m);
        res = (lr == k) ? m : res;
#pragma unroll
        for (int i = 0; i < N - 1; ++i) u[i] = wn ? u[i + 1] : u[i];
        u[N - 1] = wn ? 0u : u[N - 1];
    }
    return res;
}

template <int N>
__device__ __forceinline__ void tournament16x2(unsigned (&ua)[N], unsigned (&ub)[N], int lr, unsigned& ra, unsigned& rb) {
    ra = 0u; rb = 0u;
#pragma unroll
    for (int k = 0; k < 16; ++k) {
        const unsigned ma = row_max16u(ua[0]), mb = row_max16u(ub[0]);
        const bool wa = (ua[0] == ma), wb = (ub[0] == mb);
        ra = (lr == k) ? ma : ra; rb = (lr == k) ? mb : rb;
#pragma unroll
        for (int i = 0; i < N - 1; ++i) { ua[i] = wa ? ua[i + 1] : ua[i]; ub[i] = wb ? ub[i + 1] : ub[i]; }
        ua[N - 1] = wa ? 0u : ua[N - 1]; ub[N - 1] = wb ? 0u : ub[N - 1];
    }
}
#define SORT8_DESC() do { CE_DESC(0, 1); CE_DESC(2, 3); CE_DESC(4, 5); CE_DESC(6, 7); CE_DESC(0, 2); CE_DESC(1, 3); CE_DESC(4, 6); CE_DESC(5, 7); CE_DESC(1, 2); CE_DESC(5, 6); \
        CE_DESC(0, 4); CE_DESC(1, 5); CE_DESC(2, 6); CE_DESC(3, 7); CE_DESC(2, 4); CE_DESC(3, 5); CE_DESC(1, 2); CE_DESC(3, 4); CE_DESC(5, 6); } while (0)

__device__ void phase_topk(const Params& p, char* smem, int bid, int nblk) {
    const int tidx_ = opaque_tid();
    const int tid = tidx_, lane = tid & 63, w = __builtin_amdgcn_readfirstlane(tid >> 6), lr = lane & 15, lq = lane >> 4;
    constexpr int SS = 260;
    constexpr int WS = 16 * SS + 512;
    float* sc = (float*)smem + w * WS;
    float* tv = sc + 16 * SS + lq * 64;
    int* ti = (int*)(tv + 32);
    for (int item = bid; item < (TL / (NT / 4)) * 8; item += nblk) {
        const int ph = item & 7, t0 = (item >> 3) * (NT / 4) + w * 16;
#pragma unroll
        for (int hh = 0; hh < 2; ++hh) {
            bf16x8 af[4];
#pragma unroll
            for (int kk = 0; kk < 4; ++kk) af[kk] = *(const bf16x8*)(p.qbuf + (size_t)(t0 + lr) * 2048 + ph * 256 + hh * 128 + kk * 32 + lq * 8);
            const bf16_t* kb = p.keysb + (size_t)((ph * 2 + hh) * 128 + lr) * 128 + lq * 8;
            f32x4 acc[8];
            bf16x8 b0[4], b1[4];
#pragma unroll
            for (int kk = 0; kk < 4; ++kk) b0[kk] = *(const bf16x8*)(kb + kk * 32);
#pragma unroll
            for (int n = 0; n < 8; n += 2) {
#pragma unroll
                for (int kk = 0; kk < 4; ++kk) b1[kk] = *(const bf16x8*)(kb + (n + 1) * 16 * 128 + kk * 32);
                acc[n] = (f32x4){0.f, 0.f, 0.f, 0.f};
#pragma unroll
                for (int kk = 0; kk < 4; ++kk) acc[n] = MFMA16(af[kk], b0[kk], acc[n]);
                if (n + 2 < 8) {
#pragma unroll
                    for (int kk = 0; kk < 4; ++kk) b0[kk] = *(const bf16x8*)(kb + (n + 2) * 16 * 128 + kk * 32);
                }
                acc[n + 1] = (f32x4){0.f, 0.f, 0.f, 0.f};
#pragma unroll
                for (int kk = 0; kk < 4; ++kk) acc[n + 1] = MFMA16(af[kk], b1[kk], acc[n + 1]);
            }
#pragma unroll
            for (int n = 0; n < 8; ++n)
#pragma unroll
                for (int r = 0; r < 4; ++r) sc[(lq * 4 + r) * SS + hh * 128 + n * 16 + lr] = acc[n][r];
        }
        LDS_FENCE();
        for (int ps2 = 0; ps2 < 2; ++ps2) {
            float a0[2];
#pragma unroll
            for (int pp = 0; pp < 2; ++pp) {
                const int tt = (ps2 * 2 + pp) * 4 + lq;
                float* tvp = tv + pp * 256; int* tip = ti + pp * 256;
                unsigned ua[8], ub[8];
#pragma unroll
                for (int j = 0; j < 8; ++j) { ua[j] = key_of(sc[tt * SS + lr + 16 * j], 255u - (unsigned)(lr + 16 * j)); ub[j] = key_of(sc[tt * SS + 128 + lr + 16 * j], 255u - (unsigned)(lr + 16 * j)); }
                { unsigned (&u)[8] = ua; SORT8_DESC(); }
                { unsigned (&u)[8] = ub; SORT8_DESC(); }
                unsigned ra, rb;
                tournament16x2<8>(ua, ub, lr, ra, rb);
                const unsigned ba = bits_of_key(ra), bb = bits_of_key(rb);
                a0[pp] = __uint_as_float(ba);
                tvp[lr] = __uint_as_float(ba); tip[lr] = 255 - (int)(ba & 0xffu);
                tvp[16 + lr] = __uint_as_float(bb); tip[16 + lr] = 255 - (int)(bb & 0xffu);
            }
            LDS_FENCE();
            unsigned ca[16], cb2[16];
#pragma unroll
            for (int pp = 0; pp < 2; ++pp) {
                const float* tvp = tv + pp * 256;
                const f32x4 b0 = *(const f32x4*)(tvp + 16), b1 = *(const f32x4*)(tvp + 20), b2 = *(const f32x4*)(tvp + 24), b3 = *(const f32x4*)(tvp + 28);
                const float bj[16] = {b0[0], b0[1], b0[2], b0[3], b1[0], b1[1], b1[2], b1[3], b2[0], b2[1], b2[2], b2[3], b3[0], b3[1], b3[2], b3[3]};
#pragma unroll
                for (int j = 0; j < 16; ++j) { const unsigned kx = key_of(a0[pp] + bj[j], 255u - (unsigned)(lr * 16 + j)); if (pp == 0) ca[j] = kx; else cb2[j] = kx; }
            }
            unsigned rca, rcb;
            tournament16x2<16>(ca, cb2, lr, rca, rcb);
#pragma unroll
            for (int pp = 0; pp < 2; ++pp) {
                const int t = t0 + (ps2 * 2 + pp) * 4 + lq;
                const int* tip = ti + pp * 256;
                const unsigned cb = bits_of_key(pp == 0 ? rca : rcb);
                const float sv = __uint_as_float(cb);
                const int tag = 255 - (int)(cb & 0xffu);
                const int idx = tip[tag >> 4] * 128 + tip[16 + (tag & 15)];
                const float mx = row_max16(sv);
                const float ev = __expf(sv - mx);
                const float sm = row_sum16(ev);
                p.pidx[(size_t)t * 128 + ph * 16 + lr] = idx;
                p.pgw[(size_t)t * 128 + ph * 16 + lr] = ev / sm;
            }
            LDS_FENCE();
        }
    }
    __syncthreads();
}

typedef float f32x2 __attribute__((ext_vector_type(2)));
template <int CTRL> __device__ __forceinline__ float dppf(float x) {
    return __uint_as_float(__builtin_amdgcn_update_dpp(0u, __float_as_uint(x), CTRL, 0xf, 0xf, false));
}
__device__ __forceinline__ float red4(float a, float b, float c, float d) {
    auto r = __builtin_amdgcn_permlane32_swap(__float_as_uint(a), __float_as_uint(b), false, false);
    const float ab = __uint_as_float(r[0]) + __uint_as_float(r[1]);
    auto q = __builtin_amdgcn_permlane32_swap(__float_as_uint(c), __float_as_uint(d), false, false);
    const float cd = __uint_as_float(q[0]) + __uint_as_float(q[1]);
    auto s = __builtin_amdgcn_permlane16_swap(__float_as_uint(ab), __float_as_uint(cd), false, false);
    float x = __uint_as_float(s[0]) + __uint_as_float(s[1]);
    x += dppf<0x128>(x); x += dppf<0x124>(x); x += dppf<0x4E>(x); x += dppf<0xB1>(x);
    return x;
}
typedef unsigned u32x3 __attribute__((ext_vector_type(3)));
typedef unsigned u32x6 __attribute__((ext_vector_type(6)));
typedef float f32x32 __attribute__((ext_vector_type(32)));
#ifndef GP
#define GP 4
#endif
struct GB { unsigned a[GP], b[GP], c[GP]; };
__device__ __forceinline__ f32x32 dec32(unsigned a0, unsigned a1, unsigned a2, unsigned b0, unsigned b1, unsigned b2) {
    const u32x6 sv = (u32x6){a0, a1, a2, b0, b1, b2};
    return __builtin_amdgcn_cvt_scalef32_pk32_f32_fp6(sv, 1.0f);
}
__device__ __forceinline__ void gloadN(GB& buf, const __amdgpu_buffer_rsrc_t tab, int idxreg, int j0, int lane) {
#pragma unroll
    for (int jj = 0; jj < GP; ++jj) {
        const int e = __builtin_amdgcn_readlane(idxreg, j0 + jj);
        const u32x3 t3 = __builtin_amdgcn_raw_buffer_load_b96(tab, lane * 12, e * 768, 0);
        buf.a[jj] = t3[0]; buf.b[jj] = t3[1]; buf.c[jj] = t3[2];
    }
}
__device__ __forceinline__ float gdotsN(const GB& buf, const float (&hv)[16], float d, int j0, int lane) {
    int di = __float_as_int(d);
    f32x2 hv2[8];
#pragma unroll
    for (int k = 0; k < 8; ++k) hv2[k] = (f32x2){hv[2 * k], hv[2 * k + 1]};
    float chain0 = 0.f, chain1 = 0.f;
#pragma unroll
    for (int q = 0; q < GP / 4; ++q) {
        float pt[4];
#pragma unroll
        for (int h2 = 0; h2 < 2; ++h2) {
            const int jj = 4 * q + 2 * h2;
            unsigned w0 = buf.a[jj];
            asm volatile("" : "+v"(w0) : "v"(h2 ? chain1 : chain0));
            const f32x32 f = dec32(w0, buf.b[jj], buf.c[jj], buf.a[jj + 1], buf.b[jj + 1], buf.c[jj + 1]);
            f32x2 a0 = (f32x2){0.f, 0.f}, a1 = a0, c0 = a0, c1 = a0;
#pragma unroll
            for (int k = 0; k < 8; k += 2) {
                a0 += (f32x2){f[2 * k], f[2 * k + 1]} * hv2[k];           a1 += (f32x2){f[2 * k + 2], f[2 * k + 3]} * hv2[k + 1];
                c0 += (f32x2){f[16 + 2 * k], f[16 + 2 * k + 1]} * hv2[k]; c1 += (f32x2){f[16 + 2 * k + 2], f[16 + 2 * k + 3]} * hv2[k + 1];
            }
            const f32x2 as = a0 + a1, cs = c0 + c1;
            pt[2 * h2] = as[0] + as[1]; pt[2 * h2 + 1] = cs[0] + cs[1];
            if (h2) chain1 = pt[2 * h2 + 1]; else chain0 = pt[2 * h2 + 1];
        }
        const float x0 = red4(pt[0], pt[1], pt[2], pt[3]);
        {
            const int r0 = __builtin_amdgcn_readlane(__float_as_int(x0), 0), r1 = __builtin_amdgcn_readlane(__float_as_int(x0), 32);
            const int r2 = __builtin_amdgcn_readlane(__float_as_int(x0), 16), r3 = __builtin_amdgcn_readlane(__float_as_int(x0), 48);
            const int rel = lane - (j0 + 4 * q);
            int v = (rel == 0) ? r0 : di; v = (rel == 1) ? r1 : v; v = (rel == 2) ? r2 : v; di = (rel == 3) ? r3 : v;
        }
    }
    return __int_as_float(di);
}
__device__ __forceinline__ void gaxpyN(const GB& buf, float coef, f32x2 (&acc)[8], int j0) {
    float mk0 = 0.f, mk1 = 0.f;
#pragma unroll
    for (int jj = 0; jj < GP; jj += 2) {
        const float c0 = __int_as_float(__builtin_amdgcn_readlane(__float_as_int(coef), j0 + jj));
        const float c1 = __int_as_float(__builtin_amdgcn_readlane(__float_as_int(coef), j0 + jj + 1));
        unsigned w0 = buf.a[jj];
        asm volatile("" : "+v"(w0) : "v"((jj & 2) ? mk1 : mk0));
        const f32x32 f = dec32(w0, buf.b[jj], buf.c[jj], buf.a[jj + 1], buf.b[jj + 1], buf.c[jj + 1]);
        const f32x2 c02 = (f32x2){c0, c0}, c12 = (f32x2){c1, c1};
#pragma unroll
        for (int k = 0; k < 8; ++k) acc[k] += c02 * (f32x2){f[2 * k], f[2 * k + 1]} + c12 * (f32x2){f[16 + 2 * k], f[16 + 2 * k + 1]};
        if (jj & 2) mk1 = acc[7][1]; else mk0 = acc[7][1];
    }
}
__device__ __forceinline__ float gather_dots(const __amdgpu_buffer_rsrc_t tab, int idxreg, const float (&hv)[16], int lane) {
    float d = 0.f;
    GB bufA, bufB;
    constexpr int NG = 64 / GP;
    gloadN(bufA, tab, idxreg, 0, lane);
#pragma unroll 1
    for (int g = 0; g < NG; g += 2) {
        gloadN(bufB, tab, idxreg, (g + 1) * GP, lane);
        d = gdotsN(bufA, hv, d, g * GP, lane);
        gloadN(bufA, tab, idxreg, ((g + 2) & (NG - 1)) * GP, lane);
        d = gdotsN(bufB, hv, d, (g + 1) * GP, lane);
    }
    return d;
}
__device__ __forceinline__ void gather_axpy(const __amdgpu_buffer_rsrc_t tab, int idxreg, float coef, f32x2 (&acc)[8], int lane) {
    GB bufA, bufB;
    constexpr int NG = 64 / GP;
    gloadN(bufA, tab, idxreg, 0, lane);
#pragma unroll 1
    for (int g = 0; g < NG; g += 2) {
        gloadN(bufB, tab, idxreg, (g + 1) * GP, lane);
        gaxpyN(bufA, coef, acc, g * GP);
        gloadN(bufA, tab, idxreg, ((g + 2) & (NG - 1)) * GP, lane);
        gaxpyN(bufB, coef, acc, (g + 1) * GP);
    }
}
__device__ __forceinline__ float gelu_exact(float x) { return 0.5f * x * (1.f + erff(x * 0.7071067811865476f)); }

__device__ void phase_gather(const Params& p, int bid, int nblk) {
    const int tidx_ = opaque_tid();
    const int lane = tidx_ & 63;
    const int gw = bid * (NT / 64) + (tidx_ >> 6), nw = nblk * (NT / 64);
    const __amdgpu_buffer_rsrc_t ursrc = __builtin_amdgcn_make_buffer_rsrc((void*)p.u8, (short)0, 16384 * 768, 0x00020000);
    const __amdgpu_buffer_rsrc_t vrsrc = __builtin_amdgcn_make_buffer_rsrc((void*)p.v8, (short)0, 16384 * 768, 0x00020000);
    for (int t = gw; t < TL; t += nw) {
        float hv[16];
        {
            const u32x4 h0 = *(const u32x4*)(p.hbuf + (size_t)t * D + lane * 16), h1 = *(const u32x4*)(p.hbuf + (size_t)t * D + lane * 16 + 8);
#pragma unroll
            for (int q = 0; q < 4; ++q) { hv[2 * q] = lo2f(h0[q]); hv[2 * q + 1] = hi2f(h0[q]); hv[8 + 2 * q] = lo2f(h1[q]); hv[8 + 2 * q + 1] = hi2f(h1[q]); }
        }
        const int ia = p.pidx[(size_t)t * 128 + lane], ib = p.pidx[(size_t)t * 128 + 64 + lane];
        const float ga = p.pgw[(size_t)t * 128 + lane], gb = p.pgw[(size_t)t * 128 + 64 + lane];
        const float usA = p.usc[ia], usB = p.usc[ib], vsA = p.vsc[ia], vsB = p.vsc[ib];
        const float dA = gather_dots(ursrc, ia, hv, lane);
        const float dB = gather_dots(ursrc, ib, hv, lane);
        const float cA = gelu_exact(dA * usA) * ga * vsA, cB = gelu_exact(dB * usB) * gb * vsB;
        f32x2 acc2[8];
#pragma unroll
        for (int j = 0; j < 8; ++j) acc2[j] = (f32x2){0.f, 0.f};
        gather_axpy(vrsrc, ia, cA, acc2, lane);
        gather_axpy(vrsrc, ib, cB, acc2, lane);
        float acc[16];
#pragma unroll
        for (int j = 0; j < 8; ++j) { acc[2 * j] = acc2[j][0]; acc[2 * j + 1] = acc2[j][1]; }
        float* orow = p.out + (size_t)t * D + lane * 16;
        const float* xrow = p.x + (size_t)t * D + lane * 16;
        const float* g1 = p.mod + (t >> 11) * 6144 + 2048 + lane * 16;
        const float* g2 = g1 + 3072;
        float yo[16];
        {
            const u32x4 y0 = *(const u32x4*)(p.ybuf + (size_t)t * D + lane * 16), y1 = *(const u32x4*)(p.ybuf + (size_t)t * D + lane * 16 + 8);
#pragma unroll
            for (int q = 0; q < 4; ++q) { yo[2 * q] = lo2f(y0[q]); yo[2 * q + 1] = hi2f(y0[q]); yo[8 + 2 * q] = lo2f(y1[q]); yo[8 + 2 * q + 1] = hi2f(y1[q]); }
        }
        float y[16]; float ss = 0.f;
#pragma unroll
        for (int q = 0; q < 4; ++q) {
            const f32x4 xv = *(const f32x4*)(xrow + 4 * q), gv = *(const f32x4*)(g2 + 4 * q), g1v = *(const f32x4*)(g1 + 4 * q);
#pragma unroll
            for (int k = 0; k < 4; ++k) { y[4 * q + k] = xv[k] + g1v[k] * yo[4 * q + k] + gv[k] * acc[4 * q + k]; ss += y[4 * q + k] * y[4 * q + k]; }
        }
        ss = wave_sum(ss);
        const float rstd = rsqrtf(ss * (1.f / 1024.f) + EPS);
#pragma unroll
        for (int q = 0; q < 4; ++q) {
            const f32x4 gf = *(const f32x4*)(p.norm_f_g + lane * 16 + 4 * q);
            *(f32x4*)(orow + 4 * q) = (f32x4){y[4 * q] * rstd * gf[0], y[4 * q + 1] * rstd * gf[1], y[4 * q + 2] * rstd * gf[2], y[4 * q + 3] * rstd * gf[3]};
        }
    }
}

extern __shared__ __attribute__((aligned(16))) char dyn_smem[];

__device__ __forceinline__ void run_phase(const Params& p, int ph, char* smem, int bid, int nblk) {
#ifdef ONLY_PHASE
    if (ph != ONLY_PHASE) return;
#endif
    switch (ph) {
        case 0: phase_mod(p, smem, bid, nblk); phase_convert(p, smem, bid, nblk); break;
        case 1: phase_norm1(p, bid, nblk); break;
        case 2: { EpiZ e{p.z, p.zg, p.gate_b, p.conv_w}; gemm_run(p.hbuf, p.winT, TT, PTP, 1024, e, smem, bid, nblk); } break;
        case 3: phase_mlprep(p, bid, nblk); break;
        case 4: phase_mixers(p, smem, bid, nblk); break;
        case 5: phase_mixprep(p, bid, nblk); break;
        case 6: { EpiY e{p.ybuf}; gemm_run(p.hbuf, p.woutT, TL, 1024, 1024, e, smem, bid, nblk); } break;
        case 7: phase_norm2(p, bid, nblk); break;
        case 8: { EpiQb e{p.qbuf}; gemm_run(p.hbuf, p.wqT, TL, 2048, 1024, e, smem, bid, nblk); } break;
        case 9: phase_topk(p, smem, bid, nblk); break;
        case 10: phase_gather(p, bid, nblk); break;
    }
}
#ifndef PHASE_MASK
#define PHASE_MASK 0x7ff
#endif
constexpr int NPHASE = 11;

__device__ __forceinline__ void grid_barrier(unsigned* counter, unsigned target) {
    __syncthreads();
    if (threadIdx.x == 0) {
        __builtin_amdgcn_fence(__ATOMIC_RELEASE, "agent");
        asm volatile("s_waitcnt vmcnt(0)" ::: "memory");
        __hip_atomic_fetch_add(counter, 1u, __ATOMIC_RELAXED, __HIP_MEMORY_SCOPE_AGENT);
        while (__hip_atomic_load(counter, __ATOMIC_RELAXED, __HIP_MEMORY_SCOPE_AGENT) < target) __builtin_amdgcn_s_sleep(2);
        __builtin_amdgcn_fence(__ATOMIC_ACQUIRE, "agent");
        asm volatile("s_waitcnt vmcnt(0)" ::: "memory");
    }
    __syncthreads();
}
#if FUSED
#ifndef PROBE_REPEAT_PHASE
#define PROBE_REPEAT_PHASE (-1)
#endif
__global__ void __launch_bounds__(NT, 2) mega_kernel(Params p) {
    cg::grid_group grid = cg::this_grid();
    unsigned nbar = 0;
#define RUN_PHASE(PH) do { int nrep_ = (PROBE_REPEAT_PHASE == (PH)) ? 2 : 1; asm volatile("" : "+s"(nrep_)); \
        for (int r_ = 0; r_ < nrep_; ++r_) { run_phase(p, (PH), dyn_smem, blockIdx.x, gridDim.x); \
            if ((PH) == 0 && r_ == 0) grid.sync();   \
            else if ((PH) + 1 < NPHASE || r_ + 1 < nrep_) { ++nbar; grid_barrier(p.bar, nbar * gridDim.x); } } } while (0)
    RUN_PHASE(0); RUN_PHASE(1); RUN_PHASE(2); RUN_PHASE(3); RUN_PHASE(4); RUN_PHASE(5); RUN_PHASE(6); RUN_PHASE(7); RUN_PHASE(8); RUN_PHASE(9); RUN_PHASE(10);
#undef RUN_PHASE
}
#else
template <int PH>
__global__ void __launch_bounds__(NT, 2) phase_kernel(Params p) { run_phase(p, PH, dyn_smem, blockIdx.x, gridDim.x); }
#endif

static inline char* carve(char*& cur, size_t bytes) { char* r = cur; cur += (bytes + 255) & ~(size_t)255; return r; }

extern "C" void kernel_launch(void* const* d_in, const int* in_sizes, int n_in, void* d_out, int out_size, void* d_ws, size_t ws_size, hipStream_t stream) {
    Params p{};
    p.x = (const float*)d_in[0]; p.c = (const float*)d_in[1]; p.ctx = (const float*)d_in[2]; p.c_ctx = (const float*)d_in[3];
    p.w_mod = (const float*)d_in[4]; p.b_mod = (const float*)d_in[5]; p.norm1_g = (const float*)d_in[6]; p.w_in = (const float*)d_in[7];
    p.conv_w = (const float*)d_in[8]; p.gate_b = (const float*)d_in[9]; p.ml_norm_g = (const float*)d_in[10]; p.lr_w2 = (const float*)d_in[11];
    p.alpha_b = (const float*)d_in[12]; p.gla_norm_g = (const float*)d_in[13]; p.w_out = (const float*)d_in[14]; p.norm2_g = (const float*)d_in[15];
    p.wq = (const float*)d_in[16]; p.keys = (const float*)d_in[17]; p.pu = (const float*)d_in[18]; p.pv = (const float*)d_in[19]; p.norm_f_g = (const float*)d_in[20];
    p.out = (float*)d_out;
    char* cur = (char*)d_ws;
    p.mod = (float*)carve(cur, (size_t)33 * 6144 * 4);
    p.winT = (bf16_t*)carve(cur, (size_t)PTP * 1024 * 2);
    p.woutT = (bf16_t*)carve(cur, (size_t)1024 * 1024 * 2);
    p.wqT = (bf16_t*)carve(cur, (size_t)2048 * 1024 * 2);
    p.keysb = (bf16_t*)carve(cur, (size_t)8 * 2 * 128 * 128 * 2);
    p.u8 = (unsigned char*)carve(cur, (size_t)16384 * 768);
    p.v8 = (unsigned char*)carve(cur, (size_t)16384 * 768);
    p.usc = (float*)carve(cur, (size_t)16384 * 4);
    p.vsc = (float*)carve(cur, (size_t)16384 * 4);
    p.hbuf = (bf16_t*)carve(cur, (size_t)TT * 1024 * 2);
    p.z = (bf16_t*)carve(cur, (size_t)TT * ZS * 2);
    p.zg = (float*)carve(cur, (size_t)TT * 48 * 4);
    p.mixh = (bf16_t*)carve(cur, (size_t)2 * TL * 1024 * 2);
    p.bar = (unsigned*)carve(cur, 256);
    p.qbuf = p.z;
    p.pidx = (int*)p.mixh;
    p.pgw = (float*)((char*)p.mixh + (size_t)TL * 128 * 4);
    p.ybuf = p.mixh + (size_t)TL * 1024;
    if ((size_t)(cur - (char*)d_ws) > ws_size) { fprintf(stderr, "workspace too small: need %zu have %zu\n", (size_t)(cur - (char*)d_ws), ws_size); return; }
#if FUSED
    static int grid_blocks = 0;
    if (!grid_blocks) {
        int dev = 0, cus = 0, per_cu = 0;
        hipGetDevice(&dev);
        hipDeviceGetAttribute(&cus, hipDeviceAttributeMultiprocessorCount, dev);
        hipFuncSetAttribute((const void*)mega_kernel, hipFuncAttributeMaxDynamicSharedMemorySize, SMEM_BYTES);
        hipOccupancyMaxActiveBlocksPerMultiprocessor(&per_cu, mega_kernel, NT, SMEM_BYTES);
        if (per_cu > 1) per_cu = 1;
        grid_blocks = cus * per_cu;
    }
    hipMemsetAsync(p.bar, 0, 256, stream);
    void* args[] = {&p};
    hipError_t e = hipLaunchCooperativeKernel((void*)mega_kernel, dim3(grid_blocks), dim3(NT), args, SMEM_BYTES, stream);
    if (e != hipSuccess) fprintf(stderr, "cooperative launch failed: %s (grid %d)\n", hipGetErrorString(e), grid_blocks);
#else
    const int G = 512;
#define LAUNCH(PH) do { hipFuncSetAttribute((const void*)phase_kernel<PH>, hipFuncAttributeMaxDynamicSharedMemorySize, SMEM_BYTES); \
        hipLaunchKernelGGL(phase_kernel<PH>, dim3(G), dim3(NT), SMEM_BYTES, stream, p); } while (0)
    LAUNCH(0); LAUNCH(1); LAUNCH(2); LAUNCH(3); LAUNCH(4); LAUNCH(5); LAUNCH(6); LAUNCH(7); LAUNCH(8); LAUNCH(9);
#endif
}
```
